# Optimizing an MI355X kernel written in HIP

```python
import math
import jax, jax.numpy as jnp
from jax import lax
import numpy as np

D_MODEL = 2048
BATCH = 2
SEQ = 4096
DEPTH = 4

HEAD_DIM = 128
MIX_WIDTH = D_MODEL
A_HEADS = MIX_WIDTH // 4 // HEAD_DIM
B_HEADS = MIX_WIDTH // 2 // HEAD_DIM
B_KV_HEADS = B_HEADS // 4
C_HEADS = MIX_WIDTH // 4 // HEAD_DIM
A_W = A_HEADS * HEAD_DIM
B_QW = B_HEADS * HEAD_DIM
B_KVW = B_KV_HEADS * HEAD_DIM
C_W = C_HEADS * HEAD_DIM
DILATED_PATTERNS = ((128, 1), (512, 4), (2048, 16))
ROPE_THETA = 500000.0
ROPE_DIM = HEAD_DIM // 4
AXIAL_THETA = 10000.0
GRID_W = 64
Q_BLOCK = 128
CONV_K = 5
DELTA_CHUNK = 64
N_EXPERTS = 16
EC_CAPACITY = 2
EXPERT_FF = D_MODEL // 2
PLE_DIM = 256
NORM_EPS = 1e-6
IN_WIDTHS = (A_W, A_W, A_W, B_QW, B_KVW, B_KVW, 3 * C_W, C_W, 2 * C_HEADS, 2 * C_HEADS)
D_IN = 3 * A_W + B_QW + 2 * B_KVW + 4 * C_W + 4 * C_HEADS

kernel_name = "hybrid_parallel_heads_ec_moe_encoder"

F32 = jnp.float32


def rms_norm(x, gain):
    xf = x.astype(F32)
    y = xf * lax.rsqrt(jnp.mean(xf * xf, axis=-1, keepdims=True) + NORM_EPS)
    return (y * gain.astype(F32)).astype(x.dtype)


def rope_tables(pos, dim, theta):
    inv = theta ** (-jnp.arange(0, dim, 2, dtype=F32) / dim)
    ang = pos.astype(F32)[:, None] * inv[None, :]
    return jnp.cos(ang), jnp.sin(ang)


def rotate(x, cos, sin):
    half = x.shape[-1] // 2
    x1, x2 = x[..., :half], x[..., half:]
    cos, sin = cos.astype(x.dtype), sin.astype(x.dtype)
    return jnp.concatenate([x1 * cos - x2 * sin, x2 * cos + x1 * sin], axis=-1)


def partial_rope(x, cos, sin):
    return jnp.concatenate([rotate(x[..., :ROPE_DIM], cos, sin), x[..., ROPE_DIM:]], axis=-1)


def axial_rope(x, row_cs, col_cs):
    h = HEAD_DIM // 2
    return jnp.concatenate([rotate(x[..., :h], *row_cs), rotate(x[..., h:], *col_cs)], axis=-1)


def banded_attention(q, k, v, half):
    lead = q.shape[:-2]
    L, hd = q.shape[-2:]
    nl = len(lead)
    blk = half
    nb = -(-L // blk)
    lp = nb * blk
    qb = jnp.pad(q, [(0, 0)] * nl + [(0, lp - L), (0, 0)]).reshape(*lead, nb, blk, hd)

    def windows(t):
        tb = jnp.pad(t, [(0, 0)] * nl + [(blk, lp - L + blk), (0, 0)]).reshape(*lead, nb + 2, blk, hd)
        return jnp.concatenate([tb[..., :-2, :, :], tb[..., 1:-1, :, :], tb[..., 2:, :, :]], axis=-2)

    kw, vw = windows(k), windows(v)
    qpos = jnp.arange(lp).reshape(nb, blk)
    kpos = jnp.arange(nb)[:, None] * blk - blk + jnp.arange(3 * blk)[None, :]
    mask = ((jnp.abs(qpos[:, :, None] - kpos[:, None, :]) <= half)
            & (kpos >= 0)[:, None, :] & (kpos < L)[:, None, :])
    s = jnp.einsum('...nqd,...nkd->...nqk', qb.astype(F32), kw.astype(F32)) * (hd ** -0.5)
    s = jnp.where(mask, s, -jnp.inf)
    m = jnp.max(s, axis=-1, keepdims=True)
    e = jnp.exp(s - m)
    den = jnp.sum(e, axis=-1, keepdims=True)
    o = jnp.einsum('...nqk,...nkd->...nqd', e / den, vw.astype(F32))
    lse = (m + jnp.log(den))[..., 0]
    return o.reshape(*lead, lp, hd)[..., :L, :], lse.reshape(*lead, lp)[..., :L]


def dilated_mixer(q, k, v):
    B, H, S, hd = q.shape
    outs, lses = [], []
    for window, dil in DILATED_PATTERNS:
        half = window // (2 * dil)
        fold = lambda t: t.reshape(B, H, S // dil, dil, hd).swapaxes(2, 3)
        o, lse = banded_attention(fold(q), fold(k), fold(v), half)
        outs.append(o.swapaxes(2, 3).reshape(B, H, S, hd))
        lses.append(lse.swapaxes(2, 3).reshape(B, H, S))
    wts = jax.nn.softmax(jnp.stack(lses, axis=0), axis=0)
    return jnp.sum(wts[..., None] * jnp.stack(outs, axis=0), axis=0).astype(q.dtype)


def gqa_blocked(q, k, v):
    B, HQ, S, hd = q.shape
    hkv = k.shape[1]
    grp = HQ // hkv
    nblk = S // Q_BLOCK
    qb = q.reshape(B, hkv, grp, nblk, Q_BLOCK, hd).transpose(3, 0, 1, 2, 4, 5)
    kf, vf = k.astype(F32), v.astype(F32)
    scale = hd ** -0.5

    def attend(q_blk):
        s = jnp.einsum('bhgqd,bhkd->bhgqk', q_blk.astype(F32), kf) * scale
        return jnp.einsum('bhgqk,bhkd->bhgqd', jax.nn.softmax(s, axis=-1), vf)

    o = lax.map(attend, qb)
    return o.transpose(1, 2, 3, 0, 4, 5).reshape(B, HQ, S, hd).astype(q.dtype)


def centred_depthwise_conv(x, w):
    K = w.shape[0]
    pad = K // 2
    S = x.shape[1]
    xp = jnp.pad(x, ((0, 0), (pad, pad), (0, 0)))
    acc = xp[:, 0:S] * w[0]
    for j in range(1, K):
        acc = acc + xp[:, j:j + S] * w[j]
    return acc


def chunk_gated_delta_rule(q, k, v, g, beta):
    B, H, L, DK = q.shape
    DV = v.shape[-1]
    C = DELTA_CHUNK
    n = L // C
    q = q * (DK ** -0.5)
    kb = k * beta[..., None]
    vb = v * beta[..., None]
    chunks = lambda t: t.reshape(B, H, n, C, *t.shape[3:])
    q, k, kb, vb, g = chunks(q), chunks(k), chunks(kb), chunks(vb), chunks(g)
    gc = jnp.cumsum(g, axis=-1)
    incl = jnp.tril(jnp.ones((C, C), dtype=bool))
    strict = jnp.tril(jnp.ones((C, C), dtype=bool), -1)
    decay = jnp.exp(jnp.where(incl, gc[..., :, None] - gc[..., None, :], -jnp.inf))
    a = jnp.where(strict, jnp.einsum('bhnik,bhnjk->bhnij', kb, k) * decay, 0.0)
    rhs = jnp.concatenate([vb, kb * jnp.exp(gc)[..., None]], axis=-1)
    sol = lax.linalg.triangular_solve(a, rhs, left_side=True, lower=True, unit_diagonal=True)
    u, w = sol[..., :DV], sol[..., DV:]
    qk = jnp.einsum('bhnik,bhnjk->bhnij', q, k) * decay

    def step(state, xs):
        q_i, k_i, u_i, w_i, gc_i, qk_i = xs
        v_new = u_i - jnp.einsum('bhck,bhkv->bhcv', w_i, state)
        o_i = (jnp.einsum('bhck,bhkv->bhcv', q_i * jnp.exp(gc_i)[..., None], state)
               + jnp.einsum('bhij,bhjv->bhiv', qk_i, v_new))
        g_last = gc_i[..., -1]
        state = (state * jnp.exp(g_last)[..., None, None]
                 + jnp.einsum('bhck,bhcv->bhkv', k_i * jnp.exp(g_last[..., None] - gc_i)[..., None], v_new))
        return state, o_i

    xs = tuple(jnp.moveaxis(t, 2, 0) for t in (q, k, u, w, gc, qk))
    _, o = lax.scan(step, jnp.zeros((B, H, DK, DV), F32), xs)
    return jnp.moveaxis(o, 0, 2).reshape(B, H, L, DV)


def gated_deltanet_mixer(qkv, z, beta_logits, a_logits, conv_w, a_log, dt_bias, norm_g):
    B, S, _ = qkv.shape
    dtype = qkv.dtype
    qkv = jax.nn.silu(centred_depthwise_conv(qkv, conv_w)).astype(F32)
    q, k, v = jnp.split(qkv, 3, axis=-1)
    heads = lambda t: t.reshape(B, S, C_HEADS, HEAD_DIM).transpose(0, 2, 1, 3)
    l2n = lambda t: t * lax.rsqrt(jnp.sum(t * t, axis=-1, keepdims=True) + NORM_EPS)
    q, k, v = l2n(heads(q)), l2n(heads(k)), heads(v)
    dirs = lambda t: t.astype(F32).reshape(B, S, 2, C_HEADS).transpose(2, 0, 3, 1)
    beta = jax.nn.sigmoid(dirs(beta_logits))
    g = -jnp.exp(a_log.astype(F32))[:, None, :, None] * jax.nn.softplus(
        dirs(a_logits) + dt_bias.astype(F32)[:, None, :, None])
    o_fwd = chunk_gated_delta_rule(q, k, v, g[0], beta[0])
    flip = lambda t: jnp.flip(t, axis=2)
    o_bwd = flip(chunk_gated_delta_rule(flip(q), flip(k), flip(v), flip(g[1]), flip(beta[1])))
    o = (o_fwd + o_bwd).transpose(0, 2, 1, 3)
    o = rms_norm(o, norm_g) * jax.nn.silu(z.astype(F32).reshape(B, S, C_HEADS, HEAD_DIM))
    return o.reshape(B, S, C_W).astype(dtype)


def expert_choice_moe(h, w_router, w_gate, w_up, w_down):
    B, S, D = h.shape
    cap = EC_CAPACITY * S // N_EXPERTS
    aff = jax.nn.softmax(jnp.einsum('bsd,de->bse', h.astype(F32), w_router.astype(F32)), axis=-1)
    gates, idx = lax.top_k(jnp.swapaxes(aff, 1, 2), cap)
    xs = jnp.take_along_axis(h, idx.reshape(B, -1)[..., None], axis=1).reshape(B, N_EXPERTS, cap, D)
    hid = jax.nn.silu(jnp.einsum('becd,edf->becf', xs, w_gate)) * jnp.einsum('becd,edf->becf', xs, w_up)
    y = jnp.einsum('becf,efd->becd', hid, w_down) * gates[..., None].astype(h.dtype)
    b_ix = jnp.arange(B)[:, None, None]
    return jnp.zeros_like(h).at[b_ix, idx].add(y)


def setup_inputs(seed: int = 0) -> dict:
    key = jax.random.key(seed)
    ks = jax.random.split(key, 24)

    def dense(k, shape, fan_in):
        return jax.random.normal(k, shape, F32) * (fan_in ** -0.5)

    def gain(k, shape):
        return 1.0 + 0.02 * jax.random.normal(k, shape, F32)

    dt = jnp.exp(jax.random.uniform(ks[9], (DEPTH, 2, C_HEADS), F32,
                                    minval=math.log(1e-3), maxval=math.log(1e-1)))
    dt_bias = dt + jnp.log(-jnp.expm1(-dt))
    a_log = jnp.log(jax.random.uniform(ks[10], (DEPTH, 2, C_HEADS), F32, minval=1.0, maxval=16.0))
    return {
        "x": jax.random.normal(ks[0], (BATCH, SEQ, D_MODEL), F32),
        "p": jax.random.normal(ks[1], (DEPTH, BATCH, SEQ, PLE_DIM), F32),
        "norm_mix": gain(ks[2], (DEPTH, D_MODEL)),
        "w_in": dense(ks[3], (DEPTH, D_MODEL, D_IN), D_MODEL),
        "conv_w": dense(ks[4], (DEPTH, CONV_K, 3 * C_W), CONV_K),
        "q_norm": gain(ks[5], (DEPTH, HEAD_DIM)),
        "k_norm": gain(ks[6], (DEPTH, HEAD_DIM)),
        "out_norm_a": gain(ks[7], (DEPTH, A_W)),
        "out_norm_b": gain(ks[8], (DEPTH, B_QW)),
        "gdn_a_log": a_log,
        "gdn_dt_bias": dt_bias,
        "gdn_norm": gain(ks[11], (DEPTH, HEAD_DIM)),
        "w_out": dense(ks[12], (DEPTH, MIX_WIDTH, D_MODEL), MIX_WIDTH),
        "norm_moe": gain(ks[13], (DEPTH, D_MODEL)),
        "w_router": dense(ks[14], (DEPTH, D_MODEL, N_EXPERTS), D_MODEL),
        "w_gate": dense(ks[15], (DEPTH, N_EXPERTS, D_MODEL, EXPERT_FF), D_MODEL),
        "w_up": dense(ks[16], (DEPTH, N_EXPERTS, D_MODEL, EXPERT_FF), D_MODEL),
        "w_down": dense(ks[17], (DEPTH, N_EXPERTS, EXPERT_FF, D_MODEL), EXPERT_FF),
        "norm_ple": gain(ks[18], (DEPTH, D_MODEL)),
        "w_ple": dense(ks[19], (DEPTH, PLE_DIM, D_MODEL), PLE_DIM),
        "w_ple_gate": dense(ks[20], (DEPTH, D_MODEL, D_MODEL), D_MODEL),
        "norm_final": gain(ks[21], (D_MODEL,)),
    }


def reference(x, p, norm_mix, w_in, conv_w, q_norm, k_norm, out_norm_a, out_norm_b,
              gdn_a_log, gdn_dt_bias, gdn_norm, w_out, norm_moe, w_router, w_gate, w_up,
              w_down, norm_ple, w_ple, w_ple_gate, norm_final):
    B, S, D = x.shape
    t = jnp.arange(S)
    a_cos, a_sin = rope_tables(t, ROPE_DIM, ROPE_THETA)
    rows = S // GRID_W
    row_cs = rope_tables(jnp.repeat(jnp.arange(rows), GRID_W), HEAD_DIM // 2, AXIAL_THETA)
    col_cs = rope_tables(jnp.tile(jnp.arange(GRID_W), rows), HEAD_DIM // 2, AXIAL_THETA)
    offsets = [int(o) for o in np.cumsum(IN_WIDTHS)[:-1]]
    to_heads = lambda u, n: u.reshape(B, S, n, HEAD_DIM).transpose(0, 2, 1, 3)
    merge = lambda u: u.transpose(0, 2, 1, 3).reshape(B, S, -1)

    h = x
    for i in range(DEPTH):
        hn = rms_norm(h, norm_mix[i])
        proj = jnp.einsum('bsd,de->bse', hn, w_in[i])
        a_q, a_k, a_v, b_q, b_k, b_v, c_qkv, c_z, c_beta, c_a = jnp.split(proj, offsets, axis=-1)

        qa = partial_rope(to_heads(a_q, A_HEADS), a_cos, a_sin)
        ka = partial_rope(to_heads(a_k, A_HEADS), a_cos, a_sin)
        y_a = rms_norm(merge(dilated_mixer(qa, ka, to_heads(a_v, A_HEADS))), out_norm_a[i])

        qb = axial_rope(rms_norm(to_heads(b_q, B_HEADS), q_norm[i]), row_cs, col_cs)
        kb = axial_rope(rms_norm(to_heads(b_k, B_KV_HEADS), k_norm[i]), row_cs, col_cs)
        y_b = rms_norm(merge(gqa_blocked(qb, kb, to_heads(b_v, B_KV_HEADS))), out_norm_b[i])

        y_c = gated_deltanet_mixer(c_qkv, c_z, c_beta, c_a, conv_w[i], gdn_a_log[i],
                                   gdn_dt_bias[i], gdn_norm[i])

        y = jnp.concatenate([y_a, y_b, y_c], axis=-1)
        h = h + jnp.einsum('bse,ed->bsd', y, w_out[i])
        h = h + expert_choice_moe(rms_norm(h, norm_moe[i]), w_router[i], w_gate[i], w_up[i], w_down[i])
        gate = jax.nn.sigmoid(jnp.einsum('bsd,de->bse', rms_norm(h, norm_ple[i]), w_ple_gate[i]))
        h = h + gate * jnp.einsum('bsk,kd->bsd', p[i], w_ple[i])
    return rms_norm(h, norm_final)
```

```cpp
#include <hip/hip_runtime.h>
#include <cstdio>
#include <cstdint>

#define LAS __attribute__((address_space(3)))
typedef unsigned short bf16;
typedef float f32x4 __attribute__((ext_vector_type(4)));
typedef unsigned u32x4 __attribute__((ext_vector_type(4)));
typedef unsigned u32x2 __attribute__((ext_vector_type(2)));
typedef short bf16x8 __attribute__((ext_vector_type(8)));

constexpr int BATCH = 2, SEQ = 4096, T = BATCH * SEQ, DM = 2048, DEPTH = 4, HD = 128;
constexpr int DIN = 5136, DINP = 5120;
constexpr int COL_AQ = 0, COL_AK = 512, COL_AV = 1024, COL_BQ = 1536, COL_BK = 2560, COL_BV = 2816, COL_CQKV = 3072, COL_CZ = 4608;
constexpr int NE = 16, CAP = 512, EFF = 1024, PLE = 256;
constexpr float EPS = 1e-6f;
constexpr int NWAVES = 8, NTHR = 512;
constexpr int LDS_BYTES = 147456, LDS_MISC = 147456 - 256;
constexpr int CW_BAR = 4096;

constexpr size_t al256(size_t x) { return (x + 255) / 256 * 256; }
constexpr size_t WS_CTL = 0, CTL_BYTES = 1u << 20;
constexpr size_t SZ_WIN = (size_t)DINP * DM * 2, SZ_WOUT = (size_t)DM * DM * 2, SZ_WGU = (size_t)NE * 2048 * DM * 2, SZ_WD = (size_t)NE * DM * EFF * 2, SZ_WPG = (size_t)DM * DM * 2, SZ_WP = (size_t)DM * PLE * 2;
constexpr size_t SZ_LAYERW = SZ_WIN + SZ_WOUT + SZ_WGU + SZ_WD + SZ_WPG + SZ_WP;
constexpr size_t OFF_WIN = 0, OFF_WOUT = OFF_WIN + SZ_WIN, OFF_WGU = OFF_WOUT + SZ_WOUT, OFF_WD = OFF_WGU + SZ_WGU, OFF_WPG = OFF_WD + SZ_WD, OFF_WP = OFF_WPG + SZ_WPG;
constexpr size_t WS_W = WS_CTL + CTL_BYTES;
constexpr size_t WS_PB = WS_W + DEPTH * SZ_LAYERW;
constexpr size_t WS_TABA = WS_PB + (size_t)DEPTH * T * PLE * 2;
constexpr size_t WS_TABB = WS_TABA + (size_t)SEQ * 16 * 8;
constexpr size_t WS_H = al256(WS_TABB + 64 * 32 * 8);
constexpr size_t WS_HN = WS_H + (size_t)T * DM * 4;
constexpr size_t WS_TL = WS_HN + (size_t)T * DM * 2;
constexpr size_t WS_PROJ = WS_TL + (size_t)T * 16 * 4;
constexpr size_t WS_YMIX = WS_PROJ + (size_t)T * DINP * 2;
constexpr size_t WS_Y = WS_YMIX + (size_t)T * DM * 4;
constexpr size_t WS_AFF = WS_Y + (size_t)T * DM * 2;
constexpr size_t WS_SELI = WS_AFF + (size_t)T * 16 * 4;
constexpr size_t WS_SELG = WS_SELI + (size_t)BATCH * NE * CAP * 4;
constexpr size_t WS_SLOT = WS_SELG + (size_t)BATCH * NE * CAP * 4;
constexpr size_t WS_XS = WS_SLOT + (size_t)BATCH * NE * SEQ * 4;
constexpr size_t WS_HID = WS_XS + (size_t)NE * 1024 * DM * 2;
constexpr size_t WS_YEXP = WS_HID + (size_t)NE * 1024 * EFF * 2;
constexpr size_t WS_PL = WS_YEXP + (size_t)NE * 1024 * DM * 2;
constexpr size_t WS_DQ = WS_PL + (size_t)T * DM * 2;
constexpr size_t WS_DK = WS_DQ + (size_t)T * 512 * 4;
constexpr size_t WS_DV = WS_DK + (size_t)T * 512 * 4;
constexpr size_t WS_DB = WS_DV + (size_t)T * 512 * 4;
constexpr size_t WS_DG = WS_DB + (size_t)2 * T * 4 * 4;
constexpr size_t WS_DO = WS_DG + (size_t)2 * T * 4 * 4;
constexpr size_t WS_TMP = al256(WS_DO + (size_t)2 * T * 512 * 4);
constexpr size_t WS_END = WS_TMP + (size_t)NE * 1024 * 2048 * 4;
static_assert(WS_END < 2100000000ull, "workspace map");

__device__ const double INV_A[16] = {1.0, 0.44036660267178046, 0.19392274474868576, 0.08539710028576561, 0.03760603093086393, 0.016560440080994443, 0.0072926647372171085, 0.003211445994752591, 0.0014142135623730952, 0.000622772421914596, 0.0002742481756762073, 0.00012076973741146504, 5.318295896944988e-05, 2.341999896140934e-05, 1.0313385377212458e-05, 4.5416704806078695e-06};
__device__ const double INV_B[32] = {1.0, 0.7498942093324559, 0.5623413251903491, 0.4216965034285822, 0.31622776601683794, 0.23713737056616552, 0.1778279410038923, 0.1333521432163324, 0.09999999999999999, 0.07498942093324558, 0.056234132519034905, 0.042169650342858224, 0.03162277660168379, 0.023713737056616554, 0.01778279410038923, 0.013335214321633239, 0.01, 0.007498942093324559, 0.005623413251903491, 0.004216965034285822, 0.0031622776601683794, 0.002371373705661655, 0.0017782794100389228, 0.0013335214321633238, 0.001, 0.0007498942093324559, 0.000562341325190349, 0.00042169650342858224, 0.00031622776601683794, 0.00023713737056616554, 0.0001778279410038923, 0.0001333521432163324};

#ifndef N_LAUNCH_PER_PHASE
#define N_LAUNCH_PER_PHASE 0
#endif
#ifndef NAIVE_ATTN_B
#define NAIVE_ATTN_B 0
#endif
__device__ __forceinline__ float bf2f(bf16 b) { return __uint_as_float(((unsigned)b) << 16); }
__device__ __forceinline__ unsigned f2bf(float f) { unsigned u = __float_as_uint(f); return (u + 0x7fffu + ((u >> 16) & 1u)) >> 16; }
__device__ __forceinline__ unsigned pk2(float lo, float hi) { return f2bf(lo) | (f2bf(hi) << 16); }
__device__ __forceinline__ float wave_sum(float v) {
#pragma unroll
    for (int o = 1; o < 64; o <<= 1) v += __shfl_xor(v, o);
    return v;
}
__device__ __forceinline__ float wave_max(float v) {
#pragma unroll
    for (int o = 1; o < 64; o <<= 1) v = fmaxf(v, __shfl_xor(v, o));
    return v;
}
__device__ __forceinline__ float sigmoidf_(float x) { return 1.0f / (1.0f + __expf(-x)); }
__device__ __forceinline__ float siluf_(float x) { return x / (1.0f + __expf(-x)); }
__device__ __forceinline__ float softplusf_(float x) { return x > 20.f ? x : log1pf(__expf(x)); }
__device__ __forceinline__ void sincos_d(double a, float& c, float& s) {
    const double q = rint(a * 0.63661977236758134308);
    const double r = (a - q * 1.57079632679489655800) - q * 6.12323399573676603587e-17;
    const double r2 = r * r;
    double sp = 1.0 / 6227020800.0; sp = sp * r2 * -1.0 + 1.0 / 39916800.0; sp = sp * -r2 + 1.0 / 362880.0; sp = sp * -r2 + 1.0 / 5040.0; sp = sp * -r2 + 1.0 / 120.0; sp = sp * -r2 + 1.0 / 6.0; sp = sp * -r2 + 1.0;
    const double sr = r * sp;
    double cp = 1.0 / 87178291200.0; cp = cp * -r2 + 1.0 / 479001600.0; cp = cp * -r2 + 1.0 / 3628800.0; cp = cp * -r2 + 1.0 / 40320.0; cp = cp * -r2 + 1.0 / 720.0; cp = cp * -r2 + 1.0 / 24.0; cp = cp * -r2 + 0.5; cp = cp * -r2 + 1.0;
    const double cr = cp;
    const long long qi = (long long)q; const int m = (int)(qi & 3);
    double cs, sn;
    if (m == 0) { cs = cr; sn = sr; } else if (m == 1) { cs = -sr; sn = cr; } else if (m == 2) { cs = -cr; sn = -sr; } else { cs = sr; sn = -cr; }
    c = (float)cs; s = (float)sn;
}


#define XB_TMO      128
#define XB_XCNT(j)  (256  + 64 * (j))
#define XB_XSUB(j)  (1280 + 64 * (j))
#define XB_XGEN(j)  (2304 + 64 * (j))
#define XB_TOP      3328
#define XB_TOPGEN   3392
#define XCD_BAR_WORDS 3456
#define XB_SPIN_CAP (1u << 22)

__device__ __forceinline__ unsigned xb_ld(unsigned* p)              { return __hip_atomic_load(p, __ATOMIC_RELAXED, __HIP_MEMORY_SCOPE_AGENT); }
__device__ __forceinline__ unsigned xb_add(unsigned* p, unsigned v) { return __hip_atomic_fetch_add(p, v, __ATOMIC_RELAXED, __HIP_MEMORY_SCOPE_AGENT); }
__device__ __forceinline__ unsigned xb_xcc_id() { return (unsigned)__builtin_amdgcn_s_getreg((3 << 11) | 20) & 0xFu; }
#define XB_SPIN(cond, bar) do { unsigned _sp = 0; while (cond) { __builtin_amdgcn_s_sleep(1); \
    if ((++_sp & 255u) == 0u) { if (xb_ld(&(bar)[XB_TMO])) break; if (_sp > XB_SPIN_CAP) { atomicAdd(&(bar)[XB_TMO], 1u); break; } } } } while (0)

struct XcdBarrier {
    unsigned* bar; unsigned x;
    volatile LAS unsigned* st;
};

__device__ __forceinline__ XcdBarrier xcd_barrier_post(unsigned* bar, volatile LAS unsigned* st) {
    XcdBarrier b; b.bar = bar; b.x = xb_xcc_id(); b.st = st;
    if (threadIdx.x == 0) (void)xb_add(&bar[XB_XCNT(b.x)], 1u);
    return b;
}
__device__ __forceinline__ void xcd_barrier_complete(unsigned* bar, unsigned x, unsigned& nloc, unsigned& nx) {
    const unsigned G = gridDim.x * gridDim.y * gridDim.z;
    unsigned sum, cnt, mine, sp = 0u;
    for (;;) {
        sum = 0u; cnt = 0u; mine = 0u;
#pragma unroll
        for (unsigned j = 0; j < 16; ++j) { const unsigned c = xb_ld(&bar[XB_XCNT(j)]); sum += c; cnt += (c > 0u) ? 1u : 0u; mine = (j == x) ? c : mine; }
        if (sum == G) break;
        __builtin_amdgcn_s_sleep(1);
        if ((++sp & 255u) == 0u) { if (xb_ld(&bar[XB_TMO])) break; if (sp > XB_SPIN_CAP) { atomicAdd(&bar[XB_TMO], 1u); break; } }
    }
    nloc = mine > 0u ? mine : 1u; nx = cnt > 0u ? cnt : 1u;
}

__device__ __forceinline__ void xcd_barrier(const XcdBarrier& b) {
    asm volatile("s_waitcnt vmcnt(0)" ::: "memory");
    __syncthreads();
    if (threadIdx.x == 0) {
        unsigned* bar = b.bar;
        __builtin_amdgcn_s_waitcnt(0);
        unsigned nloc = b.st[0], nx = b.st[1];
        if (nloc == 0u) { xcd_barrier_complete(bar, b.x, nloc, nx); b.st[0] = nloc; b.st[1] = nx; }
        const unsigned old = xb_add(&bar[XB_XSUB(b.x)], 1u);
        const unsigned gen = old / nloc;
        if (old + 1u == (gen + 1u) * nloc) {
            __builtin_amdgcn_fence(__ATOMIC_RELEASE, "agent");
            asm volatile("s_waitcnt vmcnt(0)" ::: "memory");
            const unsigned og = xb_add(&bar[XB_TOP], 1u);
            const unsigned tg = og / nx;
            if (og + 1u == (tg + 1u) * nx) xb_add(&bar[XB_TOPGEN], 1u);
            else XB_SPIN(xb_ld(&bar[XB_TOPGEN]) == tg, bar);
            __builtin_amdgcn_fence(__ATOMIC_ACQUIRE, "agent");
            xb_add(&bar[XB_XGEN(b.x)], 1u);
            asm volatile("s_waitcnt vmcnt(0)" ::: "memory");
        } else {
            XB_SPIN(xb_ld(&bar[XB_XGEN(b.x)]) == gen, bar);
            __builtin_amdgcn_fence(__ATOMIC_ACQUIRE, "agent");
            asm volatile("s_waitcnt vmcnt(0)" ::: "memory");
        }
    }
    __syncthreads();
}

struct Frame {
    LAS unsigned char* lds;
    int tid, lane, wave, vcu, G;
    const float* const __attribute__((address_space(4)))* in;
    float* out;
    unsigned char* ws;
};
#define WSP(type, off) ((type*)(F.ws + (off)))

__device__ __forceinline__ void transpose_item(const float* __restrict__ W, int ldw, bf16* __restrict__ WT, int ldt, int k0, int n0, size_t drow0, LAS float* scr, int lane) {
#pragma unroll 8
    for (int i = 0; i < 32; ++i) { const int kk = 2 * i + (lane >> 5); scr[kk * 33 + (lane & 31)] = W[(size_t)(k0 + kk) * ldw + n0 + (lane & 31)]; }
    asm volatile("s_waitcnt lgkmcnt(0)" ::: "memory");
    const int c = lane & 7;
#pragma unroll
    for (int j = 0; j < 4; ++j) { const int n = (lane >> 3) + 8 * j; const LAS float* s = scr + (8 * c) * 33 + n;
        u32x4 o; o.x = pk2(s[0 * 33], s[1 * 33]); o.y = pk2(s[2 * 33], s[3 * 33]); o.z = pk2(s[4 * 33], s[5 * 33]); o.w = pk2(s[6 * 33], s[7 * 33]);
        *(u32x4*)(WT + (drow0 + n) * (size_t)ldt + k0 + 8 * c) = o; }
    asm volatile("s_waitcnt lgkmcnt(0)" ::: "memory");
}
__device__ __forceinline__ void phase_prologue(Frame& F) {
    LAS float* scr = (LAS float*)(F.lds + F.wave * 16384);
    const int gw = F.vcu * NWAVES + F.wave, NGW = F.G * NWAVES;
    constexpr int I_IN = 32 * 160, I_OUT = 32 * 64, I_G = 16 * 32 * 32, I_D = 16 * 16 * 64, I_P = 4 * 64, I_PG = 32 * 64;
    constexpr int I_LAYER = I_IN + I_OUT + 2 * I_G + I_D + I_P + I_PG;
    for (int it = gw; it < DEPTH * I_LAYER; it += NGW) {
        const int l = it / I_LAYER; int r = it % I_LAYER;
#define wl (F.ws + WS_W + (size_t)l * SZ_LAYERW)
        if (r < I_IN) { const int kb = r / 160, nb = r % 160; transpose_item(F.in[3] + (size_t)l * DM * DIN, DIN, (bf16*)(wl + OFF_WIN), DM, kb * 64, nb * 32, (size_t)nb * 32, scr, F.lane); continue; } r -= I_IN;
        if (r < I_OUT) { const int kb = r / 64, nb = r % 64; transpose_item(F.in[12] + (size_t)l * DM * DM, DM, (bf16*)(wl + OFF_WOUT), DM, kb * 64, nb * 32, (size_t)nb * 32, scr, F.lane); continue; } r -= I_OUT;
        if (r < 2 * I_G) { const int up = r / I_G; r %= I_G; const int e = r / 1024, q = r % 1024, kb = q / 32, nb = q % 32, n0 = nb * 32;
            const float* src = (up ? F.in[16] : F.in[15]) + ((size_t)(l * NE + e) * DM) * EFF;
            transpose_item(src, EFF, (bf16*)(wl + OFF_WGU), DM, kb * 64, n0, (size_t)e * 2048 + (n0 / 128) * 256 + (n0 % 128) + up * 128, scr, F.lane); continue; } r -= 2 * I_G;
        if (r < I_D) { const int e = r / 1024, q = r % 1024, kb = q / 64, nb = q % 64;
            transpose_item(F.in[17] + ((size_t)(l * NE + e) * EFF) * DM, DM, (bf16*)(wl + OFF_WD), EFF, kb * 64, nb * 32, (size_t)e * 2048 + nb * 32, scr, F.lane); continue; } r -= I_D;
        if (r < I_P) { const int kb = r / 64, nb = r % 64; transpose_item(F.in[19] + (size_t)l * PLE * DM, DM, (bf16*)(wl + OFF_WP), PLE, kb * 64, nb * 32, (size_t)nb * 32, scr, F.lane); continue; } r -= I_P;
        { const int kb = r / 64, nb = r % 64; transpose_item(F.in[20] + (size_t)l * DM * DM, DM, (bf16*)(wl + OFF_WPG), DM, kb * 64, nb * 32, (size_t)nb * 32, scr, F.lane); }
    }
    const size_t gt = (size_t)F.vcu * NTHR + F.tid, NT = (size_t)F.G * NTHR;
    { const f32x4* src = (const f32x4*)F.in[1]; u32x2* dst = WSP(u32x2, WS_PB);
      for (size_t i = gt; i < (size_t)DEPTH * T * PLE / 4; i += NT) { const f32x4 v = src[i]; u32x2 o; o.x = pk2(v.x, v.y); o.y = pk2(v.z, v.w); dst[i] = o; } }
    { const f32x4* src = (const f32x4*)F.in[0]; f32x4* dst = WSP(f32x4, WS_H);
      for (size_t i = gt; i < (size_t)T * DM / 4; i += NT) dst[i] = src[i]; }
    { float2* ta = WSP(float2, WS_TABA); for (size_t i = gt; i < (size_t)SEQ * 16; i += NT) { const int s = (int)(i >> 4), j = (int)(i & 15); float c, sn; sincos_d((double)s * INV_A[j], c, sn); ta[i] = make_float2(c, sn); }
      float2* tb = WSP(float2, WS_TABB); for (size_t i = gt; i < 64 * 32; i += NT) { const int s = (int)(i >> 5), j = (int)(i & 31); float c, sn; sincos_d((double)s * INV_B[j], c, sn); tb[i] = make_float2(c, sn); } }
}

template <int MODE>
__device__ __forceinline__ void phase_norm(Frame& F, const float* __restrict__ gain, const float* __restrict__ wsrc, int ldw, float* __restrict__ out16) {
    const float* H = WSP(float, WS_H); bf16* HN = WSP(bf16, WS_HN);
    LAS float* wT = (LAS float*)F.lds;
    if (MODE != 0) { for (int idx = F.tid; idx < 16 * DM; idx += NTHR) { const int k = idx >> 4, c = idx & 15; wT[c * DM + k] = wsrc[(size_t)k * ldw + c]; } __syncthreads(); }
    const int gw = F.vcu * NWAVES + F.wave, NGW = F.G * NWAVES, lane = F.lane;
    f32x4 g[8];
#pragma unroll
    for (int j = 0; j < 8; ++j) g[j] = *(const f32x4*)(gain + 4 * lane + 256 * j);
    for (int r = gw; r < T; r += NGW) {
        const float* hr = H + (size_t)r * DM; f32x4 v[8]; float ss = 0.f;
#pragma unroll
        for (int j = 0; j < 8; ++j) { v[j] = *(const f32x4*)(hr + 4 * lane + 256 * j); ss += (v[j].x * v[j].x + v[j].y * v[j].y) + (v[j].z * v[j].z + v[j].w * v[j].w); }
        const float rs = rsqrtf(wave_sum(ss) * (1.0f / DM) + EPS);
#pragma unroll
        for (int j = 0; j < 8; ++j) { v[j] = v[j] * rs * g[j]; u32x2 o; o.x = pk2(v[j].x, v[j].y); o.y = pk2(v[j].z, v[j].w); *(u32x2*)(HN + (size_t)r * DM + 4 * lane + 256 * j) = o; }
        if (MODE != 0) {
            float mine = 0.f;
#pragma unroll 1
            for (int c = 0; c < 16; ++c) { float a = 0.f;
#pragma unroll
                for (int j = 0; j < 8; ++j) { const f32x4 w = *(const LAS f32x4*)(wT + c * DM + 4 * lane + 256 * j); a += (v[j].x * w.x + v[j].y * w.y) + (v[j].z * w.z + v[j].w * w.w); }
                a = wave_sum(a); mine = (lane == c) ? a : mine; }
            if (MODE == 2) { const float m = wave_max(lane < 16 ? mine : -3.0e38f); const float e = lane < 16 ? expf(mine - m) : 0.f; const float sden = wave_sum(e); mine = e / sden; }
            if (lane < 16) out16[(size_t)r * 16 + lane] = mine;
        }
    }
}


namespace pg8 {
#define PG8_LAS __attribute__((address_space(3)))
typedef unsigned short bf16_t;
typedef short bf16x8 __attribute__((ext_vector_type(8)));
typedef float f32x4 __attribute__((ext_vector_type(4)));
typedef unsigned u32x4 __attribute__((ext_vector_type(4)));
constexpr int BM = 256, BK = 64, HALF = 128, HTB = HALF * BK * 2, STAGE_BYTES = 8 * HTB, NXCD = 8, WGM = 8;
__host__ __device__ __forceinline__ int lds_byte(int r, int c) { const int st = (r >> 4) * 2 + (c >> 5), rr = r & 15, cc = c & 31, ob = rr * 64 + cc * 2; return st * 1024 + (ob ^ (((ob >> 9) & 1) << 5)); }
__host__ __device__ __forceinline__ void stage_rc(int b, int& R, int& C) { const int st = b / 1024, sb = b % 1024, swz = sb ^ (((sb >> 9) & 1) << 5); R = (st >> 1) * 16 + swz / 64; C = (st & 1) * 32 + (swz % 64) / 2; }
__host__ __device__ __forceinline__ int perm32(int rho) { const int n = rho >> 4, i = rho & 15; return 8 * (i >> 2) + 4 * n + (i & 3); }
struct Unit { int pm, pn; };
struct Gemm { const bf16_t* A; const bf16_t* Bt; int M, N, K; };
struct StaticOrder {
    int nM, nN, nwg, G, c;
    __host__ __device__ void init(int M, int N, int G_, int c_) { nM = M / BM; nN = N / BM; nwg = nM * nN; G = G_; c = c_; }
    __host__ __device__ bool next(int i, Unit& u) const {
        const long L = (long)i * G + c; if (L >= nwg) return false;
        int wgid = (int)L; { const int q = nwg / NXCD, r = nwg % NXCD, xcd = wgid % NXCD, off = wgid / NXCD; wgid = (xcd < r ? xcd * (q + 1) : r * (q + 1) + (xcd - r) * q) + off; }
        const int nig = WGM * nN, gid = wgid / nig, fm = gid * WGM, gsz = (nM - fm) < WGM ? (nM - fm) : WGM;
        u.pm = fm + ((wgid % nig) % gsz); u.pn = (wgid % nig) / gsz; return true;
    }
    __device__ __forceinline__ void a_ready(const Unit&) const {}
    __device__ __forceinline__ void done(const Unit&) const {}
};
struct GroupedOrder {
    int G, c;
    __device__ bool next(int i, Unit& u) const { const int L = i * G + c; if (L >= 512) return false; const int e = L >> 5, w = L & 31; u.pm = 4 * e + (w & 3); u.pn = 8 * e + (w >> 2); return true; }
    __device__ __forceinline__ void a_ready(const Unit&) const {}
    __device__ __forceinline__ void done(const Unit&) const {}
};
__device__ __forceinline__ unsigned cvt_pk_bf16(float lo, float hi) { unsigned r; asm volatile("v_cvt_pk_bf16_f32 %0, %1, %2" : "=v"(r) : "v"(lo), "v"(hi)); return r; }
struct EpiBf16 {
    static constexpr bool PERM = true, AFTER_DRAIN = false;
    bf16_t* O; int ldc;
    __device__ __forceinline__ void operator()(const f32x4 (&acc)[2][2][4][2], const Unit& u, int wr, int wc, int fr, int fq) const {
        const int row0 = u.pm * BM + wr * 64 + fr, col0 = u.pn * BM + wc * 32 + 8 * fq;
#pragma unroll
        for (int ai = 0; ai < 2; ++ai)
#pragma unroll
            for (int m = 0; m < 4; ++m) { bf16_t* rowp = O + (size_t)(row0 + ai * HALF + m * 16) * ldc + col0;
#pragma unroll
                for (int bj = 0; bj < 2; ++bj) { const f32x4 v0 = acc[ai][bj][m][0], v1 = acc[ai][bj][m][1];
                    u32x4 w; w.x = cvt_pk_bf16(v0[0], v0[1]); w.y = cvt_pk_bf16(v0[2], v0[3]); w.z = cvt_pk_bf16(v1[0], v1[1]); w.w = cvt_pk_bf16(v1[2], v1[3]);
                    *(u32x4*)(rowp + bj * HALF) = w; } }
    }
};
struct EpiResidF32 {
    static constexpr bool PERM = false, AFTER_DRAIN = false;
    float* H; int ldc;
    __device__ __forceinline__ void operator()(const f32x4 (&acc)[2][2][4][2], const Unit& u, int wr, int wc, int fr, int fq) const {
        const int row0 = u.pm * BM + wr * 64 + fr, col0 = u.pn * BM + wc * 32 + 4 * fq;
#pragma unroll
        for (int ai = 0; ai < 2; ++ai)
#pragma unroll
            for (int m = 0; m < 4; ++m) { float* rowp = H + (size_t)(row0 + ai * HALF + m * 16) * ldc + col0;
                f32x4 h[2][2];
#pragma unroll
                for (int bj = 0; bj < 2; ++bj)
#pragma unroll
                    for (int n = 0; n < 2; ++n) h[bj][n] = *(const f32x4*)(rowp + bj * HALF + n * 16);
#pragma unroll
                for (int bj = 0; bj < 2; ++bj)
#pragma unroll
                    for (int n = 0; n < 2; ++n) *(f32x4*)(rowp + bj * HALF + n * 16) = h[bj][n] + acc[ai][bj][m][n];
                asm volatile("" ::: "memory"); }
    }
};
struct EpiGateUp {
    static constexpr bool PERM = true, AFTER_DRAIN = false;
    bf16_t* HID;
    __device__ __forceinline__ void operator()(const f32x4 (&acc)[2][2][4][2], const Unit& u, int wr, int wc, int fr, int fq) const {
        const int row0 = u.pm * BM + wr * 64 + fr, col0 = (u.pn & 7) * 128 + wc * 32 + 8 * fq;
#pragma unroll
        for (int ai = 0; ai < 2; ++ai)
#pragma unroll
            for (int m = 0; m < 4; ++m) { float o[8];
#pragma unroll
                for (int n = 0; n < 2; ++n)
#pragma unroll
                    for (int j = 0; j < 4; ++j) { const float g = acc[ai][0][m][n][j], up = acc[ai][1][m][n][j]; o[4 * n + j] = g * __builtin_amdgcn_rcpf(1.0f + __expf(-g)) * up; }
                u32x4 w; w.x = cvt_pk_bf16(o[0], o[1]); w.y = cvt_pk_bf16(o[2], o[3]); w.z = cvt_pk_bf16(o[4], o[5]); w.w = cvt_pk_bf16(o[6], o[7]);
                *(u32x4*)(HID + (size_t)(row0 + ai * HALF + m * 16) * 1024 + col0) = w; }
    }
};
struct EpiDownBf16 {
    static constexpr bool PERM = true, AFTER_DRAIN = false;
    bf16_t* O; const float* gate;
    __device__ __forceinline__ void operator()(const f32x4 (&acc)[2][2][4][2], const Unit& u, int wr, int wc, int fr, int fq) const {
        const int row0 = u.pm * BM + wr * 64 + fr, col0 = (u.pn & 7) * BM + wc * 32 + 8 * fq;
#pragma unroll
        for (int ai = 0; ai < 2; ++ai)
#pragma unroll
            for (int m = 0; m < 4; ++m) { const int row = row0 + ai * HALF + m * 16; const float gt = gate[row]; bf16_t* rowp = O + (size_t)row * 2048 + col0;
#pragma unroll
                for (int bj = 0; bj < 2; ++bj) { const f32x4 v0 = acc[ai][bj][m][0] * gt, v1 = acc[ai][bj][m][1] * gt;
                    u32x4 w; w.x = cvt_pk_bf16(v0[0], v0[1]); w.y = cvt_pk_bf16(v0[2], v0[3]); w.z = cvt_pk_bf16(v1[0], v1[1]); w.w = cvt_pk_bf16(v1[2], v1[3]);
                    *(u32x4*)(rowp + bj * HALF) = w; } }
    }
};
struct EpiPleF32 {
    static constexpr bool PERM = false, AFTER_DRAIN = false;
    float* H; const bf16_t* PL;
    __device__ __forceinline__ void operator()(const f32x4 (&acc)[2][2][4][2], const Unit& u, int wr, int wc, int fr, int fq) const {
        typedef unsigned u32x2v __attribute__((ext_vector_type(2)));
        const int row0 = u.pm * BM + wr * 64 + fr, col0 = u.pn * BM + wc * 32 + 4 * fq;
#pragma unroll
        for (int ai = 0; ai < 2; ++ai)
#pragma unroll
            for (int m = 0; m < 4; ++m) { const size_t off = (size_t)(row0 + ai * HALF + m * 16) * 2048 + col0;
                f32x4 h[2][2]; u32x2v p[2][2];
#pragma unroll
                for (int bj = 0; bj < 2; ++bj)
#pragma unroll
                    for (int n = 0; n < 2; ++n) { h[bj][n] = *(const f32x4*)(H + off + bj * HALF + n * 16); p[bj][n] = *(const u32x2v*)(PL + off + bj * HALF + n * 16); }
#pragma unroll
                for (int bj = 0; bj < 2; ++bj)
#pragma unroll
                    for (int n = 0; n < 2; ++n) { const f32x4 a = acc[ai][bj][m][n]; f32x4 pl; pl[0] = __uint_as_float(p[bj][n].x << 16); pl[1] = __uint_as_float(p[bj][n].x & 0xffff0000u); pl[2] = __uint_as_float(p[bj][n].y << 16); pl[3] = __uint_as_float(p[bj][n].y & 0xffff0000u);
                        f32x4 o;
#pragma unroll
                        for (int j = 0; j < 4; ++j) o[j] = h[bj][n][j] + __builtin_amdgcn_rcpf(1.0f + __expf(-a[j])) * pl[j];
                        *(f32x4*)(H + off + bj * HALF + n * 16) = o; }
                asm volatile("" ::: "memory"); }
    }
};
template <class Epi, class Sched, bool STAMP = false>
__device__ __forceinline__ void gemm_phase(PG8_LAS unsigned char* lds, const Gemm g, const Sched& S, const Epi& E, unsigned long long* stamps) {
    int tid_ = threadIdx.x; asm volatile("" : "+v"(tid_));
    const int tid = tid_, wid = __builtin_amdgcn_readfirstlane(tid >> 6), lane = tid & 63, wr = wid >> 2, wc = wid & 3, fr = lane & 15, fq = lane >> 4;
    const int K = g.K, nt = K / BK;
    int ts_lo = 0, ts_hi = 0, nts = 0; const unsigned long long rt_entry = STAMP ? (unsigned long long)wall_clock64() : 0ull;
#define PG8_STAMP() do { if (STAMP && wid == 0 && nts < 64) { const unsigned long long _c = (unsigned long long)clock64(); \
        ts_lo = (lane == nts) ? (int)(unsigned)_c : ts_lo; ts_hi = (lane == nts) ? (int)(unsigned)(_c >> 32) : ts_hi; ++nts; } } while (0)
    PG8_STAMP();
    unsigned voffA[2], voffB[2];
#pragma unroll
    for (int i = 0; i < 2; ++i) { int R, C; stage_rc(tid * 16 + i * 8192, R, C); const int Rb = Epi::PERM ? ((R & ~31) + perm32(R & 31)) : R;
        voffA[i] = (unsigned)(R * K + C) * 2u; voffB[i] = (unsigned)(Rb * K + C) * 2u; }
    const size_t kstep = (size_t)(BK * 2);
    const size_t hstep = (size_t)HALF * K * 2;
    const size_t tstep = 2 * hstep;
    const unsigned ldsw = (unsigned)wid * 1024u;
    const int aoff = lds_byte(wr * 64 + fr, fq * 8), boff = lds_byte(wc * 32 + fr, fq * 8);
#define PG8_SA(b, h) (((b) * 2 + (h)) * HTB)
#define PG8_SB(b, h) ((4 + (b) * 2 + (h)) * HTB)
#define PG8_STAGE(bufoff, gbase, voff) do { _Pragma("unroll") for (int _i = 0; _i < 2; ++_i) \
        __builtin_amdgcn_global_load_lds((const unsigned*)((const char*)(gbase) + (voff)[_i]), (PG8_LAS unsigned*)(lds + (bufoff) + ldsw + _i * 8192), 16, 0, 0); } while (0)
#define PG8_LDA(dst, b, h) do { _Pragma("unroll") for (int m = 0; m < 4; ++m) _Pragma("unroll") for (int k = 0; k < 2; ++k) dst[m][k] = *(const PG8_LAS bf16x8*)(lds + PG8_SA(b, h) + aoff + m * 2048 + k * 1024); } while (0)
#define PG8_LDB(dst, b, h) do { _Pragma("unroll") for (int n = 0; n < 2; ++n) _Pragma("unroll") for (int k = 0; k < 2; ++k) dst[n][k] = *(const PG8_LAS bf16x8*)(lds + PG8_SB(b, h) + boff + n * 2048 + k * 1024); } while (0)
#define PG8_MMA(ai, bj, At, Bt) do { __builtin_amdgcn_s_setprio(1); _Pragma("unroll") for (int m = 0; m < 4; ++m) _Pragma("unroll") for (int n = 0; n < 2; ++n) _Pragma("unroll") for (int k = 0; k < 2; ++k) \
        acc[ai][bj][m][n] = __builtin_amdgcn_mfma_f32_16x16x32_bf16(Bt[n][k], At[m][k], acc[ai][bj][m][n], 0, 0, 0); __builtin_amdgcn_s_setprio(0); } while (0)
#define PG8_WAIT_V(n) asm volatile("s_waitcnt vmcnt(" #n ")" ::: "memory")
#define PG8_WAIT_L(n) asm volatile("s_waitcnt lgkmcnt(" #n ")" ::: "memory")
#define PG8_BAR __builtin_amdgcn_s_barrier()
#define PG8_SCHED __builtin_amdgcn_sched_barrier(0)
    Unit cur, nxt; int ui = 0;
    if (!S.next(0, cur)) return;
    f32x4 acc[2][2][4][2];
#pragma unroll
    for (int a = 0; a < 2; ++a)
#pragma unroll
        for (int b = 0; b < 2; ++b)
#pragma unroll
            for (int m = 0; m < 4; ++m)
#pragma unroll
                for (int n = 0; n < 2; ++n) acc[a][b][m][n] = (f32x4){0.f, 0.f, 0.f, 0.f};
    bf16x8 At[4][2], B0[2][2], B1[2][2];
    const char* cA = (const char*)g.A + (size_t)cur.pm * tstep; const char* cB = (const char*)g.Bt + (size_t)cur.pn * tstep;
    S.a_ready(cur);
    PG8_STAGE(PG8_SB(0, 0), cB, voffB); PG8_STAGE(PG8_SA(0, 0), cA, voffA); PG8_STAGE(PG8_SB(0, 1), cB + hstep, voffB); PG8_STAGE(PG8_SA(0, 1), cA + hstep, voffA);
    if (wr == 1) PG8_BAR;
    PG8_WAIT_V(4); PG8_BAR;
    PG8_STAGE(PG8_SB(1, 0), cB + kstep, voffB); PG8_STAGE(PG8_SA(1, 0), cA + kstep, voffA); PG8_STAGE(PG8_SB(1, 1), cB + hstep + kstep, voffB);
    PG8_WAIT_V(6); PG8_BAR;
    PG8_STAMP();
    for (;;) {
        const bool has_next = S.next(ui + 1, nxt);
        const char* nA = has_next ? (const char*)g.A + (size_t)nxt.pm * tstep : cA; const char* nB = has_next ? (const char*)g.Bt + (size_t)nxt.pn * tstep : cB;
        for (int t = 0; t < nt; t += 2) {
            const bool last = (t == nt - 2);
            const char* a1 = cA + (size_t)(t + 1) * kstep;
            const char* a2 = last ? nA : cA + (size_t)(t + 2) * kstep; const char* b2 = last ? nB : cB + (size_t)(t + 2) * kstep;
            const char* a3 = a2 + kstep; const char* b3 = b2 + kstep;
            if (last && has_next) S.a_ready(nxt);
            PG8_LDB(B0, 0, 0); PG8_SCHED; PG8_LDA(At, 0, 0); PG8_STAGE(PG8_SA(1, 1), a1 + hstep, voffA);
            PG8_WAIT_L(8); PG8_BAR; PG8_WAIT_L(0); PG8_MMA(0, 0, At, B0); PG8_BAR; PG8_SCHED;
            PG8_LDB(B1, 0, 1); PG8_STAGE(PG8_SB(0, 0), b2, voffB);
            PG8_BAR; PG8_WAIT_L(0); PG8_MMA(0, 1, At, B1); PG8_BAR;
            PG8_LDA(At, 0, 1); PG8_STAGE(PG8_SA(0, 0), a2, voffA);
            PG8_BAR; PG8_WAIT_L(0); PG8_MMA(1, 0, At, B0); PG8_BAR; PG8_SCHED;
            PG8_STAGE(PG8_SB(0, 1), b2 + hstep, voffB);
            PG8_WAIT_V(6); PG8_BAR; PG8_MMA(1, 1, At, B1); PG8_BAR;
            PG8_LDB(B0, 1, 0); PG8_SCHED; PG8_LDA(At, 1, 0); PG8_STAGE(PG8_SA(0, 1), a2 + hstep, voffA);
            PG8_WAIT_L(8); PG8_BAR; PG8_WAIT_L(0); PG8_MMA(0, 0, At, B0); PG8_BAR; PG8_SCHED;
            PG8_LDB(B1, 1, 1); PG8_STAGE(PG8_SB(1, 0), b3, voffB);
            PG8_BAR; PG8_WAIT_L(0); PG8_MMA(0, 1, At, B1); PG8_BAR;
            PG8_LDA(At, 1, 1); PG8_STAGE(PG8_SA(1, 0), a3, voffA);
            PG8_BAR; PG8_WAIT_L(0); PG8_MMA(1, 0, At, B0); PG8_BAR; PG8_SCHED;
            PG8_STAGE(PG8_SB(1, 1), b3 + hstep, voffB);
            PG8_WAIT_V(6); PG8_BAR; PG8_MMA(1, 1, At, B1); PG8_BAR;
        }
        PG8_STAMP();
        if constexpr (!Epi::AFTER_DRAIN) { E(acc, cur, wr, wc, fr, fq); S.done(cur); }
        PG8_STAMP();
        if (!has_next) break;
#pragma unroll
        for (int a = 0; a < 2; ++a)
#pragma unroll
            for (int b = 0; b < 2; ++b)
#pragma unroll
                for (int m = 0; m < 4; ++m)
#pragma unroll
                    for (int n = 0; n < 2; ++n) acc[a][b][m][n] = (f32x4){0.f, 0.f, 0.f, 0.f};
        cur = nxt; cA = nA; cB = nB; ++ui;
    }
    PG8_WAIT_V(0);
    if (wr == 0) PG8_BAR;
    PG8_BAR;
    if constexpr (Epi::AFTER_DRAIN) { E.fused(acc, cur, wr, wc, fr, fq, lds, wid, lane); S.done(cur); }
    PG8_STAMP();
    if (STAMP && wid == 0) { stamps[lane] = lane < nts ? (((unsigned long long)(unsigned)ts_hi << 32) | (unsigned)ts_lo) : 0ull;
        if (lane == 62) stamps[62] = rt_entry; if (lane == 63) stamps[63] = (unsigned long long)wall_clock64(); }
#undef PG8_STAMP
#undef PG8_SA
#undef PG8_SB
#undef PG8_STAGE
#undef PG8_LDA
#undef PG8_LDB
#undef PG8_MMA
#undef PG8_WAIT_V
#undef PG8_WAIT_L
#undef PG8_BAR
#undef PG8_SCHED
}
}


namespace attn {
using bf16 = unsigned short;
constexpr int   D = 128, NW = 8, QBLK = 32, KVBLK = 64;
constexpr float SCALE = 0.088388347648318440f;
constexpr float THR = 8.f;
constexpr int SDEPTH = 2;
constexpr int LDQ = 5120, LDK = 5120, LDO = 2048;
constexpr size_t SHM_V = KVBLK * D * 2, SHM_K = KVBLK * D * 2, SHM_ATTN = 2 * SHM_V + 2 * SHM_K + NW * 64 * 4;
using bf16x8 = __attribute__((ext_vector_type(8))) short;
using s16x4  = __attribute__((ext_vector_type(4))) short;
using f32x16 = __attribute__((ext_vector_type(16))) float;
using f32x8  = __attribute__((ext_vector_type(8))) float;
using u32x4  = __attribute__((ext_vector_type(4))) unsigned;
#define KSWZ(row, colB) ((row) * 256 + ((colB) ^ (((row) & 7) << 4)))
#define SBAR() __builtin_amdgcn_sched_barrier(0)
__device__ __forceinline__ int crow(int r, int hi) { return (r & 3) + 8 * (r >> 2) + 4 * hi; }
__device__ __forceinline__ unsigned cvtpk(float lo, float hi) {
  unsigned r; asm volatile("v_cvt_pk_bf16_f32 %0, %1, %2" : "=v"(r) : "v"(lo), "v"(hi)); return r;
}
template <typename TIn> struct Stage;
template <> struct Stage<bf16>  { using T = bf16x8;
  __device__ static __forceinline__ T ld8(const bf16* p) { return *reinterpret_cast<const bf16x8*>(p); }
  __device__ static __forceinline__ bf16x8 tobf(T x) { return x; } };
template <> struct Stage<float> { using T = f32x8;
  __device__ static __forceinline__ T ld8(const float* p) { return *reinterpret_cast<const f32x8*>(p); }
  __device__ static __forceinline__ bf16x8 tobf(T x) {
    u32x4 w = {cvtpk(x[0], x[1]), cvtpk(x[2], x[3]), cvtpk(x[4], x[5]), cvtpk(x[6], x[7])}; return *reinterpret_cast<bf16x8*>(&w); } };

__device__ __forceinline__ void partialSM(f32x16& p0, f32x16& p1, float& m_reg, float& mn, float& alpha) {
  constexpr float C = SCALE * 1.4426950408889634f;
  float pmax = p0[0]; for (int r = 1; r < 16; ++r) pmax = fmaxf(pmax, p0[r]); for (int r = 0; r < 16; ++r) pmax = fmaxf(pmax, p1[r]);
  { auto rr = __builtin_amdgcn_permlane32_swap(__float_as_uint(pmax), __float_as_uint(pmax), false, false);
    pmax = fmaxf(__uint_as_float(rr[0]), __uint_as_float(rr[1])); }
  if (__builtin_expect(__all(pmax - m_reg <= THR / SCALE), 1)) { mn = m_reg; alpha = 1.f; }
  else { mn = fmaxf(m_reg, pmax); alpha = __builtin_amdgcn_exp2f((m_reg - mn) * C); m_reg = mn; }
  float mnC = -mn * C;
  for (int r = 0; r < 16; ++r) p0[r] = fmaf(p0[r], C, mnC); for (int r = 0; r < 16; ++r) p1[r] = fmaf(p1[r], C, mnC);
  for (int r = 0; r < 16; ++r) p0[r] = __builtin_amdgcn_exp2f(p0[r]);
}
__device__ __forceinline__ void finishSM(f32x16& p0, f32x16& p1, float alpha, float& l_reg, bf16x8& pa0, bf16x8& pa1, bf16x8& pa2, bf16x8& pa3) {
  for (int r = 0; r < 16; ++r) p1[r] = __builtin_amdgcn_exp2f(p1[r]);
  float ps = 0; for (int r = 0; r < 16; ++r) ps += p0[r]; for (int r = 0; r < 16; ++r) ps += p1[r];
  { auto rr = __builtin_amdgcn_permlane32_swap(__float_as_uint(ps), __float_as_uint(ps), false, false);
    ps = __uint_as_float(rr[0]) + __uint_as_float(rr[1]); }
  l_reg = l_reg * alpha + ps;
#define PK4(P, BASE, OUT) do { unsigned a0 = cvtpk(P[BASE + 0], P[BASE + 1]), a1 = cvtpk(P[BASE + 2], P[BASE + 3]);   \
    unsigned b0 = cvtpk(P[BASE + 4], P[BASE + 5]), b1 = cvtpk(P[BASE + 6], P[BASE + 7]);                              \
    auto r0 = __builtin_amdgcn_permlane32_swap(a0, b0, false, false); auto r1 = __builtin_amdgcn_permlane32_swap(a1, b1, false, false); \
    u32x4 w = {r0[0], r1[0], r0[1], r1[1]}; OUT = *reinterpret_cast<bf16x8*>(&w); } while (0)
  PK4(p0, 0, pa0); PK4(p0, 8, pa1); PK4(p1, 0, pa2); PK4(p1, 8, pa3);
#undef PK4
}
__device__ __forceinline__ void qkt(f32x16& p0, f32x16& p1, const bf16* Ks, const bf16x8* qr, int r32, int hi) {
  p0 = f32x16{}; p1 = f32x16{};
  for (int d0 = 0; d0 < 8; ++d0) { int cb = (d0 * 16 + hi * 8) * 2;
    bf16x8 b0 = *reinterpret_cast<const bf16x8*>((const char*)Ks + KSWZ(r32, cb));
    bf16x8 b1 = *reinterpret_cast<const bf16x8*>((const char*)Ks + KSWZ(32 + r32, cb));
    p0 = __builtin_amdgcn_mfma_f32_32x32x16_bf16(b0, qr[d0], p0, 0, 0, 0);
    p1 = __builtin_amdgcn_mfma_f32_32x32x16_bf16(b1, qr[d0], p1, 0, 0, 0); }
}
__device__ __forceinline__ int v_st(int k, int c) { const int kk = (k & ~0xC) | ((k & 4) << 1) | ((k & 8) >> 1); return ((kk >> 3) * 4 + (c >> 5)) * 512 + ((kk & 7) * 32 + (c & 31)) * 2; }
__device__ __forceinline__ int v_rd_base(int lane) { return ((lane & 3) << 3) | (((lane >> 2) & 3) << 6) | (((lane >> 4) & 1) << 5) | (((lane >> 5) & 1) << 8); }
constexpr int v_rd_off(int d0, int ks, int half) { return d0 * 512 + ks * 4096 + half * 2048; }
template <int OFF> __device__ __forceinline__ s16x4 tr_read(int vb) {
  s16x4 r; asm volatile("ds_read_b64_tr_b16 %0, %1 offset:%2" : "=&v"(r) : "v"(vb), "i"(OFF) : "memory"); return r;
}
template <int D0> __device__ __forceinline__ void pv_one(f32x16& od, int vb, bf16x8 pa0, bf16x8 pa1, bf16x8 pa2, bf16x8 pa3) {
  const s16x4 l0 = tr_read<v_rd_off(D0, 0, 0)>(vb), h0 = tr_read<v_rd_off(D0, 0, 1)>(vb), l1 = tr_read<v_rd_off(D0, 1, 0)>(vb), h1 = tr_read<v_rd_off(D0, 1, 1)>(vb);
  const s16x4 l2 = tr_read<v_rd_off(D0, 2, 0)>(vb), h2 = tr_read<v_rd_off(D0, 2, 1)>(vb), l3 = tr_read<v_rd_off(D0, 3, 0)>(vb), h3 = tr_read<v_rd_off(D0, 3, 1)>(vb);
  asm volatile("s_waitcnt lgkmcnt(0)" ::: "memory"); SBAR();
#define PK(L, H) (bf16x8){L[0], L[1], L[2], L[3], H[0], H[1], H[2], H[3]}
  od = __builtin_amdgcn_mfma_f32_32x32x16_bf16(pa0, PK(l0, h0), od, 0, 0, 0);
  od = __builtin_amdgcn_mfma_f32_32x32x16_bf16(pa1, PK(l1, h1), od, 0, 0, 0);
  od = __builtin_amdgcn_mfma_f32_32x32x16_bf16(pa2, PK(l2, h2), od, 0, 0, 0);
  od = __builtin_amdgcn_mfma_f32_32x32x16_bf16(pa3, PK(l3, h3), od, 0, 0, 0);
#undef PK
}
__device__ __forceinline__ void pv_d0(f32x16* o, int vb, bf16x8 pa0, bf16x8 pa1, bf16x8 pa2, bf16x8 pa3) {
  pv_one<0>(o[0], vb, pa0, pa1, pa2, pa3); pv_one<1>(o[1], vb, pa0, pa1, pa2, pa3); pv_one<2>(o[2], vb, pa0, pa1, pa2, pa3); pv_one<3>(o[3], vb, pa0, pa1, pa2, pa3);
}

template <typename TQ>
__device__ __forceinline__ void attn_dense_body(const TQ* __restrict__ Qb, const bf16* __restrict__ Kh, const bf16* __restrict__ Vh,
                                                float* __restrict__ Ob, int seq, char* lds) {
  using St = Stage<bf16>; using SQ = Stage<TQ>;
  int tid_ = threadIdx.x; asm volatile("" : "+v"(tid_));
  const int tid = tid_, wid = tid >> 6, lane = tid & 63, r32 = lane & 31, hi = lane >> 5;
  bf16* V_lds = (bf16*)lds; bf16* K_lds = (bf16*)(lds + 2 * SHM_V);
  float* ws = (float*)(lds + 2 * SHM_V + 2 * SHM_K) + wid * 64; float* li_l = ws; float* al_l = ws + 32;
  float m_reg = -1e30f, l_reg = 0; f32x16 o[4] = {}; bf16x8 qr[8];
  const TQ* Qw = Qb + (long)(wid * QBLK + r32) * LDQ + hi * 8;
#pragma unroll
  for (int d0 = 0; d0 < 8; ++d0) qr[d0] = SQ::tobf(SQ::ld8(Qw + d0 * 16));
  const int sr = tid >> 4, sc = (tid & 15) * 8, vst0 = v_st(sr, sc), vst1 = v_st(32 + sr, sc);
  const int vb0 = (int)(uintptr_t)V_lds + v_rd_base(lane);
  struct { typename St::T vs0, vs1, ks0, ks1; } sr_[SDEPTH];
#define SLOAD(i, k0) do { sr_[i].vs0 = St::ld8(&Vh[(long)((k0) + sr) * LDK + sc]); sr_[i].vs1 = St::ld8(&Vh[(long)((k0) + 32 + sr) * LDK + sc]); \
    sr_[i].ks0 = St::ld8(&Kh[(long)((k0) + sr) * LDK + sc]); sr_[i].ks1 = St::ld8(&Kh[(long)((k0) + 32 + sr) * LDK + sc]); } while (0)
#define SWRITE(b, i) do { *(bf16x8*)((char*)V_lds + (b) * SHM_V + vst0) = St::tobf(sr_[i].vs0);          \
    *(bf16x8*)((char*)V_lds + (b) * SHM_V + vst1) = St::tobf(sr_[i].vs1); int kc = sc * 2;               \
    *(bf16x8*)((char*)K_lds + (b) * SHM_K + KSWZ(sr, kc)) = St::tobf(sr_[i].ks0);                       \
    *(bf16x8*)((char*)K_lds + (b) * SHM_K + KSWZ(32 + sr, kc)) = St::tobf(sr_[i].ks1); } while (0)
#define SWAIT() do { if constexpr (SDEPTH == 2) asm volatile("s_waitcnt vmcnt(4)" ::: "memory"); else asm volatile("s_waitcnt vmcnt(0)" ::: "memory"); } while (0)
#define RESC(a) do { if (__any((a) < 1.f)) { if (hi == 0) al_l[r32] = (a); asm volatile("s_waitcnt lgkmcnt(0)" ::: "memory"); \
    for (int d = 0; d < 4; ++d) for (int r = 0; r < 16; ++r) o[d][r] *= al_l[crow(r, hi)]; } } while (0)
  f32x16 pA0, pA1, pB0, pB1; float mnA, mnB, alA, alB; bf16x8 pa0, pa1, pa2, pa3; const int NT = seq / KVBLK;
  constexpr int SE = 0, SO = SDEPTH - 1;
  SLOAD(SE, 0); asm volatile("s_waitcnt vmcnt(0)" ::: "memory"); SWRITE(0, SE); __syncthreads();
  qkt(pA0, pA1, K_lds, qr, r32, hi); partialSM(pA0, pA1, m_reg, mnA, alA);
  SLOAD(SO, KVBLK); if constexpr (SDEPTH == 2) { if (2 < NT) SLOAD(SE, 2 * KVBLK); }
  SWAIT(); SWRITE(1, SO); __syncthreads();
  for (int j = 1; j + 1 < NT; j += 2) {
    SBAR(); qkt(pB0, pB1, (bf16*)((char*)K_lds + SHM_K), qr, r32, hi);
    finishSM(pA0, pA1, alA, l_reg, pa0, pa1, pa2, pa3); SBAR();
    SLOAD(SO, (j + SDEPTH) * KVBLK); SBAR();
    pv_d0(o, vb0, pa0, pa1, pa2, pa3); partialSM(pB0, pB1, m_reg, mnB, alB);
    __syncthreads(); SWAIT(); SWRITE(0, SE);
    RESC(alB); __syncthreads();
    SBAR(); qkt(pA0, pA1, K_lds, qr, r32, hi);
    finishSM(pB0, pB1, alB, l_reg, pa0, pa1, pa2, pa3); SBAR();
    if (SDEPTH == 1 || j + 3 < NT) SLOAD(SE, (j + 1 + SDEPTH) * KVBLK); SBAR();
    pv_d0(o, vb0 + (int)SHM_V, pa0, pa1, pa2, pa3); partialSM(pA0, pA1, m_reg, mnA, alA);
    __syncthreads(); SWAIT(); SWRITE(1, SO);
    RESC(alA); __syncthreads();
  }
  SBAR(); qkt(pB0, pB1, (bf16*)((char*)K_lds + SHM_K), qr, r32, hi);
  finishSM(pA0, pA1, alA, l_reg, pa0, pa1, pa2, pa3); SBAR();
  pv_d0(o, vb0, pa0, pa1, pa2, pa3); partialSM(pB0, pB1, m_reg, mnB, alB);
  __syncthreads(); RESC(alB);
  finishSM(pB0, pB1, alB, l_reg, pa0, pa1, pa2, pa3); SBAR();
  pv_d0(o, vb0 + (int)SHM_V, pa0, pa1, pa2, pa3);
  if (hi == 0) li_l[r32] = l_reg; asm volatile("s_waitcnt lgkmcnt(0)" ::: "memory");
  float rli[16];
#pragma unroll
  for (int r = 0; r < 16; ++r) rli[r] = __builtin_amdgcn_rcpf(li_l[crow(r, hi)]);
  float* Ow = Ob + (long)(wid * QBLK) * LDO;
#pragma unroll
  for (int r = 0; r < 16; ++r) { int orow = crow(r, hi);
    for (int d0 = 0; d0 < 4; ++d0) Ow[(long)orow * LDO + d0 * 32 + r32] = o[d0][r] * rli[r]; }
#undef SLOAD
#undef SWRITE
#undef SWAIT
#undef RESC
}

}

template <class Epi>
__device__ __forceinline__ void naive_gemm(Frame& F, const bf16* __restrict__ A, int lda, const bf16* __restrict__ Bt, int ldb, int M, int N, int K, const Epi& epi) {
    LAS float* As = (LAS float*)F.lds;
    LAS float* Bs = As + 32 * 132;
    const int tid = F.tid, tm = tid >> 4, tn = tid & 15;
    const int ntm = M / 128, ntn = N / 64;
    for (int tile = F.vcu; tile < ntm * ntn; tile += F.G) {
        const int pm = tile / ntn, pn = tile % ntn;
        float acc[4][4];
#pragma unroll
        for (int i = 0; i < 4; ++i)
#pragma unroll
            for (int j = 0; j < 4; ++j) acc[i][j] = 0.f;
        for (int k0 = 0; k0 < K; k0 += 32) {
            { const int r = tid >> 2, ks = (tid & 3) * 8; const bf16x8 v = *(const bf16x8*)(A + (size_t)(pm * 128 + r) * lda + k0 + ks);
#pragma unroll
              for (int j = 0; j < 8; ++j) As[(ks + j) * 132 + r] = bf2f((bf16)v[j]); }
            if (tid < 256) { const int r = tid >> 2, ks = (tid & 3) * 8; const bf16x8 v = *(const bf16x8*)(Bt + (size_t)(pn * 64 + r) * ldb + k0 + ks);
#pragma unroll
              for (int j = 0; j < 8; ++j) Bs[(ks + j) * 68 + r] = bf2f((bf16)v[j]); }
            __syncthreads();
#pragma unroll 8
            for (int kk = 0; kk < 32; ++kk) { const f32x4 a = *(const LAS f32x4*)(As + kk * 132 + tm * 4); const f32x4 b = *(const LAS f32x4*)(Bs + kk * 68 + tn * 4);
#pragma unroll
                for (int i = 0; i < 4; ++i)
#pragma unroll
                    for (int j = 0; j < 4; ++j) acc[i][j] = fmaf(a[i], b[j], acc[i][j]); }
            __syncthreads();
        }
#pragma unroll
        for (int i = 0; i < 4; ++i)
#pragma unroll
            for (int j = 0; j < 4; ++j) epi(pm * 128 + tm * 4 + i, pn * 64 + tn * 4 + j, acc[i][j]);
    }
}

__device__ __forceinline__ void phase_post(Frame& F, int l) {
    bf16* PROJ = WSP(bf16, WS_PROJ);
    const float2* TA = WSP(float2, WS_TABA); const float2* TB = WSP(float2, WS_TABB);
    const float* qn = F.in[5] + l * HD; const float* kn = F.in[6] + l * HD;
    const int gw = F.vcu * NWAVES + F.wave, NGW = F.G * NWAVES, lane = F.lane;
    for (int t = gw; t < T; t += NGW) {
        const int s = t & (SEQ - 1);
        bf16* row = PROJ + (size_t)t * DINP;
#pragma unroll
        for (int u = 0; u < 2; ++u) { const int pr = lane + 64 * u, sg = pr >> 4, i = pr & 15; const int base = (sg < 4 ? COL_AQ + sg * HD : COL_AK + (sg - 4) * HD);
            const float x1 = bf2f(row[base + i]), x2 = bf2f(row[base + i + 16]); const float2 cs = TA[s * 16 + i];
            row[base + i] = (bf16)f2bf(x1 * cs.x - x2 * cs.y); row[base + i + 16] = (bf16)f2bf(x2 * cs.x + x1 * cs.y); }
        const int hf = lane >> 5, i = lane & 31; const int pos = hf == 0 ? (s >> 6) : (s & 63); const float2 cs = TB[pos * 32 + i];
        for (int hh = 0; hh < 10; ++hh) { const int base = hh < 8 ? COL_BQ + hh * HD : COL_BK + (hh - 8) * HD; const float* gn = hh < 8 ? qn : kn;
            float x1 = bf2f(row[base + hf * 64 + i]), x2 = bf2f(row[base + hf * 64 + i + 32]);
            const float rs = rsqrtf(wave_sum(x1 * x1 + x2 * x2) * (1.0f / HD) + EPS);
            x1 = x1 * rs * gn[hf * 64 + i]; x2 = x2 * rs * gn[hf * 64 + i + 32];
            row[base + hf * 64 + i] = (bf16)f2bf(x1 * cs.x - x2 * cs.y); row[base + hf * 64 + i + 32] = (bf16)f2bf(x2 * cs.x + x1 * cs.y); }
    }
}
__device__ __forceinline__ void phase_dn_prep_naive(Frame& F, int l) {
    const bf16* PROJ = WSP(bf16, WS_PROJ); const float* TL = WSP(float, WS_TL);
    float* DQ = WSP(float, WS_DQ); float* DK = WSP(float, WS_DK); float* DV = WSP(float, WS_DV); float* DB = WSP(float, WS_DB); float* DG = WSP(float, WS_DG);
    const float* cw = F.in[4] + (size_t)l * 5 * 1536;
    const int gw = F.vcu * NWAVES + F.wave, NGW = F.G * NWAVES, lane = F.lane;
    for (int t = gw; t < T; t += NGW) {
        const int s = t & (SEQ - 1);
#pragma unroll 1
        for (int g = 0; g < 12; ++g) {
            float val[2];
#pragma unroll
            for (int u = 0; u < 2; ++u) { const int c = 128 * g + 64 * u + lane; float a = 0.f;
#pragma unroll
                for (int j = 0; j < 5; ++j) { const int sp = s - 2 + j; if (sp >= 0 && sp < SEQ) a += bf2f(PROJ[(size_t)(t - 2 + j) * DINP + COL_CQKV + c]) * cw[j * 1536 + c]; }
                val[u] = siluf_(a); }
            float* dst = g < 4 ? DQ : (g < 8 ? DK : DV);
            if (g < 8) { const float ss = wave_sum(val[0] * val[0] + val[1] * val[1]); const float rs = rsqrtf(ss + EPS) * (g < 4 ? 0.08838834764831845f : 1.0f); val[0] *= rs; val[1] *= rs; }
            dst[(size_t)t * 512 + (g & 3) * 128 + lane] = val[0]; dst[(size_t)t * 512 + (g & 3) * 128 + 64 + lane] = val[1];
        }
        if (lane < 8) { const int dir = lane >> 2, hh = lane & 3; const float bl = TL[(size_t)t * 16 + dir * 4 + hh], al = TL[(size_t)t * 16 + 8 + dir * 4 + hh];
            const float A = expf(F.in[9][(l * 2 + dir) * 4 + hh]); const float dtb = F.in[10][(l * 2 + dir) * 4 + hh];
            DB[((size_t)dir * T + t) * 4 + hh] = sigmoidf_(bl); DG[((size_t)dir * T + t) * 4 + hh] = -A * softplusf_(al + dtb); }
    }
}

__device__ __forceinline__ void dn_chain_naive(Frame& F, int chain) {
    const int dir = chain >> 3, b = (chain >> 2) & 1, hh = chain & 3;
    const float* DQ = WSP(float, WS_DQ); const float* DK = WSP(float, WS_DK); const float* DV = WSP(float, WS_DV); const float* DB = WSP(float, WS_DB); const float* DG = WSP(float, WS_DG);
    float* DO = WSP(float, WS_DO);
    LAS float* kb = (LAS float*)F.lds; LAS float* qb = kb + 64 * 128; LAS float* vb = qb + 64 * 128; LAS float* bb = vb + 64 * 128; LAS float* gb = bb + 64;
    const int tid = F.tid, v = tid >> 2, kq = tid & 3;
    float S[32];
#pragma unroll
    for (int j = 0; j < 32; ++j) S[j] = 0.f;
    for (int c0 = 0; c0 < SEQ; c0 += 64) {
        __syncthreads();
        for (int idx = tid; idx < 64 * 128; idx += NTHR) { const int i = idx >> 7, d = idx & 127; const int sq = c0 + i, pos = dir ? SEQ - 1 - sq : sq; const size_t o = (size_t)(b * SEQ + pos) * 512 + hh * 128 + d;
            kb[idx] = DK[o]; qb[idx] = DQ[o]; vb[idx] = DV[o]; }
        if (tid < 64) { const int sq = c0 + tid, pos = dir ? SEQ - 1 - sq : sq; const size_t o = ((size_t)dir * T + b * SEQ + pos) * 4 + hh; bb[tid] = DB[o]; gb[tid] = DG[o]; }
        __syncthreads();
        for (int i = 0; i < 64; ++i) {
            const float a = expf(gb[i]), beta = bb[i];
            float ks = 0.f;
#pragma unroll
            for (int j = 0; j < 32; ++j) ks = fmaf(kb[i * 128 + kq * 32 + j], S[j], ks);
            ks += __shfl_xor(ks, 1); ks += __shfl_xor(ks, 2);
            const float vn = beta * (vb[i * 128 + v] - a * ks);
            float o = 0.f;
#pragma unroll
            for (int j = 0; j < 32; ++j) { S[j] = fmaf(kb[i * 128 + kq * 32 + j], vn, a * S[j]); o = fmaf(qb[i * 128 + kq * 32 + j], S[j], o); }
            o += __shfl_xor(o, 1); o += __shfl_xor(o, 2);
            if (kq == 0) { const int sq = c0 + i, pos = dir ? SEQ - 1 - sq : sq; DO[((size_t)dir * T + b * SEQ + pos) * 512 + hh * 128 + v] = o; }
        }
    }
    __syncthreads();
}
struct AttnAcc { float m, l, o0, o1; };
__device__ __forceinline__ void attn_key(AttnAcc& st, float q0, float q1, const bf16* krow, const bf16* vrow, int lane) {
    const unsigned kw = *(const unsigned*)(krow + 2 * lane), vw = *(const unsigned*)(vrow + 2 * lane);
    const float sc = wave_sum(q0 * __uint_as_float(kw << 16) + q1 * __uint_as_float(kw & 0xffff0000u)) * 0.08838834764831845f;
    const float mn = fmaxf(st.m, sc), al = __expf(st.m - mn), p = __expf(sc - mn);
    st.l = st.l * al + p; st.o0 = st.o0 * al + p * __uint_as_float(vw << 16); st.o1 = st.o1 * al + p * __uint_as_float(vw & 0xffff0000u); st.m = mn;
}
__device__ __forceinline__ void phase_mix_naive(Frame& F) {
    const bf16* PROJ = WSP(bf16, WS_PROJ); float* YMIX = WSP(float, WS_YMIX);
    if (F.vcu < 16) dn_chain_naive(F, F.vcu);
    const int gw = F.vcu * NWAVES + F.wave, NGW = F.G * NWAVES, lane = F.lane;
    for (int u = gw; u < T * 4; u += NGW) { const int t = u >> 2, hh = u & 3, b = t >> 12, s = t & (SEQ - 1);
        const unsigned qw = *(const unsigned*)(PROJ + (size_t)t * DINP + COL_AQ + hh * HD + 2 * lane); const float q0 = __uint_as_float(qw << 16), q1 = __uint_as_float(qw & 0xffff0000u);
        AttnAcc st{-1e30f, 0.f, 0.f, 0.f};
        for (int pat = 0; pat < 3; ++pat) { const int dil = pat == 0 ? 1 : (pat == 1 ? 4 : 16);
            for (int dlt = -64; dlt <= 64; ++dlt) { const int sp = s + dil * dlt; if (sp < 0 || sp >= SEQ) continue;
                const bf16* kr = PROJ + (size_t)(b * SEQ + sp) * DINP; attn_key(st, q0, q1, kr + COL_AK + hh * HD, kr + COL_AV + hh * HD, lane); } }
        const float inv = 1.0f / st.l; *(float2*)(YMIX + (size_t)t * DM + hh * HD + 2 * lane) = make_float2(st.o0 * inv, st.o1 * inv); }
    if (NAIVE_ATTN_B) for (int u = gw; u < T * 8; u += NGW) { const int t = u >> 3, hq = u & 7, kvh = hq >> 2, b = t >> 12;
        const unsigned qw = *(const unsigned*)(PROJ + (size_t)t * DINP + COL_BQ + hq * HD + 2 * lane); const float q0 = __uint_as_float(qw << 16), q1 = __uint_as_float(qw & 0xffff0000u);
        AttnAcc st{-1e30f, 0.f, 0.f, 0.f};
        const bf16* kr = PROJ + (size_t)(b * SEQ) * DINP;
        for (int j = 0; j < SEQ; ++j, kr += DINP) attn_key(st, q0, q1, kr + COL_BK + kvh * HD, kr + COL_BV + kvh * HD, lane);
        const float inv = 1.0f / st.l; *(float2*)(YMIX + (size_t)t * DM + 512 + hq * HD + 2 * lane) = make_float2(st.o0 * inv, st.o1 * inv); }
}


__device__ __forceinline__ void phase_attn_b(Frame& F, char* lds_gen) {
    const bf16* PROJ = WSP(bf16, WS_PROJ); float* YMIX = WSP(float, WS_YMIX);
    for (int u = F.vcu; u < BATCH * 8 * 16; u += F.G) {
        const int b = u >> 7, kvh = (u >> 6) & 1, hq = kvh * 4 + ((u >> 4) & 3), qb = u & 15;
        const bf16* Qb = PROJ + (size_t)(b * SEQ + qb * 256) * DINP + COL_BQ + hq * HD;
        const bf16* Kh = PROJ + (size_t)(b * SEQ) * DINP + COL_BK + kvh * HD;
        const bf16* Vh = PROJ + (size_t)(b * SEQ) * DINP + COL_BV + kvh * HD;
        float* Ob = YMIX + (size_t)(b * SEQ + qb * 256) * DM + 512 + hq * HD;
        attn::attn_dense_body<attn::bf16>(Qb, Kh, Vh, Ob, SEQ, lds_gen);
        __syncthreads();
    }
}

__device__ __forceinline__ void phase_ynorm(Frame& F, int l, bool naive_dn) {
    const bf16* PROJ = WSP(bf16, WS_PROJ); float* YMIX = WSP(float, WS_YMIX); bf16* Y = WSP(bf16, WS_Y); const float* DO = WSP(float, WS_DO);
    const float* ga = F.in[7] + (size_t)l * 512; const float* gb = F.in[8] + (size_t)l * 1024; const float* gn = F.in[11] + (size_t)l * HD;
    const int gw = F.vcu * NWAVES + F.wave, NGW = F.G * NWAVES, lane = F.lane;
    for (int t = gw; t < T; t += NGW) {
        if (naive_dn) {
#pragma unroll
            for (int hh = 0; hh < 4; ++hh) { const size_t o = (size_t)t * 512 + hh * HD; const float o0 = DO[o + lane] + DO[(size_t)T * 512 + o + lane], o1 = DO[o + lane + 64] + DO[(size_t)T * 512 + o + lane + 64];
                const float rs = rsqrtf(wave_sum(o0 * o0 + o1 * o1) * (1.0f / HD) + EPS);
                const float z0 = bf2f(PROJ[(size_t)t * DINP + COL_CZ + hh * HD + lane]), z1 = bf2f(PROJ[(size_t)t * DINP + COL_CZ + hh * HD + lane + 64]);
                Y[(size_t)t * DM + 1536 + hh * HD + lane] = (bf16)f2bf(o0 * rs * gn[lane] * siluf_(z0)); Y[(size_t)t * DM + 1536 + hh * HD + lane + 64] = (bf16)f2bf(o1 * rs * gn[lane + 64] * siluf_(z1)); }
        }
        const float* yr = YMIX + (size_t)t * DM; bf16* yo = Y + (size_t)t * DM;
        { f32x4 a0 = *(const f32x4*)(yr + 4 * lane), a1 = *(const f32x4*)(yr + 256 + 4 * lane);
          const float rs = rsqrtf(wave_sum((a0.x * a0.x + a0.y * a0.y) + (a0.z * a0.z + a0.w * a0.w) + (a1.x * a1.x + a1.y * a1.y) + (a1.z * a1.z + a1.w * a1.w)) * (1.0f / 512) + EPS);
          const f32x4 g0 = *(const f32x4*)(ga + 4 * lane), g1 = *(const f32x4*)(ga + 256 + 4 * lane); a0 = a0 * rs * g0; a1 = a1 * rs * g1;
          u32x2 o; o.x = pk2(a0.x, a0.y); o.y = pk2(a0.z, a0.w); *(u32x2*)(yo + 4 * lane) = o; o.x = pk2(a1.x, a1.y); o.y = pk2(a1.z, a1.w); *(u32x2*)(yo + 256 + 4 * lane) = o; }
        { f32x4 a[4]; float ss = 0.f;
#pragma unroll
          for (int j = 0; j < 4; ++j) { a[j] = *(const f32x4*)(yr + 512 + 256 * j + 4 * lane); ss += (a[j].x * a[j].x + a[j].y * a[j].y) + (a[j].z * a[j].z + a[j].w * a[j].w); }
          const float rs = rsqrtf(wave_sum(ss) * (1.0f / 1024) + EPS);
#pragma unroll
          for (int j = 0; j < 4; ++j) { const f32x4 g = *(const f32x4*)(gb + 256 * j + 4 * lane); a[j] = a[j] * rs * g; u32x2 o; o.x = pk2(a[j].x, a[j].y); o.y = pk2(a[j].z, a[j].w); *(u32x2*)(yo + 512 + 256 * j + 4 * lane) = o; } }
    }
}

__device__ __forceinline__ void phase_select(Frame& F) {
    const float* AFF = WSP(float, WS_AFF); int* SELI = WSP(int, WS_SELI); float* SELG = WSP(float, WS_SELG); int* SLOT = WSP(int, WS_SLOT);
    LAS unsigned* key = (LAS unsigned*)F.lds;
    LAS unsigned* hist = key + 4096;
    LAS unsigned* ctl = hist + 256;
    LAS unsigned* scan = ctl + 8;
    const int tid = F.tid;
    for (int u = F.vcu; u < BATCH * NE; u += F.G) {
        const int b = u / NE, e = u % NE;
        __syncthreads();
        for (int i = tid; i < SEQ; i += NTHR) key[i] = __float_as_uint(AFF[(size_t)(b * SEQ + i) * 16 + e]);
        if (tid == 0) { ctl[0] = 0u; ctl[1] = CAP; }
        __syncthreads();
        for (int pass = 3; pass >= 0; --pass) {
            const int shift = pass * 8; const unsigned hmask = pass == 3 ? 0u : ~((1u << (shift + 8)) - 1u);
            if (tid < 256) hist[tid] = 0u;
            __syncthreads();
            const unsigned prefix = ctl[0];
            for (int i = tid; i < SEQ; i += NTHR) { const unsigned k = key[i]; if ((k & hmask) == (prefix & hmask)) __hip_atomic_fetch_add(hist + ((k >> shift) & 255u), 1u, __ATOMIC_RELAXED, __HIP_MEMORY_SCOPE_WORKGROUP); }
            __syncthreads();
            if (tid == 0) { unsigned want = ctl[1], cum = 0u; int bsel = 0;
                for (int bn = 255; bn >= 0; --bn) { const unsigned hcount = hist[bn]; if (cum + hcount >= want) { bsel = bn; break; } cum += hcount; }
                ctl[0] = prefix | ((unsigned)bsel << shift); ctl[1] = want - cum; }
            __syncthreads();
        }
        const unsigned thr = ctl[0], want_eq = ctl[1];
        unsigned cg = 0, ce = 0;
#pragma unroll
        for (int j = 0; j < 8; ++j) { const unsigned k = key[8 * tid + j]; cg += k > thr; ce += k == thr; }
        scan[tid] = cg; scan[512 + tid] = ce;
        __syncthreads();
        if (tid < 64) { unsigned sg = 0, se = 0;
            unsigned lg[8], le[8];
#pragma unroll
            for (int j = 0; j < 8; ++j) { lg[j] = scan[8 * tid + j]; le[j] = scan[512 + 8 * tid + j]; sg += lg[j]; se += le[j]; }
            unsigned pg = sg, pe = se;
#pragma unroll
            for (int o = 1; o < 64; o <<= 1) { const unsigned tg = __shfl_up(pg, o), te = __shfl_up(pe, o); if (tid >= o) { pg += tg; pe += te; } }
            unsigned bg = pg - sg, be = pe - se;
#pragma unroll
            for (int j = 0; j < 8; ++j) { scan[8 * tid + j] = bg; scan[512 + 8 * tid + j] = be; bg += lg[j]; be += le[j]; }
        }
        __syncthreads();
        unsigned pg = scan[tid], pe = scan[512 + tid];
#pragma unroll
        for (int j = 0; j < 8; ++j) { const int i = 8 * tid + j; const unsigned k = key[i]; int slot = -1;
            if (k > thr) { slot = (int)(pg + (pe < want_eq ? pe : want_eq)); pg++; }
            else if (k == thr) { if (pe < want_eq) slot = (int)(pg + pe); pe++; }
            SLOT[(size_t)(b * NE + e) * SEQ + i] = slot;
            if (slot >= 0) { SELI[(size_t)(b * NE + e) * CAP + slot] = i; SELG[(size_t)e * 1024 + b * CAP + slot] = __uint_as_float(k); } }
    }
}
__device__ __forceinline__ void phase_gather(Frame& F) {
    const int* SELI = WSP(int, WS_SELI); const bf16* HN = WSP(bf16, WS_HN); bf16* XS = WSP(bf16, WS_XS);
    const int gw = F.vcu * NWAVES + F.wave, NGW = F.G * NWAVES, lane = F.lane;
    for (int r = gw; r < NE * 1024; r += NGW) { const int e = r >> 10, q = r & 1023, b = q >> 9, slot = q & 511; const int i = SELI[(size_t)(b * NE + e) * CAP + slot];
        const u32x4* src = (const u32x4*)(HN + (size_t)(b * SEQ + i) * DM); u32x4* dst = (u32x4*)(XS + (size_t)r * DM);
#pragma unroll
        for (int j = 0; j < 4; ++j) dst[lane + 64 * j] = src[lane + 64 * j]; }
}
__device__ __forceinline__ void phase_combine(Frame& F, const float* __restrict__ gain) {
    float* H = WSP(float, WS_H); bf16* HN = WSP(bf16, WS_HN); const int* SLOT = WSP(int, WS_SLOT); const bf16* YEXP = WSP(bf16, WS_YEXP);
    const int gw = F.vcu * NWAVES + F.wave, NGW = F.G * NWAVES, lane = F.lane;
    for (int t = gw; t < T; t += NGW) { const int b = t >> 12, s = t & (SEQ - 1);
        float* hr = H + (size_t)t * DM; f32x4 v[8];
#pragma unroll
        for (int j = 0; j < 8; ++j) v[j] = *(const f32x4*)(hr + 4 * lane + 256 * j);
        const int myslot = lane < NE ? SLOT[(size_t)(b * NE + lane) * SEQ + s] : -1;
        for (int e = 0; e < NE; ++e) { const int slot = __shfl(myslot, e); if (slot < 0) continue;
            const bf16* yr = YEXP + (size_t)(e * 1024 + b * CAP + slot) * DM;
#pragma unroll
            for (int j = 0; j < 8; ++j) { const u32x2 w = *(const u32x2*)(yr + 4 * lane + 256 * j);
                v[j].x += __uint_as_float(w.x << 16); v[j].y += __uint_as_float(w.x & 0xffff0000u); v[j].z += __uint_as_float(w.y << 16); v[j].w += __uint_as_float(w.y & 0xffff0000u); } }
        float ss = 0.f;
#pragma unroll
        for (int j = 0; j < 8; ++j) { *(f32x4*)(hr + 4 * lane + 256 * j) = v[j]; ss += (v[j].x * v[j].x + v[j].y * v[j].y) + (v[j].z * v[j].z + v[j].w * v[j].w); }
        const float rs = rsqrtf(wave_sum(ss) * (1.0f / DM) + EPS);
#pragma unroll
        for (int j = 0; j < 8; ++j) { const f32x4 g = *(const f32x4*)(gain + 4 * lane + 256 * j); const f32x4 o = v[j] * rs * g; u32x2 w; w.x = pk2(o.x, o.y); w.y = pk2(o.z, o.w); *(u32x2*)(HN + (size_t)t * DM + 4 * lane + 256 * j) = w; }
    }
}
__device__ __forceinline__ void phase_final(Frame& F) {
    const float* H = WSP(float, WS_H); const float* gain = F.in[21];
    const int gw = F.vcu * NWAVES + F.wave, NGW = F.G * NWAVES, lane = F.lane;
    for (int t = gw; t < T; t += NGW) { const float* hr = H + (size_t)t * DM; f32x4 v[8]; float ss = 0.f;
#pragma unroll
        for (int j = 0; j < 8; ++j) { v[j] = *(const f32x4*)(hr + 4 * lane + 256 * j); ss += (v[j].x * v[j].x + v[j].y * v[j].y) + (v[j].z * v[j].z + v[j].w * v[j].w); }
        const float rs = rsqrtf(wave_sum(ss) * (1.0f / DM) + EPS);
#pragma unroll
        for (int j = 0; j < 8; ++j) { const f32x4 g = *(const f32x4*)(gain + 4 * lane + 256 * j); *(f32x4*)(F.out + (size_t)t * DM + 4 * lane + 256 * j) = v[j] * rs * g; } }
}

struct EpiStoreBf16 { bf16* C; int ldc; __device__ __forceinline__ void operator()(int m, int n, float v) const { C[(size_t)m * ldc + n] = (bf16)f2bf(v); } };
struct EpiStoreF32 { float* C; int ldc; __device__ __forceinline__ void operator()(int m, int n, float v) const { C[(size_t)m * ldc + n] = v; } };
struct EpiResid { float* H; __device__ __forceinline__ void operator()(int m, int n, float v) const { H[(size_t)m * DM + n] += v; } };
struct EpiDown { bf16* C; const float* gate; __device__ __forceinline__ void operator()(int m, int n, float v) const { C[(size_t)m * DM + n] = (bf16)f2bf(v * gate[m]); } };
struct EpiPle { float* H; const bf16* PL; __device__ __forceinline__ void operator()(int m, int n, float v) const { H[(size_t)m * DM + n] += sigmoidf_(v) * bf2f(PL[(size_t)m * DM + n]); } };

#ifndef NAIVE_GEMM
#define NAIVE_GEMM 0
#endif
constexpr int NPL = 14;
constexpr int NPHASES = 1 + DEPTH * NPL + 1;
struct Args { const float* in[22]; float* out; unsigned char* ws; int ph_lo, ph_hi; };

__global__ void __launch_bounds__(NTHR, 2) mk_fwd(Args args) {
    extern __shared__ __attribute__((aligned(16))) unsigned char lds_raw[];
    Frame F;
    F.lds = (LAS unsigned char*)lds_raw;
    F.tid = threadIdx.x; F.lane = F.tid & 63; F.wave = __builtin_amdgcn_readfirstlane(F.tid >> 6);
    F.G = gridDim.x; { const int bx = blockIdx.x; F.vcu = (F.G % 8 == 0) ? (bx % 8) * (F.G / 8) + bx / 8 : bx; }
    const int vcu0 = F.vcu;
    F.in = (const float* const __attribute__((address_space(4)))*)__builtin_amdgcn_kernarg_segment_ptr(); F.out = args.out; F.ws = args.ws;
    const int lo = args.ph_lo, hi = args.ph_hi;
    volatile LAS unsigned* misc = (volatile LAS unsigned*)(F.lds + LDS_MISC);
    if (F.tid < 4) misc[F.tid] = 0u;
    __syncthreads();
    XcdBarrier bar; bar.bar = (unsigned*)(args.ws + WS_CTL) + CW_BAR; bar.x = 0; bar.st = misc;
    if (hi - lo > 1) bar = xcd_barrier_post((unsigned*)(args.ws + WS_CTL) + CW_BAR, misc);
#ifndef ONLY
#define ONLY -1
#endif
#ifndef MASK
#define MASK 0xFFFF
#endif
#define EN(j) ((ONLY < 0 || ONLY == (j)) && ((MASK >> (j)) & 1))
#define IN(k) (lo <= (k) && (k) < hi)
#define INL(j) (EN((j) + 1) && IN(pb + (j)) && seam(pb + (j)))
#define LAUNDER() do { unsigned char* w_ = args.ws; int t_ = threadIdx.x; const float* const __attribute__((address_space(4)))* i_ = (const float* const __attribute__((address_space(4)))*)__builtin_amdgcn_kernarg_segment_ptr(); int v_ = vcu0, g_ = (int)gridDim.x; asm volatile("" : "+s"(w_), "+v"(t_), "+s"(i_), "+s"(v_), "+s"(g_)); F.ws = w_; F.tid = t_; F.lane = t_ & 63; F.wave = __builtin_amdgcn_readfirstlane(t_ >> 6); F.in = i_; F.vcu = v_; F.G = g_; } while (0)
#define seam(k) (((k) > lo) ? (xcd_barrier(bar), true) : true)
    if (EN(0) && IN(0)) phase_prologue(F);
#pragma unroll 1
    for (int l = 0; l < DEPTH; ++l) {
        const int pb = 1 + l * NPL;
#define wl (F.ws + WS_W + (size_t)l * SZ_LAYERW)
        if (INL(0)) { LAUNDER(); phase_norm<1>(F, F.in[2] + (size_t)l * DM, F.in[3] + (size_t)l * DM * DIN + DINP, DIN, WSP(float, WS_TL)); }
        if (INL(1)) { LAUNDER();
#if NAIVE_GEMM
            EpiStoreBf16 E{WSP(bf16, WS_PROJ), DINP}; naive_gemm(F, WSP(bf16, WS_HN), DM, (const bf16*)(wl + OFF_WIN), DM, T, DINP, DM, E);
#else
            pg8::Gemm g{WSP(bf16, WS_HN), (const bf16*)(wl + OFF_WIN), T, DINP, DM}; pg8::StaticOrder S; S.init(T, DINP, F.G, (int)blockIdx.x); pg8::EpiBf16 E{WSP(bf16, WS_PROJ), DINP};
            pg8::gemm_phase<pg8::EpiBf16, pg8::StaticOrder>(F.lds, g, S, E, nullptr);
#endif
        }
        if (INL(2)) { LAUNDER(); phase_dn_prep_naive(F, l); phase_post(F, l); }
        if (INL(3)) { LAUNDER(); phase_mix_naive(F); if (!NAIVE_ATTN_B) { __syncthreads(); phase_attn_b(F, (char*)lds_raw); } }
        if (INL(4)) { LAUNDER(); phase_ynorm(F, l, true); }
        if (INL(5)) { LAUNDER();
#if NAIVE_GEMM
            EpiResid E{WSP(float, WS_H)}; naive_gemm(F, WSP(bf16, WS_Y), DM, (const bf16*)(wl + OFF_WOUT), DM, T, DM, DM, E);
#else
            pg8::Gemm g{WSP(bf16, WS_Y), (const bf16*)(wl + OFF_WOUT), T, DM, DM}; pg8::StaticOrder S; S.init(T, DM, F.G, (int)blockIdx.x); pg8::EpiResidF32 E{WSP(float, WS_H), DM};
            pg8::gemm_phase<pg8::EpiResidF32, pg8::StaticOrder>(F.lds, g, S, E, nullptr);
#endif
        }
        if (INL(6)) { LAUNDER(); phase_norm<2>(F, F.in[13] + (size_t)l * DM, F.in[14] + (size_t)l * DM * NE, NE, WSP(float, WS_AFF)); }
        if (INL(7)) { LAUNDER(); phase_select(F); }
        if (INL(8)) { LAUNDER(); phase_gather(F); }
        if (INL(9)) { LAUNDER();
#if NAIVE_GEMM
            for (int e = 0; e < NE; ++e) { EpiStoreF32 E{WSP(float, WS_TMP) + (size_t)e * 1024 * 2048, 2048};
                naive_gemm(F, WSP(bf16, WS_XS) + (size_t)e * 1024 * DM, DM, (const bf16*)(wl + OFF_WGU) + (size_t)e * 2048 * DM, DM, 1024, 2048, DM, E); }
            { EpiStoreBf16 E{WSP(bf16, WS_PL), DM}; naive_gemm(F, WSP(bf16, WS_PB) + (size_t)l * T * PLE, PLE, (const bf16*)(wl + OFF_WP), PLE, T, DM, PLE, E); }
#else
            { pg8::Gemm g{WSP(bf16, WS_XS), (const bf16*)(wl + OFF_WGU), NE * 1024, NE * 2048, DM}; pg8::GroupedOrder S{F.G, F.vcu}; pg8::EpiGateUp E{WSP(bf16, WS_HID)};
              pg8::gemm_phase<pg8::EpiGateUp, pg8::GroupedOrder>(F.lds, g, S, E, nullptr); }
#endif
        }
#if !NAIVE_GEMM
        if (INL(10)) { LAUNDER(); pg8::Gemm g{WSP(bf16, WS_PB) + (size_t)l * T * PLE, (const bf16*)(wl + OFF_WP), T, DM, PLE}; pg8::StaticOrder S; S.init(T, DM, F.G, (int)blockIdx.x); pg8::EpiBf16 E{WSP(bf16, WS_PL), DM};
              pg8::gemm_phase<pg8::EpiBf16, pg8::StaticOrder>(F.lds, g, S, E, nullptr); }
#endif
        if (NAIVE_GEMM && INL(10)) {
            const float* TMP = WSP(float, WS_TMP); bf16* HID = WSP(bf16, WS_HID);
            for (size_t i = (size_t)F.vcu * NTHR + F.tid; i < (size_t)NE * 1024 * EFF; i += (size_t)F.G * NTHR) { const size_t r = i >> 10; const int f = (int)(i & 1023);
                const float gt = TMP[r * 2048 + (f >> 7) * 256 + (f & 127)], up = TMP[r * 2048 + (f >> 7) * 256 + 128 + (f & 127)]; HID[i] = (bf16)f2bf(siluf_(gt) * up); }
        }
        if (INL(11)) { LAUNDER();
#if NAIVE_GEMM
            for (int e = 0; e < NE; ++e) { EpiDown E{WSP(bf16, WS_YEXP) + (size_t)e * 1024 * DM, WSP(float, WS_SELG) + (size_t)e * 1024};
                naive_gemm(F, WSP(bf16, WS_HID) + (size_t)e * 1024 * EFF, EFF, (const bf16*)(wl + OFF_WD) + (size_t)e * 2048 * EFF, EFF, 1024, DM, EFF, E); }
#else
            pg8::Gemm g{WSP(bf16, WS_HID), (const bf16*)(wl + OFF_WD), NE * 1024, NE * 2048, EFF}; pg8::GroupedOrder S{F.G, F.vcu}; pg8::EpiDownBf16 E{WSP(bf16, WS_YEXP), WSP(float, WS_SELG)};
            pg8::gemm_phase<pg8::EpiDownBf16, pg8::GroupedOrder>(F.lds, g, S, E, nullptr);
#endif
        }
        if (INL(12)) { LAUNDER(); phase_combine(F, F.in[18] + (size_t)l * DM); }
        if (INL(13)) { LAUNDER();
#if NAIVE_GEMM
            EpiPle E{WSP(float, WS_H), WSP(bf16, WS_PL)}; naive_gemm(F, WSP(bf16, WS_HN), DM, (const bf16*)(wl + OFF_WPG), DM, T, DM, DM, E);
#else
            pg8::Gemm g{WSP(bf16, WS_HN), (const bf16*)(wl + OFF_WPG), T, DM, DM}; pg8::StaticOrder S; S.init(T, DM, F.G, (int)blockIdx.x); pg8::EpiPleF32 E{WSP(float, WS_H), WSP(bf16, WS_PL)};
            pg8::gemm_phase<pg8::EpiPleF32, pg8::StaticOrder>(F.lds, g, S, E, nullptr);
#endif
        }
    }
    if (EN(15) && IN(NPHASES - 1) && seam(NPHASES - 1)) phase_final(F);
#undef IN
#undef INL
#undef seam
#undef wl
}

extern "C" void kernel_launch(void* const* d_in, const int* in_sizes, int n_in, void* d_out, int out_size, void* d_ws, size_t ws_size, hipStream_t stream) {
    static int grid = 0;
    if (grid == 0) {
        if (n_in != 22 || out_size != T * DM || ws_size < WS_END) { fprintf(stderr, "kernel_launch: unexpected shapes (n_in %d out %d ws %zu need %zu)\n", n_in, out_size, ws_size, (size_t)WS_END); grid = -1; return; }
        int dev = 0, cus = 0;
        if (hipGetDevice(&dev) != hipSuccess || hipDeviceGetAttribute(&cus, hipDeviceAttributeMultiprocessorCount, dev) != hipSuccess) { grid = -1; return; }
        if (hipFuncSetAttribute((const void*)mk_fwd, hipFuncAttributeMaxDynamicSharedMemorySize, LDS_BYTES) != hipSuccess) { fprintf(stderr, "kernel_launch: hipFuncSetAttribute failed\n"); grid = -1; return; }
        grid = cus;
    }
    if (grid < 0) return;
    Args a{};
    for (int i = 0; i < 22; ++i) a.in[i] = (const float*)d_in[i];
    a.out = (float*)d_out; a.ws = (unsigned char*)d_ws;
    if (hipMemsetAsync((char*)d_ws + WS_CTL, 0, CTL_BYTES, stream) != hipSuccess) { fprintf(stderr, "kernel_launch: memset failed\n"); return; }
#if N_LAUNCH_PER_PHASE
    for (int ph = 0; ph < NPHASES; ++ph) {
        a.ph_lo = ph; a.ph_hi = ph + 1;
        hipLaunchKernelGGL(mk_fwd, dim3(grid), dim3(NTHR), LDS_BYTES, stream, a);
    }
#else
    a.ph_lo = 0; a.ph_hi = NPHASES;
    hipLaunchKernelGGL(mk_fwd, dim3(grid), dim3(NTHR), LDS_BYTES, stream, a);
#endif
}
```

```cpp
#include <hip/hip_runtime.h>
#include <cstdio>
#include <cstdint>

#define LAS __attribute__((address_space(3)))
#define GAS __attribute__((address_space(1)))
typedef unsigned short bf16;
typedef float f32x4 __attribute__((ext_vector_type(4)));
typedef unsigned u32x4 __attribute__((ext_vector_type(4)));
typedef unsigned u32x2 __attribute__((ext_vector_type(2)));
typedef short bf16x8 __attribute__((ext_vector_type(8)));

constexpr int BATCH = 2, SEQ = 4096, T = BATCH * SEQ, DM = 2048, DEPTH = 4, HD = 128;
constexpr int DIN = 5136, DINP = 5120;
constexpr int COL_AQ = 0, COL_AK = 512, COL_AV = 1024, COL_BQ = 1536, COL_BK = 2560, COL_BV = 2816, COL_CQKV = 3072, COL_CZ = 4608;
constexpr int NE = 16, CAP = 512, EFF = 1024, PLE = 256;
constexpr float EPS = 1e-6f;
constexpr int NWAVES = 8, NTHR = 512;
constexpr int LDS_BYTES = 147456, LDS_MISC = 147456 - 256;
constexpr int CW_BAR = 4096;

constexpr size_t al256(size_t x) { return (x + 255) / 256 * 256; }
constexpr size_t WS_CTL = 0, CTL_BYTES = 1u << 20;
constexpr size_t SZ_WIN = (size_t)DINP * DM * 2, SZ_WOUT = (size_t)DM * DM * 2, SZ_WGU = (size_t)NE * 2048 * DM * 2, SZ_WD = (size_t)NE * DM * EFF * 2, SZ_WPG = (size_t)DM * DM * 2, SZ_WP = (size_t)DM * PLE * 2;
constexpr size_t SZ_LAYERW = SZ_WIN + SZ_WOUT + SZ_WGU + SZ_WD + SZ_WPG + SZ_WP;
constexpr size_t OFF_WIN = 0, OFF_WOUT = OFF_WIN + SZ_WIN, OFF_WGU = OFF_WOUT + SZ_WOUT, OFF_WD = OFF_WGU + SZ_WGU, OFF_WPG = OFF_WD + SZ_WD, OFF_WP = OFF_WPG + SZ_WPG;
constexpr size_t WS_W = WS_CTL + CTL_BYTES;
constexpr size_t WS_PB = WS_W + DEPTH * SZ_LAYERW;
constexpr size_t WS_TABA = WS_PB + (size_t)DEPTH * T * PLE * 2;
constexpr size_t WS_TABB = WS_TABA + (size_t)SEQ * 16 * 8;
constexpr size_t WS_H = al256(WS_TABB + 64 * 32 * 8);
constexpr size_t WS_HN = WS_H + (size_t)T * DM * 4;
constexpr size_t WS_TL = WS_HN + (size_t)T * DM * 2;
constexpr size_t WS_PROJ = WS_TL + (size_t)T * 16 * 4;
constexpr size_t WS_YMIX = WS_PROJ + (size_t)T * DINP * 2;
constexpr size_t WS_Y = WS_YMIX + (size_t)T * DM * 4;
constexpr size_t WS_AFF = WS_Y + (size_t)T * DM * 2;
constexpr size_t WS_SELI = WS_AFF + (size_t)T * 16 * 4;
constexpr size_t WS_SELG = WS_SELI + (size_t)BATCH * NE * CAP * 4;
constexpr size_t WS_SLOT = WS_SELG + (size_t)BATCH * NE * CAP * 4;
constexpr size_t WS_XS = WS_SLOT + (size_t)BATCH * NE * SEQ * 4;
constexpr size_t WS_HID = WS_XS + (size_t)NE * 1024 * DM * 2;
constexpr size_t WS_YEXP = WS_HID + (size_t)NE * 1024 * EFF * 2;
constexpr size_t WS_PL = WS_YEXP + (size_t)NE * 1024 * DM * 2;
constexpr size_t WS_DQ = WS_PL + (size_t)T * DM * 2;
constexpr size_t WS_DK = WS_DQ + (size_t)T * 512 * 4;
constexpr size_t WS_DV = WS_DK + (size_t)T * 512 * 4;
constexpr size_t WS_DB = WS_DV + (size_t)T * 512 * 4;
constexpr size_t WS_DG = WS_DB + (size_t)2 * T * 4 * 4;
constexpr size_t WS_DO = WS_DG + (size_t)2 * T * 4 * 4;
constexpr size_t WS_TMP = al256(WS_DO + (size_t)2 * T * 512 * 4);
constexpr size_t WS_CM = WS_TMP + (size_t)NE * 1024 * 2048 * 4;
constexpr size_t WS_CN = WS_CM + (size_t)16 * 64 * 128 * 128 * 2;
constexpr size_t WS_CS = WS_CN + (size_t)16 * 64 * 128 * 128 * 2;
constexpr size_t WS_CP = WS_CS + (size_t)16 * 64 * 128 * 128 * 2;
constexpr size_t WS_CR = WS_CP + (size_t)16 * 64 * 64 * 128 * 2;
constexpr size_t WS_END = WS_CR + (size_t)16 * 64 * 64 * 128 * 4;
constexpr size_t WS_RS = WS_XS;
constexpr size_t WS_SELR = WS_XS + (size_t)3 * T * 4;
constexpr size_t WS_WTL = WS_SELR + (size_t)NE * 1024 * 4;
static_assert(WS_END < 2140000000ull, "workspace map");

__device__ const double INV_A[16] = {1.0, 0.44036660267178046, 0.19392274474868576, 0.08539710028576561, 0.03760603093086393, 0.016560440080994443, 0.0072926647372171085, 0.003211445994752591, 0.0014142135623730952, 0.000622772421914596, 0.0002742481756762073, 0.00012076973741146504, 5.318295896944988e-05, 2.341999896140934e-05, 1.0313385377212458e-05, 4.5416704806078695e-06};
__device__ const double INV_B[32] = {1.0, 0.7498942093324559, 0.5623413251903491, 0.4216965034285822, 0.31622776601683794, 0.23713737056616552, 0.1778279410038923, 0.1333521432163324, 0.09999999999999999, 0.07498942093324558, 0.056234132519034905, 0.042169650342858224, 0.03162277660168379, 0.023713737056616554, 0.01778279410038923, 0.013335214321633239, 0.01, 0.007498942093324559, 0.005623413251903491, 0.004216965034285822, 0.0031622776601683794, 0.002371373705661655, 0.0017782794100389228, 0.0013335214321633238, 0.001, 0.0007498942093324559, 0.000562341325190349, 0.00042169650342858224, 0.00031622776601683794, 0.00023713737056616554, 0.0001778279410038923, 0.0001333521432163324};

#ifndef N_LAUNCH_PER_PHASE
#define N_LAUNCH_PER_PHASE 0
#endif
#ifndef NAIVE_DN
#define NAIVE_DN 0
#endif
#ifndef NAIVE_ATTN_A
#define NAIVE_ATTN_A 0
#endif
#ifndef NAIVE_ATTN_B
#define NAIVE_ATTN_B 0
#endif
__device__ __forceinline__ int lane_id() { int l; asm volatile("v_mbcnt_lo_u32_b32 %0, -1, 0\n\tv_mbcnt_hi_u32_b32 %0, -1, %0" : "=v"(l)); return l; }
#define TIDX(w0) ((w0) * 64 + lane_id())
__device__ __forceinline__ float bperm(float v, int src_lane) { return __int_as_float(__builtin_amdgcn_ds_bpermute(src_lane << 2, __float_as_int(v))); }
typedef __bf16 bf16v2_t __attribute__((ext_vector_type(2)));
typedef float f32v2_t __attribute__((ext_vector_type(2)));
__device__ __forceinline__ unsigned cvt_pk_rne(float lo, float hi) { const f32v2_t v = {lo, hi}; return __builtin_bit_cast(unsigned, __builtin_convertvector(v, bf16v2_t)); }
__device__ __forceinline__ float bf2f(bf16 b) { return __uint_as_float(((unsigned)b) << 16); }
__device__ __forceinline__ unsigned f2bf(float f) { unsigned u = __float_as_uint(f); return (u + 0x7fffu + ((u >> 16) & 1u)) >> 16; }
__device__ __forceinline__ unsigned pk2(float lo, float hi) { return cvt_pk_rne(lo, hi); }
__device__ __forceinline__ float wave_sum(float v) {
#pragma unroll
    for (int o = 1; o < 64; o <<= 1) v += __shfl_xor(v, o);
    return v;
}
__device__ __forceinline__ float wave_max(float v) {
#pragma unroll
    for (int o = 1; o < 64; o <<= 1) v = fmaxf(v, __shfl_xor(v, o));
    return v;
}
__device__ __forceinline__ float sigmoidf_(float x) { return __builtin_amdgcn_rcpf(1.0f + __expf(-x)); }
__device__ __forceinline__ float siluf_(float x) { return x * __builtin_amdgcn_rcpf(1.0f + __expf(-x)); }
__device__ __forceinline__ float softplusf_(float x) { const float e = __expf(-fabsf(x)); const float lg = e < 1e-3f ? e * (1.0f - 0.5f * e + 0.33333333f * e * e) : __logf(1.0f + e); return fmaxf(x, 0.f) + lg; }
__device__ __forceinline__ void sincos_d(double a, float& c, float& s) {
    const double q = rint(a * 0.63661977236758134308);
    const double r = (a - q * 1.57079632679489655800) - q * 6.12323399573676603587e-17;
    const double r2 = r * r;
    double sp = 1.0 / 6227020800.0; sp = sp * r2 * -1.0 + 1.0 / 39916800.0; sp = sp * -r2 + 1.0 / 362880.0; sp = sp * -r2 + 1.0 / 5040.0; sp = sp * -r2 + 1.0 / 120.0; sp = sp * -r2 + 1.0 / 6.0; sp = sp * -r2 + 1.0;
    const double sr = r * sp;
    double cp = 1.0 / 87178291200.0; cp = cp * -r2 + 1.0 / 479001600.0; cp = cp * -r2 + 1.0 / 3628800.0; cp = cp * -r2 + 1.0 / 40320.0; cp = cp * -r2 + 1.0 / 720.0; cp = cp * -r2 + 1.0 / 24.0; cp = cp * -r2 + 0.5; cp = cp * -r2 + 1.0;
    const double cr = cp;
    const long long qi = (long long)q; const int m = (int)(qi & 3);
    double cs, sn;
    if (m == 0) { cs = cr; sn = sr; } else if (m == 1) { cs = -sr; sn = cr; } else if (m == 2) { cs = -cr; sn = -sr; } else { cs = sr; sn = -cr; }
    c = (float)cs; s = (float)sn;
}


#define XB_TMO      128
#define XB_XCNT(j)  (256  + 64 * (j))
#define XB_XSUB(j)  (1280 + 64 * (j))
#define XB_XGEN(j)  (2304 + 64 * (j))
#define XB_TOP      3328
#define XB_TOPGEN   3392
#define XCD_BAR_WORDS 3456
#define XB_SPIN_CAP (1u << 22)

__device__ __forceinline__ unsigned xb_ld(unsigned* p)              { return __hip_atomic_load(p, __ATOMIC_RELAXED, __HIP_MEMORY_SCOPE_AGENT); }
__device__ __forceinline__ unsigned xb_add(unsigned* p, unsigned v) { return __hip_atomic_fetch_add(p, v, __ATOMIC_RELAXED, __HIP_MEMORY_SCOPE_AGENT); }
__device__ __forceinline__ unsigned xb_xcc_id() { return (unsigned)__builtin_amdgcn_s_getreg((3 << 11) | 20) & 0xFu; }
#define XB_SPIN(cond, bar) do { unsigned _sp = 0; while (cond) { __builtin_amdgcn_s_sleep(1); \
    if ((++_sp & 255u) == 0u) { if (xb_ld(&(bar)[XB_TMO])) break; if (_sp > XB_SPIN_CAP) { atomicAdd(&(bar)[XB_TMO], 1u); break; } } } } while (0)

struct XcdBarrier {
    unsigned* bar; unsigned x; int w0;
    volatile LAS unsigned* st;
};

__device__ __forceinline__ XcdBarrier xcd_barrier_post(unsigned* bar, volatile LAS unsigned* st, int w0) {
    XcdBarrier b; b.bar = bar; b.x = xb_xcc_id(); b.st = st; b.w0 = w0;
    if (TIDX(w0) == 0) (void)xb_add(&bar[XB_XCNT(b.x)], 1u);
    return b;
}
__device__ __forceinline__ void xcd_barrier_complete(unsigned* bar, unsigned x, unsigned& nloc, unsigned& nx) {
    const unsigned G = gridDim.x * gridDim.y * gridDim.z;
    unsigned sum, cnt, mine, sp = 0u;
    for (;;) {
        sum = 0u; cnt = 0u; mine = 0u;
#pragma unroll
        for (unsigned j = 0; j < 16; ++j) { const unsigned c = xb_ld(&bar[XB_XCNT(j)]); sum += c; cnt += (c > 0u) ? 1u : 0u; mine = (j == x) ? c : mine; }
        if (sum == G) break;
        __builtin_amdgcn_s_sleep(1);
        if ((++sp & 255u) == 0u) { if (xb_ld(&bar[XB_TMO])) break; if (sp > XB_SPIN_CAP) { atomicAdd(&bar[XB_TMO], 1u); break; } }
    }
    nloc = mine > 0u ? mine : 1u; nx = cnt > 0u ? cnt : 1u;
}

__device__ __forceinline__ void xcd_barrier(const XcdBarrier& b) {
    asm volatile("s_waitcnt vmcnt(0)" ::: "memory");
    __syncthreads();
    if (TIDX(b.w0) == 0) {
        unsigned* bar = b.bar;
        __builtin_amdgcn_s_waitcnt(0);
        unsigned nloc = b.st[0], nx = b.st[1];
        if (nloc == 0u) { xcd_barrier_complete(bar, b.x, nloc, nx); b.st[0] = nloc; b.st[1] = nx; }
        const unsigned old = xb_add(&bar[XB_XSUB(b.x)], 1u);
        const unsigned gen = old / nloc;
        if (old + 1u == (gen + 1u) * nloc) {
            __builtin_amdgcn_fence(__ATOMIC_RELEASE, "agent");
            asm volatile("s_waitcnt vmcnt(0)" ::: "memory");
            const unsigned og = xb_add(&bar[XB_TOP], 1u);
            const unsigned tg = og / nx;
            if (og + 1u == (tg + 1u) * nx) xb_add(&bar[XB_TOPGEN], 1u);
            else XB_SPIN(xb_ld(&bar[XB_TOPGEN]) == tg, bar);
            __builtin_amdgcn_fence(__ATOMIC_ACQUIRE, "agent");
            xb_add(&bar[XB_XGEN(b.x)], 1u);
            asm volatile("s_waitcnt vmcnt(0)" ::: "memory");
        } else {
            XB_SPIN(xb_ld(&bar[XB_XGEN(b.x)]) == gen, bar);
            __builtin_amdgcn_fence(__ATOMIC_ACQUIRE, "agent");
            asm volatile("s_waitcnt vmcnt(0)" ::: "memory");
        }
    }
    __syncthreads();
}

__device__ __forceinline__ void bar_sync(XcdBarrier& b, unsigned* words) { GAS unsigned* w = (GAS unsigned*)words; asm volatile("" : "+s"(w)); b.bar = (unsigned*)w; xcd_barrier(b); }

#define GIN(k) ((const float*)(const GAS float*)F.in[k])
struct Frame {
    LAS unsigned char* lds;
    int tid, lane, wave, vcu, G;
    const float* const __attribute__((address_space(4)))* in;
    float* out;
    unsigned char* ws;
};
#define WSP(type, off) ((type*)(F.ws + (off)))

template <bool GAM>
__device__ __forceinline__ void transpose_item(const float* __restrict__ W, int ldw, bf16* __restrict__ WT, int ldt, int k0, int n0, size_t drow0, LAS unsigned* scr, int lane, const float* __restrict__ gam) {
    const float* src = W + (size_t)k0 * ldw + n0 + lane;
    unsigned g0 = 0u, g1 = 0u;
    if (GAM) { const u32x2 gp = *(const u32x2*)(gam + k0 + 2 * lane); g0 = gp.x; g1 = gp.y; }
#pragma unroll 8
    for (int kk = 0; kk < 64; ++kk) { float v0 = __builtin_nontemporal_load(src + (size_t)(2 * kk) * ldw), v1 = __builtin_nontemporal_load(src + (size_t)(2 * kk + 1) * ldw);
        if (GAM) { v0 *= __uint_as_float(__builtin_amdgcn_readlane(g0, kk)); v1 *= __uint_as_float(__builtin_amdgcn_readlane(g1, kk)); }
        scr[lane * 65 + kk] = pk2(v0, v1); }
    asm volatile("s_waitcnt lgkmcnt(0)" ::: "memory");
    const int c = lane & 15;
#pragma unroll
    for (int j = 0; j < 16; ++j) { const int n = (lane >> 4) + 4 * j; const LAS unsigned* sp = scr + n * 65 + 4 * c;
        u32x4 o; o.x = sp[0]; o.y = sp[1]; o.z = sp[2]; o.w = sp[3];
        __builtin_nontemporal_store(o, (u32x4*)(WT + (drow0 + n) * (size_t)ldt + k0 + 8 * c)); }
    asm volatile("s_waitcnt lgkmcnt(0)" ::: "memory");
}
__device__ __forceinline__ void phase_prologue(Frame& F) {
    LAS unsigned* scr = (LAS unsigned*)(F.lds + F.wave * 16640);
    const int gw = F.vcu * NWAVES + F.wave, NGW = F.G * NWAVES;
    constexpr int I_IN = 16 * 80, I_OUT = 16 * 32, I_G = 16 * 16 * 16, I_D = 16 * 8 * 32, I_P = 2 * 32, I_PG = 16 * 32;
    constexpr int I_LAYER = I_IN + I_OUT + 2 * I_G + I_D + I_P + I_PG;
    for (int it = gw; it < DEPTH * I_LAYER; it += NGW) {
        const int l = it / I_LAYER; int r = it % I_LAYER;
#define wl (F.ws + WS_W + (size_t)l * SZ_LAYERW)
        if (r < I_IN) { const int kb = r / 80, nb = r % 80; transpose_item<true>(GIN(3) + (size_t)l * DM * DIN, DIN, (bf16*)(wl + OFF_WIN), DM, kb * 128, nb * 64, (size_t)nb * 64, scr, F.lane, GIN(2) + (size_t)l * DM); continue; } r -= I_IN;
        if (r < I_OUT) { const int kb = r / 32, nb = r % 32; transpose_item<false>(GIN(12) + (size_t)l * DM * DM, DM, (bf16*)(wl + OFF_WOUT), DM, kb * 128, nb * 64, (size_t)nb * 64, scr, F.lane, nullptr); continue; } r -= I_OUT;
        if (r < 2 * I_G) { const int up = r / I_G; r %= I_G; const int e = r / 256, q = r % 256, kb = q / 16, nb = q % 16, n0 = nb * 64;
            const float* src = (up ? GIN(16) : GIN(15)) + ((size_t)(l * NE + e) * DM) * EFF;
            transpose_item<true>(src, EFF, (bf16*)(wl + OFF_WGU), DM, kb * 128, n0, (size_t)e * 2048 + (n0 / 128) * 256 + (n0 % 128) + up * 128, scr, F.lane, GIN(13) + (size_t)l * DM); continue; } r -= 2 * I_G;
        if (r < I_D) { const int e = r / 256, q = r % 256, kb = q / 32, nb = q % 32;
            transpose_item<false>(GIN(17) + ((size_t)(l * NE + e) * EFF) * DM, DM, (bf16*)(wl + OFF_WD), EFF, kb * 128, nb * 64, (size_t)e * 2048 + nb * 64, scr, F.lane, nullptr); continue; } r -= I_D;
        if (r < I_P) { const int kb = r / 32, nb = r % 32; transpose_item<false>(GIN(19) + (size_t)l * PLE * DM, DM, (bf16*)(wl + OFF_WP), PLE, kb * 128, nb * 64, (size_t)nb * 64, scr, F.lane, nullptr); continue; } r -= I_P;
        { const int kb = r / 32, nb = r % 32; transpose_item<true>(GIN(20) + (size_t)l * DM * DM, DM, (bf16*)(wl + OFF_WPG), DM, kb * 128, nb * 64, (size_t)nb * 64, scr, F.lane, GIN(18) + (size_t)l * DM); }
    }
    const size_t gt = (size_t)F.vcu * NTHR + (size_t)(F.wave * 64 + lane_id()), NT = (size_t)F.G * NTHR;
    { const f32x4* src = (const f32x4*)GIN(1); u32x2* dst = WSP(u32x2, WS_PB);
      constexpr size_t N = (size_t)DEPTH * T * PLE / 4;
      for (size_t i0 = gt; i0 < N; i0 += 8 * NT) { f32x4 v[8];
#pragma unroll
          for (int k = 0; k < 8; ++k) { const size_t i = i0 + k * NT; v[k] = (f32x4){0.f, 0.f, 0.f, 0.f}; if (i < N) v[k] = __builtin_nontemporal_load(src + i); }
#pragma unroll
          for (int k = 0; k < 8; ++k) { const size_t i = i0 + k * NT; if (i < N) { u32x2 o; o.x = pk2(v[k].x, v[k].y); o.y = pk2(v[k].z, v[k].w); dst[i] = o; } } } }
    { const f32x4* src = (const f32x4*)GIN(0); u32x2* dst = WSP(u32x2, WS_H);
      constexpr size_t N = (size_t)T * DM / 4;
      for (size_t i0 = gt; i0 < N; i0 += 8 * NT) { f32x4 v[8];
#pragma unroll
          for (int k = 0; k < 8; ++k) { const size_t i = i0 + k * NT; v[k] = (f32x4){0.f, 0.f, 0.f, 0.f}; if (i < N) v[k] = __builtin_nontemporal_load(src + i); }
#pragma unroll
          for (int k = 0; k < 8; ++k) { const size_t i = i0 + k * NT; if (i < N) { u32x2 o; o.x = pk2(v[k].x, v[k].y); o.y = pk2(v[k].z, v[k].w); dst[i] = o; } } } }
#ifdef CHECK_NAN_FILL
    { u32x4* dst = WSP(u32x4, WS_CM); const u32x4 nn = {0xffffffffu, 0xffffffffu, 0xffffffffu, 0xffffffffu};
      for (size_t i = gt; i < (WS_END - WS_CM) / 16; i += NT) dst[i] = nn;
      u32x4* d2 = WSP(u32x4, WS_YMIX); for (size_t i = gt; i < (WS_XS - WS_YMIX) / 16; i += NT) d2[i] = nn; }
#endif
    { float* dst = WSP(float, WS_WTL);
      for (size_t i = gt; i < (size_t)DEPTH * 2 * 16 * DM; i += NT) { const int ls = (int)(i >> 15), l = ls >> 1, sset = ls & 1, k = (int)(i >> 4) & (DM - 1), c = (int)i & 15;
          const float* w = sset ? GIN(14) + (size_t)l * DM * NE : GIN(3) + (size_t)l * DM * DIN + DINP; const int ldw = sset ? NE : DIN; const float* g = (sset ? GIN(13) : GIN(2)) + (size_t)l * DM;
          dst[((size_t)ls * 16 + c) * DM + k] = g[k] * w[(size_t)k * ldw + c]; } }
    { float2* ta = WSP(float2, WS_TABA); for (size_t i = gt; i < (size_t)SEQ * 16; i += NT) { const int s = (int)(i >> 4), j = (int)(i & 15); float c, sn; sincos_d((double)s * INV_A[j], c, sn); ta[i] = make_float2(c, sn); }
      float2* tb = WSP(float2, WS_TABB); for (size_t i = gt; i < 64 * 32; i += NT) { const int s = (int)(i >> 5), j = (int)(i & 31); float c, sn; sincos_d((double)s * INV_B[j], c, sn); tb[i] = make_float2(c, sn); } }
}

template <int MODE>
__device__ __forceinline__ void phase_norm(Frame& F, const float* __restrict__ wtg, float* __restrict__ out16, float* __restrict__ rsout) {
    const bf16* H = WSP(bf16, WS_H);
    LAS float* wT = (LAS float*)F.lds;
#pragma unroll 1
    for (int h = 0; h < 2; ++h) { f32x4 st[8];
#pragma unroll
      for (int i = 0; i < 8; ++i) st[i] = *(const f32x4*)(wtg + 4 * (F.tid + NTHR * (8 * h + i)));
#pragma unroll
      for (int i = 0; i < 8; ++i) *(LAS f32x4*)(wT + 4 * (F.tid + NTHR * (8 * h + i))) = st[i]; }
    __syncthreads();
    const int gw = F.vcu * NWAVES + F.wave, NGW = F.G * NWAVES, lane = F.lane;
    for (int r0 = gw * 4; r0 < T; r0 += NGW * 4) {
        f32x4 v[4][8];
#pragma unroll
        for (int rr = 0; rr < 4; ++rr) { const bf16* hr = H + (size_t)(r0 + rr) * DM; float ss = 0.f;
#pragma unroll
            for (int j = 0; j < 8; ++j) { const u32x2 hw = *(const u32x2*)(hr + 4 * lane + 256 * j); v[rr][j].x = __uint_as_float(hw.x << 16); v[rr][j].y = __uint_as_float(hw.x & 0xffff0000u); v[rr][j].z = __uint_as_float(hw.y << 16); v[rr][j].w = __uint_as_float(hw.y & 0xffff0000u); ss += (v[rr][j].x * v[rr][j].x + v[rr][j].y * v[rr][j].y) + (v[rr][j].z * v[rr][j].z + v[rr][j].w * v[rr][j].w); }
            const float rs = rsqrtf(wave_sum(ss) * (1.0f / DM) + EPS); if (lane == 0) rsout[r0 + rr] = rs;
#pragma unroll
            for (int j = 0; j < 8; ++j) v[rr][j] = v[rr][j] * rs; }
        float a[64];
#pragma unroll
        for (int c = 0; c < 16; ++c) { float p0 = 0.f, p1 = 0.f, p2 = 0.f, p3 = 0.f; asm volatile("" ::: "memory");
#pragma unroll
            for (int j = 0; j < 8; ++j) { const f32x4 w = *(const LAS f32x4*)(wT + c * DM + 4 * lane + 256 * j);
                p0 += (v[0][j].x * w.x + v[0][j].y * w.y) + (v[0][j].z * w.z + v[0][j].w * w.w); p1 += (v[1][j].x * w.x + v[1][j].y * w.y) + (v[1][j].z * w.z + v[1][j].w * w.w);
                p2 += (v[2][j].x * w.x + v[2][j].y * w.y) + (v[2][j].z * w.z + v[2][j].w * w.w); p3 += (v[3][j].x * w.x + v[3][j].y * w.y) + (v[3][j].z * w.z + v[3][j].w * w.w); }
            a[c] = p0; a[16 + c] = p1; a[32 + c] = p2; a[48 + c] = p3; }
#define TR_STEP(N, M) _Pragma("unroll") for (int k = 0; k < (N) / 2; ++k) { const bool up = (lane & (M)) != 0; const float keep = up ? a[k + (N) / 2] : a[k], send = up ? a[k] : a[k + (N) / 2]; a[k] = keep + __shfl_xor(send, (M)); }
        TR_STEP(64, 32) TR_STEP(32, 16) TR_STEP(16, 8) TR_STEP(8, 4) TR_STEP(4, 2) TR_STEP(2, 1)
#undef TR_STEP
        float mine = a[0];
        if (MODE == 2) { float m = mine; m = fmaxf(m, __shfl_xor(m, 1)); m = fmaxf(m, __shfl_xor(m, 2)); m = fmaxf(m, __shfl_xor(m, 4)); m = fmaxf(m, __shfl_xor(m, 8));
            const float e = expf(mine - m); float sden = e; sden += __shfl_xor(sden, 1); sden += __shfl_xor(sden, 2); sden += __shfl_xor(sden, 4); sden += __shfl_xor(sden, 8); mine = e / sden; }
        out16[(size_t)r0 * 16 + lane] = mine;
    }
}

namespace pg8 {
#define PG8_LAS __attribute__((address_space(3)))
typedef unsigned short bf16_t;
typedef short bf16x8 __attribute__((ext_vector_type(8)));
typedef float f32x4 __attribute__((ext_vector_type(4)));
typedef unsigned u32x4 __attribute__((ext_vector_type(4)));
constexpr int BM = 256, BK = 64, HALF = 128, HTB = HALF * BK * 2, STAGE_BYTES = 8 * HTB, NXCD = 8, WGM = 8;
__host__ __device__ __forceinline__ int lds_byte(int r, int c) { const int st = (r >> 4) * 2 + (c >> 5), rr = r & 15, cc = c & 31, ob = rr * 64 + cc * 2; return st * 1024 + (ob ^ (((ob >> 9) & 1) << 5)); }
__host__ __device__ __forceinline__ void stage_rc(int b, int& R, int& C) { const int st = b / 1024, sb = b % 1024, swz = sb ^ (((sb >> 9) & 1) << 5); R = (st >> 1) * 16 + swz / 64; C = (st & 1) * 32 + (swz % 64) / 2; }
__host__ __device__ __forceinline__ int perm32(int rho) { const int n = rho >> 4, i = rho & 15; return 8 * (i >> 2) + 4 * n + (i & 3); }
struct Unit { int pm, pn; };
struct Gemm { const bf16_t* A; const bf16_t* Bt; int M, N, K; };
struct StaticOrder {
    static constexpr bool GATHER = false;
    int nM, nN, nwg, G, c;
    __host__ __device__ void init(int M, int N, int G_, int c_) { nM = M / BM; nN = N / BM; nwg = nM * nN; G = G_; c = c_; }
    __host__ __device__ bool next(int i, Unit& u) const {
        const long L = (long)i * G + c; if (L >= nwg) return false;
        int wgid = (int)L; { const int q = nwg / NXCD, r = nwg % NXCD, xcd = wgid % NXCD, off = wgid / NXCD; wgid = (xcd < r ? xcd * (q + 1) : r * (q + 1) + (xcd - r) * q) + off; }
        const int nig = WGM * nN, gid = wgid / nig, fm = gid * WGM, gsz = (nM - fm) < WGM ? (nM - fm) : WGM;
        u.pm = fm + ((wgid % nig) % gsz); u.pn = (wgid % nig) / gsz; return true;
    }
    __device__ __forceinline__ void a_ready(const Unit&) const {}
    __device__ __forceinline__ void done(const Unit&) const {}
};
struct TailOrder {
    static constexpr bool GATHER = false;
    int c, first;
    __device__ bool next(int i, Unit& u) const { if (c < first || c >= first + 128 || i >= 2) return false; const int L = (c - first) * 2 + i; u.pm = L >> 3; u.pn = L & 7; return true; }
    __device__ __forceinline__ void a_ready(const Unit&) const {}
    __device__ __forceinline__ void done(const Unit&) const {}
};
struct GroupedOrder {
    static constexpr bool GATHER = false;
    int G, c;
    __device__ bool next(int i, Unit& u) const { const int L = i * G + c; if (L >= 512) return false; const int e = L >> 5, w = L & 31; u.pm = 4 * e + (w & 3); u.pn = 8 * e + (w >> 2); return true; }
    __device__ __forceinline__ void a_ready(const Unit&) const {}
    __device__ __forceinline__ void done(const Unit&) const {}
};
struct GroupedGatherOrder {
    static constexpr bool GATHER = true;
    int G, c; const int* seli;
    __device__ bool next(int i, Unit& u) const { const int L = i * G + c; if (L >= 512) return false; const int e = L >> 5, w = L & 31; u.pm = 4 * e + (w & 3); u.pn = 8 * e + (w >> 2); return true; }
    __device__ __forceinline__ int arow(const Unit& u, int r) const { const int row = u.pm * 256 + r, e = row >> 10, q = row & 1023, b = q >> 9, slot = q & 511; return b * 4096 + seli[(b * 16 + e) * 512 + slot]; }
    __device__ __forceinline__ void a_ready(const Unit&) const {}
    __device__ __forceinline__ void done(const Unit&) const {}
};
__device__ __forceinline__ unsigned cvt_pk_bf16(float lo, float hi) { return cvt_pk_rne(lo, hi); }
struct EpiBf16 {
    static constexpr bool PERM = true, AFTER_DRAIN = false;
    bf16_t* O; int ldc;
    __device__ __forceinline__ void operator()(const f32x4 (&acc)[2][2][4][2], const Unit& u, int wr, int wc, int fr, int fq) const {
        const int row0 = u.pm * BM + wr * 64 + fr, col0 = u.pn * BM + wc * 32 + 8 * fq;
        asm volatile("s_nop 15\n\ts_nop 7" ::: "memory");
#pragma unroll
        for (int ai = 0; ai < 2; ++ai)
#pragma unroll
            for (int m = 0; m < 4; ++m) { bf16_t* rowp = O + (size_t)(row0 + ai * HALF + m * 16) * ldc + col0;
#pragma unroll
                for (int bj = 0; bj < 2; ++bj) { const f32x4 v0 = acc[ai][bj][m][0], v1 = acc[ai][bj][m][1];
                    u32x4 w; w.x = cvt_pk_bf16(v0[0], v0[1]); w.y = cvt_pk_bf16(v0[2], v0[3]); w.z = cvt_pk_bf16(v1[0], v1[1]); w.w = cvt_pk_bf16(v1[2], v1[3]);
                    *(u32x4*)(rowp + bj * HALF) = w; } }
    }
};
__device__ __forceinline__ float bfe(const u32x4& w, int e) { const unsigned x = w[e >> 1]; return __uint_as_float((e & 1) ? (x & 0xffff0000u) : (x << 16)); }
struct EpiBf16Rs {
    static constexpr bool PERM = true, AFTER_DRAIN = false;
    bf16_t* O; int ldc; const float* rs;
    __device__ __forceinline__ void operator()(const f32x4 (&acc)[2][2][4][2], const Unit& u, int wr, int wc, int fr, int fq) const {
        const int row0 = u.pm * BM + wr * 64 + fr, col0 = u.pn * BM + wc * 32 + 8 * fq;
#pragma unroll
        for (int ai = 0; ai < 2; ++ai)
#pragma unroll
            for (int m = 0; m < 4; ++m) { const int row = row0 + ai * HALF + m * 16; const float s = rs[row]; bf16_t* rowp = O + (size_t)row * ldc + col0;
#pragma unroll
                for (int bj = 0; bj < 2; ++bj) { const f32x4 v0 = acc[ai][bj][m][0] * s, v1 = acc[ai][bj][m][1] * s;
                    u32x4 w; w.x = cvt_pk_bf16(v0[0], v0[1]); w.y = cvt_pk_bf16(v0[2], v0[3]); w.z = cvt_pk_bf16(v1[0], v1[1]); w.w = cvt_pk_bf16(v1[2], v1[3]);
                    *(u32x4*)(rowp + bj * HALF) = w; } }
    }
};
struct EpiResidBf16 {
    static constexpr bool PERM = true, AFTER_DRAIN = false;
    bf16_t* H; int ldc;
    __device__ __forceinline__ void operator()(const f32x4 (&acc)[2][2][4][2], const Unit& u, int wr, int wc, int fr, int fq) const {
        const int row0 = u.pm * BM + wr * 64 + fr, col0 = u.pn * BM + wc * 32 + 8 * fq;
#pragma unroll
        for (int ai = 0; ai < 2; ++ai)
#pragma unroll
            for (int m = 0; m < 4; ++m) { bf16_t* rowp = H + (size_t)(row0 + ai * HALF + m * 16) * ldc + col0;
                u32x4 h[2];
#pragma unroll
                for (int bj = 0; bj < 2; ++bj) h[bj] = *(const u32x4*)(rowp + bj * HALF);
#pragma unroll
                for (int bj = 0; bj < 2; ++bj) { const f32x4 v0 = acc[ai][bj][m][0], v1 = acc[ai][bj][m][1];
                    u32x4 w; w.x = cvt_pk_bf16(bfe(h[bj], 0) + v0[0], bfe(h[bj], 1) + v0[1]); w.y = cvt_pk_bf16(bfe(h[bj], 2) + v0[2], bfe(h[bj], 3) + v0[3]);
                    w.z = cvt_pk_bf16(bfe(h[bj], 4) + v1[0], bfe(h[bj], 5) + v1[1]); w.w = cvt_pk_bf16(bfe(h[bj], 6) + v1[2], bfe(h[bj], 7) + v1[3]);
                    *(u32x4*)(rowp + bj * HALF) = w; }
                asm volatile("" ::: "memory"); }
    }
};
struct EpiPleBf16 {
    static constexpr bool PERM = true, AFTER_DRAIN = false;
    const bf16_t* Hin; bf16_t* Hout; const bf16_t* PL; const float* rs;
    __device__ __forceinline__ void operator()(const f32x4 (&acc)[2][2][4][2], const Unit& u, int wr, int wc, int fr, int fq) const {
        const int row0 = u.pm * BM + wr * 64 + fr, col0 = u.pn * BM + wc * 32 + 8 * fq;
#pragma unroll
        for (int ai = 0; ai < 2; ++ai)
#pragma unroll
            for (int m = 0; m < 4; ++m) { const int row = row0 + ai * HALF + m * 16; const float s = rs[row]; const size_t off = (size_t)row * 2048 + col0;
                u32x4 h[2], p[2];
#pragma unroll
                for (int bj = 0; bj < 2; ++bj) { h[bj] = *(const u32x4*)(Hin + off + bj * HALF); p[bj] = *(const u32x4*)(PL + off + bj * HALF); }
#pragma unroll
                for (int bj = 0; bj < 2; ++bj) { float o[8];
#pragma unroll
                    for (int e = 0; e < 8; ++e) { const float a = acc[ai][bj][m][e >> 2][e & 3] * s; o[e] = bfe(h[bj], e) + __builtin_amdgcn_rcpf(1.0f + __expf(-a)) * bfe(p[bj], e); }
                    u32x4 w; w.x = cvt_pk_bf16(o[0], o[1]); w.y = cvt_pk_bf16(o[2], o[3]); w.z = cvt_pk_bf16(o[4], o[5]); w.w = cvt_pk_bf16(o[6], o[7]);
                    *(u32x4*)(Hout + off + bj * HALF) = w; }
                asm volatile("" ::: "memory"); }
    }
};
struct EpiResidF32 {
    static constexpr bool PERM = false, AFTER_DRAIN = false;
    float* H; int ldc;
    __device__ __forceinline__ void operator()(const f32x4 (&acc)[2][2][4][2], const Unit& u, int wr, int wc, int fr, int fq) const {
        const int row0 = u.pm * BM + wr * 64 + fr, col0 = u.pn * BM + wc * 32 + 4 * fq;
#pragma unroll
        for (int ai = 0; ai < 2; ++ai)
#pragma unroll
            for (int m = 0; m < 4; ++m) { float* rowp = H + (size_t)(row0 + ai * HALF + m * 16) * ldc + col0;
                f32x4 h[2][2];
#pragma unroll
                for (int bj = 0; bj < 2; ++bj)
#pragma unroll
                    for (int n = 0; n < 2; ++n) h[bj][n] = *(const f32x4*)(rowp + bj * HALF + n * 16);
#pragma unroll
                for (int bj = 0; bj < 2; ++bj)
#pragma unroll
                    for (int n = 0; n < 2; ++n) *(f32x4*)(rowp + bj * HALF + n * 16) = h[bj][n] + acc[ai][bj][m][n];
                asm volatile("" ::: "memory"); }
    }
};
struct EpiGateUp {
    static constexpr bool PERM = true, AFTER_DRAIN = false;
    bf16_t* HID; const float* selr;
    __device__ __forceinline__ void operator()(const f32x4 (&acc)[2][2][4][2], const Unit& u, int wr, int wc, int fr, int fq) const {
        const int row0 = u.pm * BM + wr * 64 + fr, col0 = (u.pn & 7) * 128 + wc * 32 + 8 * fq;
#pragma unroll
        for (int ai = 0; ai < 2; ++ai)
#pragma unroll
            for (int m = 0; m < 4; ++m) { float o[8]; const float s = selr[row0 + ai * HALF + m * 16];
#pragma unroll
                for (int n = 0; n < 2; ++n)
#pragma unroll
                    for (int j = 0; j < 4; ++j) { const float g = acc[ai][0][m][n][j] * s, up = acc[ai][1][m][n][j] * s; o[4 * n + j] = g * __builtin_amdgcn_rcpf(1.0f + __expf(-g)) * up; }
                u32x4 w; w.x = cvt_pk_bf16(o[0], o[1]); w.y = cvt_pk_bf16(o[2], o[3]); w.z = cvt_pk_bf16(o[4], o[5]); w.w = cvt_pk_bf16(o[6], o[7]);
                *(u32x4*)(HID + (size_t)(row0 + ai * HALF + m * 16) * 1024 + col0) = w; }
    }
};
struct EpiDownBf16 {
    static constexpr bool PERM = true, AFTER_DRAIN = false;
    bf16_t* O; const float* gate;
    __device__ __forceinline__ void operator()(const f32x4 (&acc)[2][2][4][2], const Unit& u, int wr, int wc, int fr, int fq) const {
        const int row0 = u.pm * BM + wr * 64 + fr, col0 = (u.pn & 7) * BM + wc * 32 + 8 * fq;
#pragma unroll
        for (int ai = 0; ai < 2; ++ai)
#pragma unroll
            for (int m = 0; m < 4; ++m) { const int row = row0 + ai * HALF + m * 16; const float gt = gate[row]; bf16_t* rowp = O + (size_t)row * 2048 + col0;
#pragma unroll
                for (int bj = 0; bj < 2; ++bj) { const f32x4 v0 = acc[ai][bj][m][0] * gt, v1 = acc[ai][bj][m][1] * gt;
                    u32x4 w; w.x = cvt_pk_bf16(v0[0], v0[1]); w.y = cvt_pk_bf16(v0[2], v0[3]); w.z = cvt_pk_bf16(v1[0], v1[1]); w.w = cvt_pk_bf16(v1[2], v1[3]);
                    *(u32x4*)(rowp + bj * HALF) = w; } }
    }
};
struct EpiPleF32 {
    static constexpr bool PERM = false, AFTER_DRAIN = false;
    float* H; const bf16_t* PL;
    __device__ __forceinline__ void operator()(const f32x4 (&acc)[2][2][4][2], const Unit& u, int wr, int wc, int fr, int fq) const {
        typedef unsigned u32x2v __attribute__((ext_vector_type(2)));
        const int row0 = u.pm * BM + wr * 64 + fr, col0 = u.pn * BM + wc * 32 + 4 * fq;
#pragma unroll
        for (int ai = 0; ai < 2; ++ai)
#pragma unroll
            for (int m = 0; m < 4; ++m) { const size_t off = (size_t)(row0 + ai * HALF + m * 16) * 2048 + col0;
                f32x4 h[2][2]; u32x2v p[2][2];
#pragma unroll
                for (int bj = 0; bj < 2; ++bj)
#pragma unroll
                    for (int n = 0; n < 2; ++n) { h[bj][n] = *(const f32x4*)(H + off + bj * HALF + n * 16); p[bj][n] = *(const u32x2v*)(PL + off + bj * HALF + n * 16); }
#pragma unroll
                for (int bj = 0; bj < 2; ++bj)
#pragma unroll
                    for (int n = 0; n < 2; ++n) { const f32x4 a = acc[ai][bj][m][n]; f32x4 pl; pl[0] = __uint_as_float(p[bj][n].x << 16); pl[1] = __uint_as_float(p[bj][n].x & 0xffff0000u); pl[2] = __uint_as_float(p[bj][n].y << 16); pl[3] = __uint_as_float(p[bj][n].y & 0xffff0000u);
                        f32x4 o;
#pragma unroll
                        for (int j = 0; j < 4; ++j) o[j] = h[bj][n][j] + __builtin_amdgcn_rcpf(1.0f + __expf(-a[j])) * pl[j];
                        *(f32x4*)(H + off + bj * HALF + n * 16) = o; }
                asm volatile("" ::: "memory"); }
    }
};
template <class Epi, class Sched, bool STAMP = false>
__device__ __forceinline__ void gemm_phase(PG8_LAS unsigned char* lds, const Gemm g, const Sched& S, const Epi& E, unsigned long long* stamps, const int wave0) {
    int tid_ = wave0 * 64 + lane_id(); asm volatile("" : "+v"(tid_));
    const int tid = tid_, wid = __builtin_amdgcn_readfirstlane(tid >> 6), lane = tid & 63, wr = wid >> 2, wc = wid & 3, fr = lane & 15, fq = lane >> 4;
    const int K = g.K, nt = K / BK;
    int ts_lo = 0, ts_hi = 0, nts = 0; const unsigned long long rt_entry = STAMP ? (unsigned long long)wall_clock64() : 0ull;
#define PG8_STAMP() do { if (STAMP && wid == 0 && nts < 64) { const unsigned long long _c = (unsigned long long)clock64(); \
        ts_lo = (lane == nts) ? (int)(unsigned)_c : ts_lo; ts_hi = (lane == nts) ? (int)(unsigned)(_c >> 32) : ts_hi; ++nts; } } while (0)
    PG8_STAMP();
    unsigned voffA[2], voffB[2];
    unsigned gvc[2][2] = {{0u, 0u}, {0u, 0u}}, gvn[2][2] = {{0u, 0u}, {0u, 0u}}; int gR[2] = {0, 0}, gC[2] = {0, 0};
#pragma unroll
    for (int i = 0; i < 2; ++i) { int R, C; stage_rc(tid * 16 + i * 8192, R, C); const int Rb = Epi::PERM ? ((R & ~31) + perm32(R & 31)) : R;
        voffA[i] = (unsigned)(R * K + C) * 2u; voffB[i] = (unsigned)(Rb * K + C) * 2u; gR[i] = R; gC[i] = C; }
    const size_t kstep = (size_t)(BK * 2);
    const size_t hstep = (size_t)HALF * K * 2;
    const size_t tstep = 2 * hstep;
    const unsigned ldsw = (unsigned)wid * 1024u;
    const int aoff = lds_byte(wr * 64 + fr, fq * 8), boff = lds_byte(wc * 32 + fr, fq * 8);
#define PG8_SA(b, h) (((b) * 2 + (h)) * HTB)
#define PG8_SB(b, h) ((4 + (b) * 2 + (h)) * HTB)
#define PG8_STAGE(bufoff, gbase, voff) do { _Pragma("unroll") for (int _i = 0; _i < 2; ++_i) \
        __builtin_amdgcn_global_load_lds((const unsigned*)((const char*)(gbase) + (voff)[_i]), (PG8_LAS unsigned*)(lds + (bufoff) + ldsw + _i * 8192), 16, 0, 0); } while (0)
#define PG8_STAGE_A(bufoff, gbase, h, un) do { if constexpr (Sched::GATHER) { unsigned _o[2]; _o[0] = (un) ? gvn[h][0] : gvc[h][0]; _o[1] = (un) ? gvn[h][1] : gvc[h][1]; PG8_STAGE(bufoff, gbase, _o); } \
        else { PG8_STAGE(bufoff, (gbase) + ((h) ? hstep : (size_t)0), voffA); } } while (0)
#define PG8_GOFF(dst, u) do { _Pragma("unroll") for (int _h = 0; _h < 2; ++_h) _Pragma("unroll") for (int _i = 0; _i < 2; ++_i) dst[_h][_i] = ((unsigned)S.arow(u, _h * HALF + gR[_i]) * (unsigned)K + (unsigned)gC[_i]) * 2u; } while (0)
#define PG8_LDA(dst, b, h) do { _Pragma("unroll") for (int m = 0; m < 4; ++m) _Pragma("unroll") for (int k = 0; k < 2; ++k) dst[m][k] = *(const PG8_LAS bf16x8*)(lds + PG8_SA(b, h) + aoff + m * 2048 + k * 1024); } while (0)
#define PG8_LDB(dst, b, h) do { _Pragma("unroll") for (int n = 0; n < 2; ++n) _Pragma("unroll") for (int k = 0; k < 2; ++k) dst[n][k] = *(const PG8_LAS bf16x8*)(lds + PG8_SB(b, h) + boff + n * 2048 + k * 1024); } while (0)
#define PG8_MMA(ai, bj, At, Bt) do { __builtin_amdgcn_s_setprio(1); _Pragma("unroll") for (int m = 0; m < 4; ++m) _Pragma("unroll") for (int n = 0; n < 2; ++n) _Pragma("unroll") for (int k = 0; k < 2; ++k) \
        acc[ai][bj][m][n] = __builtin_amdgcn_mfma_f32_16x16x32_bf16(Bt[n][k], At[m][k], acc[ai][bj][m][n], 0, 0, 0); __builtin_amdgcn_s_setprio(0); } while (0)
#define PG8_WAIT_V(n) asm volatile("s_waitcnt vmcnt(" #n ")" ::: "memory")
#define PG8_WAIT_L(n) asm volatile("s_waitcnt lgkmcnt(" #n ")" ::: "memory")
#define PG8_BAR __builtin_amdgcn_s_barrier()
#define PG8_SCHED __builtin_amdgcn_sched_barrier(0)
    Unit cur, nxt; int ui = 0;
    if (!S.next(0, cur)) return;
    f32x4 acc[2][2][4][2];
#pragma unroll
    for (int a = 0; a < 2; ++a)
#pragma unroll
        for (int b = 0; b < 2; ++b)
#pragma unroll
            for (int m = 0; m < 4; ++m)
#pragma unroll
                for (int n = 0; n < 2; ++n) acc[a][b][m][n] = (f32x4){0.f, 0.f, 0.f, 0.f};
    bf16x8 At[4][2], B0[2][2], B1[2][2];
    const char* cA = (const char*)g.A + (Sched::GATHER ? (size_t)0 : (size_t)cur.pm * tstep); const char* cB = (const char*)g.Bt + (size_t)cur.pn * tstep;
    if constexpr (Sched::GATHER) PG8_GOFF(gvc, cur);
    S.a_ready(cur);
    PG8_STAGE(PG8_SB(0, 0), cB, voffB); PG8_STAGE_A(PG8_SA(0, 0), cA, 0, false); PG8_STAGE(PG8_SB(0, 1), cB + hstep, voffB); PG8_STAGE_A(PG8_SA(0, 1), cA, 1, false);
    if (wr == 1) PG8_BAR;
    PG8_WAIT_V(4); PG8_BAR;
    PG8_STAGE(PG8_SB(1, 0), cB + kstep, voffB); PG8_STAGE_A(PG8_SA(1, 0), cA + kstep, 0, false); PG8_STAGE(PG8_SB(1, 1), cB + hstep + kstep, voffB);
    PG8_WAIT_V(6); PG8_BAR;
    PG8_STAMP();
    for (;;) {
        const bool has_next = S.next(ui + 1, nxt);
        if constexpr (Sched::GATHER) { if (has_next) PG8_GOFF(gvn, nxt); }
        const char* nA = (has_next && !Sched::GATHER) ? (const char*)g.A + (size_t)nxt.pm * tstep : cA; const char* nB = has_next ? (const char*)g.Bt + (size_t)nxt.pn * tstep : cB;
        for (int t = 0; t < nt; t += 2) {
            const bool last = (t == nt - 2);
            const char* a1 = cA + (size_t)(t + 1) * kstep;
            const char* a2 = last ? nA : cA + (size_t)(t + 2) * kstep; const char* b2 = last ? nB : cB + (size_t)(t + 2) * kstep;
            const char* a3 = a2 + kstep; const char* b3 = b2 + kstep;
            if (last && has_next) S.a_ready(nxt);
            const bool un = last && has_next;
            PG8_LDB(B0, 0, 0); PG8_SCHED; PG8_LDA(At, 0, 0); PG8_STAGE_A(PG8_SA(1, 1), a1, 1, false);
            PG8_WAIT_L(8); PG8_BAR; PG8_WAIT_L(0); PG8_MMA(0, 0, At, B0); PG8_BAR; PG8_SCHED;
            PG8_LDB(B1, 0, 1); PG8_STAGE(PG8_SB(0, 0), b2, voffB);
            PG8_BAR; PG8_WAIT_L(0); PG8_MMA(0, 1, At, B1); PG8_BAR;
            PG8_LDA(At, 0, 1); PG8_STAGE_A(PG8_SA(0, 0), a2, 0, un);
            PG8_BAR; PG8_WAIT_L(0); PG8_MMA(1, 0, At, B0); PG8_BAR; PG8_SCHED;
            PG8_STAGE(PG8_SB(0, 1), b2 + hstep, voffB);
            PG8_WAIT_V(6); PG8_BAR; PG8_MMA(1, 1, At, B1); PG8_BAR;
            PG8_LDB(B0, 1, 0); PG8_SCHED; PG8_LDA(At, 1, 0); PG8_STAGE_A(PG8_SA(0, 1), a2, 1, un);
            PG8_WAIT_L(8); PG8_BAR; PG8_WAIT_L(0); PG8_MMA(0, 0, At, B0); PG8_BAR; PG8_SCHED;
            PG8_LDB(B1, 1, 1); PG8_STAGE(PG8_SB(1, 0), b3, voffB);
            PG8_BAR; PG8_WAIT_L(0); PG8_MMA(0, 1, At, B1); PG8_BAR;
            PG8_LDA(At, 1, 1); PG8_STAGE_A(PG8_SA(1, 0), a3, 0, un);
            PG8_BAR; PG8_WAIT_L(0); PG8_MMA(1, 0, At, B0); PG8_BAR; PG8_SCHED;
            PG8_STAGE(PG8_SB(1, 1), b3 + hstep, voffB);
            PG8_WAIT_V(6); PG8_BAR; PG8_MMA(1, 1, At, B1); PG8_BAR;
        }
        PG8_STAMP();
        if constexpr (!Epi::AFTER_DRAIN) { E(acc, cur, wr, wc, fr, fq); S.done(cur); }
        PG8_STAMP();
        if (!has_next) break;
#pragma unroll
        for (int a = 0; a < 2; ++a)
#pragma unroll
            for (int b = 0; b < 2; ++b)
#pragma unroll
                for (int m = 0; m < 4; ++m)
#pragma unroll
                    for (int n = 0; n < 2; ++n) acc[a][b][m][n] = (f32x4){0.f, 0.f, 0.f, 0.f};
        cur = nxt; cA = nA; cB = nB; ++ui;
        if constexpr (Sched::GATHER) { _Pragma("unroll") for (int _h = 0; _h < 2; ++_h) _Pragma("unroll") for (int _i = 0; _i < 2; ++_i) gvc[_h][_i] = gvn[_h][_i]; }
    }
    PG8_WAIT_V(0);
    if (wr == 0) PG8_BAR;
    PG8_BAR;
    if constexpr (Epi::AFTER_DRAIN) { E.fused(acc, cur, wr, wc, fr, fq, lds, wid, lane); S.done(cur); }
    PG8_STAMP();
    if (STAMP && wid == 0) { stamps[lane] = lane < nts ? (((unsigned long long)(unsigned)ts_hi << 32) | (unsigned)ts_lo) : 0ull;
        if (lane == 62) stamps[62] = rt_entry; if (lane == 63) stamps[63] = (unsigned long long)wall_clock64(); }
#undef PG8_STAMP
#undef PG8_SA
#undef PG8_SB
#undef PG8_STAGE
#undef PG8_STAGE_A
#undef PG8_GOFF
#undef PG8_LDA
#undef PG8_LDB
#undef PG8_MMA
#undef PG8_WAIT_V
#undef PG8_WAIT_L
#undef PG8_BAR
#undef PG8_SCHED
}
}


namespace attn {
using bf16 = unsigned short;
constexpr int   D = 128, NW = 8, QBLK = 32, KVBLK = 64;
constexpr float SCALE = 0.088388347648318440f;
constexpr float THR = 8.f;
constexpr int SDEPTH = 1;
constexpr int LDQ = 5120, LDK = 5120, LDO = 2048;
constexpr size_t SHM_V = KVBLK * D * 2, SHM_K = KVBLK * D * 2, SHM_ATTN = 2 * SHM_V + 2 * SHM_K + NW * 64 * 4;
using bf16x8 = __attribute__((ext_vector_type(8))) short;
using s16x4  = __attribute__((ext_vector_type(4))) short;
using f32x16 = __attribute__((ext_vector_type(16))) float;
using f32x8  = __attribute__((ext_vector_type(8))) float;
using u32x4  = __attribute__((ext_vector_type(4))) unsigned;
#define KSWZ(row, colB) ((row) * 256 + ((colB) ^ (((row) & 7) << 4)))
#define SBAR() __builtin_amdgcn_sched_barrier(0)
__device__ __forceinline__ int crow(int r, int hi) { return (r & 3) + 8 * (r >> 2) + 4 * hi; }
__device__ __forceinline__ unsigned cvtpk(float lo, float hi) { return cvt_pk_rne(lo, hi); }
template <typename TIn> struct Stage;
template <> struct Stage<bf16>  { using T = bf16x8;
  __device__ static __forceinline__ T ld8(const bf16* p) { return *reinterpret_cast<const bf16x8*>(p); }
  __device__ static __forceinline__ bf16x8 tobf(T x) { return x; } };
template <> struct Stage<float> { using T = f32x8;
  __device__ static __forceinline__ T ld8(const float* p) { return *reinterpret_cast<const f32x8*>(p); }
  __device__ static __forceinline__ bf16x8 tobf(T x) {
    u32x4 w = {cvtpk(x[0], x[1]), cvtpk(x[2], x[3]), cvtpk(x[4], x[5]), cvtpk(x[6], x[7])}; return *reinterpret_cast<bf16x8*>(&w); } };

__device__ __forceinline__ void partialSM(f32x16& p0, f32x16& p1, float& m_reg, float& mn, float& alpha) {
  constexpr float C = SCALE * 1.4426950408889634f;
  float pmax = p0[0]; for (int r = 1; r < 16; ++r) pmax = fmaxf(pmax, p0[r]); for (int r = 0; r < 16; ++r) pmax = fmaxf(pmax, p1[r]);
  { auto rr = __builtin_amdgcn_permlane32_swap(__float_as_uint(pmax), __float_as_uint(pmax), false, false);
    pmax = fmaxf(__uint_as_float(rr[0]), __uint_as_float(rr[1])); }
  if (__builtin_expect(__all(pmax - m_reg <= THR / SCALE), 1)) { mn = m_reg; alpha = 1.f; }
  else { mn = fmaxf(m_reg, pmax); alpha = __builtin_amdgcn_exp2f((m_reg - mn) * C); m_reg = mn; }
  float mnC = -mn * C;
  for (int r = 0; r < 16; ++r) p0[r] = fmaf(p0[r], C, mnC); for (int r = 0; r < 16; ++r) p1[r] = fmaf(p1[r], C, mnC);
  for (int r = 0; r < 16; ++r) p0[r] = __builtin_amdgcn_exp2f(p0[r]);
}
__device__ __forceinline__ void finishSM(f32x16& p0, f32x16& p1, float alpha, float& l_reg, bf16x8& pa0, bf16x8& pa1, bf16x8& pa2, bf16x8& pa3) {
  for (int r = 0; r < 16; ++r) p1[r] = __builtin_amdgcn_exp2f(p1[r]);
  float ps = 0; for (int r = 0; r < 16; ++r) ps += p0[r]; for (int r = 0; r < 16; ++r) ps += p1[r];
  { auto rr = __builtin_amdgcn_permlane32_swap(__float_as_uint(ps), __float_as_uint(ps), false, false);
    ps = __uint_as_float(rr[0]) + __uint_as_float(rr[1]); }
  l_reg = l_reg * alpha + ps;
#define PK4(P, BASE, OUT) do { unsigned a0 = cvtpk(P[BASE + 0], P[BASE + 1]), a1 = cvtpk(P[BASE + 2], P[BASE + 3]);   \
    unsigned b0 = cvtpk(P[BASE + 4], P[BASE + 5]), b1 = cvtpk(P[BASE + 6], P[BASE + 7]);                              \
    auto r0 = __builtin_amdgcn_permlane32_swap(a0, b0, false, false); auto r1 = __builtin_amdgcn_permlane32_swap(a1, b1, false, false); \
    u32x4 w = {r0[0], r1[0], r0[1], r1[1]}; OUT = *reinterpret_cast<bf16x8*>(&w); } while (0)
  PK4(p0, 0, pa0); PK4(p0, 8, pa1); PK4(p1, 0, pa2); PK4(p1, 8, pa3);
#undef PK4
}
__device__ __forceinline__ void qkt(f32x16& p0, f32x16& p1, const bf16* Ks, const bf16x8* qr, int r32, int hi) {
  p0 = f32x16{}; p1 = f32x16{};
  for (int d0 = 0; d0 < 8; ++d0) { int cb = (d0 * 16 + hi * 8) * 2;
    bf16x8 b0 = *reinterpret_cast<const bf16x8*>((const char*)Ks + KSWZ(r32, cb));
    bf16x8 b1 = *reinterpret_cast<const bf16x8*>((const char*)Ks + KSWZ(32 + r32, cb));
    p0 = __builtin_amdgcn_mfma_f32_32x32x16_bf16(b0, qr[d0], p0, 0, 0, 0);
    p1 = __builtin_amdgcn_mfma_f32_32x32x16_bf16(b1, qr[d0], p1, 0, 0, 0); }
}
__device__ __forceinline__ int v_st(int k, int c) { const int kk = (k & ~0xC) | ((k & 4) << 1) | ((k & 8) >> 1); return ((kk >> 3) * 4 + (c >> 5)) * 512 + ((kk & 7) * 32 + (c & 31)) * 2; }
__device__ __forceinline__ int v_rd_base(int lane) { return ((lane & 3) << 3) | (((lane >> 2) & 3) << 6) | (((lane >> 4) & 1) << 5) | (((lane >> 5) & 1) << 8); }
constexpr int v_rd_off(int d0, int ks, int half) { return d0 * 512 + ks * 4096 + half * 2048; }
template <int OFF> __device__ __forceinline__ s16x4 tr_read(int vb) {
  s16x4 r; asm volatile("ds_read_b64_tr_b16 %0, %1 offset:%2" : "=&v"(r) : "v"(vb), "i"(OFF) : "memory"); return r;
}
template <int D0> __device__ __forceinline__ void pv_one(f32x16& od, int vb, bf16x8 pa0, bf16x8 pa1, bf16x8 pa2, bf16x8 pa3) {
  const s16x4 l0 = tr_read<v_rd_off(D0, 0, 0)>(vb), h0 = tr_read<v_rd_off(D0, 0, 1)>(vb), l1 = tr_read<v_rd_off(D0, 1, 0)>(vb), h1 = tr_read<v_rd_off(D0, 1, 1)>(vb);
  const s16x4 l2 = tr_read<v_rd_off(D0, 2, 0)>(vb), h2 = tr_read<v_rd_off(D0, 2, 1)>(vb), l3 = tr_read<v_rd_off(D0, 3, 0)>(vb), h3 = tr_read<v_rd_off(D0, 3, 1)>(vb);
  asm volatile("s_waitcnt lgkmcnt(0)" ::: "memory"); SBAR();
#define PK(L, H) (bf16x8){L[0], L[1], L[2], L[3], H[0], H[1], H[2], H[3]}
  od = __builtin_amdgcn_mfma_f32_32x32x16_bf16(pa0, PK(l0, h0), od, 0, 0, 0);
  od = __builtin_amdgcn_mfma_f32_32x32x16_bf16(pa1, PK(l1, h1), od, 0, 0, 0);
  od = __builtin_amdgcn_mfma_f32_32x32x16_bf16(pa2, PK(l2, h2), od, 0, 0, 0);
  od = __builtin_amdgcn_mfma_f32_32x32x16_bf16(pa3, PK(l3, h3), od, 0, 0, 0);
#undef PK
}
__device__ __forceinline__ void pv_d0(f32x16* o, int vb, bf16x8 pa0, bf16x8 pa1, bf16x8 pa2, bf16x8 pa3) {
  pv_one<0>(o[0], vb, pa0, pa1, pa2, pa3); pv_one<1>(o[1], vb, pa0, pa1, pa2, pa3); pv_one<2>(o[2], vb, pa0, pa1, pa2, pa3); pv_one<3>(o[3], vb, pa0, pa1, pa2, pa3);
}

template <typename TQ>
__device__ __forceinline__ void attn_dense_body(const TQ* __restrict__ Qb, const bf16* __restrict__ Kh, const bf16* __restrict__ Vh,
                                                float* __restrict__ Ob, int seq, char* lds, const int wave0) {
  using St = Stage<bf16>; using SQ = Stage<TQ>;
  int tid_ = wave0 * 64 + lane_id(); asm volatile("" : "+v"(tid_));
  const int tid = tid_, wid = tid >> 6, lane = tid & 63, r32 = lane & 31, hi = lane >> 5;
  bf16* V_lds = (bf16*)lds; bf16* K_lds = (bf16*)(lds + 2 * SHM_V);
  float* ws = (float*)(lds + 2 * SHM_V + 2 * SHM_K) + wid * 64; float* li_l = ws; float* al_l = ws + 32;
  float m_reg = -1e30f, l_reg = 0; f32x16 o[4] = {}; bf16x8 qr[8];
  const TQ* Qw = Qb + (long)(wid * QBLK + r32) * LDQ + hi * 8;
#pragma unroll
  for (int d0 = 0; d0 < 8; ++d0) qr[d0] = SQ::tobf(SQ::ld8(Qw + d0 * 16));
  const int sr = tid >> 4, sc = (tid & 15) * 8, vst0 = v_st(sr, sc), vst1 = v_st(32 + sr, sc);
  const int vb0 = (int)(uintptr_t)V_lds + v_rd_base(lane);
  struct { typename St::T vs0, vs1, ks0, ks1; } sr_[SDEPTH];
#define SLOAD(i, k0) do { sr_[i].vs0 = St::ld8(&Vh[(long)((k0) + sr) * LDK + sc]); sr_[i].vs1 = St::ld8(&Vh[(long)((k0) + 32 + sr) * LDK + sc]); \
    sr_[i].ks0 = St::ld8(&Kh[(long)((k0) + sr) * LDK + sc]); sr_[i].ks1 = St::ld8(&Kh[(long)((k0) + 32 + sr) * LDK + sc]); } while (0)
#define SWRITE(b, i) do { *(bf16x8*)((char*)V_lds + (b) * SHM_V + vst0) = St::tobf(sr_[i].vs0);          \
    *(bf16x8*)((char*)V_lds + (b) * SHM_V + vst1) = St::tobf(sr_[i].vs1); int kc = sc * 2;               \
    *(bf16x8*)((char*)K_lds + (b) * SHM_K + KSWZ(sr, kc)) = St::tobf(sr_[i].ks0);                       \
    *(bf16x8*)((char*)K_lds + (b) * SHM_K + KSWZ(32 + sr, kc)) = St::tobf(sr_[i].ks1); } while (0)
#define SWAIT() do { if constexpr (SDEPTH == 2) asm volatile("s_waitcnt vmcnt(4)" ::: "memory"); else asm volatile("s_waitcnt vmcnt(0)" ::: "memory"); } while (0)
#define RESC(a) do { if (__any((a) < 1.f)) { if (hi == 0) al_l[r32] = (a); asm volatile("s_waitcnt lgkmcnt(0)" ::: "memory"); \
    for (int d = 0; d < 4; ++d) for (int r = 0; r < 16; ++r) o[d][r] *= al_l[crow(r, hi)]; } } while (0)
  f32x16 pA0, pA1, pB0, pB1; float mnA, mnB, alA, alB; bf16x8 pa0, pa1, pa2, pa3; const int NT = seq / KVBLK;
  constexpr int SE = 0, SO = SDEPTH - 1;
  SLOAD(SE, 0); asm volatile("s_waitcnt vmcnt(0)" ::: "memory"); SWRITE(0, SE); __syncthreads();
  qkt(pA0, pA1, K_lds, qr, r32, hi); partialSM(pA0, pA1, m_reg, mnA, alA);
  SLOAD(SO, KVBLK); if constexpr (SDEPTH == 2) { if (2 < NT) SLOAD(SE, 2 * KVBLK); }
  SWAIT(); SWRITE(1, SO); __syncthreads();
  for (int j = 1; j + 1 < NT; j += 2) {
    SBAR(); qkt(pB0, pB1, (bf16*)((char*)K_lds + SHM_K), qr, r32, hi);
    finishSM(pA0, pA1, alA, l_reg, pa0, pa1, pa2, pa3); SBAR();
    SLOAD(SO, (j + SDEPTH) * KVBLK); SBAR();
    pv_d0(o, vb0, pa0, pa1, pa2, pa3); partialSM(pB0, pB1, m_reg, mnB, alB);
    __syncthreads(); SWAIT(); SWRITE(0, SE);
    RESC(alB); __syncthreads();
    SBAR(); qkt(pA0, pA1, K_lds, qr, r32, hi);
    finishSM(pB0, pB1, alB, l_reg, pa0, pa1, pa2, pa3); SBAR();
    if (SDEPTH == 1 || j + 3 < NT) SLOAD(SE, (j + 1 + SDEPTH) * KVBLK); SBAR();
    pv_d0(o, vb0 + (int)SHM_V, pa0, pa1, pa2, pa3); partialSM(pA0, pA1, m_reg, mnA, alA);
    __syncthreads(); SWAIT(); SWRITE(1, SO);
    RESC(alA); __syncthreads();
  }
  SBAR(); qkt(pB0, pB1, (bf16*)((char*)K_lds + SHM_K), qr, r32, hi);
  finishSM(pA0, pA1, alA, l_reg, pa0, pa1, pa2, pa3); SBAR();
  pv_d0(o, vb0, pa0, pa1, pa2, pa3); partialSM(pB0, pB1, m_reg, mnB, alB);
  __syncthreads(); RESC(alB);
  finishSM(pB0, pB1, alB, l_reg, pa0, pa1, pa2, pa3); SBAR();
  pv_d0(o, vb0 + (int)SHM_V, pa0, pa1, pa2, pa3);
  if (hi == 0) li_l[r32] = l_reg; asm volatile("s_waitcnt lgkmcnt(0)" ::: "memory");
  float rli[16];
#pragma unroll
  for (int r = 0; r < 16; ++r) rli[r] = __builtin_amdgcn_rcpf(li_l[crow(r, hi)]);
  float* Ow = Ob + (long)(wid * QBLK) * LDO;
#pragma unroll
  for (int r = 0; r < 16; ++r) { int orow = crow(r, hi);
    for (int d0 = 0; d0 < 4; ++d0) Ow[(long)orow * LDO + d0 * 32 + r32] = o[d0][r] * rli[r]; }
#undef SLOAD
#undef SWRITE
#undef SWAIT
#undef RESC
}

}

template <class Epi>
__device__ __forceinline__ void naive_gemm(Frame& F, const bf16* __restrict__ A, int lda, const bf16* __restrict__ Bt, int ldb, int M, int N, int K, const Epi& epi) {
    LAS float* As = (LAS float*)F.lds;
    LAS float* Bs = As + 32 * 132;
    const int tid = F.tid, tm = tid >> 4, tn = tid & 15;
    const int ntm = M / 128, ntn = N / 64;
    for (int tile = F.vcu; tile < ntm * ntn; tile += F.G) {
        const int pm = tile / ntn, pn = tile % ntn;
        float acc[4][4];
#pragma unroll
        for (int i = 0; i < 4; ++i)
#pragma unroll
            for (int j = 0; j < 4; ++j) acc[i][j] = 0.f;
        for (int k0 = 0; k0 < K; k0 += 32) {
            { const int r = tid >> 2, ks = (tid & 3) * 8; const bf16x8 v = *(const bf16x8*)(A + (size_t)(pm * 128 + r) * lda + k0 + ks);
#pragma unroll
              for (int j = 0; j < 8; ++j) As[(ks + j) * 132 + r] = bf2f((bf16)v[j]); }
            if (tid < 256) { const int r = tid >> 2, ks = (tid & 3) * 8; const bf16x8 v = *(const bf16x8*)(Bt + (size_t)(pn * 64 + r) * ldb + k0 + ks);
#pragma unroll
              for (int j = 0; j < 8; ++j) Bs[(ks + j) * 68 + r] = bf2f((bf16)v[j]); }
            __syncthreads();
#pragma unroll 8
            for (int kk = 0; kk < 32; ++kk) { const f32x4 a = *(const LAS f32x4*)(As + kk * 132 + tm * 4); const f32x4 b = *(const LAS f32x4*)(Bs + kk * 68 + tn * 4);
#pragma unroll
                for (int i = 0; i < 4; ++i)
#pragma unroll
                    for (int j = 0; j < 4; ++j) acc[i][j] = fmaf(a[i], b[j], acc[i][j]); }
            __syncthreads();
        }
#pragma unroll
        for (int i = 0; i < 4; ++i)
#pragma unroll
            for (int j = 0; j < 4; ++j) epi(pm * 128 + tm * 4 + i, pn * 64 + tn * 4 + j, acc[i][j]);
    }
}

__device__ __forceinline__ void phase_post(Frame& F, int l) {
    bf16* PROJ = WSP(bf16, WS_PROJ);
    const float2* TA = WSP(float2, WS_TABA); const float2* TB = WSP(float2, WS_TABB);
    const float* qn = GIN(5) + l * HD; const float* kn = GIN(6) + l * HD;
    const int gw = F.vcu * NWAVES + F.wave, NGW = F.G * NWAVES, lane = F.lane;
    const int sgA = lane >> 3, iA = (lane & 7) * 2, baseA = (sgA < 4 ? COL_AQ + sgA * HD : COL_AK + (sgA - 4) * HD) + iA;
    const int hsel = lane >> 5, q = lane & 31, hf = q >> 4, i2 = (q & 15) * 2, eo = hf * 64 + i2;
    const float gq0 = qn[eo], gq1 = qn[eo + 1], gq2 = qn[eo + 32], gq3 = qn[eo + 33], gk0 = kn[eo], gk1 = kn[eo + 1], gk2 = kn[eo + 32], gk3 = kn[eo + 33];
    for (int t = gw; t < T; t += NGW) {
        const int s = t & (SEQ - 1);
        bf16* row = PROJ + (size_t)t * DINP;
        const unsigned a1 = *(const unsigned*)(row + baseA), a2 = *(const unsigned*)(row + baseA + 16);
        const f32x4 csa = *(const f32x4*)(TA + s * 16 + iA);
        const int pos = hf == 0 ? (s >> 6) : (s & 63); const f32x4 csb = *(const f32x4*)(TB + pos * 32 + i2);
        unsigned b1[5], b2[5];
#pragma unroll
        for (int p = 0; p < 5; ++p) { const int hh = 2 * p + hsel, base = (p < 4 ? COL_BQ + hh * HD : COL_BK + (hh - 8) * HD) + eo; b1[p] = *(const unsigned*)(row + base); b2[p] = *(const unsigned*)(row + base + 32); }
        { const float x1l = __uint_as_float(a1 << 16), x1h = __uint_as_float(a1 & 0xffff0000u), x2l = __uint_as_float(a2 << 16), x2h = __uint_as_float(a2 & 0xffff0000u);
          *(unsigned*)(row + baseA) = pk2(x1l * csa.x - x2l * csa.y, x1h * csa.z - x2h * csa.w); *(unsigned*)(row + baseA + 16) = pk2(x2l * csa.x + x1l * csa.y, x2h * csa.z + x1h * csa.w); }
#pragma unroll
        for (int p = 0; p < 5; ++p) { const int hh = 2 * p + hsel, base = (p < 4 ? COL_BQ + hh * HD : COL_BK + (hh - 8) * HD) + eo;
            float x1l = __uint_as_float(b1[p] << 16), x1h = __uint_as_float(b1[p] & 0xffff0000u), x2l = __uint_as_float(b2[p] << 16), x2h = __uint_as_float(b2[p] & 0xffff0000u);
            float ss = (x1l * x1l + x1h * x1h) + (x2l * x2l + x2h * x2h);
            ss += __shfl_xor(ss, 1); ss += __shfl_xor(ss, 2); ss += __shfl_xor(ss, 4); ss += __shfl_xor(ss, 8); ss += __shfl_xor(ss, 16);
            const float rs = rsqrtf(ss * (1.0f / HD) + EPS);
            x1l = x1l * rs * (p < 4 ? gq0 : gk0); x1h = x1h * rs * (p < 4 ? gq1 : gk1); x2l = x2l * rs * (p < 4 ? gq2 : gk2); x2h = x2h * rs * (p < 4 ? gq3 : gk3);
            *(unsigned*)(row + base) = pk2(x1l * csb.x - x2l * csb.y, x1h * csb.z - x2h * csb.w); *(unsigned*)(row + base + 32) = pk2(x2l * csb.x + x1l * csb.y, x2h * csb.z + x1h * csb.w); }
    }
}
__device__ __forceinline__ void phase_dn_prep_naive(Frame& F, int l) {
    const bf16* PROJ = WSP(bf16, WS_PROJ); const float* TL = WSP(float, WS_TL);
    float* DQ = WSP(float, WS_DQ); float* DK = WSP(float, WS_DK); float* DV = WSP(float, WS_DV); float* DB = WSP(float, WS_DB); float* DG = WSP(float, WS_DG);
    const float* cw = GIN(4) + (size_t)l * 5 * 1536;
    const int gw = F.vcu * NWAVES + F.wave, NGW = F.G * NWAVES, lane = F.lane;
    for (int t = gw; t < T; t += NGW) {
        const int s = t & (SEQ - 1);
#pragma unroll 1
        for (int g = 0; g < 12; ++g) {
            float val[2];
#pragma unroll
            for (int u = 0; u < 2; ++u) { const int c = 128 * g + 64 * u + lane; float a = 0.f;
#pragma unroll
                for (int j = 0; j < 5; ++j) { const int sp = s - 2 + j; if (sp >= 0 && sp < SEQ) a += bf2f(PROJ[(size_t)(t - 2 + j) * DINP + COL_CQKV + c]) * cw[j * 1536 + c]; }
                val[u] = siluf_(a); }
            float* dst = g < 4 ? DQ : (g < 8 ? DK : DV);
            if (g < 8) { const float ss = wave_sum(val[0] * val[0] + val[1] * val[1]); const float rs = rsqrtf(ss + EPS) * (g < 4 ? 0.08838834764831845f : 1.0f); val[0] *= rs; val[1] *= rs; }
            dst[(size_t)t * 512 + (g & 3) * 128 + lane] = val[0]; dst[(size_t)t * 512 + (g & 3) * 128 + 64 + lane] = val[1];
        }
        if (lane < 8) { const int dir = lane >> 2, hh = lane & 3; const float bl = TL[(size_t)t * 16 + dir * 4 + hh], al = TL[(size_t)t * 16 + 8 + dir * 4 + hh];
            const float A = expf(GIN(9)[(l * 2 + dir) * 4 + hh]); const float dtb = GIN(10)[(l * 2 + dir) * 4 + hh];
            DB[((size_t)dir * T + t) * 4 + hh] = sigmoidf_(bl); DG[((size_t)dir * T + t) * 4 + hh] = -A * softplusf_(al + dtb); }
    }
}


namespace dn {
typedef float f32x4 __attribute__((ext_vector_type(4)));
typedef short bf16x8 __attribute__((ext_vector_type(8)));
typedef short bf16x4 __attribute__((ext_vector_type(4)));
constexpr int KB_OFF = 0, QB_OFF = 17408, VB_OFF = 34816;
constexpr int KDT_OFF = 52224, UT_OFF = 70656, WT_OFF = 89088;
constexpr int AM_OFF = 107520;
constexpr int QKM_OFF = 123904;
constexpr int GC_OFF = 133120;
__device__ __forceinline__ unsigned cvtpk(float lo, float hi) { return cvt_pk_rne(lo, hi); }
__device__ __forceinline__ f32x4 mfma16(bf16x8 a, bf16x8 b, f32x4 c) { return __builtin_amdgcn_mfma_f32_16x16x32_bf16(a, b, c, 0, 0, 0); }
__device__ __forceinline__ void mfma_settle() { asm volatile("s_nop 15\n\ts_nop 7" ::: "memory"); }
}

__device__ __forceinline__ void phase_dn_chunk(Frame& F, int l) {
    using namespace dn;
#define WSQ(type, off) ((type*)(wsq + (off)))
    LAS unsigned char* L = F.lds;
    LAS float* GC = (LAS float*)(L + GC_OFF);
    const int wave = F.wave;
    for (int u = F.vcu; u < 1024; u += F.G) {
        int tid_ = wave * 64 + lane_id(); asm volatile("" : "+v"(tid_));
        const int tid = tid_, lane = tid & 63, g4 = lane >> 4, l15 = lane & 15;
        const int dir = u >> 9, b = (u >> 8) & 1, hh = (u >> 6) & 3, c = u & 63;
        const int chain = dir * 8 + b * 4 + hh, cs = dir ? 63 - c : c;
        const size_t ub = (size_t)chain * 64 + cs;
        GAS unsigned char* wsq_ = (GAS unsigned char*)F.ws; asm volatile("" : "+s"(wsq_)); unsigned char* wsq = (unsigned char*)wsq_;
        __syncthreads();
        if (wave == 0) {
            const int pos = dir ? 63 - lane : lane; const size_t t = (size_t)b * SEQ + c * 64 + pos;
            const float* TL = WSQ(float, WS_TL); const float bl = TL[t * 16 + dir * 4 + hh], al = TL[t * 16 + 8 + dir * 4 + hh];
            const float Acoef = expf(GIN(9)[(l * 2 + dir) * 4 + hh]), dtb = GIN(10)[(l * 2 + dir) * 4 + hh];
            float gc = -Acoef * softplusf_(al + dtb);
#pragma unroll
            for (int o = 1; o < 64; o <<= 1) { const float tv = bperm(gc, lane >= o ? lane - o : lane); if (lane >= o) gc += tv; }
            const float glast = bperm(gc, 63);
            const float beta = sigmoidf_(bl), egc = expf(gc); GC[lane] = gc; GC[64 + lane] = beta; GC[128 + lane] = egc; GC[192 + lane] = expf(glast - gc); if (lane == 0) GC[256] = expf(glast); GC[320 + lane] = beta * egc;
        }
        __syncthreads();
#ifndef DBG_NOCONV
        if (tid < 384) {
            const int rg = tid / 48, o = tid % 48, part = o >> 4, oo = o & 15;
            const int chl = part * 512 + hh * 128 + oo * 8;
            const float* cw = GIN(4) + (size_t)l * 5 * 1536;
            const bf16* src = WSQ(bf16, WS_PROJ) + (size_t)(b * SEQ) * DINP + COL_CQKV + chl;
            float w[5][8];
#pragma unroll
            for (int j = 0; j < 5; ++j) { const f32x4 w0 = *(const f32x4*)(cw + j * 1536 + chl), w1 = *(const f32x4*)(cw + j * 1536 + chl + 4);
                w[j][0] = w0.x; w[j][1] = w0.y; w[j][2] = w0.z; w[j][3] = w0.w; w[j][4] = w1.x; w[j][5] = w1.y; w[j][6] = w1.z; w[j][7] = w1.w; }
            bf16x8 xin[12];
#pragma unroll
            for (int dr = 0; dr < 12; ++dr) { const int sq = c * 64 + rg * 8 - 2 + dr; xin[dr] = (bf16x8){0, 0, 0, 0, 0, 0, 0, 0}; if (sq >= 0 && sq < SEQ) xin[dr] = *(const bf16x8*)(src + (size_t)sq * DINP); }
#pragma unroll
            for (int hp = 0; hp < 2; ++hp) {
                float acc[4][8];
#pragma unroll
                for (int r = 0; r < 4; ++r)
#pragma unroll
                    for (int e = 0; e < 8; ++e) acc[r][e] = 0.f;
#pragma unroll
                for (int dr = 0; dr < 8; ++dr) { float xf[8];
#pragma unroll
                        for (int e = 0; e < 8; ++e) xf[e] = bf2f((bf16)xin[4 * hp + dr][e]);
#pragma unroll
                        for (int r = 0; r < 4; ++r) { const int j = dr - r; if (j >= 0 && j < 5) {
#pragma unroll
                            for (int e = 0; e < 8; ++e) acc[r][e] = fmaf(xf[e], w[j][e], acc[r][e]); } } }
#pragma unroll
                for (int r = 0; r < 4; ++r) {
#pragma unroll
                    for (int e = 0; e < 8; ++e) acc[r][e] = siluf_(acc[r][e]);
                    if (part < 2) { float ss = 0.f;
#pragma unroll
                        for (int e = 0; e < 8; ++e) ss = fmaf(acc[r][e], acc[r][e], ss);
                        ss += bperm(ss, lane ^ 1); ss += bperm(ss, lane ^ 2); ss += bperm(ss, lane ^ 4); ss += bperm(ss, lane ^ 8);
                        const float rs = rsqrtf(ss + EPS) * (part == 0 ? 0.08838834764831845f : 1.0f);
#pragma unroll
                        for (int e = 0; e < 8; ++e) acc[r][e] *= rs; }
                    const int i = dir ? 63 - (rg * 8 + hp * 4 + r) : rg * 8 + hp * 4 + r;
                    u32x4 pk; pk.x = cvtpk(acc[r][0], acc[r][1]); pk.y = cvtpk(acc[r][2], acc[r][3]); pk.z = cvtpk(acc[r][4], acc[r][5]); pk.w = cvtpk(acc[r][6], acc[r][7]);
                    *(LAS u32x4*)(L + (part == 0 ? QB_OFF : (part == 1 ? KB_OFF : VB_OFF)) + i * 272 + oo * 16) = pk;
                }
                if (part == 1) {
                    const int ib = dir ? 60 - rg * 8 - hp * 4 : rg * 8 + hp * 4;
                    float kd[4];
#pragma unroll
                    for (int m = 0; m < 4; ++m) kd[m] = GC[192 + ib + m];
#pragma unroll
                    for (int e = 0; e < 8; ++e) { float v4[4];
#pragma unroll
                        for (int m = 0; m < 4; ++m) v4[m] = (dir ? acc[3 - m][e] : acc[m][e]) * kd[m];
                        u32x2 pk; pk.x = cvtpk(v4[0], v4[1]); pk.y = cvtpk(v4[2], v4[3]);
                        *(LAS u32x2*)(L + KDT_OFF + (oo * 8 + e) * 144 + ib * 2) = pk; }
                }
            }
        }
        __syncthreads();
#endif
        { const int sel = wave >> 2, rt = wave & 3;
          f32x4 acc[4];
#pragma unroll
          for (int ct = 0; ct < 4; ++ct) acc[ct] = (f32x4){0.f, 0.f, 0.f, 0.f};
          const LAS unsigned char* ab2 = L + (sel ? QB_OFF : KB_OFF) + (16 * rt + l15) * 272 + g4 * 16; const LAS unsigned char* bb2 = L + KB_OFF + l15 * 272 + g4 * 16;
#pragma unroll
          for (int kb = 0; kb < 4; ++kb) { const bf16x8 a = *(const LAS bf16x8*)(ab2 + kb * 64);
#pragma unroll
              for (int ct = 0; ct < 4; ++ct) { const bf16x8 bb = *(const LAS bf16x8*)(bb2 + ct * 4352 + kb * 64); acc[ct] = mfma16(a, bb, acc[ct]); } }
#pragma unroll
          for (int ct = 0; ct < 4; ++ct)
#pragma unroll
              for (int r = 0; r < 4; ++r) { const int i = 16 * rt + 4 * g4 + r, j = 16 * ct + l15; const float dec = j <= i ? expf(GC[i] - GC[j]) : 0.f; const float val = acc[ct][r] * dec;
                  if (sel == 0) ((LAS float*)(L + AM_OFF))[i * 64 + j] = j < i ? GC[64 + i] * val : 0.f;
                  else ((LAS bf16*)(L + QKM_OFF))[i * 72 + j] = (bf16)f2bf(val); } }
        __syncthreads();
#ifndef DBG_NOSOLVE
        if (tid < 256) {
            const LAS bf16* srcc = (const LAS bf16*)(L + (tid < 128 ? VB_OFF : KB_OFF)) + (tid & 127); const LAS float* scv = GC + (tid < 128 ? 64 : 320);
            LAS unsigned char* xrow = L + (tid < 128 ? UT_OFF + tid * 144 : WT_OFF + (tid - 128) * 144);
            int zoff; asm volatile("v_mov_b32 %0, 0" : "=v"(zoff));
            const LAS float* AM = (const LAS float*)(L + AM_OFF) + zoff;
#pragma unroll
            for (int r = 0; r < 4; ++r) {
                float acc[16];
#pragma unroll
                for (int ii = 0; ii < 16; ++ii) acc[ii] = scv[16 * r + ii] * bf2f(srcc[(16 * r + ii) * 136]);
#pragma unroll 1
                for (int sb = 0; sb < r; ++sb) {
                    const u32x4 x0 = *(const LAS u32x4*)(xrow + sb * 32), x1 = *(const LAS u32x4*)(xrow + sb * 32 + 16); float xs[16];
                    xs[0] = __uint_as_float(x0.x << 16); xs[1] = __uint_as_float(x0.x & 0xffff0000u); xs[2] = __uint_as_float(x0.y << 16); xs[3] = __uint_as_float(x0.y & 0xffff0000u);
                    xs[4] = __uint_as_float(x0.z << 16); xs[5] = __uint_as_float(x0.z & 0xffff0000u); xs[6] = __uint_as_float(x0.w << 16); xs[7] = __uint_as_float(x0.w & 0xffff0000u);
                    xs[8] = __uint_as_float(x1.x << 16); xs[9] = __uint_as_float(x1.x & 0xffff0000u); xs[10] = __uint_as_float(x1.y << 16); xs[11] = __uint_as_float(x1.y & 0xffff0000u);
                    xs[12] = __uint_as_float(x1.z << 16); xs[13] = __uint_as_float(x1.z & 0xffff0000u); xs[14] = __uint_as_float(x1.w << 16); xs[15] = __uint_as_float(x1.w & 0xffff0000u);
#pragma unroll
                    for (int ii = 0; ii < 16; ++ii) { const LAS float* ar = AM + (16 * r + ii) * 64 + 16 * sb; float s0 = 0.f, s1 = 0.f; if ((ii & 3) == 0) asm volatile("" ::: "memory");
#pragma unroll
                        for (int q = 0; q < 4; ++q) { const f32x4 a = *(const LAS f32x4*)(ar + 4 * q); s0 = fmaf(a.x, xs[4 * q], s0); s1 = fmaf(a.y, xs[4 * q + 1], s1); s0 = fmaf(a.z, xs[4 * q + 2], s0); s1 = fmaf(a.w, xs[4 * q + 3], s1); }
                        acc[ii] -= s0 + s1; }
                }
#pragma unroll
                for (int ii = 1; ii < 16; ++ii) { const LAS float* ar = AM + (16 * r + ii) * 64 + 16 * r; float s0 = 0.f, s1 = 0.f;
#pragma unroll
                    for (int q = 0; q < (ii + 3) / 4; ++q) { const f32x4 a = *(const LAS f32x4*)(ar + 4 * q); s0 = fmaf(a.x, acc[4 * q], s0); s1 = fmaf(a.y, acc[4 * q + 1], s1); s0 = fmaf(a.z, acc[4 * q + 2], s0); s1 = fmaf(a.w, acc[4 * q + 3], s1); }
                    acc[ii] -= s0 + s1; }
                u32x4 pk; pk.x = cvtpk(acc[0], acc[1]); pk.y = cvtpk(acc[2], acc[3]); pk.z = cvtpk(acc[4], acc[5]); pk.w = cvtpk(acc[6], acc[7]); *(LAS u32x4*)(xrow + r * 32) = pk;
                pk.x = cvtpk(acc[8], acc[9]); pk.y = cvtpk(acc[10], acc[11]); pk.z = cvtpk(acc[12], acc[13]); pk.w = cvtpk(acc[14], acc[15]); *(LAS u32x4*)(xrow + r * 32 + 16) = pk;
            }
        }
        __syncthreads();
#endif
        { const int sel = wave >> 2, it = wave & 3;
          f32x4 acc[8];
#pragma unroll
          for (int dt = 0; dt < 8; ++dt) acc[dt] = (f32x4){0.f, 0.f, 0.f, 0.f};
          const LAS unsigned char* bb4 = L + QKM_OFF + (16 * it + l15) * 144 + g4 * 16; const LAS unsigned char* ab4 = L + (sel ? UT_OFF : WT_OFF) + l15 * 144 + g4 * 16;
#pragma unroll
          for (int kb = 0; kb < 2; ++kb) { const bf16x8 bb = *(const LAS bf16x8*)(bb4 + kb * 64);
#pragma unroll
              for (int dt = 0; dt < 8; ++dt) { const bf16x8 a = *(const LAS bf16x8*)(ab4 + dt * 2304 + kb * 64); acc[dt] = mfma16(a, bb, acc[dt]); } }
          mfma_settle();
          const int i = 16 * it + l15, trow = dir ? 63 - i : i;
          if (sel == 0) { bf16* CP = WSQ(bf16, WS_CP) + (ub * 64 + trow) * 128; const float eg = GC[128 + i];
#pragma unroll
              for (int dt = 0; dt < 8; ++dt) { const int d = 16 * dt + 4 * g4; const u32x2 qw = *(const LAS u32x2*)(L + QB_OFF + i * 272 + d * 2);
                  const float q0 = __uint_as_float(qw.x << 16), q1 = __uint_as_float(qw.x & 0xffff0000u), q2 = __uint_as_float(qw.y << 16), q3 = __uint_as_float(qw.y & 0xffff0000u);
                  u32x2 o; o.x = cvtpk(q0 * eg - acc[dt][0], q1 * eg - acc[dt][1]); o.y = cvtpk(q2 * eg - acc[dt][2], q3 * eg - acc[dt][3]); *(u32x2*)(CP + 32 * (dt >> 1) + 8 * g4 + 4 * (dt & 1)) = o; } }
          else { float* CR = WSQ(float, WS_CR) + (ub * 64 + trow) * 128;
#pragma unroll
              for (int dt = 0; dt < 8; ++dt) *(f32x4*)(CR + 16 * dt + 4 * g4) = acc[dt]; } }
        { f32x4 acc[8];
#pragma unroll
          for (int ct = 0; ct < 8; ++ct) acc[ct] = (f32x4){0.f, 0.f, 0.f, 0.f};
          const LAS unsigned char* lane_off = L + l15 * 144 + g4 * 16;
#pragma unroll
          for (int kb = 0; kb < 2; ++kb) { const bf16x8 a = *(const LAS bf16x8*)(lane_off + WT_OFF + wave * 2304 + kb * 64);
#pragma unroll
              for (int ct = 0; ct < 8; ++ct) { const bf16x8 bb = *(const LAS bf16x8*)(lane_off + KDT_OFF + ct * 2304 + kb * 64); acc[ct] = mfma16(a, bb, acc[ct]); } }
          mfma_settle();
          bf16* CM = WSQ(bf16, WS_CM) + ub * 16384; const float eg = GC[256];
          const int dpp = 32 * (wave >> 1) + 8 * g4 + 4 * (wave & 1);
#pragma unroll
          for (int ct = 0; ct < 8; ++ct) { const int d = 16 * ct + l15, dp = 16 * wave + 4 * g4; float m[4];
#pragma unroll
              for (int r = 0; r < 4; ++r) m[r] = (d == dp + r ? eg : 0.f) - acc[ct][r];
              u32x2 o; o.x = cvtpk(m[0], m[1]); o.y = cvtpk(m[2], m[3]); *(u32x2*)(CM + (size_t)d * 128 + dpp) = o; }
#pragma unroll
          for (int ct = 0; ct < 8; ++ct) acc[ct] = (f32x4){0.f, 0.f, 0.f, 0.f};
#pragma unroll
          for (int kb = 0; kb < 2; ++kb) { const bf16x8 a = *(const LAS bf16x8*)(lane_off + KDT_OFF + wave * 2304 + kb * 64);
#pragma unroll
              for (int ct = 0; ct < 8; ++ct) { const bf16x8 bb = *(const LAS bf16x8*)(lane_off + UT_OFF + ct * 2304 + kb * 64); acc[ct] = mfma16(a, bb, acc[ct]); } }
          mfma_settle();
          bf16* CN = WSQ(bf16, WS_CN) + ub * 16384;
#pragma unroll
          for (int ct = 0; ct < 8; ++ct) { u32x2 o; o.x = cvtpk(acc[ct][0], acc[ct][1]); o.y = cvtpk(acc[ct][2], acc[ct][3]); *(u32x2*)(CN + ((size_t)(ct * 8 + wave) * 64 + lane) * 4) = o; } }
    }
}
#undef WSQ

#define DN_SCAN_STEP(cs, NS, MS) do {            \
        const LAS unsigned char* Mb = L + ((cs) & 1) * 34816;                                                                                        \
        const int c4 = (cs) + 3 < 64 ? (cs) + 3 : 63, c5 = (cs) + 4 < 64 ? (cs) + 4 : 63;                                                           \
        if (active) {                                                                                                                               \
        bf16* cso = CS + (size_t)(cs) * 16384 + ((size_t)(wv * 8) * 64 + lane) * 4;                                                                  \
        unsigned sp[8][2]; f32x4 acc[8];                                                                                                            \
        _Pragma("unroll") for (int r = 0; r < 8; ++r) { sp[r][0] = cvtpk(S[r][0], S[r][1]); sp[r][1] = cvtpk(S[r][2], S[r][3]); u32x2 o; o.x = sp[r][0]; o.y = sp[r][1]; *(u32x2*)(cso + 256 * r) = o; \
            acc[r][0] = __uint_as_float(NS[r].x << 16); acc[r][1] = __uint_as_float(NS[r].x & 0xffff0000u); acc[r][2] = __uint_as_float(NS[r].y << 16); acc[r][3] = __uint_as_float(NS[r].y & 0xffff0000u); } \
        _Pragma("unroll") for (int r = 0; r < 8; ++r) NS[r] = *(const u32x2*)(CN + (size_t)c4 * 16384 + ((size_t)(wv * 8 + r) * 64 + lane) * 4);         \
        _Pragma("unroll") for (int kb = 0; kb < 4; ++kb) { u32x4 bw; bw.x = sp[2 * kb][0]; bw.y = sp[2 * kb][1]; bw.z = sp[2 * kb + 1][0]; bw.w = sp[2 * kb + 1][1]; const bf16x8 bfrag = *reinterpret_cast<bf16x8*>(&bw); \
            _Pragma("unroll") for (int r = 0; r < 8; ++r)                                                                                           \
                acc[r] = mfma16(*(const LAS bf16x8*)(Mb + (16 * r + l15) * 272 + (32 * kb + 8 * g4) * 2), bfrag, acc[r]); }                            \
        _Pragma("unroll") for (int r = 0; r < 8; ++r) S[r] = acc[r];                                                                                 \
        } else {     \
                                \
          LAS unsigned char* Mn = L + (((cs) + 1) & 1) * 34816;                                                                                      \
          _Pragma("unroll") for (int q = 0; q < 8; ++q) { const int id = tl + 256 * q; *(LAS u32x4*)(Mn + (id >> 4) * 272 + (id & 15) * 16) = MS[q]; }   \
          _Pragma("unroll") for (int q = 0; q < 8; ++q) MS[q] = *(const u32x4*)(CM + (size_t)c5 * 16384 + (size_t)(tl + 256 * q) * 8);                 \
        }                                                                                                                                           \
        asm volatile("s_waitcnt lgkmcnt(0)" ::: "memory"); __builtin_amdgcn_s_barrier(); asm volatile("" ::: "memory");     \
    } while (0)
__device__ __forceinline__ void phase_dn_scan(Frame& F) {
    using namespace dn;
    if (blockIdx.x >= 32) return;
    const int chain = (int)blockIdx.x >> 1, tid = F.tid, lane = F.lane, wave = F.wave, g4 = lane >> 4, l15 = lane & 15;
    const bool active = wave < 4; const int wv = ((int)blockIdx.x & 1) * 4 + (wave & 3);
    const int tl = tid & 255;
    LAS unsigned char* L = F.lds;
    const bf16* CM = WSP(bf16, WS_CM) + (size_t)chain * 64 * 16384; const bf16* CN = WSP(bf16, WS_CN) + (size_t)chain * 64 * 16384; bf16* CS = WSP(bf16, WS_CS) + (size_t)chain * 64 * 16384;
    f32x4 S[8];
#pragma unroll
    for (int r = 0; r < 8; ++r) S[r] = (f32x4){0.f, 0.f, 0.f, 0.f};
    u32x4 m0[8], m1[8], m2[8]; u32x2 n0[8], n1[8], n2[8];
#pragma unroll
    for (int q = 0; q < 8; ++q) { m0[q] = (u32x4){0u, 0u, 0u, 0u}; m1[q] = m0[q]; m2[q] = m0[q]; }
#pragma unroll
    for (int r = 0; r < 8; ++r) { n0[r] = (u32x2){0u, 0u}; n1[r] = n0[r]; n2[r] = n0[r]; }
    __syncthreads();
    if (!active) {
#pragma unroll
        for (int q = 0; q < 8; ++q) { const size_t o = (size_t)(tl + 256 * q) * 8; m0[q] = *(const u32x4*)(CM + o); m1[q] = *(const u32x4*)(CM + 16384 + o); m2[q] = *(const u32x4*)(CM + 2 * 16384 + o); }
#pragma unroll
        for (int q = 0; q < 8; ++q) { const int id = tl + 256 * q; *(LAS u32x4*)(L + (id >> 4) * 272 + (id & 15) * 16) = m0[q]; }
#pragma unroll
        for (int q = 0; q < 8; ++q) m0[q] = *(const u32x4*)(CM + 3 * 16384 + (size_t)(tl + 256 * q) * 8);
    } else {
#pragma unroll
        for (int r = 0; r < 8; ++r) { const size_t o = ((size_t)(wv * 8 + r) * 64 + lane) * 4; n0[r] = *(const u32x2*)(CN + o); n1[r] = *(const u32x2*)(CN + 16384 + o); n2[r] = *(const u32x2*)(CN + 2 * 16384 + o); }
    }
    __syncthreads();
#pragma unroll 1
    for (int cs = 0; cs < 63; cs += 3) {
        DN_SCAN_STEP(cs, n0, m1);
        DN_SCAN_STEP(cs + 1, n1, m2);
        DN_SCAN_STEP(cs + 2, n2, m0);
    }
    DN_SCAN_STEP(63, n0, m1);
}
#undef DN_SCAN_STEP

__device__ __forceinline__ void phase_dn_out(Frame& F, int l) {
    using namespace dn;
    const bf16* PROJ = WSP(bf16, WS_PROJ); bf16* Y = WSP(bf16, WS_Y); const float* gn = GIN(11) + (size_t)l * HD;
    const int lane = F.lane, wave = F.wave, g4 = lane >> 4, l15 = lane & 15, it = wave & 3, vh = wave >> 2;
    LAS float* part = (LAS float*)F.lds;
    for (int u = F.vcu; u < 512; u += F.G) {
        const int b = u >> 8, hh = (u >> 6) & 3, c = u & 63;
        f32x4 acc[4];
#pragma unroll
        for (int q = 0; q < 4; ++q) acc[q] = (f32x4){0.f, 0.f, 0.f, 0.f};
#pragma unroll
        for (int dir = 0; dir < 2; ++dir) { const int chain = dir * 8 + b * 4 + hh, cs = dir ? 63 - c : c; const size_t ub = (size_t)chain * 64 + cs;
            const bf16* CP = WSP(bf16, WS_CP) + ub * 8192 + (size_t)(16 * it + l15) * 128 + 8 * g4; const bf16* CS = WSP(bf16, WS_CS) + ub * 16384 + (size_t)lane * 4; const float* CR = WSP(float, WS_CR) + ub * 8192 + (size_t)(16 * it + l15) * 128;
#pragma unroll
            for (int kb = 0; kb < 4; ++kb) { const bf16x8 bb = *(const bf16x8*)(CP + 32 * kb);
#pragma unroll
                for (int q = 0; q < 4; ++q) { const bf16* sp_ = CS + (size_t)((vh * 4 + q) * 8 + 2 * kb) * 256; const u32x2 a0 = *(const u32x2*)sp_, a1 = *(const u32x2*)(sp_ + 256); u32x4 aw; aw.x = a0.x; aw.y = a0.y; aw.z = a1.x; aw.w = a1.y;
                    acc[q] = mfma16(*reinterpret_cast<bf16x8*>(&aw), bb, acc[q]); } }
#pragma unroll
            for (int q = 0; q < 4; ++q) acc[q] += *(const f32x4*)(CR + 16 * (vh * 4 + q) + 4 * g4); }
        float ss = 0.f;
#pragma unroll
        for (int q = 0; q < 4; ++q) ss += (acc[q][0] * acc[q][0] + acc[q][1] * acc[q][1]) + (acc[q][2] * acc[q][2] + acc[q][3] * acc[q][3]);
        ss += __shfl_xor(ss, 16); ss += __shfl_xor(ss, 32);
        const int i = 16 * it + l15; const size_t t = (size_t)b * SEQ + c * 64 + i;
        u32x2 zw4[4]; f32x4 gg4[4];
#pragma unroll
        for (int q = 0; q < 4; ++q) { const int vv = 16 * (vh * 4 + q) + 4 * g4; zw4[q] = *(const u32x2*)(PROJ + t * DINP + COL_CZ + hh * HD + vv); gg4[q] = *(const f32x4*)(gn + vv); }
        __syncthreads();
        if (g4 == 0) part[vh * 64 + 16 * it + l15] = ss;
        __syncthreads();
        const float rs = rsqrtf((part[i] + part[64 + i]) * (1.0f / HD) + EPS);
#pragma unroll
        for (int q = 0; q < 4; ++q) { const int vv = 16 * (vh * 4 + q) + 4 * g4; const u32x2 zw = zw4[q]; const f32x4 gg = gg4[q];
            const float z0 = __uint_as_float(zw.x << 16), z1 = __uint_as_float(zw.x & 0xffff0000u), z2 = __uint_as_float(zw.y << 16), z3 = __uint_as_float(zw.y & 0xffff0000u);
            u32x2 o; o.x = cvtpk(acc[q][0] * rs * gg.x * siluf_(z0), acc[q][1] * rs * gg.y * siluf_(z1)); o.y = cvtpk(acc[q][2] * rs * gg.z * siluf_(z2), acc[q][3] * rs * gg.w * siluf_(z3));
            *(u32x2*)(Y + t * DM + 1536 + hh * HD + vv) = o; }
    }
}

__device__ __forceinline__ void dn_chain_naive(Frame& F, int chain) {
    const int dir = chain >> 3, b = (chain >> 2) & 1, hh = chain & 3;
    const float* DQ = WSP(float, WS_DQ); const float* DK = WSP(float, WS_DK); const float* DV = WSP(float, WS_DV); const float* DB = WSP(float, WS_DB); const float* DG = WSP(float, WS_DG);
    float* DO = WSP(float, WS_DO);
    LAS float* kb = (LAS float*)F.lds; LAS float* qb = kb + 64 * 128; LAS float* vb = qb + 64 * 128; LAS float* bb = vb + 64 * 128; LAS float* gb = bb + 64;
    const int tid = F.tid, v = tid >> 2, kq = tid & 3;
    float S[32];
#pragma unroll
    for (int j = 0; j < 32; ++j) S[j] = 0.f;
    for (int c0 = 0; c0 < SEQ; c0 += 64) {
        __syncthreads();
        for (int idx = tid; idx < 64 * 128; idx += NTHR) { const int i = idx >> 7, d = idx & 127; const int sq = c0 + i, pos = dir ? SEQ - 1 - sq : sq; const size_t o = (size_t)(b * SEQ + pos) * 512 + hh * 128 + d;
            kb[idx] = DK[o]; qb[idx] = DQ[o]; vb[idx] = DV[o]; }
        if (tid < 64) { const int sq = c0 + tid, pos = dir ? SEQ - 1 - sq : sq; const size_t o = ((size_t)dir * T + b * SEQ + pos) * 4 + hh; bb[tid] = DB[o]; gb[tid] = DG[o]; }
        __syncthreads();
        for (int i = 0; i < 64; ++i) {
            const float a = expf(gb[i]), beta = bb[i];
            float ks = 0.f;
#pragma unroll
            for (int j = 0; j < 32; ++j) ks = fmaf(kb[i * 128 + kq * 32 + j], S[j], ks);
            ks += __shfl_xor(ks, 1); ks += __shfl_xor(ks, 2);
            const float vn = beta * (vb[i * 128 + v] - a * ks);
            float o = 0.f;
#pragma unroll
            for (int j = 0; j < 32; ++j) { S[j] = fmaf(kb[i * 128 + kq * 32 + j], vn, a * S[j]); o = fmaf(qb[i * 128 + kq * 32 + j], S[j], o); }
            o += __shfl_xor(o, 1); o += __shfl_xor(o, 2);
            if (kq == 0) { const int sq = c0 + i, pos = dir ? SEQ - 1 - sq : sq; DO[((size_t)dir * T + b * SEQ + pos) * 512 + hh * 128 + v] = o; }
        }
    }
    __syncthreads();
}
struct AttnAcc { float m, l, o0, o1; };
__device__ __forceinline__ void attn_key(AttnAcc& st, float q0, float q1, const bf16* krow, const bf16* vrow, int lane) {
    const unsigned kw = *(const unsigned*)(krow + 2 * lane), vw = *(const unsigned*)(vrow + 2 * lane);
    const float sc = wave_sum(q0 * __uint_as_float(kw << 16) + q1 * __uint_as_float(kw & 0xffff0000u)) * 0.08838834764831845f;
    const float mn = fmaxf(st.m, sc), al = __expf(st.m - mn), p = __expf(sc - mn);
    st.l = st.l * al + p; st.o0 = st.o0 * al + p * __uint_as_float(vw << 16); st.o1 = st.o1 * al + p * __uint_as_float(vw & 0xffff0000u); st.m = mn;
}
__device__ __forceinline__ void phase_mix_naive(Frame& F) {
    const bf16* PROJ = WSP(bf16, WS_PROJ); float* YMIX = WSP(float, WS_YMIX);
    if (NAIVE_DN) { if (F.vcu < 16) dn_chain_naive(F, F.vcu); } else { phase_dn_scan(F); __syncthreads(); }
    const int gw = F.vcu * NWAVES + F.wave, NGW = F.G * NWAVES, lane = F.lane;
    if (NAIVE_ATTN_A) for (int u = gw; u < T * 4; u += NGW) { const int t = u >> 2, hh = u & 3, b = t >> 12, s = t & (SEQ - 1);
        const unsigned qw = *(const unsigned*)(PROJ + (size_t)t * DINP + COL_AQ + hh * HD + 2 * lane); const float q0 = __uint_as_float(qw << 16), q1 = __uint_as_float(qw & 0xffff0000u);
        AttnAcc st{-1e30f, 0.f, 0.f, 0.f};
        for (int pat = 0; pat < 3; ++pat) { const int dil = pat == 0 ? 1 : (pat == 1 ? 4 : 16);
            for (int dlt = -64; dlt <= 64; ++dlt) { const int sp = s + dil * dlt; if (sp < 0 || sp >= SEQ) continue;
                const bf16* kr = PROJ + (size_t)(b * SEQ + sp) * DINP; attn_key(st, q0, q1, kr + COL_AK + hh * HD, kr + COL_AV + hh * HD, lane); } }
        const float inv = 1.0f / st.l; *(float2*)(YMIX + (size_t)t * DM + hh * HD + 2 * lane) = make_float2(st.o0 * inv, st.o1 * inv); }
    if (NAIVE_ATTN_B) for (int u = gw; u < T * 8; u += NGW) { const int t = u >> 3, hq = u & 7, kvh = hq >> 2, b = t >> 12;
        const unsigned qw = *(const unsigned*)(PROJ + (size_t)t * DINP + COL_BQ + hq * HD + 2 * lane); const float q0 = __uint_as_float(qw << 16), q1 = __uint_as_float(qw & 0xffff0000u);
        AttnAcc st{-1e30f, 0.f, 0.f, 0.f};
        const bf16* kr = PROJ + (size_t)(b * SEQ) * DINP;
        for (int j = 0; j < SEQ; ++j, kr += DINP) attn_key(st, q0, q1, kr + COL_BK + kvh * HD, kr + COL_BV + kvh * HD, lane);
        const float inv = 1.0f / st.l; *(float2*)(YMIX + (size_t)t * DM + 512 + hq * HD + 2 * lane) = make_float2(st.o0 * inv, st.o1 * inv); }
}


__device__ __forceinline__ void phase_attn_b(Frame& F, char* lds_gen) {
    const bf16* PROJ = WSP(bf16, WS_PROJ); float* YMIX = WSP(float, WS_YMIX);
    for (int u = F.vcu; u < BATCH * 8 * 16; u += F.G) {
        const int b = u >> 7, kvh = (u >> 6) & 1, hq = kvh * 4 + ((u >> 4) & 3), qb = u & 15;
        const bf16* Qb = PROJ + (size_t)(b * SEQ + qb * 256) * DINP + COL_BQ + hq * HD;
        const bf16* Kh = PROJ + (size_t)(b * SEQ) * DINP + COL_BK + kvh * HD;
        const bf16* Vh = PROJ + (size_t)(b * SEQ) * DINP + COL_BV + kvh * HD;
        float* Ob = YMIX + (size_t)(b * SEQ + qb * 256) * DM + 512 + hq * HD;
        attn::attn_dense_body<attn::bf16>(Qb, Kh, Vh, Ob, SEQ, lds_gen, F.wave);
        __syncthreads();
    }
}


constexpr size_t WS_OPA = WS_TMP;
constexpr size_t WS_LSE = WS_TMP + (size_t)3 * T * 512 * 4;
__device__ __forceinline__ void phase_attn_a(Frame& F) {
    using namespace dn;
    constexpr int K_OFF = 0, VT_OFF = 69632;
    LAS unsigned char* L = F.lds;
    const int wave = F.wave;
    if (F.G > 64 && blockIdx.x < 32) return;
    const int ufirst = F.G > 64 ? (int)blockIdx.x - 32 : (int)blockIdx.x, ustep = F.G > 64 ? F.G - 32 : F.G;
    for (int u = ufirst; u < 768; u += ustep) {
        int tid_ = wave * 64 + lane_id(); asm volatile("" : "+v"(tid_));
        const int tid = tid_, lane = tid & 63, g4 = lane >> 4, l15 = lane & 15;
        GAS unsigned char* wsq_ = (GAS unsigned char*)F.ws; asm volatile("" : "+s"(wsq_)); unsigned char* wsq = (unsigned char*)wsq_;
        const bf16* PROJ = (const bf16*)(wsq + WS_PROJ);
        const int p = u >> 8, rem = u & 255, b = rem >> 7, hh = (rem >> 5) & 3, w32 = rem & 31;
        const int dsh = 2 * p, dil = 1 << dsh, Lf = SEQ >> dsh, nblk = Lf >> 7;
        const int r = w32 / nblk, i0 = (w32 % nblk) * 128;
        const bf16* base = PROJ + (size_t)(b * SEQ + r) * DINP + hh * HD;
        const size_t jstride = (size_t)dil * DINP;
        __syncthreads();
#pragma unroll
        for (int q = 0; q < 8; ++q) { const int id = tid + 512 * q, row = id >> 4, c16 = id & 15, j = i0 - 64 + row;
            u32x4 v = {0u, 0u, 0u, 0u}; if (j >= 0 && j < Lf) v = *(const u32x4*)(base + (size_t)j * jstride + COL_AK + c16 * 8);
            *(LAS u32x4*)(L + K_OFF + row * 272 + c16 * 16) = v; }
#pragma unroll
        for (int g = 0; g < 8; ++g) { const int kk0 = 32 * wave + 4 * g; unsigned rv[4];
#pragma unroll
            for (int m = 0; m < 4; ++m) { const int j = i0 - 64 + kk0 + m; rv[m] = (j >= 0 && j < Lf) ? *(const unsigned*)(base + (size_t)j * jstride + COL_AV + 2 * lane) : 0u; }
            u32x2 lo, hi; lo.x = (rv[0] & 0xffffu) | (rv[1] << 16); lo.y = (rv[2] & 0xffffu) | (rv[3] << 16); hi.x = (rv[0] >> 16) | (rv[1] & 0xffff0000u); hi.y = (rv[2] >> 16) | (rv[3] & 0xffff0000u);
            *(LAS u32x2*)(L + VT_OFF + (2 * lane) * 528 + kk0 * 2) = lo; *(LAS u32x2*)(L + VT_OFF + (2 * lane + 1) * 528 + kk0 * 2) = hi; }
        const int iq = i0 + 16 * wave + l15;
        bf16x8 qf[4];
#pragma unroll
        for (int kb = 0; kb < 4; ++kb) qf[kb] = *(const bf16x8*)(base + (size_t)iq * jstride + COL_AQ + 32 * kb + 8 * g4);
        __syncthreads();
        f32x4 sc[9];
        const LAS unsigned char* kb_ = L + K_OFF + (16 * wave + l15) * 272 + g4 * 16;
#pragma unroll
        for (int kt = 0; kt < 9; ++kt) { sc[kt] = (f32x4){0.f, 0.f, 0.f, 0.f};
#pragma unroll
            for (int kb = 0; kb < 4; ++kb) sc[kt] = mfma16(*(const LAS bf16x8*)(kb_ + kt * 4352 + kb * 64), qf[kb], sc[kt]); }
        constexpr float C = 0.08838834764831845f * 1.4426950408889634f;
        float mx = -3.0e38f;
#pragma unroll
        for (int kt = 0; kt < 9; ++kt)
#pragma unroll
            for (int rr = 0; rr < 4; ++rr) { const int dlt = -64 + 16 * kt + 4 * g4 + rr - l15, j = iq + dlt; const bool ok = dlt >= -64 && dlt <= 64 && j >= 0 && j < Lf;
                sc[kt][rr] = ok ? sc[kt][rr] : -3.0e38f; mx = fmaxf(mx, sc[kt][rr]); }
        mx = fmaxf(mx, __shfl_xor(mx, 16)); mx = fmaxf(mx, __shfl_xor(mx, 32));
        float lsum = 0.f; const float mC = mx * C;
#pragma unroll
        for (int kt = 0; kt < 9; ++kt)
#pragma unroll
            for (int rr = 0; rr < 4; ++rr) { const float pv = sc[kt][rr] > -1.0e38f ? __builtin_amdgcn_exp2f(sc[kt][rr] * C - mC) : 0.f; sc[kt][rr] = pv; lsum += pv; }
        lsum += __shfl_xor(lsum, 16); lsum += __shfl_xor(lsum, 32);
        f32x4 o[8];
#pragma unroll
        for (int dt = 0; dt < 8; ++dt) o[dt] = (f32x4){0.f, 0.f, 0.f, 0.f};
        const LAS unsigned char* vb_ = L + VT_OFF + l15 * 528 + (16 * wave + 4 * g4) * 2;
#pragma unroll
        for (int pp = 0; pp < 5; ++pp) { u32x4 bw; bw.x = cvtpk(sc[2 * pp][0], sc[2 * pp][1]); bw.y = cvtpk(sc[2 * pp][2], sc[2 * pp][3]);
            if (pp < 4) { bw.z = cvtpk(sc[2 * pp + 1][0], sc[2 * pp + 1][1]); bw.w = cvtpk(sc[2 * pp + 1][2], sc[2 * pp + 1][3]); } else { bw.z = 0u; bw.w = 0u; }
            const bf16x8 bfrag = *reinterpret_cast<bf16x8*>(&bw);
#pragma unroll
            for (int dt = 0; dt < 8; ++dt) { const u32x2 a0 = *(const LAS u32x2*)(vb_ + dt * 8448 + pp * 64); u32x2 a1 = {0u, 0u}; if (pp < 4) a1 = *(const LAS u32x2*)(vb_ + dt * 8448 + pp * 64 + 32);
                u32x4 aw; aw.x = a0.x; aw.y = a0.y; aw.z = a1.x; aw.w = a1.y; o[dt] = mfma16(*reinterpret_cast<bf16x8*>(&aw), bfrag, o[dt]); } }
        const float inv = 1.0f / lsum;
        const size_t t = (size_t)b * SEQ + (size_t)iq * dil + r;
        bf16* OP = (bf16*)(wsq + WS_OPA) + ((size_t)p * T + t) * 512 + hh * HD + 4 * g4;
#pragma unroll
        for (int dt = 0; dt < 8; ++dt) { u32x2 w; w.x = cvtpk(o[dt][0] * inv, o[dt][1] * inv); w.y = cvtpk(o[dt][2] * inv, o[dt][3] * inv); *(u32x2*)(OP + 16 * dt) = w; }
        if (g4 == 0) ((float*)(wsq + WS_LSE))[((size_t)p * T + t) * 4 + hh] = mx * 0.08838834764831845f + __logf(lsum);
    }
}

__device__ __forceinline__ void phase_ynorm(Frame& F, int l, bool naive_dn) {
    const bf16* PROJ = WSP(bf16, WS_PROJ); float* YMIX = WSP(float, WS_YMIX); bf16* Y = WSP(bf16, WS_Y); const float* DO = WSP(float, WS_DO);
    const float* ga = GIN(7) + (size_t)l * 512; const float* gb = GIN(8) + (size_t)l * 1024; const float* gn = GIN(11) + (size_t)l * HD;
    const int gw = F.vcu * NWAVES + F.wave, NGW = F.G * NWAVES, lane = F.lane;
    for (int t = gw; t < T; t += NGW) {
        if (naive_dn) {
#pragma unroll
            for (int hh = 0; hh < 4; ++hh) { const size_t o = (size_t)t * 512 + hh * HD; const float o0 = DO[o + lane] + DO[(size_t)T * 512 + o + lane], o1 = DO[o + lane + 64] + DO[(size_t)T * 512 + o + lane + 64];
                const float rs = rsqrtf(wave_sum(o0 * o0 + o1 * o1) * (1.0f / HD) + EPS);
                const float z0 = bf2f(PROJ[(size_t)t * DINP + COL_CZ + hh * HD + lane]), z1 = bf2f(PROJ[(size_t)t * DINP + COL_CZ + hh * HD + lane + 64]);
                Y[(size_t)t * DM + 1536 + hh * HD + lane] = (bf16)f2bf(o0 * rs * gn[lane] * siluf_(z0)); Y[(size_t)t * DM + 1536 + hh * HD + lane + 64] = (bf16)f2bf(o1 * rs * gn[lane + 64] * siluf_(z1)); }
        }
        const float* yr = YMIX + (size_t)t * DM; bf16* yo = Y + (size_t)t * DM;
        f32x4 bq[4];
#pragma unroll
        for (int j = 0; j < 4; ++j) bq[j] = *(const f32x4*)(yr + 512 + 256 * j + 4 * lane);
        { f32x4 a0, a1;
          if (NAIVE_ATTN_A) { a0 = *(const f32x4*)(yr + 4 * lane); a1 = *(const f32x4*)(yr + 256 + 4 * lane); }
          else { const bf16* OPA = WSP(bf16, WS_OPA); const float* LSE = WSP(float, WS_LSE); const int h0 = lane >> 5;
              float l0[3], l1[3];
#pragma unroll
              for (int p = 0; p < 3; ++p) { l0[p] = LSE[((size_t)p * T + t) * 4 + h0]; l1[p] = LSE[((size_t)p * T + t) * 4 + 2 + h0]; }
              const float m0 = fmaxf(l0[0], fmaxf(l0[1], l0[2])), m1 = fmaxf(l1[0], fmaxf(l1[1], l1[2]));
              float w0[3], w1[3], s0 = 0.f, s1 = 0.f;
#pragma unroll
              for (int p = 0; p < 3; ++p) { w0[p] = __expf(l0[p] - m0); w1[p] = __expf(l1[p] - m1); s0 += w0[p]; s1 += w1[p]; }
              a0 = (f32x4){0.f, 0.f, 0.f, 0.f}; a1 = a0;
#pragma unroll
              for (int p = 0; p < 3; ++p) { const u32x2 x0 = *(const u32x2*)(OPA + ((size_t)p * T + t) * 512 + 4 * lane), x1 = *(const u32x2*)(OPA + ((size_t)p * T + t) * 512 + 256 + 4 * lane);
                  const f32x4 f0 = {__uint_as_float(x0.x << 16), __uint_as_float(x0.x & 0xffff0000u), __uint_as_float(x0.y << 16), __uint_as_float(x0.y & 0xffff0000u)}, f1 = {__uint_as_float(x1.x << 16), __uint_as_float(x1.x & 0xffff0000u), __uint_as_float(x1.y << 16), __uint_as_float(x1.y & 0xffff0000u)};
                  a0 += f0 * (w0[p] / s0); a1 += f1 * (w1[p] / s1); } }
          const float rs = rsqrtf(wave_sum((a0.x * a0.x + a0.y * a0.y) + (a0.z * a0.z + a0.w * a0.w) + (a1.x * a1.x + a1.y * a1.y) + (a1.z * a1.z + a1.w * a1.w)) * (1.0f / 512) + EPS);
          const f32x4 g0 = *(const f32x4*)(ga + 4 * lane), g1 = *(const f32x4*)(ga + 256 + 4 * lane); a0 = a0 * rs * g0; a1 = a1 * rs * g1;
          u32x2 o; o.x = pk2(a0.x, a0.y); o.y = pk2(a0.z, a0.w); *(u32x2*)(yo + 4 * lane) = o; o.x = pk2(a1.x, a1.y); o.y = pk2(a1.z, a1.w); *(u32x2*)(yo + 256 + 4 * lane) = o; }
        { f32x4 a[4]; float ss = 0.f;
#pragma unroll
          for (int j = 0; j < 4; ++j) { a[j] = bq[j]; ss += (a[j].x * a[j].x + a[j].y * a[j].y) + (a[j].z * a[j].z + a[j].w * a[j].w); }
          const float rs = rsqrtf(wave_sum(ss) * (1.0f / 1024) + EPS);
#pragma unroll
          for (int j = 0; j < 4; ++j) { const f32x4 g = *(const f32x4*)(gb + 256 * j + 4 * lane); a[j] = a[j] * rs * g; u32x2 o; o.x = pk2(a[j].x, a[j].y); o.y = pk2(a[j].z, a[j].w); *(u32x2*)(yo + 512 + 256 * j + 4 * lane) = o; } }
    }
}

__device__ __forceinline__ void phase_select(Frame& F) {
    const float* AFF = WSP(float, WS_AFF); int* SELI = WSP(int, WS_SELI); float* SELG = WSP(float, WS_SELG); int* SLOT = WSP(int, WS_SLOT); float* SELR = WSP(float, WS_SELR); const float* RS2 = WSP(float, WS_RS) + T;
    LAS unsigned* key = (LAS unsigned*)F.lds;
    LAS unsigned* hist = key + 4096;
    LAS unsigned* ctl = hist + 256;
    LAS unsigned* scan = ctl + 8;
    const int tid = F.tid;
    for (int u = F.vcu; u < BATCH * NE; u += F.G) {
        const int b = u / NE, e = u % NE;
        __syncthreads();
        for (int i = tid; i < SEQ; i += NTHR) key[i] = __float_as_uint(AFF[(size_t)(b * SEQ + i) * 16 + e]);
        if (tid == 0) { ctl[0] = 0u; ctl[2] = CAP; }
        __syncthreads();
        for (int pass = 3; pass >= 0; --pass) {
            const int shift = pass * 8; const unsigned hmask = pass == 3 ? 0u : ~((1u << (shift + 8)) - 1u);
            if (tid < 256) hist[tid] = 0u;
            __syncthreads();
            const unsigned prefix = ctl[0];
            for (int i = tid; i < SEQ; i += NTHR) { const unsigned k = key[i]; if ((k & hmask) == (prefix & hmask)) __hip_atomic_fetch_add(hist + ((k >> shift) & 255u), 1u, __ATOMIC_RELAXED, __HIP_MEMORY_SCOPE_WORKGROUP); }
            __syncthreads();
            if (tid < 64) {
                const unsigned want = ctl[2]; const unsigned c0 = hist[4 * tid], c1 = hist[4 * tid + 1], c2 = hist[4 * tid + 2], c3 = hist[4 * tid + 3]; const unsigned sl = (c0 + c1) + (c2 + c3);
                unsigned suf = sl;
#pragma unroll
                for (int o = 1; o < 64; o <<= 1) { const unsigned tv = __shfl_down(suf, o); if (tid + o < 64) suf += tv; }
                unsigned cum = suf - sl;
                int bsel = -1; unsigned cb = 0;
                if (cum < want && cum + c3 >= want) { bsel = 3; cb = cum; } cum += c3;
                if (bsel < 0 && cum < want && cum + c2 >= want) { bsel = 2; cb = cum; } cum += c2;
                if (bsel < 0 && cum < want && cum + c1 >= want) { bsel = 1; cb = cum; } cum += c1;
                if (bsel < 0 && cum < want && cum + c0 >= want) { bsel = 0; cb = cum; }
                if (bsel >= 0) { ctl[0] = prefix | ((unsigned)(4 * tid + bsel) << shift); ctl[2] = want - cb; } }
            __syncthreads();
        }
        const unsigned thr = ctl[0], want_eq = ctl[2];
        unsigned cg = 0, ce = 0;
#pragma unroll
        for (int j = 0; j < 8; ++j) { const unsigned k = key[8 * tid + j]; cg += k > thr; ce += k == thr; }
        scan[tid] = cg; scan[512 + tid] = ce;
        __syncthreads();
        if (tid < 64) { unsigned sg = 0, se = 0;
            unsigned lg[8], le[8];
#pragma unroll
            for (int j = 0; j < 8; ++j) { lg[j] = scan[8 * tid + j]; le[j] = scan[512 + 8 * tid + j]; sg += lg[j]; se += le[j]; }
            unsigned pg = sg, pe = se;
#pragma unroll
            for (int o = 1; o < 64; o <<= 1) { const unsigned tg = __shfl_up(pg, o), te = __shfl_up(pe, o); if (tid >= o) { pg += tg; pe += te; } }
            unsigned bg = pg - sg, be = pe - se;
#pragma unroll
            for (int j = 0; j < 8; ++j) { scan[8 * tid + j] = bg; scan[512 + 8 * tid + j] = be; bg += lg[j]; be += le[j]; }
        }
        __syncthreads();
        unsigned pg = scan[tid], pe = scan[512 + tid];
#pragma unroll
        for (int j = 0; j < 8; ++j) { const int i = 8 * tid + j; const unsigned k = key[i]; int slot = -1;
            if (k > thr) { slot = (int)(pg + (pe < want_eq ? pe : want_eq)); pg++; }
            else if (k == thr) { if (pe < want_eq) slot = (int)(pg + pe); pe++; }
            SLOT[(size_t)(b * NE + e) * SEQ + i] = slot;
            if (slot >= 0) { SELI[(size_t)(b * NE + e) * CAP + slot] = i; SELG[(size_t)e * 1024 + b * CAP + slot] = __uint_as_float(k); SELR[(size_t)e * 1024 + b * CAP + slot] = RS2[b * SEQ + i]; } }
    }
}
__device__ __forceinline__ void phase_gather(Frame& F) {
    const int* SELI = WSP(int, WS_SELI); const bf16* HN = WSP(bf16, WS_HN); bf16* XS = WSP(bf16, WS_XS);
    const int gw = F.vcu * NWAVES + F.wave, NGW = F.G * NWAVES, lane = F.lane;
    for (int r = gw; r < NE * 1024; r += NGW) { const int e = r >> 10, q = r & 1023, b = q >> 9, slot = q & 511; const int i = SELI[(size_t)(b * NE + e) * CAP + slot];
        const u32x4* src = (const u32x4*)(HN + (size_t)(b * SEQ + i) * DM); u32x4* dst = (u32x4*)(XS + (size_t)r * DM);
#pragma unroll
        for (int j = 0; j < 4; ++j) dst[lane + 64 * j] = src[lane + 64 * j]; }
}
#define ADD_BF4(V, W) do { (V).x += __uint_as_float((W).x << 16); (V).y += __uint_as_float((W).x & 0xffff0000u); (V).z += __uint_as_float((W).y << 16); (V).w += __uint_as_float((W).y & 0xffff0000u); } while (0)
__device__ __forceinline__ void phase_combine(Frame& F) {
    const bf16* H = WSP(bf16, WS_H); bf16* H1 = WSP(bf16, WS_HN); float* RS3 = WSP(float, WS_RS) + 2 * T; const int* SLOT = WSP(int, WS_SLOT); const bf16* YEXP = WSP(bf16, WS_YEXP);
    const int gw = F.vcu * NWAVES + F.wave, NGW = F.G * NWAVES, lane = F.lane;
    int nslot = -1; u32x2 hw[8];
    if (gw < T) { nslot = lane < NE ? SLOT[(size_t)((gw >> 12) * NE + lane) * SEQ + (gw & (SEQ - 1))] : -1;
#pragma unroll
        for (int j = 0; j < 8; ++j) hw[j] = *(const u32x2*)(H + (size_t)gw * DM + 4 * lane + 256 * j); }
    for (int t = gw; t < T; t += NGW) { const int b = t >> 12;
        const int myslot = nslot; f32x4 v[8];
#pragma unroll
        for (int j = 0; j < 8; ++j) { v[j].x = __uint_as_float(hw[j].x << 16); v[j].y = __uint_as_float(hw[j].x & 0xffff0000u); v[j].z = __uint_as_float(hw[j].y << 16); v[j].w = __uint_as_float(hw[j].y & 0xffff0000u); }
        const int tn = t + NGW;
        if (tn < T) { nslot = lane < NE ? SLOT[(size_t)((tn >> 12) * NE + lane) * SEQ + (tn & (SEQ - 1))] : -1;
#pragma unroll
            for (int j = 0; j < 8; ++j) hw[j] = *(const u32x2*)(H + (size_t)tn * DM + 4 * lane + 256 * j); }
        unsigned long long mask = __ballot(myslot >= 0);
        while (mask) {
            const int e0 = __builtin_ctzll(mask); mask &= mask - 1; const int s0 = __builtin_amdgcn_readlane(myslot, e0);
            const bool h1 = mask != 0; int e1 = e0, s1 = s0; if (h1) { e1 = __builtin_ctzll(mask); mask &= mask - 1; s1 = __builtin_amdgcn_readlane(myslot, e1); }
            const bool h2 = mask != 0; int e2 = e0, s2 = s0; if (h2) { e2 = __builtin_ctzll(mask); mask &= mask - 1; s2 = __builtin_amdgcn_readlane(myslot, e2); }
            const bf16* y0 = YEXP + (size_t)(e0 * 1024 + b * CAP + s0) * DM + 4 * lane; const bf16* y1 = YEXP + (size_t)(e1 * 1024 + b * CAP + s1) * DM + 4 * lane; const bf16* y2 = YEXP + (size_t)(e2 * 1024 + b * CAP + s2) * DM + 4 * lane;
            u32x2 w0[8], w1[8], w2[8];
#pragma unroll
            for (int j = 0; j < 8; ++j) w0[j] = *(const u32x2*)(y0 + 256 * j);
            if (h1) {
#pragma unroll
                for (int j = 0; j < 8; ++j) w1[j] = *(const u32x2*)(y1 + 256 * j); }
            if (h2) {
#pragma unroll
                for (int j = 0; j < 8; ++j) w2[j] = *(const u32x2*)(y2 + 256 * j); }
#pragma unroll
            for (int j = 0; j < 8; ++j) ADD_BF4(v[j], w0[j]);
            if (h1) {
#pragma unroll
                for (int j = 0; j < 8; ++j) ADD_BF4(v[j], w1[j]); }
            if (h2) {
#pragma unroll
                for (int j = 0; j < 8; ++j) ADD_BF4(v[j], w2[j]); }
        }
        float ss = 0.f;
#pragma unroll
        for (int j = 0; j < 8; ++j) { u32x2 w; w.x = pk2(v[j].x, v[j].y); w.y = pk2(v[j].z, v[j].w); *(u32x2*)(H1 + (size_t)t * DM + 4 * lane + 256 * j) = w; ss += (v[j].x * v[j].x + v[j].y * v[j].y) + (v[j].z * v[j].z + v[j].w * v[j].w); }
        const float rs = rsqrtf(wave_sum(ss) * (1.0f / DM) + EPS); if (lane == 0) RS3[t] = rs;
    }
}
#undef ADD_BF4
__device__ __forceinline__ void phase_final(Frame& F, float oscale) {
    const bf16* H = WSP(bf16, WS_H); const float* gain = GIN(21);
    const int gw = F.vcu * NWAVES + F.wave, NGW = F.G * NWAVES, lane = F.lane;
    for (int t = gw; t < T; t += NGW) { const bf16* hr = H + (size_t)t * DM; f32x4 v[8]; float ss = 0.f;
#pragma unroll
        for (int j = 0; j < 8; ++j) { const u32x2 w = *(const u32x2*)(hr + 4 * lane + 256 * j); v[j].x = __uint_as_float(w.x << 16); v[j].y = __uint_as_float(w.x & 0xffff0000u); v[j].z = __uint_as_float(w.y << 16); v[j].w = __uint_as_float(w.y & 0xffff0000u); ss += (v[j].x * v[j].x + v[j].y * v[j].y) + (v[j].z * v[j].z + v[j].w * v[j].w); }
        const float rs = rsqrtf(wave_sum(ss) * (1.0f / DM) + EPS);
#pragma unroll
        for (int j = 0; j < 8; ++j) { const f32x4 g = *(const f32x4*)(gain + 4 * lane + 256 * j); *(f32x4*)(F.out + (size_t)t * DM + 4 * lane + 256 * j) = v[j] * (rs * oscale) * g; } }
}


#ifdef DBG_CHECKSUM
constexpr int CW_SUM = 8192;
constexpr size_t WS_PREV = WS_DQ;
__device__ __forceinline__ void dbg_checksum(Frame& F) {
    struct Buf { size_t off, bytes; };
    const Buf bufs[9] = {{WS_TL, (size_t)T * 16 * 4}, {WS_PROJ, (size_t)T * DINP * 2}, {WS_CM, (size_t)16 * 64 * 16384 * 2}, {WS_CN, (size_t)16 * 64 * 16384 * 2}, {WS_CP, (size_t)16 * 64 * 8192 * 2},
                         {WS_CR, (size_t)16 * 64 * 8192 * 4}, {WS_CS, (size_t)16 * 64 * 16384 * 2}, {WS_Y, (size_t)T * DM * 2}, {WS_H, (size_t)T * DM * 4}};
    const size_t gt = (size_t)F.vcu * NTHR + F.tid, NT = (size_t)F.G * NTHR;
#pragma unroll 1
    for (int k = 0; k < 9; ++k) { const unsigned* p = (const unsigned*)(F.ws + bufs[k].off); unsigned a = 0;
        for (size_t i = gt; i < bufs[k].bytes / 4; i += NT) a += p[i] * (unsigned)(2654435761u + 2u * (unsigned)(i & 1023));
#pragma unroll
        for (int o = 1; o < 64; o <<= 1) a += __shfl_xor(a, o);
        if (F.lane == 0) __hip_atomic_fetch_add((unsigned*)(F.ws + WS_CTL) + CW_SUM + k, a, __ATOMIC_RELAXED, __HIP_MEMORY_SCOPE_AGENT); }
}
__device__ __forceinline__ unsigned dbg_compare(Frame& F) {
    const unsigned* cur = (const unsigned*)(F.ws + WS_CTL) + CW_SUM; const unsigned* prev = (const unsigned*)(F.ws + WS_PREV);
    unsigned code = 0;
    if (__hip_atomic_load(prev, __ATOMIC_RELAXED, __HIP_MEMORY_SCOPE_AGENT) == 0x600DF00Du) {
#pragma unroll 1
        for (int k = 0; k < 9; ++k) if (__hip_atomic_load(prev + 1 + k, __ATOMIC_RELAXED, __HIP_MEMORY_SCOPE_AGENT) != __hip_atomic_load(cur + k, __ATOMIC_RELAXED, __HIP_MEMORY_SCOPE_AGENT)) code |= 1u << k; }
    return code;
}
__device__ __forceinline__ void dbg_store_prev(Frame& F) {
    if (F.vcu == 0 && F.tid == 0) { const unsigned* cur = (const unsigned*)(F.ws + WS_CTL) + CW_SUM; unsigned* prev = (unsigned*)(F.ws + WS_PREV);
        for (int k = 0; k < 9; ++k) __hip_atomic_store(prev + 1 + k, __hip_atomic_load(cur + k, __ATOMIC_RELAXED, __HIP_MEMORY_SCOPE_AGENT), __ATOMIC_RELAXED, __HIP_MEMORY_SCOPE_AGENT);
        __hip_atomic_store(prev, 0x600DF00Du, __ATOMIC_RELAXED, __HIP_MEMORY_SCOPE_AGENT); }
}
#endif

struct EpiStoreBf16 { bf16* C; int ldc; __device__ __forceinline__ void operator()(int m, int n, float v) const { C[(size_t)m * ldc + n] = (bf16)f2bf(v); } };
struct EpiStoreF32 { float* C; int ldc; __device__ __forceinline__ void operator()(int m, int n, float v) const { C[(size_t)m * ldc + n] = v; } };
struct EpiResid { float* H; __device__ __forceinline__ void operator()(int m, int n, float v) const { H[(size_t)m * DM + n] += v; } };
struct EpiDown { bf16* C; const float* gate; __device__ __forceinline__ void operator()(int m, int n, float v) const { C[(size_t)m * DM + n] = (bf16)f2bf(v * gate[m]); } };
struct EpiPle { float* H; const bf16* PL; __device__ __forceinline__ void operator()(int m, int n, float v) const { H[(size_t)m * DM + n] += sigmoidf_(v) * bf2f(PL[(size_t)m * DM + n]); } };

#ifndef NAIVE_GEMM
#define NAIVE_GEMM 0
#endif
constexpr int NPL = 14;
constexpr int NPHASES = 1 + DEPTH * NPL + 1;
struct Args { const float* in[22]; float* out; unsigned char* ws; int ph_lo, ph_hi; };

#ifndef ONLY
#define ONLY -1
#endif
#ifndef MASK
#define MASK 0xFFFF
#endif
#define EN(j) ((ONLY < 0 || ONLY == (j)) && ((MASK >> (j)) & 1))
#ifndef REPMASK
#define REPMASK 0
#endif
#define NREP(b) (((REPMASK >> (b)) & 1) ? 2 : 1)
#define REPEAT(b) for (int rep_ = 0; rep_ < NREP(b); ++rep_, __syncthreads())
#define IN(k) (lo <= (k) && (k) < hi)
#define INL(j) (EN((j) + 1) && IN(pb + (j)) && seam(pb + (j)))
#define LAUNDER() do { GAS unsigned char* w_ = (GAS unsigned char*)args.ws; int t_ = wave0 * 64 + lane_id(); const float* const __attribute__((address_space(4)))* i_ = (const float* const __attribute__((address_space(4)))*)__builtin_amdgcn_kernarg_segment_ptr(); int v_ = vcu0, g_ = (int)gridDim.x; asm volatile("" : "+s"(w_), "+v"(t_), "+s"(i_), "+s"(v_), "+s"(g_)); F.ws = (unsigned char*)w_; F.tid = t_; F.lane = t_ & 63; F.wave = wave0; F.in = i_; F.vcu = v_; F.G = g_; } while (0)
#define seam(k) (((k) > lo) ? (bar_sync(bar, (unsigned*)(args.ws + WS_CTL) + CW_BAR), true) : true)

template <int l>
__device__ __forceinline__ void layer_phases(Frame& F, const Args& args, XcdBarrier& bar, const int lo, const int hi, const int vcu0, unsigned char* lds_raw, const int wave0) {
        const int pb = 1 + l * NPL;
#define wl (F.ws + WS_W + (size_t)l * SZ_LAYERW)
        if (INL(0)) REPEAT(1) { LAUNDER(); phase_norm<1>(F, WSP(float, WS_WTL) + (size_t)(2 * l) * 16 * DM, WSP(float, WS_TL), WSP(float, WS_RS)); }
        if (INL(1)) REPEAT(2) { LAUNDER();
#if NAIVE_GEMM
            EpiStoreBf16 E{WSP(bf16, WS_PROJ), DINP}; naive_gemm(F, WSP(bf16, WS_HN), DM, (const bf16*)(wl + OFF_WIN), DM, T, DINP, DM, E);
#else
            { pg8::Gemm g{WSP(bf16, WS_H), (const bf16*)(wl + OFF_WIN), T, DINP, DM}; pg8::StaticOrder S; S.init(T, DINP, F.G, (int)blockIdx.x); pg8::EpiBf16Rs E{WSP(bf16, WS_PROJ), DINP, WSP(float, WS_RS)};
              pg8::gemm_phase<pg8::EpiBf16Rs, pg8::StaticOrder>(F.lds, g, S, E, nullptr, F.wave); }
            if (F.G == 256) { LAUNDER(); pg8::Gemm g{WSP(bf16, WS_PB) + (size_t)l * T * PLE, (const bf16*)(wl + OFF_WP), T, DM, PLE}; pg8::TailOrder S{(int)blockIdx.x, 128}; pg8::EpiBf16 E{WSP(bf16, WS_PL), DM};
              pg8::gemm_phase<pg8::EpiBf16, pg8::TailOrder>(F.lds, g, S, E, nullptr, F.wave); }
#endif
        }
        if (INL(2)) { REPEAT(3) { LAUNDER(); if (NAIVE_DN) phase_dn_prep_naive(F, l); else phase_dn_chunk(F, l); } __syncthreads(); LAUNDER(); phase_post(F, l); }
        if (INL(3)) { REPEAT(4) { LAUNDER(); phase_mix_naive(F); } if (!NAIVE_ATTN_A) REPEAT(5) { __syncthreads(); LAUNDER(); phase_attn_a(F); } if (!NAIVE_ATTN_B) REPEAT(6) { __syncthreads(); LAUNDER(); phase_attn_b(F, (char*)lds_raw); } }
        if (INL(4)) { LAUNDER(); if (!NAIVE_DN) REPEAT(7) { phase_dn_out(F, l); __syncthreads(); LAUNDER(); } REPEAT(8) phase_ynorm(F, l, NAIVE_DN != 0); }
        if (INL(5)) { LAUNDER();
#if NAIVE_GEMM
            EpiResid E{WSP(float, WS_H)}; naive_gemm(F, WSP(bf16, WS_Y), DM, (const bf16*)(wl + OFF_WOUT), DM, T, DM, DM, E);
#else
            pg8::Gemm g{WSP(bf16, WS_Y), (const bf16*)(wl + OFF_WOUT), T, DM, DM}; pg8::StaticOrder S; S.init(T, DM, F.G, (int)blockIdx.x); pg8::EpiResidBf16 E{WSP(bf16, WS_H), DM};
            pg8::gemm_phase<pg8::EpiResidBf16, pg8::StaticOrder>(F.lds, g, S, E, nullptr, F.wave);
#endif
        }
        if (INL(6)) REPEAT(9) { LAUNDER(); phase_norm<2>(F, WSP(float, WS_WTL) + (size_t)(2 * l + 1) * 16 * DM, WSP(float, WS_AFF), WSP(float, WS_RS) + T); }
        if (INL(7)) REPEAT(10) { LAUNDER(); phase_select(F); }
        if (NAIVE_GEMM && INL(8)) REPEAT(11) { LAUNDER(); phase_gather(F); }
        if (INL(9)) REPEAT(12) { LAUNDER();
#if NAIVE_GEMM
            for (int e = 0; e < NE; ++e) { EpiStoreF32 E{WSP(float, WS_TMP) + (size_t)e * 1024 * 2048, 2048};
                naive_gemm(F, WSP(bf16, WS_XS) + (size_t)e * 1024 * DM, DM, (const bf16*)(wl + OFF_WGU) + (size_t)e * 2048 * DM, DM, 1024, 2048, DM, E); }
            { EpiStoreBf16 E{WSP(bf16, WS_PL), DM}; naive_gemm(F, WSP(bf16, WS_PB) + (size_t)l * T * PLE, PLE, (const bf16*)(wl + OFF_WP), PLE, T, DM, PLE, E); }
#else
            { pg8::Gemm g{WSP(bf16, WS_H), (const bf16*)(wl + OFF_WGU), NE * 1024, NE * 2048, DM}; pg8::GroupedGatherOrder S{F.G, F.vcu, WSP(int, WS_SELI)}; pg8::EpiGateUp E{WSP(bf16, WS_HID), WSP(float, WS_SELR)};
              pg8::gemm_phase<pg8::EpiGateUp, pg8::GroupedGatherOrder>(F.lds, g, S, E, nullptr, F.wave); }
#endif
        }
#if !NAIVE_GEMM
        if (F.G != 256 && INL(10)) REPEAT(13) { LAUNDER(); pg8::Gemm g{WSP(bf16, WS_PB) + (size_t)l * T * PLE, (const bf16*)(wl + OFF_WP), T, DM, PLE}; pg8::StaticOrder S; S.init(T, DM, F.G, (int)blockIdx.x); pg8::EpiBf16 E{WSP(bf16, WS_PL), DM};
              pg8::gemm_phase<pg8::EpiBf16, pg8::StaticOrder>(F.lds, g, S, E, nullptr, F.wave); }
#endif
        if (NAIVE_GEMM && INL(10)) {
            const float* TMP = WSP(float, WS_TMP); bf16* HID = WSP(bf16, WS_HID);
            for (size_t i = (size_t)F.vcu * NTHR + F.tid; i < (size_t)NE * 1024 * EFF; i += (size_t)F.G * NTHR) { const size_t r = i >> 10; const int f = (int)(i & 1023);
                const float gt = TMP[r * 2048 + (f >> 7) * 256 + (f & 127)], up = TMP[r * 2048 + (f >> 7) * 256 + 128 + (f & 127)]; HID[i] = (bf16)f2bf(siluf_(gt) * up); }
        }
        if (INL(11)) REPEAT(14) { LAUNDER();
#if NAIVE_GEMM
            for (int e = 0; e < NE; ++e) { EpiDown E{WSP(bf16, WS_YEXP) + (size_t)e * 1024 * DM, WSP(float, WS_SELG) + (size_t)e * 1024};
                naive_gemm(F, WSP(bf16, WS_HID) + (size_t)e * 1024 * EFF, EFF, (const bf16*)(wl + OFF_WD) + (size_t)e * 2048 * EFF, EFF, 1024, DM, EFF, E); }
#else
            pg8::Gemm g{WSP(bf16, WS_HID), (const bf16*)(wl + OFF_WD), NE * 1024, NE * 2048, EFF}; pg8::GroupedOrder S{F.G, F.vcu}; pg8::EpiDownBf16 E{WSP(bf16, WS_YEXP), WSP(float, WS_SELG)};
            pg8::gemm_phase<pg8::EpiDownBf16, pg8::GroupedOrder>(F.lds, g, S, E, nullptr, F.wave);
#endif
        }
        if (INL(12)) { LAUNDER(); phase_combine(F); }
        if (INL(13)) { LAUNDER();
#if NAIVE_GEMM
            EpiPle E{WSP(float, WS_H), WSP(bf16, WS_PL)}; naive_gemm(F, WSP(bf16, WS_HN), DM, (const bf16*)(wl + OFF_WPG), DM, T, DM, DM, E);
#else
            pg8::Gemm g{WSP(bf16, WS_HN), (const bf16*)(wl + OFF_WPG), T, DM, DM}; pg8::StaticOrder S; S.init(T, DM, F.G, (int)blockIdx.x); pg8::EpiPleBf16 E{WSP(bf16, WS_HN), WSP(bf16, WS_H), WSP(bf16, WS_PL), WSP(float, WS_RS) + 2 * T};
            pg8::gemm_phase<pg8::EpiPleBf16, pg8::StaticOrder>(F.lds, g, S, E, nullptr, F.wave);
#endif
        }
}

__global__ void __launch_bounds__(NTHR, 2) mk_fwd(Args args) {
    extern __shared__ __attribute__((aligned(16))) unsigned char lds_raw[];
    Frame F;
    F.lds = (LAS unsigned char*)lds_raw;
    const int wave0 = __builtin_amdgcn_readfirstlane((int)threadIdx.x >> 6);
    F.wave = wave0; F.tid = wave0 * 64 + lane_id(); F.lane = F.tid & 63;
    F.G = gridDim.x; { const int bx = blockIdx.x; F.vcu = (F.G % 8 == 0) ? (bx % 8) * (F.G / 8) + bx / 8 : bx; }
    const int vcu0 = F.vcu;
    F.in = (const float* const __attribute__((address_space(4)))*)__builtin_amdgcn_kernarg_segment_ptr(); F.out = args.out; F.ws = args.ws;
    const int lo = args.ph_lo, hi = args.ph_hi;
    volatile LAS unsigned* misc = (volatile LAS unsigned*)(F.lds + LDS_MISC);
#ifdef CHECK_NAN_FILL
    for (int i = F.tid; i < LDS_MISC / 4; i += NTHR) ((LAS unsigned*)F.lds)[i] = 0xffffffffu;
    __syncthreads();
#endif
    if (F.tid < 4) misc[F.tid] = 0u;
    __syncthreads();
    XcdBarrier bar; bar.bar = (unsigned*)(args.ws + WS_CTL) + CW_BAR; bar.x = 0; bar.st = misc; bar.w0 = wave0;
    if (hi - lo > 1) bar = xcd_barrier_post((unsigned*)(args.ws + WS_CTL) + CW_BAR, misc, wave0);
    if (EN(0) && IN(0)) REPEAT(0) phase_prologue(F);
    layer_phases<0>(F, args, bar, lo, hi, vcu0, lds_raw, wave0);
    layer_phases<1>(F, args, bar, lo, hi, vcu0, lds_raw, wave0);
    layer_phases<2>(F, args, bar, lo, hi, vcu0, lds_raw, wave0);
    layer_phases<3>(F, args, bar, lo, hi, vcu0, lds_raw, wave0);
#ifdef DBG_CHECKSUM
    if (IN(NPHASES - 1)) { xcd_barrier(bar); LAUNDER(); dbg_checksum(F); xcd_barrier(bar); const unsigned code = dbg_compare(F); xcd_barrier(bar); dbg_store_prev(F); phase_final(F, 1.0f + (float)code); }
#else
    if (EN(15) && IN(NPHASES - 1) && seam(NPHASES - 1)) phase_final(F, 1.0f);
#endif
#undef IN
#undef INL
#undef seam
#undef wl
}

extern "C" void kernel_launch(void* const* d_in, const int* in_sizes, int n_in, void* d_out, int out_size, void* d_ws, size_t ws_size, hipStream_t stream) {
    static int grid = 0;
    if (grid == 0) {
        if (n_in != 22 || out_size != T * DM || ws_size < WS_END) { fprintf(stderr, "kernel_launch: unexpected shapes (n_in %d out %d ws %zu need %zu)\n", n_in, out_size, ws_size, (size_t)WS_END); grid = -1; return; }
        int dev = 0, cus = 0;
        if (hipGetDevice(&dev) != hipSuccess || hipDeviceGetAttribute(&cus, hipDeviceAttributeMultiprocessorCount, dev) != hipSuccess) { grid = -1; return; }
        if (hipFuncSetAttribute((const void*)mk_fwd, hipFuncAttributeMaxDynamicSharedMemorySize, LDS_BYTES) != hipSuccess) { fprintf(stderr, "kernel_launch: hipFuncSetAttribute failed\n"); grid = -1; return; }
        grid = cus;
    }
    if (grid < 0) return;
    Args a{};
    for (int i = 0; i < 22; ++i) a.in[i] = (const float*)d_in[i];
    a.out = (float*)d_out; a.ws = (unsigned char*)d_ws;
    if (hipMemsetAsync((char*)d_ws + WS_CTL, 0, CTL_BYTES, stream) != hipSuccess) { fprintf(stderr, "kernel_launch: memset failed\n"); return; }
#if N_LAUNCH_PER_PHASE
    for (int ph = 0; ph < NPHASES; ++ph) {
        a.ph_lo = ph; a.ph_hi = ph + 1;
        hipLaunchKernelGGL(mk_fwd, dim3(grid), dim3(NTHR), LDS_BYTES, stream, a);
    }
#else
    a.ph_lo = 0; a.ph_hi = NPHASES;
    hipLaunchKernelGGL(mk_fwd, dim3(grid), dim3(NTHR), LDS_BYTES, stream, a);
#endif
}
```

```cpp
#include <hip/hip_runtime.h>
#include <cstdio>
#include <cstdint>

#define LAS __attribute__((address_space(3)))
#define GAS __attribute__((address_space(1)))
typedef unsigned short bf16;
typedef float f32x4 __attribute__((ext_vector_type(4)));
typedef unsigned u32x4 __attribute__((ext_vector_type(4)));
typedef unsigned u32x2 __attribute__((ext_vector_type(2)));
typedef short bf16x8 __attribute__((ext_vector_type(8)));

constexpr int BATCH = 2, SEQ = 4096, T = BATCH * SEQ, DM = 2048, DEPTH = 4, HD = 128;
constexpr int DIN = 5136, DINP = 5120;
constexpr int COL_AQ = 0, COL_AK = 512, COL_AV = 1024, COL_BQ = 1536, COL_BK = 2560, COL_BV = 2816, COL_CQKV = 3072, COL_CZ = 4608;
constexpr int NE = 16, CAP = 512, EFF = 1024, PLE = 256;
constexpr float EPS = 1e-6f;
constexpr int NWAVES = 8, NTHR = 512;
constexpr int LDS_BYTES = 147456, LDS_MISC = 147456 - 256;
constexpr int CW_SCAN = 32768;
constexpr int CW_BAR = 4096;

constexpr size_t al256(size_t x) { return (x + 255) / 256 * 256; }
constexpr size_t WS_CTL = 0, CTL_BYTES = 1u << 20;
constexpr size_t SZ_WIN = (size_t)DINP * DM * 2, SZ_WOUT = (size_t)DM * DM * 2, SZ_WGU = (size_t)NE * 2048 * DM * 2, SZ_WD = (size_t)NE * DM * EFF * 2, SZ_WPG = (size_t)DM * DM * 2, SZ_WP = (size_t)DM * PLE * 2;
constexpr size_t SZ_LAYERW = SZ_WIN + SZ_WOUT + SZ_WGU + SZ_WD + SZ_WPG + SZ_WP;
constexpr size_t OFF_WIN = 0, OFF_WOUT = OFF_WIN + SZ_WIN, OFF_WGU = OFF_WOUT + SZ_WOUT, OFF_WD = OFF_WGU + SZ_WGU, OFF_WPG = OFF_WD + SZ_WD, OFF_WP = OFF_WPG + SZ_WPG;
constexpr size_t WS_W = WS_CTL + CTL_BYTES;
constexpr size_t WS_PB = WS_W + DEPTH * SZ_LAYERW;
constexpr size_t WS_TABA = WS_PB + (size_t)DEPTH * T * PLE * 2;
constexpr size_t WS_TABB = WS_TABA + (size_t)SEQ * 16 * 8;
constexpr size_t WS_H = al256(WS_TABB + 64 * 32 * 8);
constexpr size_t WS_HN = WS_H + (size_t)T * DM * 4;
constexpr size_t WS_TL = WS_HN + (size_t)T * DM * 2;
constexpr size_t WS_PROJ = WS_TL + (size_t)T * 16 * 4;
constexpr size_t WS_YMIX = WS_PROJ + (size_t)T * DINP * 2;
constexpr size_t WS_Y = WS_YMIX + (size_t)T * DM * 4;
constexpr size_t WS_AFF = WS_Y + (size_t)T * DM * 2;
constexpr size_t WS_SELI = WS_AFF + (size_t)T * 16 * 4;
constexpr size_t WS_SELG = WS_SELI + (size_t)BATCH * NE * CAP * 4;
constexpr size_t WS_SLOT = WS_SELG + (size_t)BATCH * NE * CAP * 4;
constexpr size_t WS_XS = WS_SLOT + (size_t)BATCH * NE * SEQ * 4;
constexpr size_t WS_HID = WS_XS + (size_t)NE * 1024 * DM * 2;
constexpr size_t WS_YEXP = WS_HID + (size_t)NE * 1024 * EFF * 2;
constexpr size_t WS_PL = WS_YEXP + (size_t)NE * 1024 * DM * 2;
constexpr size_t WS_DQ = WS_PL + (size_t)T * DM * 2;
constexpr size_t WS_DK = WS_DQ + (size_t)T * 512 * 4;
constexpr size_t WS_DV = WS_DK + (size_t)T * 512 * 4;
constexpr size_t WS_DB = WS_DV + (size_t)T * 512 * 4;
constexpr size_t WS_DG = WS_DB + (size_t)2 * T * 4 * 4;
constexpr size_t WS_DO = WS_DG + (size_t)2 * T * 4 * 4;
constexpr size_t WS_TMP = al256(WS_DO + (size_t)2 * T * 512 * 4);
constexpr size_t WS_CM = WS_TMP + (size_t)NE * 1024 * 2048 * 4;
constexpr size_t WS_CN = WS_CM + (size_t)16 * 64 * 128 * 128 * 2;
constexpr size_t WS_CS = WS_CN + (size_t)16 * 64 * 128 * 128 * 2;
constexpr size_t WS_CP = WS_CS + (size_t)16 * 64 * 128 * 128 * 2;
constexpr size_t WS_CR = WS_CP + (size_t)16 * 64 * 64 * 128 * 2;
constexpr size_t WS_END = WS_CR + (size_t)16 * 64 * 64 * 128 * 4;
constexpr size_t WS_RS = WS_XS;
constexpr size_t WS_SELR = WS_XS + (size_t)3 * T * 4;
constexpr size_t WS_WTL = WS_SELR + (size_t)NE * 1024 * 4;
static_assert(WS_END < 2140000000ull, "workspace map");

__device__ const double INV_A[16] = {1.0, 0.44036660267178046, 0.19392274474868576, 0.08539710028576561, 0.03760603093086393, 0.016560440080994443, 0.0072926647372171085, 0.003211445994752591, 0.0014142135623730952, 0.000622772421914596, 0.0002742481756762073, 0.00012076973741146504, 5.318295896944988e-05, 2.341999896140934e-05, 1.0313385377212458e-05, 4.5416704806078695e-06};
__device__ const double INV_B[32] = {1.0, 0.7498942093324559, 0.5623413251903491, 0.4216965034285822, 0.31622776601683794, 0.23713737056616552, 0.1778279410038923, 0.1333521432163324, 0.09999999999999999, 0.07498942093324558, 0.056234132519034905, 0.042169650342858224, 0.03162277660168379, 0.023713737056616554, 0.01778279410038923, 0.013335214321633239, 0.01, 0.007498942093324559, 0.005623413251903491, 0.004216965034285822, 0.0031622776601683794, 0.002371373705661655, 0.0017782794100389228, 0.0013335214321633238, 0.001, 0.0007498942093324559, 0.000562341325190349, 0.00042169650342858224, 0.00031622776601683794, 0.00023713737056616554, 0.0001778279410038923, 0.0001333521432163324};

#ifndef N_LAUNCH_PER_PHASE
#define N_LAUNCH_PER_PHASE 0
#endif
#ifndef NAIVE_DN
#define NAIVE_DN 0
#endif
#ifndef NAIVE_ATTN_A
#define NAIVE_ATTN_A 0
#endif
#ifndef NAIVE_ATTN_B
#define NAIVE_ATTN_B 0
#endif
__device__ __forceinline__ int lane_id() { int l; asm volatile("v_mbcnt_lo_u32_b32 %0, -1, 0\n\tv_mbcnt_hi_u32_b32 %0, -1, %0" : "=v"(l)); return l; }
#define TIDX(w0) ((w0) * 64 + lane_id())
__device__ __forceinline__ float bperm(float v, int src_lane) { return __int_as_float(__builtin_amdgcn_ds_bpermute(src_lane << 2, __float_as_int(v))); }
typedef __bf16 bf16v2_t __attribute__((ext_vector_type(2)));
typedef float f32v2_t __attribute__((ext_vector_type(2)));
__device__ __forceinline__ unsigned cvt_pk_rne(float lo, float hi) { const f32v2_t v = {lo, hi}; return __builtin_bit_cast(unsigned, __builtin_convertvector(v, bf16v2_t)); }
__device__ __forceinline__ float bf2f(bf16 b) { return __uint_as_float(((unsigned)b) << 16); }
__device__ __forceinline__ unsigned f2bf(float f) { unsigned u = __float_as_uint(f); return (u + 0x7fffu + ((u >> 16) & 1u)) >> 16; }
__device__ __forceinline__ unsigned pk2(float lo, float hi) { return cvt_pk_rne(lo, hi); }
__device__ __forceinline__ float wave_sum(float v) {
#pragma unroll
    for (int o = 1; o < 64; o <<= 1) v += __shfl_xor(v, o);
    return v;
}
__device__ __forceinline__ float wave_max(float v) {
#pragma unroll
    for (int o = 1; o < 64; o <<= 1) v = fmaxf(v, __shfl_xor(v, o));
    return v;
}
__device__ __forceinline__ float sigmoidf_(float x) { return __builtin_amdgcn_rcpf(1.0f + __expf(-x)); }
__device__ __forceinline__ float siluf_(float x) { return x * __builtin_amdgcn_rcpf(1.0f + __expf(-x)); }
__device__ __forceinline__ float softplusf_(float x) { const float e = __expf(-fabsf(x)); const float lg = e < 1e-3f ? e * (1.0f - 0.5f * e + 0.33333333f * e * e) : __logf(1.0f + e); return fmaxf(x, 0.f) + lg; }
__device__ __forceinline__ void sincos_d(double a, float& c, float& s) {
    const double q = rint(a * 0.63661977236758134308);
    const double r = (a - q * 1.57079632679489655800) - q * 6.12323399573676603587e-17;
    const double r2 = r * r;
    double sp = 1.0 / 6227020800.0; sp = sp * r2 * -1.0 + 1.0 / 39916800.0; sp = sp * -r2 + 1.0 / 362880.0; sp = sp * -r2 + 1.0 / 5040.0; sp = sp * -r2 + 1.0 / 120.0; sp = sp * -r2 + 1.0 / 6.0; sp = sp * -r2 + 1.0;
    const double sr = r * sp;
    double cp = 1.0 / 87178291200.0; cp = cp * -r2 + 1.0 / 479001600.0; cp = cp * -r2 + 1.0 / 3628800.0; cp = cp * -r2 + 1.0 / 40320.0; cp = cp * -r2 + 1.0 / 720.0; cp = cp * -r2 + 1.0 / 24.0; cp = cp * -r2 + 0.5; cp = cp * -r2 + 1.0;
    const double cr = cp;
    const long long qi = (long long)q; const int m = (int)(qi & 3);
    double cs, sn;
    if (m == 0) { cs = cr; sn = sr; } else if (m == 1) { cs = -sr; sn = cr; } else if (m == 2) { cs = -cr; sn = -sr; } else { cs = sr; sn = -cr; }
    c = (float)cs; s = (float)sn;
}


#define XB_TMO      128
#define XB_XCNT(j)  (256  + 64 * (j))
#define XB_XSUB(j)  (1280 + 64 * (j))
#define XB_XGEN(j)  (2304 + 64 * (j))
#define XB_TOP      3328
#define XB_TOPGEN   3392
#define XCD_BAR_WORDS 3456
#define XB_SPIN_CAP (1u << 22)

__device__ __forceinline__ unsigned xb_ld(unsigned* p)              { return __hip_atomic_load(p, __ATOMIC_RELAXED, __HIP_MEMORY_SCOPE_AGENT); }
__device__ __forceinline__ unsigned xb_add(unsigned* p, unsigned v) { return __hip_atomic_fetch_add(p, v, __ATOMIC_RELAXED, __HIP_MEMORY_SCOPE_AGENT); }
__device__ __forceinline__ unsigned xb_xcc_id() { return (unsigned)__builtin_amdgcn_s_getreg((3 << 11) | 20) & 0xFu; }
#define XB_SPIN(cond, bar) do { unsigned _sp = 0; while (cond) { __builtin_amdgcn_s_sleep(1); \
    if ((++_sp & 255u) == 0u) { if (xb_ld(&(bar)[XB_TMO])) break; if (_sp > XB_SPIN_CAP) { atomicAdd(&(bar)[XB_TMO], 1u); break; } } } } while (0)

struct XcdBarrier {
    unsigned* bar; unsigned x; int w0;
    volatile LAS unsigned* st;
};

__device__ __forceinline__ XcdBarrier xcd_barrier_post(unsigned* bar, volatile LAS unsigned* st, int w0) {
    XcdBarrier b; b.bar = bar; b.x = xb_xcc_id(); b.st = st; b.w0 = w0;
    if (TIDX(w0) == 0) (void)xb_add(&bar[XB_XCNT(b.x)], 1u);
    return b;
}
__device__ __forceinline__ void xcd_barrier_complete(unsigned* bar, unsigned x, unsigned& nloc, unsigned& nx) {
    const unsigned G = gridDim.x * gridDim.y * gridDim.z;
    unsigned sum, cnt, mine, sp = 0u;
    for (;;) {
        sum = 0u; cnt = 0u; mine = 0u;
#pragma unroll
        for (unsigned j = 0; j < 16; ++j) { const unsigned c = xb_ld(&bar[XB_XCNT(j)]); sum += c; cnt += (c > 0u) ? 1u : 0u; mine = (j == x) ? c : mine; }
        if (sum == G) break;
        __builtin_amdgcn_s_sleep(1);
        if ((++sp & 255u) == 0u) { if (xb_ld(&bar[XB_TMO])) break; if (sp > XB_SPIN_CAP) { atomicAdd(&bar[XB_TMO], 1u); break; } }
    }
    nloc = mine > 0u ? mine : 1u; nx = cnt > 0u ? cnt : 1u;
}

__device__ __forceinline__ void xcd_barrier(const XcdBarrier& b) {
    asm volatile("s_waitcnt vmcnt(0)" ::: "memory");
    __syncthreads();
    if (TIDX(b.w0) == 0) {
        unsigned* bar = b.bar;
        __builtin_amdgcn_s_waitcnt(0);
        unsigned nloc = b.st[0], nx = b.st[1];
        if (nloc == 0u) { xcd_barrier_complete(bar, b.x, nloc, nx); b.st[0] = nloc; b.st[1] = nx; }
        const unsigned old = xb_add(&bar[XB_XSUB(b.x)], 1u);
        const unsigned gen = old / nloc;
        if (old + 1u == (gen + 1u) * nloc) {
            __builtin_amdgcn_fence(__ATOMIC_RELEASE, "agent");
            asm volatile("s_waitcnt vmcnt(0)" ::: "memory");
            const unsigned og = xb_add(&bar[XB_TOP], 1u);
            const unsigned tg = og / nx;
            if (og + 1u == (tg + 1u) * nx) xb_add(&bar[XB_TOPGEN], 1u);
            else XB_SPIN(xb_ld(&bar[XB_TOPGEN]) == tg, bar);
            __builtin_amdgcn_fence(__ATOMIC_ACQUIRE, "agent");
            xb_add(&bar[XB_XGEN(b.x)], 1u);
            asm volatile("s_waitcnt vmcnt(0)" ::: "memory");
        } else {
            XB_SPIN(xb_ld(&bar[XB_XGEN(b.x)]) == gen, bar);
            __builtin_amdgcn_fence(__ATOMIC_ACQUIRE, "agent");
            asm volatile("s_waitcnt vmcnt(0)" ::: "memory");
        }
    }
    __syncthreads();
}

__device__ __forceinline__ void bar_sync(XcdBarrier& b, unsigned* words) { GAS unsigned* w = (GAS unsigned*)words; asm volatile("" : "+s"(w)); b.bar = (unsigned*)w; xcd_barrier(b); }

#define GIN(k) ((const float*)(const GAS float*)F.in[k])
struct Frame {
    LAS unsigned char* lds;
    int tid, lane, wave, vcu, G;
    const float* const __attribute__((address_space(4)))* in;
    float* out;
    unsigned char* ws;
};
#define WSP(type, off) ((type*)(F.ws + (off)))

template <bool GAM>
__device__ __forceinline__ void transpose_item(const float* __restrict__ W, int ldw, bf16* __restrict__ WT, int ldt, int k0, int n0, size_t drow0, LAS unsigned* scr, int lane, const float* __restrict__ gam) {
    const float* src = W + (size_t)k0 * ldw + n0 + lane;
    unsigned g0 = 0u, g1 = 0u;
    if (GAM) { const u32x2 gp = *(const u32x2*)(gam + k0 + 2 * lane); g0 = gp.x; g1 = gp.y; }
#pragma unroll 8
    for (int kk = 0; kk < 64; ++kk) { float v0 = __builtin_nontemporal_load(src + (size_t)(2 * kk) * ldw), v1 = __builtin_nontemporal_load(src + (size_t)(2 * kk + 1) * ldw);
        if (GAM) { v0 *= __uint_as_float(__builtin_amdgcn_readlane(g0, kk)); v1 *= __uint_as_float(__builtin_amdgcn_readlane(g1, kk)); }
        scr[lane * 65 + kk] = pk2(v0, v1); }
    asm volatile("s_waitcnt lgkmcnt(0)" ::: "memory");
    const int c = lane & 15;
#pragma unroll
    for (int j = 0; j < 16; ++j) { const int n = (lane >> 4) + 4 * j; const LAS unsigned* sp = scr + n * 65 + 4 * c;
        u32x4 o; o.x = sp[0]; o.y = sp[1]; o.z = sp[2]; o.w = sp[3];
        __builtin_nontemporal_store(o, (u32x4*)(WT + (drow0 + n) * (size_t)ldt + k0 + 8 * c)); }
    asm volatile("s_waitcnt lgkmcnt(0)" ::: "memory");
}
__device__ __forceinline__ void phase_prologue(Frame& F) {
    LAS unsigned* scr = (LAS unsigned*)(F.lds + F.wave * 16640);
    const int gw = F.vcu * NWAVES + F.wave, NGW = F.G * NWAVES;
    constexpr int I_IN = 16 * 80, I_OUT = 16 * 32, I_G = 16 * 16 * 16, I_D = 16 * 8 * 32, I_P = 2 * 32, I_PG = 16 * 32;
    constexpr int I_LAYER = I_IN + I_OUT + 2 * I_G + I_D + I_P + I_PG;
    for (int it = gw; it < DEPTH * I_LAYER; it += NGW) {
        const int l = it / I_LAYER; int r = it % I_LAYER;
#define wl (F.ws + WS_W + (size_t)l * SZ_LAYERW)
        if (r < I_IN) { const int kb = r / 80, nb = r % 80; transpose_item<true>(GIN(3) + (size_t)l * DM * DIN, DIN, (bf16*)(wl + OFF_WIN), DM, kb * 128, nb * 64, (size_t)nb * 64, scr, F.lane, GIN(2) + (size_t)l * DM); continue; } r -= I_IN;
        if (r < I_OUT) { const int kb = r / 32, nb = r % 32; transpose_item<false>(GIN(12) + (size_t)l * DM * DM, DM, (bf16*)(wl + OFF_WOUT), DM, kb * 128, nb * 64, (size_t)nb * 64, scr, F.lane, nullptr); continue; } r -= I_OUT;
        if (r < 2 * I_G) { const int up = r / I_G; r %= I_G; const int e = r / 256, q = r % 256, kb = q / 16, nb = q % 16, n0 = nb * 64;
            const float* src = (up ? GIN(16) : GIN(15)) + ((size_t)(l * NE + e) * DM) * EFF;
            transpose_item<true>(src, EFF, (bf16*)(wl + OFF_WGU), DM, kb * 128, n0, (size_t)e * 2048 + (n0 / 128) * 256 + (n0 % 128) + up * 128, scr, F.lane, GIN(13) + (size_t)l * DM); continue; } r -= 2 * I_G;
        if (r < I_D) { const int e = r / 256, q = r % 256, kb = q / 32, nb = q % 32;
            transpose_item<false>(GIN(17) + ((size_t)(l * NE + e) * EFF) * DM, DM, (bf16*)(wl + OFF_WD), EFF, kb * 128, nb * 64, (size_t)e * 2048 + nb * 64, scr, F.lane, nullptr); continue; } r -= I_D;
        if (r < I_P) { const int kb = r / 32, nb = r % 32; transpose_item<false>(GIN(19) + (size_t)l * PLE * DM, DM, (bf16*)(wl + OFF_WP), PLE, kb * 128, nb * 64, (size_t)nb * 64, scr, F.lane, nullptr); continue; } r -= I_P;
        { const int kb = r / 32, nb = r % 32; transpose_item<true>(GIN(20) + (size_t)l * DM * DM, DM, (bf16*)(wl + OFF_WPG), DM, kb * 128, nb * 64, (size_t)nb * 64, scr, F.lane, GIN(18) + (size_t)l * DM); }
    }
    const size_t gt = (size_t)F.vcu * NTHR + (size_t)(F.wave * 64 + lane_id()), NT = (size_t)F.G * NTHR;
    { const f32x4* src = (const f32x4*)GIN(1); u32x2* dst = WSP(u32x2, WS_PB);
      for (size_t i = gt; i < (size_t)DEPTH * T * PLE / 4; i += NT) { const f32x4 v = src[i]; u32x2 o; o.x = pk2(v.x, v.y); o.y = pk2(v.z, v.w); dst[i] = o; } }
    { const f32x4* src = (const f32x4*)GIN(0); u32x2* dst = WSP(u32x2, WS_H);
      for (size_t i = gt; i < (size_t)T * DM / 4; i += NT) { const f32x4 v = src[i]; u32x2 o; o.x = pk2(v.x, v.y); o.y = pk2(v.z, v.w); dst[i] = o; } }
#ifdef CHECK_NAN_FILL
    { u32x4* dst = WSP(u32x4, WS_CM); const u32x4 nn = {0xffffffffu, 0xffffffffu, 0xffffffffu, 0xffffffffu};
      for (size_t i = gt; i < (WS_END - WS_CM) / 16; i += NT) dst[i] = nn;
      u32x4* d2 = WSP(u32x4, WS_YMIX); for (size_t i = gt; i < (WS_XS - WS_YMIX) / 16; i += NT) d2[i] = nn; }
#endif
    { float* dst = WSP(float, WS_WTL);
      for (size_t i = gt; i < (size_t)DEPTH * 2 * 16 * DM; i += NT) { const int ls = (int)(i >> 15), l = ls >> 1, sset = ls & 1, k = (int)(i >> 4) & (DM - 1), c = (int)i & 15;
          const float* w = sset ? GIN(14) + (size_t)l * DM * NE : GIN(3) + (size_t)l * DM * DIN + DINP; const int ldw = sset ? NE : DIN; const float* g = (sset ? GIN(13) : GIN(2)) + (size_t)l * DM;
          dst[((size_t)ls * 16 + c) * DM + k] = g[k] * w[(size_t)k * ldw + c]; } }
    { float2* ta = WSP(float2, WS_TABA); for (size_t i = gt; i < (size_t)SEQ * 16; i += NT) { const int s = (int)(i >> 4), j = (int)(i & 15); float c, sn; sincos_d((double)s * INV_A[j], c, sn); ta[i] = make_float2(c, sn); }
      float2* tb = WSP(float2, WS_TABB); for (size_t i = gt; i < 64 * 32; i += NT) { const int s = (int)(i >> 5), j = (int)(i & 31); float c, sn; sincos_d((double)s * INV_B[j], c, sn); tb[i] = make_float2(c, sn); } }
}

template <int MODE>
__device__ __forceinline__ void phase_norm(Frame& F, const float* __restrict__ wtg, float* __restrict__ out16, float* __restrict__ rsout) {
    const bf16* H = WSP(bf16, WS_H);
    LAS float* wT = (LAS float*)F.lds;
#pragma unroll 1
    for (int h = 0; h < 2; ++h) { f32x4 st[8];
#pragma unroll
      for (int i = 0; i < 8; ++i) st[i] = *(const f32x4*)(wtg + 4 * (F.tid + NTHR * (8 * h + i)));
#pragma unroll
      for (int i = 0; i < 8; ++i) *(LAS f32x4*)(wT + 4 * (F.tid + NTHR * (8 * h + i))) = st[i]; }
    __syncthreads();
    const int gw = F.vcu * NWAVES + F.wave, NGW = F.G * NWAVES, lane = F.lane;
    for (int r0 = gw * 4; r0 < T; r0 += NGW * 4) {
        f32x4 v[4][8];
#pragma unroll
        for (int rr = 0; rr < 4; ++rr) { const bf16* hr = H + (size_t)(r0 + rr) * DM; float ss = 0.f;
#pragma unroll
            for (int j = 0; j < 8; ++j) { const u32x2 hw = *(const u32x2*)(hr + 4 * lane + 256 * j); v[rr][j].x = __uint_as_float(hw.x << 16); v[rr][j].y = __uint_as_float(hw.x & 0xffff0000u); v[rr][j].z = __uint_as_float(hw.y << 16); v[rr][j].w = __uint_as_float(hw.y & 0xffff0000u); ss += (v[rr][j].x * v[rr][j].x + v[rr][j].y * v[rr][j].y) + (v[rr][j].z * v[rr][j].z + v[rr][j].w * v[rr][j].w); }
            const float rs = rsqrtf(wave_sum(ss) * (1.0f / DM) + EPS); if (lane == 0) rsout[r0 + rr] = rs;
#pragma unroll
            for (int j = 0; j < 8; ++j) v[rr][j] = v[rr][j] * rs; }
        float a[64];
#pragma unroll
        for (int c = 0; c < 16; ++c) { float p0 = 0.f, p1 = 0.f, p2 = 0.f, p3 = 0.f; asm volatile("" ::: "memory");
#pragma unroll
            for (int j = 0; j < 8; ++j) { const f32x4 w = *(const LAS f32x4*)(wT + c * DM + 4 * lane + 256 * j);
                p0 += (v[0][j].x * w.x + v[0][j].y * w.y) + (v[0][j].z * w.z + v[0][j].w * w.w); p1 += (v[1][j].x * w.x + v[1][j].y * w.y) + (v[1][j].z * w.z + v[1][j].w * w.w);
                p2 += (v[2][j].x * w.x + v[2][j].y * w.y) + (v[2][j].z * w.z + v[2][j].w * w.w); p3 += (v[3][j].x * w.x + v[3][j].y * w.y) + (v[3][j].z * w.z + v[3][j].w * w.w); }
            a[c] = p0; a[16 + c] = p1; a[32 + c] = p2; a[48 + c] = p3; }
#define TR_STEP(N, M) _Pragma("unroll") for (int k = 0; k < (N) / 2; ++k) { const bool up = (lane & (M)) != 0; const float keep = up ? a[k + (N) / 2] : a[k], send = up ? a[k] : a[k + (N) / 2]; a[k] = keep + __shfl_xor(send, (M)); }
        TR_STEP(64, 32) TR_STEP(32, 16) TR_STEP(16, 8) TR_STEP(8, 4) TR_STEP(4, 2) TR_STEP(2, 1)
#undef TR_STEP
        float mine = a[0];
        if (MODE == 2) { float m = mine; m = fmaxf(m, __shfl_xor(m, 1)); m = fmaxf(m, __shfl_xor(m, 2)); m = fmaxf(m, __shfl_xor(m, 4)); m = fmaxf(m, __shfl_xor(m, 8));
            const float e = expf(mine - m); float sden = e; sden += __shfl_xor(sden, 1); sden += __shfl_xor(sden, 2); sden += __shfl_xor(sden, 4); sden += __shfl_xor(sden, 8); mine = e / sden; }
        out16[(size_t)r0 * 16 + lane] = mine;
    }
}

namespace pg8 {
#define PG8_LAS __attribute__((address_space(3)))
typedef unsigned short bf16_t;
typedef short bf16x8 __attribute__((ext_vector_type(8)));
typedef float f32x4 __attribute__((ext_vector_type(4)));
typedef unsigned u32x4 __attribute__((ext_vector_type(4)));
constexpr int BM = 256, BK = 64, HALF = 128, HTB = HALF * BK * 2, STAGE_BYTES = 8 * HTB, NXCD = 8, WGM = 8;
__host__ __device__ __forceinline__ int lds_byte(int r, int c) { const int st = (r >> 4) * 2 + (c >> 5), rr = r & 15, cc = c & 31, ob = rr * 64 + cc * 2; return st * 1024 + (ob ^ (((ob >> 9) & 1) << 5)); }
__host__ __device__ __forceinline__ void stage_rc(int b, int& R, int& C) { const int st = b / 1024, sb = b % 1024, swz = sb ^ (((sb >> 9) & 1) << 5); R = (st >> 1) * 16 + swz / 64; C = (st & 1) * 32 + (swz % 64) / 2; }
__host__ __device__ __forceinline__ int perm32(int rho) { const int n = rho >> 4, i = rho & 15; return 8 * (i >> 2) + 4 * n + (i & 3); }
struct Unit { int pm, pn; };
struct Gemm { const bf16_t* A; const bf16_t* Bt; int M, N, K; };
struct StaticOrder {
    static constexpr bool GATHER = false;
    int nM, nN, nwg, G, c;
    __host__ __device__ void init(int M, int N, int G_, int c_) { nM = M / BM; nN = N / BM; nwg = nM * nN; G = G_; c = c_; }
    __host__ __device__ bool next(int i, Unit& u) const {
        const long L = (long)i * G + c; if (L >= nwg) return false;
        int wgid = (int)L; { const int q = nwg / NXCD, r = nwg % NXCD, xcd = wgid % NXCD, off = wgid / NXCD; wgid = (xcd < r ? xcd * (q + 1) : r * (q + 1) + (xcd - r) * q) + off; }
        const int nig = WGM * nN, gid = wgid / nig, fm = gid * WGM, gsz = (nM - fm) < WGM ? (nM - fm) : WGM;
        u.pm = fm + ((wgid % nig) % gsz); u.pn = (wgid % nig) / gsz; return true;
    }
    __device__ __forceinline__ void a_ready(const Unit&) const {}
    __device__ __forceinline__ void done(const Unit&) const {}
};
struct TailOrder {
    static constexpr bool GATHER = false;
    int c, first;
    __device__ bool next(int i, Unit& u) const { if (c < first || c >= first + 128 || i >= 2) return false; const int L = (c - first) * 2 + i; u.pm = L >> 3; u.pn = L & 7; return true; }
    __device__ __forceinline__ void a_ready(const Unit&) const {}
    __device__ __forceinline__ void done(const Unit&) const {}
};
struct GroupedOrder {
    static constexpr bool GATHER = false;
    int G, c;
    __device__ bool next(int i, Unit& u) const { const int L = i * G + c; if (L >= 512) return false; const int e = L >> 5, w = L & 31; u.pm = 4 * e + (w & 3); u.pn = 8 * e + (w >> 2); return true; }
    __device__ __forceinline__ void a_ready(const Unit&) const {}
    __device__ __forceinline__ void done(const Unit&) const {}
};
struct GroupedGatherOrder {
    static constexpr bool GATHER = true;
    int G, c; const int* seli;
    __device__ bool next(int i, Unit& u) const { const int L = i * G + c; if (L >= 512) return false; const int e = L >> 5, w = L & 31; u.pm = 4 * e + (w & 3); u.pn = 8 * e + (w >> 2); return true; }
    __device__ __forceinline__ int arow(const Unit& u, int r) const { const int row = u.pm * 256 + r, e = row >> 10, q = row & 1023, b = q >> 9, slot = q & 511; return b * 4096 + seli[(b * 16 + e) * 512 + slot]; }
    __device__ __forceinline__ void a_ready(const Unit&) const {}
    __device__ __forceinline__ void done(const Unit&) const {}
};
__device__ __forceinline__ unsigned cvt_pk_bf16(float lo, float hi) { return cvt_pk_rne(lo, hi); }
struct EpiBf16 {
    static constexpr bool PERM = true, AFTER_DRAIN = false;
    bf16_t* O; int ldc;
    __device__ __forceinline__ void operator()(const f32x4 (&acc)[2][2][4][2], const Unit& u, int wr, int wc, int fr, int fq) const {
        const int row0 = u.pm * BM + wr * 64 + fr, col0 = u.pn * BM + wc * 32 + 8 * fq;
        asm volatile("s_nop 15\n\ts_nop 7" ::: "memory");
#pragma unroll
        for (int ai = 0; ai < 2; ++ai)
#pragma unroll
            for (int m = 0; m < 4; ++m) { bf16_t* rowp = O + (size_t)(row0 + ai * HALF + m * 16) * ldc + col0;
#pragma unroll
                for (int bj = 0; bj < 2; ++bj) { const f32x4 v0 = acc[ai][bj][m][0], v1 = acc[ai][bj][m][1];
                    u32x4 w; w.x = cvt_pk_bf16(v0[0], v0[1]); w.y = cvt_pk_bf16(v0[2], v0[3]); w.z = cvt_pk_bf16(v1[0], v1[1]); w.w = cvt_pk_bf16(v1[2], v1[3]);
                    *(u32x4*)(rowp + bj * HALF) = w; } }
    }
};
__device__ __forceinline__ float bfe(const u32x4& w, int e) { const unsigned x = w[e >> 1]; return __uint_as_float((e & 1) ? (x & 0xffff0000u) : (x << 16)); }
struct EpiBf16Rs {
    static constexpr bool PERM = true, AFTER_DRAIN = false;
    bf16_t* O; int ldc; const float* rs;
    __device__ __forceinline__ void operator()(const f32x4 (&acc)[2][2][4][2], const Unit& u, int wr, int wc, int fr, int fq) const {
        const int row0 = u.pm * BM + wr * 64 + fr, col0 = u.pn * BM + wc * 32 + 8 * fq;
#pragma unroll
        for (int ai = 0; ai < 2; ++ai)
#pragma unroll
            for (int m = 0; m < 4; ++m) { const int row = row0 + ai * HALF + m * 16; const float s = rs[row]; bf16_t* rowp = O + (size_t)row * ldc + col0;
#pragma unroll
                for (int bj = 0; bj < 2; ++bj) { const f32x4 v0 = acc[ai][bj][m][0] * s, v1 = acc[ai][bj][m][1] * s;
                    u32x4 w; w.x = cvt_pk_bf16(v0[0], v0[1]); w.y = cvt_pk_bf16(v0[2], v0[3]); w.z = cvt_pk_bf16(v1[0], v1[1]); w.w = cvt_pk_bf16(v1[2], v1[3]);
                    *(u32x4*)(rowp + bj * HALF) = w; } }
    }
};
struct EpiResidBf16 {
    static constexpr bool PERM = true, AFTER_DRAIN = false;
    bf16_t* H; int ldc;
    __device__ __forceinline__ void operator()(const f32x4 (&acc)[2][2][4][2], const Unit& u, int wr, int wc, int fr, int fq) const {
        const int row0 = u.pm * BM + wr * 64 + fr, col0 = u.pn * BM + wc * 32 + 8 * fq;
#pragma unroll
        for (int ai = 0; ai < 2; ++ai)
#pragma unroll
            for (int m = 0; m < 4; ++m) { bf16_t* rowp = H + (size_t)(row0 + ai * HALF + m * 16) * ldc + col0;
                u32x4 h[2];
#pragma unroll
                for (int bj = 0; bj < 2; ++bj) h[bj] = *(const u32x4*)(rowp + bj * HALF);
#pragma unroll
                for (int bj = 0; bj < 2; ++bj) { const f32x4 v0 = acc[ai][bj][m][0], v1 = acc[ai][bj][m][1];
                    u32x4 w; w.x = cvt_pk_bf16(bfe(h[bj], 0) + v0[0], bfe(h[bj], 1) + v0[1]); w.y = cvt_pk_bf16(bfe(h[bj], 2) + v0[2], bfe(h[bj], 3) + v0[3]);
                    w.z = cvt_pk_bf16(bfe(h[bj], 4) + v1[0], bfe(h[bj], 5) + v1[1]); w.w = cvt_pk_bf16(bfe(h[bj], 6) + v1[2], bfe(h[bj], 7) + v1[3]);
                    *(u32x4*)(rowp + bj * HALF) = w; }
                asm volatile("" ::: "memory"); }
    }
};
struct EpiPleBf16 {
    static constexpr bool PERM = true, AFTER_DRAIN = false;
    const bf16_t* Hin; bf16_t* Hout; const bf16_t* PL; const float* rs;
    __device__ __forceinline__ void operator()(const f32x4 (&acc)[2][2][4][2], const Unit& u, int wr, int wc, int fr, int fq) const {
        const int row0 = u.pm * BM + wr * 64 + fr, col0 = u.pn * BM + wc * 32 + 8 * fq;
#pragma unroll
        for (int ai = 0; ai < 2; ++ai)
#pragma unroll
            for (int m = 0; m < 4; ++m) { const int row = row0 + ai * HALF + m * 16; const float s = rs[row]; const size_t off = (size_t)row * 2048 + col0;
                u32x4 h[2], p[2];
#pragma unroll
                for (int bj = 0; bj < 2; ++bj) { h[bj] = *(const u32x4*)(Hin + off + bj * HALF); p[bj] = *(const u32x4*)(PL + off + bj * HALF); }
#pragma unroll
                for (int bj = 0; bj < 2; ++bj) { float o[8];
#pragma unroll
                    for (int e = 0; e < 8; ++e) { const float a = acc[ai][bj][m][e >> 2][e & 3] * s; o[e] = bfe(h[bj], e) + __builtin_amdgcn_rcpf(1.0f + __expf(-a)) * bfe(p[bj], e); }
                    u32x4 w; w.x = cvt_pk_bf16(o[0], o[1]); w.y = cvt_pk_bf16(o[2], o[3]); w.z = cvt_pk_bf16(o[4], o[5]); w.w = cvt_pk_bf16(o[6], o[7]);
                    *(u32x4*)(Hout + off + bj * HALF) = w; }
                asm volatile("" ::: "memory"); }
    }
};
struct EpiResidF32 {
    static constexpr bool PERM = false, AFTER_DRAIN = false;
    float* H; int ldc;
    __device__ __forceinline__ void operator()(const f32x4 (&acc)[2][2][4][2], const Unit& u, int wr, int wc, int fr, int fq) const {
        const int row0 = u.pm * BM + wr * 64 + fr, col0 = u.pn * BM + wc * 32 + 4 * fq;
#pragma unroll
        for (int ai = 0; ai < 2; ++ai)
#pragma unroll
            for (int m = 0; m < 4; ++m) { float* rowp = H + (size_t)(row0 + ai * HALF + m * 16) * ldc + col0;
                f32x4 h[2][2];
#pragma unroll
                for (int bj = 0; bj < 2; ++bj)
#pragma unroll
                    for (int n = 0; n < 2; ++n) h[bj][n] = *(const f32x4*)(rowp + bj * HALF + n * 16);
#pragma unroll
                for (int bj = 0; bj < 2; ++bj)
#pragma unroll
                    for (int n = 0; n < 2; ++n) *(f32x4*)(rowp + bj * HALF + n * 16) = h[bj][n] + acc[ai][bj][m][n];
                asm volatile("" ::: "memory"); }
    }
};
struct EpiGateUp {
    static constexpr bool PERM = true, AFTER_DRAIN = false;
    bf16_t* HID; const float* selr;
    __device__ __forceinline__ void operator()(const f32x4 (&acc)[2][2][4][2], const Unit& u, int wr, int wc, int fr, int fq) const {
        const int row0 = u.pm * BM + wr * 64 + fr, col0 = (u.pn & 7) * 128 + wc * 32 + 8 * fq;
#pragma unroll
        for (int ai = 0; ai < 2; ++ai)
#pragma unroll
            for (int m = 0; m < 4; ++m) { float o[8]; const float s = selr[row0 + ai * HALF + m * 16];
#pragma unroll
                for (int n = 0; n < 2; ++n)
#pragma unroll
                    for (int j = 0; j < 4; ++j) { const float g = acc[ai][0][m][n][j] * s, up = acc[ai][1][m][n][j] * s; o[4 * n + j] = g * __builtin_amdgcn_rcpf(1.0f + __expf(-g)) * up; }
                u32x4 w; w.x = cvt_pk_bf16(o[0], o[1]); w.y = cvt_pk_bf16(o[2], o[3]); w.z = cvt_pk_bf16(o[4], o[5]); w.w = cvt_pk_bf16(o[6], o[7]);
                *(u32x4*)(HID + (size_t)(row0 + ai * HALF + m * 16) * 1024 + col0) = w; }
    }
};
struct EpiDownBf16 {
    static constexpr bool PERM = true, AFTER_DRAIN = false;
    bf16_t* O; const float* gate;
    __device__ __forceinline__ void operator()(const f32x4 (&acc)[2][2][4][2], const Unit& u, int wr, int wc, int fr, int fq) const {
        const int row0 = u.pm * BM + wr * 64 + fr, col0 = (u.pn & 7) * BM + wc * 32 + 8 * fq;
#pragma unroll
        for (int ai = 0; ai < 2; ++ai)
#pragma unroll
            for (int m = 0; m < 4; ++m) { const int row = row0 + ai * HALF + m * 16; const float gt = gate[row]; bf16_t* rowp = O + (size_t)row * 2048 + col0;
#pragma unroll
                for (int bj = 0; bj < 2; ++bj) { const f32x4 v0 = acc[ai][bj][m][0] * gt, v1 = acc[ai][bj][m][1] * gt;
                    u32x4 w; w.x = cvt_pk_bf16(v0[0], v0[1]); w.y = cvt_pk_bf16(v0[2], v0[3]); w.z = cvt_pk_bf16(v1[0], v1[1]); w.w = cvt_pk_bf16(v1[2], v1[3]);
                    *(u32x4*)(rowp + bj * HALF) = w; } }
    }
};
struct EpiPleF32 {
    static constexpr bool PERM = false, AFTER_DRAIN = false;
    float* H; const bf16_t* PL;
    __device__ __forceinline__ void operator()(const f32x4 (&acc)[2][2][4][2], const Unit& u, int wr, int wc, int fr, int fq) const {
        typedef unsigned u32x2v __attribute__((ext_vector_type(2)));
        const int row0 = u.pm * BM + wr * 64 + fr, col0 = u.pn * BM + wc * 32 + 4 * fq;
#pragma unroll
        for (int ai = 0; ai < 2; ++ai)
#pragma unroll
            for (int m = 0; m < 4; ++m) { const size_t off = (size_t)(row0 + ai * HALF + m * 16) * 2048 + col0;
                f32x4 h[2][2]; u32x2v p[2][2];
#pragma unroll
                for (int bj = 0; bj < 2; ++bj)
#pragma unroll
                    for (int n = 0; n < 2; ++n) { h[bj][n] = *(const f32x4*)(H + off + bj * HALF + n * 16); p[bj][n] = *(const u32x2v*)(PL + off + bj * HALF + n * 16); }
#pragma unroll
                for (int bj = 0; bj < 2; ++bj)
#pragma unroll
                    for (int n = 0; n < 2; ++n) { const f32x4 a = acc[ai][bj][m][n]; f32x4 pl; pl[0] = __uint_as_float(p[bj][n].x << 16); pl[1] = __uint_as_float(p[bj][n].x & 0xffff0000u); pl[2] = __uint_as_float(p[bj][n].y << 16); pl[3] = __uint_as_float(p[bj][n].y & 0xffff0000u);
                        f32x4 o;
#pragma unroll
                        for (int j = 0; j < 4; ++j) o[j] = h[bj][n][j] + __builtin_amdgcn_rcpf(1.0f + __expf(-a[j])) * pl[j];
                        *(f32x4*)(H + off + bj * HALF + n * 16) = o; }
                asm volatile("" ::: "memory"); }
    }
};
template <class Epi, class Sched, bool STAMP = false>
__device__ __forceinline__ void gemm_phase(PG8_LAS unsigned char* lds, const Gemm g, const Sched& S, const Epi& E, unsigned long long* stamps, const int wave0) {
    int tid_ = wave0 * 64 + lane_id(); asm volatile("" : "+v"(tid_));
    const int tid = tid_, wid = __builtin_amdgcn_readfirstlane(tid >> 6), lane = tid & 63, wr = wid >> 2, wc = wid & 3, fr = lane & 15, fq = lane >> 4;
    const int K = g.K, nt = K / BK;
    int ts_lo = 0, ts_hi = 0, nts = 0; const unsigned long long rt_entry = STAMP ? (unsigned long long)wall_clock64() : 0ull;
#define PG8_STAMP() do { if (STAMP && wid == 0 && nts < 64) { const unsigned long long _c = (unsigned long long)clock64(); \
        ts_lo = (lane == nts) ? (int)(unsigned)_c : ts_lo; ts_hi = (lane == nts) ? (int)(unsigned)(_c >> 32) : ts_hi; ++nts; } } while (0)
    PG8_STAMP();
    unsigned voffA[2], voffB[2];
    unsigned gvc[2][2] = {{0u, 0u}, {0u, 0u}}, gvn[2][2] = {{0u, 0u}, {0u, 0u}}; int gR[2] = {0, 0}, gC[2] = {0, 0};
#pragma unroll
    for (int i = 0; i < 2; ++i) { int R, C; stage_rc(tid * 16 + i * 8192, R, C); const int Rb = Epi::PERM ? ((R & ~31) + perm32(R & 31)) : R;
        voffA[i] = (unsigned)(R * K + C) * 2u; voffB[i] = (unsigned)(Rb * K + C) * 2u; gR[i] = R; gC[i] = C; }
    const size_t kstep = (size_t)(BK * 2);
    const size_t hstep = (size_t)HALF * K * 2;
    const size_t tstep = 2 * hstep;
    const unsigned ldsw = (unsigned)wid * 1024u;
    const int aoff = lds_byte(wr * 64 + fr, fq * 8), boff = lds_byte(wc * 32 + fr, fq * 8);
#define PG8_SA(b, h) (((b) * 2 + (h)) * HTB)
#define PG8_SB(b, h) ((4 + (b) * 2 + (h)) * HTB)
#define PG8_STAGE(bufoff, gbase, voff) do { _Pragma("unroll") for (int _i = 0; _i < 2; ++_i) \
        __builtin_amdgcn_global_load_lds((const unsigned*)((const char*)(gbase) + (voff)[_i]), (PG8_LAS unsigned*)(lds + (bufoff) + ldsw + _i * 8192), 16, 0, 0); } while (0)
#define PG8_STAGE_A(bufoff, gbase, h, un) do { if constexpr (Sched::GATHER) { unsigned _o[2]; _o[0] = (un) ? gvn[h][0] : gvc[h][0]; _o[1] = (un) ? gvn[h][1] : gvc[h][1]; PG8_STAGE(bufoff, gbase, _o); } \
        else { PG8_STAGE(bufoff, (gbase) + ((h) ? hstep : (size_t)0), voffA); } } while (0)
#define PG8_GOFF(dst, u) do { _Pragma("unroll") for (int _h = 0; _h < 2; ++_h) _Pragma("unroll") for (int _i = 0; _i < 2; ++_i) dst[_h][_i] = ((unsigned)S.arow(u, _h * HALF + gR[_i]) * (unsigned)K + (unsigned)gC[_i]) * 2u; } while (0)
#define PG8_LDA(dst, b, h) do { _Pragma("unroll") for (int m = 0; m < 4; ++m) _Pragma("unroll") for (int k = 0; k < 2; ++k) dst[m][k] = *(const PG8_LAS bf16x8*)(lds + PG8_SA(b, h) + aoff + m * 2048 + k * 1024); } while (0)
#define PG8_LDB(dst, b, h) do { _Pragma("unroll") for (int n = 0; n < 2; ++n) _Pragma("unroll") for (int k = 0; k < 2; ++k) dst[n][k] = *(const PG8_LAS bf16x8*)(lds + PG8_SB(b, h) + boff + n * 2048 + k * 1024); } while (0)
#define PG8_MMA(ai, bj, At, Bt) do { __builtin_amdgcn_s_setprio(1); _Pragma("unroll") for (int m = 0; m < 4; ++m) _Pragma("unroll") for (int n = 0; n < 2; ++n) _Pragma("unroll") for (int k = 0; k < 2; ++k) \
        acc[ai][bj][m][n] = __builtin_amdgcn_mfma_f32_16x16x32_bf16(Bt[n][k], At[m][k], acc[ai][bj][m][n], 0, 0, 0); __builtin_amdgcn_s_setprio(0); } while (0)
#define PG8_WAIT_V(n) asm volatile("s_waitcnt vmcnt(" #n ")" ::: "memory")
#define PG8_WAIT_L(n) asm volatile("s_waitcnt lgkmcnt(" #n ")" ::: "memory")
#define PG8_BAR __builtin_amdgcn_s_barrier()
#define PG8_SCHED __builtin_amdgcn_sched_barrier(0)
    Unit cur, nxt; int ui = 0;
    if (!S.next(0, cur)) return;
    f32x4 acc[2][2][4][2];
#pragma unroll
    for (int a = 0; a < 2; ++a)
#pragma unroll
        for (int b = 0; b < 2; ++b)
#pragma unroll
            for (int m = 0; m < 4; ++m)
#pragma unroll
                for (int n = 0; n < 2; ++n) acc[a][b][m][n] = (f32x4){0.f, 0.f, 0.f, 0.f};
    bf16x8 At[4][2], B0[2][2], B1[2][2];
    const char* cA = (const char*)g.A + (Sched::GATHER ? (size_t)0 : (size_t)cur.pm * tstep); const char* cB = (const char*)g.Bt + (size_t)cur.pn * tstep;
    if constexpr (Sched::GATHER) PG8_GOFF(gvc, cur);
    S.a_ready(cur);
    PG8_STAGE(PG8_SB(0, 0), cB, voffB); PG8_STAGE_A(PG8_SA(0, 0), cA, 0, false); PG8_STAGE(PG8_SB(0, 1), cB + hstep, voffB); PG8_STAGE_A(PG8_SA(0, 1), cA, 1, false);
    if (wr == 1) PG8_BAR;
    PG8_WAIT_V(4); PG8_BAR;
    PG8_STAGE(PG8_SB(1, 0), cB + kstep, voffB); PG8_STAGE_A(PG8_SA(1, 0), cA + kstep, 0, false); PG8_STAGE(PG8_SB(1, 1), cB + hstep + kstep, voffB);
    PG8_WAIT_V(6); PG8_BAR;
    PG8_STAMP();
    for (;;) {
        const bool has_next = S.next(ui + 1, nxt);
        if constexpr (Sched::GATHER) { if (has_next) PG8_GOFF(gvn, nxt); }
        const char* nA = (has_next && !Sched::GATHER) ? (const char*)g.A + (size_t)nxt.pm * tstep : cA; const char* nB = has_next ? (const char*)g.Bt + (size_t)nxt.pn * tstep : cB;
        for (int t = 0; t < nt; t += 2) {
            const bool last = (t == nt - 2);
            const char* a1 = cA + (size_t)(t + 1) * kstep;
            const char* a2 = last ? nA : cA + (size_t)(t + 2) * kstep; const char* b2 = last ? nB : cB + (size_t)(t + 2) * kstep;
            const char* a3 = a2 + kstep; const char* b3 = b2 + kstep;
            if (last && has_next) S.a_ready(nxt);
            const bool un = last && has_next;
            PG8_LDB(B0, 0, 0); PG8_SCHED; PG8_LDA(At, 0, 0); PG8_STAGE_A(PG8_SA(1, 1), a1, 1, false);
            PG8_WAIT_L(8); PG8_BAR; PG8_WAIT_L(0); PG8_MMA(0, 0, At, B0); PG8_BAR; PG8_SCHED;
            PG8_LDB(B1, 0, 1); PG8_STAGE(PG8_SB(0, 0), b2, voffB);
            PG8_BAR; PG8_WAIT_L(0); PG8_MMA(0, 1, At, B1); PG8_BAR;
            PG8_LDA(At, 0, 1); PG8_STAGE_A(PG8_SA(0, 0), a2, 0, un);
            PG8_BAR; PG8_WAIT_L(0); PG8_MMA(1, 0, At, B0); PG8_BAR; PG8_SCHED;
            PG8_STAGE(PG8_SB(0, 1), b2 + hstep, voffB);
            PG8_WAIT_V(6); PG8_BAR; PG8_MMA(1, 1, At, B1); PG8_BAR;
            PG8_LDB(B0, 1, 0); PG8_SCHED; PG8_LDA(At, 1, 0); PG8_STAGE_A(PG8_SA(0, 1), a2, 1, un);
            PG8_WAIT_L(8); PG8_BAR; PG8_WAIT_L(0); PG8_MMA(0, 0, At, B0); PG8_BAR; PG8_SCHED;
            PG8_LDB(B1, 1, 1); PG8_STAGE(PG8_SB(1, 0), b3, voffB);
            PG8_BAR; PG8_WAIT_L(0); PG8_MMA(0, 1, At, B1); PG8_BAR;
            PG8_LDA(At, 1, 1); PG8_STAGE_A(PG8_SA(1, 0), a3, 0, un);
            PG8_BAR; PG8_WAIT_L(0); PG8_MMA(1, 0, At, B0); PG8_BAR; PG8_SCHED;
            PG8_STAGE(PG8_SB(1, 1), b3 + hstep, voffB);
            PG8_WAIT_V(6); PG8_BAR; PG8_MMA(1, 1, At, B1); PG8_BAR;
        }
        PG8_STAMP();
        if constexpr (!Epi::AFTER_DRAIN) { E(acc, cur, wr, wc, fr, fq); S.done(cur); }
        PG8_STAMP();
        if (!has_next) break;
#pragma unroll
        for (int a = 0; a < 2; ++a)
#pragma unroll
            for (int b = 0; b < 2; ++b)
#pragma unroll
                for (int m = 0; m < 4; ++m)
#pragma unroll
                    for (int n = 0; n < 2; ++n) acc[a][b][m][n] = (f32x4){0.f, 0.f, 0.f, 0.f};
        cur = nxt; cA = nA; cB = nB; ++ui;
        if constexpr (Sched::GATHER) { _Pragma("unroll") for (int _h = 0; _h < 2; ++_h) _Pragma("unroll") for (int _i = 0; _i < 2; ++_i) gvc[_h][_i] = gvn[_h][_i]; }
    }
    PG8_WAIT_V(0);
    if (wr == 0) PG8_BAR;
    PG8_BAR;
    if constexpr (Epi::AFTER_DRAIN) { E.fused(acc, cur, wr, wc, fr, fq, lds, wid, lane); S.done(cur); }
    PG8_STAMP();
    if (STAMP && wid == 0) { stamps[lane] = lane < nts ? (((unsigned long long)(unsigned)ts_hi << 32) | (unsigned)ts_lo) : 0ull;
        if (lane == 62) stamps[62] = rt_entry; if (lane == 63) stamps[63] = (unsigned long long)wall_clock64(); }
#undef PG8_STAMP
#undef PG8_SA
#undef PG8_SB
#undef PG8_STAGE
#undef PG8_STAGE_A
#undef PG8_GOFF
#undef PG8_LDA
#undef PG8_LDB
#undef PG8_MMA
#undef PG8_WAIT_V
#undef PG8_WAIT_L
#undef PG8_BAR
#undef PG8_SCHED
}
}


namespace attn {
using bf16 = unsigned short;
constexpr int   D = 128, NW = 8, QBLK = 32, KVBLK = 64;
constexpr float SCALE = 0.088388347648318440f;
constexpr float THR = 8.f;
constexpr int SDEPTH = 1;
constexpr int LDQ = 5120, LDK = 5120, LDO = 2048;
constexpr size_t SHM_V = KVBLK * D * 2, SHM_K = KVBLK * D * 2, SHM_ATTN = 2 * SHM_V + 2 * SHM_K + NW * 64 * 4;
using bf16x8 = __attribute__((ext_vector_type(8))) short;
using s16x4  = __attribute__((ext_vector_type(4))) short;
using f32x16 = __attribute__((ext_vector_type(16))) float;
using f32x8  = __attribute__((ext_vector_type(8))) float;
using u32x4  = __attribute__((ext_vector_type(4))) unsigned;
#define KSWZ(row, colB) ((row) * 256 + ((colB) ^ (((row) & 7) << 4)))
#define SBAR() __builtin_amdgcn_sched_barrier(0)
__device__ __forceinline__ int crow(int r, int hi) { return (r & 3) + 8 * (r >> 2) + 4 * hi; }
__device__ __forceinline__ unsigned cvtpk(float lo, float hi) { return cvt_pk_rne(lo, hi); }
template <typename TIn> struct Stage;
template <> struct Stage<bf16>  { using T = bf16x8;
  __device__ static __forceinline__ T ld8(const bf16* p) { return *reinterpret_cast<const bf16x8*>(p); }
  __device__ static __forceinline__ bf16x8 tobf(T x) { return x; } };
template <> struct Stage<float> { using T = f32x8;
  __device__ static __forceinline__ T ld8(const float* p) { return *reinterpret_cast<const f32x8*>(p); }
  __device__ static __forceinline__ bf16x8 tobf(T x) {
    u32x4 w = {cvtpk(x[0], x[1]), cvtpk(x[2], x[3]), cvtpk(x[4], x[5]), cvtpk(x[6], x[7])}; return *reinterpret_cast<bf16x8*>(&w); } };

__device__ __forceinline__ void partialSM(f32x16& p0, f32x16& p1, float& m_reg, float& mn, float& alpha) {
  constexpr float C = SCALE * 1.4426950408889634f;
  float pmax = p0[0]; for (int r = 1; r < 16; ++r) pmax = fmaxf(pmax, p0[r]); for (int r = 0; r < 16; ++r) pmax = fmaxf(pmax, p1[r]);
  { auto rr = __builtin_amdgcn_permlane32_swap(__float_as_uint(pmax), __float_as_uint(pmax), false, false);
    pmax = fmaxf(__uint_as_float(rr[0]), __uint_as_float(rr[1])); }
  if (__builtin_expect(__all(pmax - m_reg <= THR / SCALE), 1)) { mn = m_reg; alpha = 1.f; }
  else { mn = fmaxf(m_reg, pmax); alpha = __builtin_amdgcn_exp2f((m_reg - mn) * C); m_reg = mn; }
  float mnC = -mn * C;
  for (int r = 0; r < 16; ++r) p0[r] = fmaf(p0[r], C, mnC); for (int r = 0; r < 16; ++r) p1[r] = fmaf(p1[r], C, mnC);
  for (int r = 0; r < 16; ++r) p0[r] = __builtin_amdgcn_exp2f(p0[r]);
}
__device__ __forceinline__ void finishSM(f32x16& p0, f32x16& p1, float alpha, float& l_reg, bf16x8& pa0, bf16x8& pa1, bf16x8& pa2, bf16x8& pa3) {
  for (int r = 0; r < 16; ++r) p1[r] = __builtin_amdgcn_exp2f(p1[r]);
  float ps = 0; for (int r = 0; r < 16; ++r) ps += p0[r]; for (int r = 0; r < 16; ++r) ps += p1[r];
  { auto rr = __builtin_amdgcn_permlane32_swap(__float_as_uint(ps), __float_as_uint(ps), false, false);
    ps = __uint_as_float(rr[0]) + __uint_as_float(rr[1]); }
  l_reg = l_reg * alpha + ps;
#define PK4(P, BASE, OUT) do { unsigned a0 = cvtpk(P[BASE + 0], P[BASE + 1]), a1 = cvtpk(P[BASE + 2], P[BASE + 3]);   \
    unsigned b0 = cvtpk(P[BASE + 4], P[BASE + 5]), b1 = cvtpk(P[BASE + 6], P[BASE + 7]);                              \
    auto r0 = __builtin_amdgcn_permlane32_swap(a0, b0, false, false); auto r1 = __builtin_amdgcn_permlane32_swap(a1, b1, false, false); \
    u32x4 w = {r0[0], r1[0], r0[1], r1[1]}; OUT = *reinterpret_cast<bf16x8*>(&w); } while (0)
  PK4(p0, 0, pa0); PK4(p0, 8, pa1); PK4(p1, 0, pa2); PK4(p1, 8, pa3);
#undef PK4
}
__device__ __forceinline__ void qkt(f32x16& p0, f32x16& p1, const bf16* Ks, const bf16x8* qr, int r32, int hi) {
  p0 = f32x16{}; p1 = f32x16{};
  for (int d0 = 0; d0 < 8; ++d0) { int cb = (d0 * 16 + hi * 8) * 2;
    bf16x8 b0 = *reinterpret_cast<const bf16x8*>((const char*)Ks + KSWZ(r32, cb));
    bf16x8 b1 = *reinterpret_cast<const bf16x8*>((const char*)Ks + KSWZ(32 + r32, cb));
    p0 = __builtin_amdgcn_mfma_f32_32x32x16_bf16(b0, qr[d0], p0, 0, 0, 0);
    p1 = __builtin_amdgcn_mfma_f32_32x32x16_bf16(b1, qr[d0], p1, 0, 0, 0); }
}
__device__ __forceinline__ int v_st(int k, int c) { const int kk = (k & ~0xC) | ((k & 4) << 1) | ((k & 8) >> 1); return ((kk >> 3) * 4 + (c >> 5)) * 512 + ((kk & 7) * 32 + (c & 31)) * 2; }
__device__ __forceinline__ int v_rd_base(int lane) { return ((lane & 3) << 3) | (((lane >> 2) & 3) << 6) | (((lane >> 4) & 1) << 5) | (((lane >> 5) & 1) << 8); }
constexpr int v_rd_off(int d0, int ks, int half) { return d0 * 512 + ks * 4096 + half * 2048; }
template <int OFF> __device__ __forceinline__ s16x4 tr_read(int vb) {
  s16x4 r; asm volatile("ds_read_b64_tr_b16 %0, %1 offset:%2" : "=&v"(r) : "v"(vb), "i"(OFF) : "memory"); return r;
}
template <int D0> __device__ __forceinline__ void pv_one(f32x16& od, int vb, bf16x8 pa0, bf16x8 pa1, bf16x8 pa2, bf16x8 pa3) {
  const s16x4 l0 = tr_read<v_rd_off(D0, 0, 0)>(vb), h0 = tr_read<v_rd_off(D0, 0, 1)>(vb), l1 = tr_read<v_rd_off(D0, 1, 0)>(vb), h1 = tr_read<v_rd_off(D0, 1, 1)>(vb);
  const s16x4 l2 = tr_read<v_rd_off(D0, 2, 0)>(vb), h2 = tr_read<v_rd_off(D0, 2, 1)>(vb), l3 = tr_read<v_rd_off(D0, 3, 0)>(vb), h3 = tr_read<v_rd_off(D0, 3, 1)>(vb);
  asm volatile("s_waitcnt lgkmcnt(0)" ::: "memory"); SBAR();
#define PK(L, H) (bf16x8){L[0], L[1], L[2], L[3], H[0], H[1], H[2], H[3]}
  od = __builtin_amdgcn_mfma_f32_32x32x16_bf16(pa0, PK(l0, h0), od, 0, 0, 0);
  od = __builtin_amdgcn_mfma_f32_32x32x16_bf16(pa1, PK(l1, h1), od, 0, 0, 0);
  od = __builtin_amdgcn_mfma_f32_32x32x16_bf16(pa2, PK(l2, h2), od, 0, 0, 0);
  od = __builtin_amdgcn_mfma_f32_32x32x16_bf16(pa3, PK(l3, h3), od, 0, 0, 0);
#undef PK
}
__device__ __forceinline__ void pv_d0(f32x16* o, int vb, bf16x8 pa0, bf16x8 pa1, bf16x8 pa2, bf16x8 pa3) {
  pv_one<0>(o[0], vb, pa0, pa1, pa2, pa3); pv_one<1>(o[1], vb, pa0, pa1, pa2, pa3); pv_one<2>(o[2], vb, pa0, pa1, pa2, pa3); pv_one<3>(o[3], vb, pa0, pa1, pa2, pa3);
}

template <typename TQ>
__device__ __forceinline__ void attn_dense_body(const TQ* __restrict__ Qb, const bf16* __restrict__ Kh, const bf16* __restrict__ Vh,
                                                float* __restrict__ Ob, int seq, char* lds, const int wave0) {
  using St = Stage<bf16>; using SQ = Stage<TQ>;
  int tid_ = wave0 * 64 + lane_id(); asm volatile("" : "+v"(tid_));
  const int tid = tid_, wid = tid >> 6, lane = tid & 63, r32 = lane & 31, hi = lane >> 5;
  bf16* V_lds = (bf16*)lds; bf16* K_lds = (bf16*)(lds + 2 * SHM_V);
  float* ws = (float*)(lds + 2 * SHM_V + 2 * SHM_K) + wid * 64; float* li_l = ws; float* al_l = ws + 32;
  float m_reg = -1e30f, l_reg = 0; f32x16 o[4] = {}; bf16x8 qr[8];
  const TQ* Qw = Qb + (long)(wid * QBLK + r32) * LDQ + hi * 8;
#pragma unroll
  for (int d0 = 0; d0 < 8; ++d0) qr[d0] = SQ::tobf(SQ::ld8(Qw + d0 * 16));
  const int sr = tid >> 4, sc = (tid & 15) * 8, vst0 = v_st(sr, sc), vst1 = v_st(32 + sr, sc);
  const int vb0 = (int)(uintptr_t)V_lds + v_rd_base(lane);
  struct { typename St::T vs0, vs1, ks0, ks1; } sr_[SDEPTH];
#define SLOAD(i, k0) do { sr_[i].vs0 = St::ld8(&Vh[(long)((k0) + sr) * LDK + sc]); sr_[i].vs1 = St::ld8(&Vh[(long)((k0) + 32 + sr) * LDK + sc]); \
    sr_[i].ks0 = St::ld8(&Kh[(long)((k0) + sr) * LDK + sc]); sr_[i].ks1 = St::ld8(&Kh[(long)((k0) + 32 + sr) * LDK + sc]); } while (0)
#define SWRITE(b, i) do { *(bf16x8*)((char*)V_lds + (b) * SHM_V + vst0) = St::tobf(sr_[i].vs0);          \
    *(bf16x8*)((char*)V_lds + (b) * SHM_V + vst1) = St::tobf(sr_[i].vs1); int kc = sc * 2;               \
    *(bf16x8*)((char*)K_lds + (b) * SHM_K + KSWZ(sr, kc)) = St::tobf(sr_[i].ks0);                       \
    *(bf16x8*)((char*)K_lds + (b) * SHM_K + KSWZ(32 + sr, kc)) = St::tobf(sr_[i].ks1); } while (0)
#define SWAIT() do { if constexpr (SDEPTH == 2) asm volatile("s_waitcnt vmcnt(4)" ::: "memory"); else asm volatile("s_waitcnt vmcnt(0)" ::: "memory"); } while (0)
#define RESC(a) do { if (__any((a) < 1.f)) { if (hi == 0) al_l[r32] = (a); asm volatile("s_waitcnt lgkmcnt(0)" ::: "memory"); \
    for (int d = 0; d < 4; ++d) for (int r = 0; r < 16; ++r) o[d][r] *= al_l[crow(r, hi)]; } } while (0)
  f32x16 pA0, pA1, pB0, pB1; float mnA, mnB, alA, alB; bf16x8 pa0, pa1, pa2, pa3; const int NT = seq / KVBLK;
  constexpr int SE = 0, SO = SDEPTH - 1;
  SLOAD(SE, 0); asm volatile("s_waitcnt vmcnt(0)" ::: "memory"); SWRITE(0, SE); __syncthreads();
  qkt(pA0, pA1, K_lds, qr, r32, hi); partialSM(pA0, pA1, m_reg, mnA, alA);
  SLOAD(SO, KVBLK); if constexpr (SDEPTH == 2) { if (2 < NT) SLOAD(SE, 2 * KVBLK); }
  SWAIT(); SWRITE(1, SO); __syncthreads();
  for (int j = 1; j + 1 < NT; j += 2) {
    SBAR(); qkt(pB0, pB1, (bf16*)((char*)K_lds + SHM_K), qr, r32, hi);
    finishSM(pA0, pA1, alA, l_reg, pa0, pa1, pa2, pa3); SBAR();
    SLOAD(SO, (j + SDEPTH) * KVBLK); SBAR();
    pv_d0(o, vb0, pa0, pa1, pa2, pa3); partialSM(pB0, pB1, m_reg, mnB, alB);
    __syncthreads(); SWAIT(); SWRITE(0, SE);
    RESC(alB); __syncthreads();
    SBAR(); qkt(pA0, pA1, K_lds, qr, r32, hi);
    finishSM(pB0, pB1, alB, l_reg, pa0, pa1, pa2, pa3); SBAR();
    if (SDEPTH == 1 || j + 3 < NT) SLOAD(SE, (j + 1 + SDEPTH) * KVBLK); SBAR();
    pv_d0(o, vb0 + (int)SHM_V, pa0, pa1, pa2, pa3); partialSM(pA0, pA1, m_reg, mnA, alA);
    __syncthreads(); SWAIT(); SWRITE(1, SO);
    RESC(alA); __syncthreads();
  }
  SBAR(); qkt(pB0, pB1, (bf16*)((char*)K_lds + SHM_K), qr, r32, hi);
  finishSM(pA0, pA1, alA, l_reg, pa0, pa1, pa2, pa3); SBAR();
  pv_d0(o, vb0, pa0, pa1, pa2, pa3); partialSM(pB0, pB1, m_reg, mnB, alB);
  __syncthreads(); RESC(alB);
  finishSM(pB0, pB1, alB, l_reg, pa0, pa1, pa2, pa3); SBAR();
  pv_d0(o, vb0 + (int)SHM_V, pa0, pa1, pa2, pa3);
  if (hi == 0) li_l[r32] = l_reg; asm volatile("s_waitcnt lgkmcnt(0)" ::: "memory");
  float rli[16];
#pragma unroll
  for (int r = 0; r < 16; ++r) rli[r] = __builtin_amdgcn_rcpf(li_l[crow(r, hi)]);
  float* Ow = Ob + (long)(wid * QBLK) * LDO;
#pragma unroll
  for (int r = 0; r < 16; ++r) { int orow = crow(r, hi);
    for (int d0 = 0; d0 < 4; ++d0) Ow[(long)orow * LDO + d0 * 32 + r32] = o[d0][r] * rli[r]; }
#undef SLOAD
#undef SWRITE
#undef SWAIT
#undef RESC
}

}

template <class Epi>
__device__ __forceinline__ void naive_gemm(Frame& F, const bf16* __restrict__ A, int lda, const bf16* __restrict__ Bt, int ldb, int M, int N, int K, const Epi& epi) {
    LAS float* As = (LAS float*)F.lds;
    LAS float* Bs = As + 32 * 132;
    const int tid = F.tid, tm = tid >> 4, tn = tid & 15;
    const int ntm = M / 128, ntn = N / 64;
    for (int tile = F.vcu; tile < ntm * ntn; tile += F.G) {
        const int pm = tile / ntn, pn = tile % ntn;
        float acc[4][4];
#pragma unroll
        for (int i = 0; i < 4; ++i)
#pragma unroll
            for (int j = 0; j < 4; ++j) acc[i][j] = 0.f;
        for (int k0 = 0; k0 < K; k0 += 32) {
            { const int r = tid >> 2, ks = (tid & 3) * 8; const bf16x8 v = *(const bf16x8*)(A + (size_t)(pm * 128 + r) * lda + k0 + ks);
#pragma unroll
              for (int j = 0; j < 8; ++j) As[(ks + j) * 132 + r] = bf2f((bf16)v[j]); }
            if (tid < 256) { const int r = tid >> 2, ks = (tid & 3) * 8; const bf16x8 v = *(const bf16x8*)(Bt + (size_t)(pn * 64 + r) * ldb + k0 + ks);
#pragma unroll
              for (int j = 0; j < 8; ++j) Bs[(ks + j) * 68 + r] = bf2f((bf16)v[j]); }
            __syncthreads();
#pragma unroll 8
            for (int kk = 0; kk < 32; ++kk) { const f32x4 a = *(const LAS f32x4*)(As + kk * 132 + tm * 4); const f32x4 b = *(const LAS f32x4*)(Bs + kk * 68 + tn * 4);
#pragma unroll
                for (int i = 0; i < 4; ++i)
#pragma unroll
                    for (int j = 0; j < 4; ++j) acc[i][j] = fmaf(a[i], b[j], acc[i][j]); }
            __syncthreads();
        }
#pragma unroll
        for (int i = 0; i < 4; ++i)
#pragma unroll
            for (int j = 0; j < 4; ++j) epi(pm * 128 + tm * 4 + i, pn * 64 + tn * 4 + j, acc[i][j]);
    }
}

__device__ __forceinline__ void phase_post(Frame& F, int l) {
    bf16* PROJ = WSP(bf16, WS_PROJ);
    const float2* TA = WSP(float2, WS_TABA); const float2* TB = WSP(float2, WS_TABB);
    const float* qn = GIN(5) + l * HD; const float* kn = GIN(6) + l * HD;
    const int gw = F.vcu * NWAVES + F.wave, NGW = F.G * NWAVES, lane = F.lane;
    const int sgA = lane >> 3, iA = (lane & 7) * 2, baseA = (sgA < 4 ? COL_AQ + sgA * HD : COL_AK + (sgA - 4) * HD) + iA;
    const int hsel = lane >> 5, q = lane & 31, hf = q >> 4, i2 = (q & 15) * 2, eo = hf * 64 + i2;
    const float gq0 = qn[eo], gq1 = qn[eo + 1], gq2 = qn[eo + 32], gq3 = qn[eo + 33], gk0 = kn[eo], gk1 = kn[eo + 1], gk2 = kn[eo + 32], gk3 = kn[eo + 33];
    for (int t = gw; t < T; t += NGW) {
        const int s = t & (SEQ - 1);
        bf16* row = PROJ + (size_t)t * DINP;
        const unsigned a1 = *(const unsigned*)(row + baseA), a2 = *(const unsigned*)(row + baseA + 16);
        const f32x4 csa = *(const f32x4*)(TA + s * 16 + iA);
        const int pos = hf == 0 ? (s >> 6) : (s & 63); const f32x4 csb = *(const f32x4*)(TB + pos * 32 + i2);
        unsigned b1[5], b2[5];
#pragma unroll
        for (int p = 0; p < 5; ++p) { const int hh = 2 * p + hsel, base = (p < 4 ? COL_BQ + hh * HD : COL_BK + (hh - 8) * HD) + eo; b1[p] = *(const unsigned*)(row + base); b2[p] = *(const unsigned*)(row + base + 32); }
        { const float x1l = __uint_as_float(a1 << 16), x1h = __uint_as_float(a1 & 0xffff0000u), x2l = __uint_as_float(a2 << 16), x2h = __uint_as_float(a2 & 0xffff0000u);
          *(unsigned*)(row + baseA) = pk2(x1l * csa.x - x2l * csa.y, x1h * csa.z - x2h * csa.w); *(unsigned*)(row + baseA + 16) = pk2(x2l * csa.x + x1l * csa.y, x2h * csa.z + x1h * csa.w); }
#pragma unroll
        for (int p = 0; p < 5; ++p) { const int hh = 2 * p + hsel, base = (p < 4 ? COL_BQ + hh * HD : COL_BK + (hh - 8) * HD) + eo;
            float x1l = __uint_as_float(b1[p] << 16), x1h = __uint_as_float(b1[p] & 0xffff0000u), x2l = __uint_as_float(b2[p] << 16), x2h = __uint_as_float(b2[p] & 0xffff0000u);
            float ss = (x1l * x1l + x1h * x1h) + (x2l * x2l + x2h * x2h);
            ss += __shfl_xor(ss, 1); ss += __shfl_xor(ss, 2); ss += __shfl_xor(ss, 4); ss += __shfl_xor(ss, 8); ss += __shfl_xor(ss, 16);
            const float rs = rsqrtf(ss * (1.0f / HD) + EPS);
            x1l = x1l * rs * (p < 4 ? gq0 : gk0); x1h = x1h * rs * (p < 4 ? gq1 : gk1); x2l = x2l * rs * (p < 4 ? gq2 : gk2); x2h = x2h * rs * (p < 4 ? gq3 : gk3);
            *(unsigned*)(row + base) = pk2(x1l * csb.x - x2l * csb.y, x1h * csb.z - x2h * csb.w); *(unsigned*)(row + base + 32) = pk2(x2l * csb.x + x1l * csb.y, x2h * csb.z + x1h * csb.w); }
    }
}
__device__ __forceinline__ void phase_dn_prep_naive(Frame& F, int l) {
    const bf16* PROJ = WSP(bf16, WS_PROJ); const float* TL = WSP(float, WS_TL);
    float* DQ = WSP(float, WS_DQ); float* DK = WSP(float, WS_DK); float* DV = WSP(float, WS_DV); float* DB = WSP(float, WS_DB); float* DG = WSP(float, WS_DG);
    const float* cw = GIN(4) + (size_t)l * 5 * 1536;
    const int gw = F.vcu * NWAVES + F.wave, NGW = F.G * NWAVES, lane = F.lane;
    for (int t = gw; t < T; t += NGW) {
        const int s = t & (SEQ - 1);
#pragma unroll 1
        for (int g = 0; g < 12; ++g) {
            float val[2];
#pragma unroll
            for (int u = 0; u < 2; ++u) { const int c = 128 * g + 64 * u + lane; float a = 0.f;
#pragma unroll
                for (int j = 0; j < 5; ++j) { const int sp = s - 2 + j; if (sp >= 0 && sp < SEQ) a += bf2f(PROJ[(size_t)(t - 2 + j) * DINP + COL_CQKV + c]) * cw[j * 1536 + c]; }
                val[u] = siluf_(a); }
            float* dst = g < 4 ? DQ : (g < 8 ? DK : DV);
            if (g < 8) { const float ss = wave_sum(val[0] * val[0] + val[1] * val[1]); const float rs = rsqrtf(ss + EPS) * (g < 4 ? 0.08838834764831845f : 1.0f); val[0] *= rs; val[1] *= rs; }
            dst[(size_t)t * 512 + (g & 3) * 128 + lane] = val[0]; dst[(size_t)t * 512 + (g & 3) * 128 + 64 + lane] = val[1];
        }
        if (lane < 8) { const int dir = lane >> 2, hh = lane & 3; const float bl = TL[(size_t)t * 16 + dir * 4 + hh], al = TL[(size_t)t * 16 + 8 + dir * 4 + hh];
            const float A = expf(GIN(9)[(l * 2 + dir) * 4 + hh]); const float dtb = GIN(10)[(l * 2 + dir) * 4 + hh];
            DB[((size_t)dir * T + t) * 4 + hh] = sigmoidf_(bl); DG[((size_t)dir * T + t) * 4 + hh] = -A * softplusf_(al + dtb); }
    }
}


namespace dn {
typedef float f32x4 __attribute__((ext_vector_type(4)));
typedef short bf16x8 __attribute__((ext_vector_type(8)));
typedef short bf16x4 __attribute__((ext_vector_type(4)));
constexpr int KB_OFF = 0, QB_OFF = 17408, VB_OFF = 34816;
constexpr int KDT_OFF = 52224, UT_OFF = 70656, WT_OFF = 89088;
constexpr int AM_OFF = 107520;
constexpr int QKM_OFF = 123904;
constexpr int GC_OFF = 133120;
__device__ __forceinline__ unsigned cvtpk(float lo, float hi) { return cvt_pk_rne(lo, hi); }
__device__ __forceinline__ f32x4 mfma16(bf16x8 a, bf16x8 b, f32x4 c) { return __builtin_amdgcn_mfma_f32_16x16x32_bf16(a, b, c, 0, 0, 0); }
__device__ __forceinline__ void mfma_settle() { asm volatile("s_nop 15\n\ts_nop 7" ::: "memory"); }
}

__device__ __forceinline__ void phase_dn_chunk(Frame& F, int l) {
    using namespace dn;
#define WSQ(type, off) ((type*)(wsq + (off)))
    LAS unsigned char* L = F.lds;
    LAS float* GC = (LAS float*)(L + GC_OFF);
    const int wave = F.wave;
    for (int u = F.vcu; u < 1024; u += F.G) {
        int tid_ = wave * 64 + lane_id(); asm volatile("" : "+v"(tid_));
        const int tid = tid_, lane = tid & 63, g4 = lane >> 4, l15 = lane & 15;
        const int dir = u >> 9, b = (u >> 8) & 1, hh = (u >> 6) & 3, c = u & 63;
        const int chain = dir * 8 + b * 4 + hh, cs = dir ? 63 - c : c;
        const size_t ub = (size_t)chain * 64 + cs;
        GAS unsigned char* wsq_ = (GAS unsigned char*)F.ws; asm volatile("" : "+s"(wsq_)); unsigned char* wsq = (unsigned char*)wsq_;
        __syncthreads();
        if (wave == 0) {
            const int pos = dir ? 63 - lane : lane; const size_t t = (size_t)b * SEQ + c * 64 + pos;
            const float* TL = WSQ(float, WS_TL); const float bl = TL[t * 16 + dir * 4 + hh], al = TL[t * 16 + 8 + dir * 4 + hh];
            const float Acoef = expf(GIN(9)[(l * 2 + dir) * 4 + hh]), dtb = GIN(10)[(l * 2 + dir) * 4 + hh];
            float gc = -Acoef * softplusf_(al + dtb);
#pragma unroll
            for (int o = 1; o < 64; o <<= 1) { const float tv = bperm(gc, lane >= o ? lane - o : lane); if (lane >= o) gc += tv; }
            const float glast = bperm(gc, 63);
            const float beta = sigmoidf_(bl), egc = expf(gc); GC[lane] = gc; GC[64 + lane] = beta; GC[128 + lane] = egc; GC[192 + lane] = expf(glast - gc); if (lane == 0) GC[256] = expf(glast); GC[320 + lane] = beta * egc;
        }
        __syncthreads();
#ifndef DBG_NOCONV
        if (tid < 384) {
            const int rg = tid / 48, o = tid % 48, part = o >> 4, oo = o & 15;
            const int chl = part * 512 + hh * 128 + oo * 8;
            const float* cw = GIN(4) + (size_t)l * 5 * 1536;
            const bf16* src = WSQ(bf16, WS_PROJ) + (size_t)(b * SEQ) * DINP + COL_CQKV + chl;
            float w[5][8];
#pragma unroll
            for (int j = 0; j < 5; ++j) { const f32x4 w0 = *(const f32x4*)(cw + j * 1536 + chl), w1 = *(const f32x4*)(cw + j * 1536 + chl + 4);
                w[j][0] = w0.x; w[j][1] = w0.y; w[j][2] = w0.z; w[j][3] = w0.w; w[j][4] = w1.x; w[j][5] = w1.y; w[j][6] = w1.z; w[j][7] = w1.w; }
            bf16x8 xin[12];
#pragma unroll
            for (int dr = 0; dr < 12; ++dr) { const int sq = c * 64 + rg * 8 - 2 + dr; xin[dr] = (bf16x8){0, 0, 0, 0, 0, 0, 0, 0}; if (sq >= 0 && sq < SEQ) xin[dr] = *(const bf16x8*)(src + (size_t)sq * DINP); }
#pragma unroll
            for (int hp = 0; hp < 2; ++hp) {
                float acc[4][8];
#pragma unroll
                for (int r = 0; r < 4; ++r)
#pragma unroll
                    for (int e = 0; e < 8; ++e) acc[r][e] = 0.f;
#pragma unroll
                for (int dr = 0; dr < 8; ++dr) { float xf[8];
#pragma unroll
                        for (int e = 0; e < 8; ++e) xf[e] = bf2f((bf16)xin[4 * hp + dr][e]);
#pragma unroll
                        for (int r = 0; r < 4; ++r) { const int j = dr - r; if (j >= 0 && j < 5) {
#pragma unroll
                            for (int e = 0; e < 8; ++e) acc[r][e] = fmaf(xf[e], w[j][e], acc[r][e]); } } }
#pragma unroll
                for (int r = 0; r < 4; ++r) {
#pragma unroll
                    for (int e = 0; e < 8; ++e) acc[r][e] = siluf_(acc[r][e]);
                    if (part < 2) { float ss = 0.f;
#pragma unroll
                        for (int e = 0; e < 8; ++e) ss = fmaf(acc[r][e], acc[r][e], ss);
                        ss += bperm(ss, lane ^ 1); ss += bperm(ss, lane ^ 2); ss += bperm(ss, lane ^ 4); ss += bperm(ss, lane ^ 8);
                        const float rs = rsqrtf(ss + EPS) * (part == 0 ? 0.08838834764831845f : 1.0f);
#pragma unroll
                        for (int e = 0; e < 8; ++e) acc[r][e] *= rs; }
                    const int i = dir ? 63 - (rg * 8 + hp * 4 + r) : rg * 8 + hp * 4 + r;
                    u32x4 pk; pk.x = cvtpk(acc[r][0], acc[r][1]); pk.y = cvtpk(acc[r][2], acc[r][3]); pk.z = cvtpk(acc[r][4], acc[r][5]); pk.w = cvtpk(acc[r][6], acc[r][7]);
                    *(LAS u32x4*)(L + (part == 0 ? QB_OFF : (part == 1 ? KB_OFF : VB_OFF)) + i * 272 + oo * 16) = pk;
                }
                if (part == 1) {
                    const int ib = dir ? 60 - rg * 8 - hp * 4 : rg * 8 + hp * 4;
                    float kd[4];
#pragma unroll
                    for (int m = 0; m < 4; ++m) kd[m] = GC[192 + ib + m];
#pragma unroll
                    for (int e = 0; e < 8; ++e) { float v4[4];
#pragma unroll
                        for (int m = 0; m < 4; ++m) v4[m] = (dir ? acc[3 - m][e] : acc[m][e]) * kd[m];
                        u32x2 pk; pk.x = cvtpk(v4[0], v4[1]); pk.y = cvtpk(v4[2], v4[3]);
                        *(LAS u32x2*)(L + KDT_OFF + (oo * 8 + e) * 144 + ib * 2) = pk; }
                }
            }
        }
        __syncthreads();
#endif
        { const int sel = wave >> 2, rt = wave & 3;
          f32x4 acc[4];
#pragma unroll
          for (int ct = 0; ct < 4; ++ct) acc[ct] = (f32x4){0.f, 0.f, 0.f, 0.f};
          const LAS unsigned char* ab2 = L + (sel ? QB_OFF : KB_OFF) + (16 * rt + l15) * 272 + g4 * 16; const LAS unsigned char* bb2 = L + KB_OFF + l15 * 272 + g4 * 16;
#pragma unroll
          for (int kb = 0; kb < 4; ++kb) { const bf16x8 a = *(const LAS bf16x8*)(ab2 + kb * 64);
#pragma unroll
              for (int ct = 0; ct < 4; ++ct) { const bf16x8 bb = *(const LAS bf16x8*)(bb2 + ct * 4352 + kb * 64); acc[ct] = mfma16(a, bb, acc[ct]); } }
#pragma unroll
          for (int ct = 0; ct < 4; ++ct)
#pragma unroll
              for (int r = 0; r < 4; ++r) { const int i = 16 * rt + 4 * g4 + r, j = 16 * ct + l15; const float dec = j <= i ? expf(GC[i] - GC[j]) : 0.f; const float val = acc[ct][r] * dec;
                  if (sel == 0) ((LAS float*)(L + AM_OFF))[i * 64 + j] = j < i ? GC[64 + i] * val : 0.f;
                  else ((LAS bf16*)(L + QKM_OFF))[i * 72 + j] = (bf16)f2bf(val); } }
        __syncthreads();
#ifndef DBG_NOSOLVE
        if (tid < 256) {
            const LAS bf16* srcc = (const LAS bf16*)(L + (tid < 128 ? VB_OFF : KB_OFF)) + (tid & 127); const LAS float* scv = GC + (tid < 128 ? 64 : 320);
            LAS unsigned char* xrow = L + (tid < 128 ? UT_OFF + tid * 144 : WT_OFF + (tid - 128) * 144);
            int zoff; asm volatile("v_mov_b32 %0, 0" : "=v"(zoff));
            const LAS float* AM = (const LAS float*)(L + AM_OFF) + zoff;
#pragma unroll
            for (int r = 0; r < 4; ++r) {
                float acc[16];
#pragma unroll
                for (int ii = 0; ii < 16; ++ii) acc[ii] = scv[16 * r + ii] * bf2f(srcc[(16 * r + ii) * 136]);
#pragma unroll 1
                for (int sb = 0; sb < r; ++sb) {
                    const u32x4 x0 = *(const LAS u32x4*)(xrow + sb * 32), x1 = *(const LAS u32x4*)(xrow + sb * 32 + 16); float xs[16];
                    xs[0] = __uint_as_float(x0.x << 16); xs[1] = __uint_as_float(x0.x & 0xffff0000u); xs[2] = __uint_as_float(x0.y << 16); xs[3] = __uint_as_float(x0.y & 0xffff0000u);
                    xs[4] = __uint_as_float(x0.z << 16); xs[5] = __uint_as_float(x0.z & 0xffff0000u); xs[6] = __uint_as_float(x0.w << 16); xs[7] = __uint_as_float(x0.w & 0xffff0000u);
                    xs[8] = __uint_as_float(x1.x << 16); xs[9] = __uint_as_float(x1.x & 0xffff0000u); xs[10] = __uint_as_float(x1.y << 16); xs[11] = __uint_as_float(x1.y & 0xffff0000u);
                    xs[12] = __uint_as_float(x1.z << 16); xs[13] = __uint_as_float(x1.z & 0xffff0000u); xs[14] = __uint_as_float(x1.w << 16); xs[15] = __uint_as_float(x1.w & 0xffff0000u);
#pragma unroll
                    for (int ii = 0; ii < 16; ++ii) { const LAS float* ar = AM + (16 * r + ii) * 64 + 16 * sb; float s0 = 0.f, s1 = 0.f; if ((ii & 3) == 0) asm volatile("" ::: "memory");
#pragma unroll
                        for (int q = 0; q < 4; ++q) { const f32x4 a = *(const LAS f32x4*)(ar + 4 * q); s0 = fmaf(a.x, xs[4 * q], s0); s1 = fmaf(a.y, xs[4 * q + 1], s1); s0 = fmaf(a.z, xs[4 * q + 2], s0); s1 = fmaf(a.w, xs[4 * q + 3], s1); }
                        acc[ii] -= s0 + s1; }
                }
#pragma unroll
                for (int ii = 1; ii < 16; ++ii) { const LAS float* ar = AM + (16 * r + ii) * 64 + 16 * r; float s0 = 0.f, s1 = 0.f;
#pragma unroll
                    for (int q = 0; q < (ii + 3) / 4; ++q) { const f32x4 a = *(const LAS f32x4*)(ar + 4 * q); s0 = fmaf(a.x, acc[4 * q], s0); s1 = fmaf(a.y, acc[4 * q + 1], s1); s0 = fmaf(a.z, acc[4 * q + 2], s0); s1 = fmaf(a.w, acc[4 * q + 3], s1); }
                    acc[ii] -= s0 + s1; }
                u32x4 pk; pk.x = cvtpk(acc[0], acc[1]); pk.y = cvtpk(acc[2], acc[3]); pk.z = cvtpk(acc[4], acc[5]); pk.w = cvtpk(acc[6], acc[7]); *(LAS u32x4*)(xrow + r * 32) = pk;
                pk.x = cvtpk(acc[8], acc[9]); pk.y = cvtpk(acc[10], acc[11]); pk.z = cvtpk(acc[12], acc[13]); pk.w = cvtpk(acc[14], acc[15]); *(LAS u32x4*)(xrow + r * 32 + 16) = pk;
            }
        }
        __syncthreads();
#endif
        { const int sel = wave >> 2, it = wave & 3;
          f32x4 acc[8];
#pragma unroll
          for (int dt = 0; dt < 8; ++dt) acc[dt] = (f32x4){0.f, 0.f, 0.f, 0.f};
          const LAS unsigned char* bb4 = L + QKM_OFF + (16 * it + l15) * 144 + g4 * 16; const LAS unsigned char* ab4 = L + (sel ? UT_OFF : WT_OFF) + l15 * 144 + g4 * 16;
#pragma unroll
          for (int kb = 0; kb < 2; ++kb) { const bf16x8 bb = *(const LAS bf16x8*)(bb4 + kb * 64);
#pragma unroll
              for (int dt = 0; dt < 8; ++dt) { const bf16x8 a = *(const LAS bf16x8*)(ab4 + dt * 2304 + kb * 64); acc[dt] = mfma16(a, bb, acc[dt]); } }
          mfma_settle();
          const int i = 16 * it + l15, trow = dir ? 63 - i : i;
          if (sel == 0) { bf16* CP = WSQ(bf16, WS_CP) + (ub * 64 + trow) * 128; const float eg = GC[128 + i];
#pragma unroll
              for (int dt = 0; dt < 8; ++dt) { const int d = 16 * dt + 4 * g4; const u32x2 qw = *(const LAS u32x2*)(L + QB_OFF + i * 272 + d * 2);
                  const float q0 = __uint_as_float(qw.x << 16), q1 = __uint_as_float(qw.x & 0xffff0000u), q2 = __uint_as_float(qw.y << 16), q3 = __uint_as_float(qw.y & 0xffff0000u);
                  u32x2 o; o.x = cvtpk(q0 * eg - acc[dt][0], q1 * eg - acc[dt][1]); o.y = cvtpk(q2 * eg - acc[dt][2], q3 * eg - acc[dt][3]); *(u32x2*)(CP + 32 * (dt >> 1) + 8 * g4 + 4 * (dt & 1)) = o; } }
          else { float* CR = WSQ(float, WS_CR) + (ub * 64 + trow) * 128;
#pragma unroll
              for (int dt = 0; dt < 8; ++dt) *(f32x4*)(CR + 16 * dt + 4 * g4) = acc[dt]; } }
        { f32x4 acc[8];
#pragma unroll
          for (int ct = 0; ct < 8; ++ct) acc[ct] = (f32x4){0.f, 0.f, 0.f, 0.f};
          const LAS unsigned char* lane_off = L + l15 * 144 + g4 * 16;
#pragma unroll
          for (int kb = 0; kb < 2; ++kb) { const bf16x8 a = *(const LAS bf16x8*)(lane_off + WT_OFF + wave * 2304 + kb * 64);
#pragma unroll
              for (int ct = 0; ct < 8; ++ct) { const bf16x8 bb = *(const LAS bf16x8*)(lane_off + KDT_OFF + ct * 2304 + kb * 64); acc[ct] = mfma16(a, bb, acc[ct]); } }
          mfma_settle();
          bf16* CM = WSQ(bf16, WS_CM) + ub * 16384; const float eg = GC[256];
          const int dpp = 32 * (wave >> 1) + 8 * g4 + 4 * (wave & 1);
#pragma unroll
          for (int ct = 0; ct < 8; ++ct) { const int d = 16 * ct + l15, dp = 16 * wave + 4 * g4; float m[4];
#pragma unroll
              for (int r = 0; r < 4; ++r) m[r] = (d == dp + r ? eg : 0.f) - acc[ct][r];
              u32x2 o; o.x = cvtpk(m[0], m[1]); o.y = cvtpk(m[2], m[3]); *(u32x2*)(CM + (size_t)d * 128 + dpp) = o; }
#pragma unroll
          for (int ct = 0; ct < 8; ++ct) acc[ct] = (f32x4){0.f, 0.f, 0.f, 0.f};
#pragma unroll
          for (int kb = 0; kb < 2; ++kb) { const bf16x8 a = *(const LAS bf16x8*)(lane_off + KDT_OFF + wave * 2304 + kb * 64);
#pragma unroll
              for (int ct = 0; ct < 8; ++ct) { const bf16x8 bb = *(const LAS bf16x8*)(lane_off + UT_OFF + ct * 2304 + kb * 64); acc[ct] = mfma16(a, bb, acc[ct]); } }
          mfma_settle();
          bf16* CN = WSQ(bf16, WS_CN) + ub * 16384;
#pragma unroll
          for (int ct = 0; ct < 8; ++ct) { u32x2 o; o.x = cvtpk(acc[ct][0], acc[ct][1]); o.y = cvtpk(acc[ct][2], acc[ct][3]); *(u32x2*)(CN + ((size_t)(ct * 8 + wave) * 64 + lane) * 4) = o; } }
    }
}
#undef WSQ

#define DN_SCAN_STEP(cs, NS, MS) do {            \
        const LAS unsigned char* Mb = L + ((cs) & 1) * 34816;                                                                                        \
        const int c4 = (cs) + 3 < 64 ? (cs) + 3 : 63, c5 = (cs) + 4 < 64 ? (cs) + 4 : 63;                                                           \
        if (active) {                                                                                                                               \
        bf16* cso = CS + (size_t)(cs) * 16384 + ((size_t)(wv * 8) * 64 + lane) * 4;                                                                  \
        unsigned sp[8][2]; f32x4 acc[8];                                                                                                            \
        _Pragma("unroll") for (int r = 0; r < 8; ++r) { sp[r][0] = cvtpk(S[r][0], S[r][1]); sp[r][1] = cvtpk(S[r][2], S[r][3]); u32x2 o; o.x = sp[r][0]; o.y = sp[r][1]; *(u32x2*)(cso + 256 * r) = o; \
            acc[r][0] = __uint_as_float(NS[r].x << 16); acc[r][1] = __uint_as_float(NS[r].x & 0xffff0000u); acc[r][2] = __uint_as_float(NS[r].y << 16); acc[r][3] = __uint_as_float(NS[r].y & 0xffff0000u); } \
        _Pragma("unroll") for (int r = 0; r < 8; ++r) NS[r] = *(const u32x2*)(CN + (size_t)c4 * 16384 + ((size_t)(wv * 8 + r) * 64 + lane) * 4);         \
        _Pragma("unroll") for (int kb = 0; kb < 4; ++kb) { u32x4 bw; bw.x = sp[2 * kb][0]; bw.y = sp[2 * kb][1]; bw.z = sp[2 * kb + 1][0]; bw.w = sp[2 * kb + 1][1]; const bf16x8 bfrag = *reinterpret_cast<bf16x8*>(&bw); \
            _Pragma("unroll") for (int r = 0; r < 8; ++r)                                                                                           \
                acc[r] = mfma16(*(const LAS bf16x8*)(Mb + (16 * r + l15) * 272 + (32 * kb + 8 * g4) * 2), bfrag, acc[r]); }                            \
        _Pragma("unroll") for (int r = 0; r < 8; ++r) S[r] = acc[r];                                                                                 \
        } else {     \
                                \
          LAS unsigned char* Mn = L + (((cs) + 1) & 1) * 34816;                                                                                      \
          _Pragma("unroll") for (int q = 0; q < 8; ++q) { const int id = tl + 256 * q; *(LAS u32x4*)(Mn + (id >> 4) * 272 + (id & 15) * 16) = MS[q]; }   \
          _Pragma("unroll") for (int q = 0; q < 8; ++q) MS[q] = *(const u32x4*)(CM + (size_t)c5 * 16384 + (size_t)(tl + 256 * q) * 8);                 \
        }                                                                                                                                           \
        asm volatile("s_waitcnt lgkmcnt(0)" ::: "memory"); __builtin_amdgcn_s_barrier(); asm volatile("" ::: "memory");     \
    } while (0)
__device__ __forceinline__ void phase_dn_scan(Frame& F) {
    using namespace dn;
    if (blockIdx.x >= 32) return;
    const int chain = (int)blockIdx.x >> 1, tid = F.tid, lane = F.lane, wave = F.wave, g4 = lane >> 4, l15 = lane & 15;
    const bool active = wave < 4; const int wv = ((int)blockIdx.x & 1) * 4 + (wave & 3);
    const int tl = tid & 255;
    LAS unsigned char* L = F.lds;
    const bf16* CM = WSP(bf16, WS_CM) + (size_t)chain * 64 * 16384; const bf16* CN = WSP(bf16, WS_CN) + (size_t)chain * 64 * 16384; bf16* CS = WSP(bf16, WS_CS) + (size_t)chain * 64 * 16384;
    f32x4 S[8];
#pragma unroll
    for (int r = 0; r < 8; ++r) S[r] = (f32x4){0.f, 0.f, 0.f, 0.f};
    u32x4 m0[8], m1[8], m2[8]; u32x2 n0[8], n1[8], n2[8];
#pragma unroll
    for (int q = 0; q < 8; ++q) { m0[q] = (u32x4){0u, 0u, 0u, 0u}; m1[q] = m0[q]; m2[q] = m0[q]; }
#pragma unroll
    for (int r = 0; r < 8; ++r) { n0[r] = (u32x2){0u, 0u}; n1[r] = n0[r]; n2[r] = n0[r]; }
    __syncthreads();
    if (!active) {
#pragma unroll
        for (int q = 0; q < 8; ++q) { const size_t o = (size_t)(tl + 256 * q) * 8; m0[q] = *(const u32x4*)(CM + o); m1[q] = *(const u32x4*)(CM + 16384 + o); m2[q] = *(const u32x4*)(CM + 2 * 16384 + o); }
#pragma unroll
        for (int q = 0; q < 8; ++q) { const int id = tl + 256 * q; *(LAS u32x4*)(L + (id >> 4) * 272 + (id & 15) * 16) = m0[q]; }
#pragma unroll
        for (int q = 0; q < 8; ++q) m0[q] = *(const u32x4*)(CM + 3 * 16384 + (size_t)(tl + 256 * q) * 8);
    } else {
#pragma unroll
        for (int r = 0; r < 8; ++r) { const size_t o = ((size_t)(wv * 8 + r) * 64 + lane) * 4; n0[r] = *(const u32x2*)(CN + o); n1[r] = *(const u32x2*)(CN + 16384 + o); n2[r] = *(const u32x2*)(CN + 2 * 16384 + o); }
    }
    __syncthreads();
#pragma unroll 1
    for (int cs = 0; cs < 63; cs += 3) {
        DN_SCAN_STEP(cs, n0, m1);
        DN_SCAN_STEP(cs + 1, n1, m2);
        DN_SCAN_STEP(cs + 2, n2, m0);
    }
    DN_SCAN_STEP(63, n0, m1);
}
#undef DN_SCAN_STEP

__device__ __forceinline__ void phase_dn_out(Frame& F, int l, const int ufirst, const int ustep, const int uend) {
    using namespace dn;
    const bf16* PROJ = WSP(bf16, WS_PROJ); bf16* Y = WSP(bf16, WS_Y); const float* gn = GIN(11) + (size_t)l * HD;
    const int lane = F.lane, wave = F.wave, g4 = lane >> 4, l15 = lane & 15, it = wave & 3, vh = wave >> 2;
    LAS float* part = (LAS float*)F.lds;
    for (int u = ufirst; u < uend; u += ustep) {
        const int b = u >> 8, hh = (u >> 6) & 3, c = u & 63;
        f32x4 acc[4];
#pragma unroll
        for (int q = 0; q < 4; ++q) acc[q] = (f32x4){0.f, 0.f, 0.f, 0.f};
#pragma unroll
        for (int dir = 0; dir < 2; ++dir) { const int chain = dir * 8 + b * 4 + hh, cs = dir ? 63 - c : c; const size_t ub = (size_t)chain * 64 + cs;
            const bf16* CP = WSP(bf16, WS_CP) + ub * 8192 + (size_t)(16 * it + l15) * 128 + 8 * g4; const bf16* CS = WSP(bf16, WS_CS) + ub * 16384 + (size_t)lane * 4; const float* CR = WSP(float, WS_CR) + ub * 8192 + (size_t)(16 * it + l15) * 128;
#pragma unroll
            for (int kb = 0; kb < 4; ++kb) { const bf16x8 bb = *(const bf16x8*)(CP + 32 * kb);
#pragma unroll
                for (int q = 0; q < 4; ++q) { const bf16* sp_ = CS + (size_t)((vh * 4 + q) * 8 + 2 * kb) * 256; const u32x2 a0 = *(const u32x2*)sp_, a1 = *(const u32x2*)(sp_ + 256); u32x4 aw; aw.x = a0.x; aw.y = a0.y; aw.z = a1.x; aw.w = a1.y;
                    acc[q] = mfma16(*reinterpret_cast<bf16x8*>(&aw), bb, acc[q]); } }
#pragma unroll
            for (int q = 0; q < 4; ++q) acc[q] += *(const f32x4*)(CR + 16 * (vh * 4 + q) + 4 * g4); }
        float ss = 0.f;
#pragma unroll
        for (int q = 0; q < 4; ++q) ss += (acc[q][0] * acc[q][0] + acc[q][1] * acc[q][1]) + (acc[q][2] * acc[q][2] + acc[q][3] * acc[q][3]);
        ss += __shfl_xor(ss, 16); ss += __shfl_xor(ss, 32);
        const int i = 16 * it + l15; const size_t t = (size_t)b * SEQ + c * 64 + i;
        u32x2 zw4[4]; f32x4 gg4[4];
#pragma unroll
        for (int q = 0; q < 4; ++q) { const int vv = 16 * (vh * 4 + q) + 4 * g4; zw4[q] = *(const u32x2*)(PROJ + t * DINP + COL_CZ + hh * HD + vv); gg4[q] = *(const f32x4*)(gn + vv); }
        __syncthreads();
        if (g4 == 0) part[vh * 64 + 16 * it + l15] = ss;
        __syncthreads();
        const float rs = rsqrtf((part[i] + part[64 + i]) * (1.0f / HD) + EPS);
#pragma unroll
        for (int q = 0; q < 4; ++q) { const int vv = 16 * (vh * 4 + q) + 4 * g4; const u32x2 zw = zw4[q]; const f32x4 gg = gg4[q];
            const float z0 = __uint_as_float(zw.x << 16), z1 = __uint_as_float(zw.x & 0xffff0000u), z2 = __uint_as_float(zw.y << 16), z3 = __uint_as_float(zw.y & 0xffff0000u);
            u32x2 o; o.x = cvtpk(acc[q][0] * rs * gg.x * siluf_(z0), acc[q][1] * rs * gg.y * siluf_(z1)); o.y = cvtpk(acc[q][2] * rs * gg.z * siluf_(z2), acc[q][3] * rs * gg.w * siluf_(z3));
            *(u32x2*)(Y + t * DM + 1536 + hh * HD + vv) = o; }
    }
}

__device__ __forceinline__ void dn_chain_naive(Frame& F, int chain) {
    const int dir = chain >> 3, b = (chain >> 2) & 1, hh = chain & 3;
    const float* DQ = WSP(float, WS_DQ); const float* DK = WSP(float, WS_DK); const float* DV = WSP(float, WS_DV); const float* DB = WSP(float, WS_DB); const float* DG = WSP(float, WS_DG);
    float* DO = WSP(float, WS_DO);
    LAS float* kb = (LAS float*)F.lds; LAS float* qb = kb + 64 * 128; LAS float* vb = qb + 64 * 128; LAS float* bb = vb + 64 * 128; LAS float* gb = bb + 64;
    const int tid = F.tid, v = tid >> 2, kq = tid & 3;
    float S[32];
#pragma unroll
    for (int j = 0; j < 32; ++j) S[j] = 0.f;
    for (int c0 = 0; c0 < SEQ; c0 += 64) {
        __syncthreads();
        for (int idx = tid; idx < 64 * 128; idx += NTHR) { const int i = idx >> 7, d = idx & 127; const int sq = c0 + i, pos = dir ? SEQ - 1 - sq : sq; const size_t o = (size_t)(b * SEQ + pos) * 512 + hh * 128 + d;
            kb[idx] = DK[o]; qb[idx] = DQ[o]; vb[idx] = DV[o]; }
        if (tid < 64) { const int sq = c0 + tid, pos = dir ? SEQ - 1 - sq : sq; const size_t o = ((size_t)dir * T + b * SEQ + pos) * 4 + hh; bb[tid] = DB[o]; gb[tid] = DG[o]; }
        __syncthreads();
        for (int i = 0; i < 64; ++i) {
            const float a = expf(gb[i]), beta = bb[i];
            float ks = 0.f;
#pragma unroll
            for (int j = 0; j < 32; ++j) ks = fmaf(kb[i * 128 + kq * 32 + j], S[j], ks);
            ks += __shfl_xor(ks, 1); ks += __shfl_xor(ks, 2);
            const float vn = beta * (vb[i * 128 + v] - a * ks);
            float o = 0.f;
#pragma unroll
            for (int j = 0; j < 32; ++j) { S[j] = fmaf(kb[i * 128 + kq * 32 + j], vn, a * S[j]); o = fmaf(qb[i * 128 + kq * 32 + j], S[j], o); }
            o += __shfl_xor(o, 1); o += __shfl_xor(o, 2);
            if (kq == 0) { const int sq = c0 + i, pos = dir ? SEQ - 1 - sq : sq; DO[((size_t)dir * T + b * SEQ + pos) * 512 + hh * 128 + v] = o; }
        }
    }
    __syncthreads();
}
struct AttnAcc { float m, l, o0, o1; };
__device__ __forceinline__ void attn_key(AttnAcc& st, float q0, float q1, const bf16* krow, const bf16* vrow, int lane) {
    const unsigned kw = *(const unsigned*)(krow + 2 * lane), vw = *(const unsigned*)(vrow + 2 * lane);
    const float sc = wave_sum(q0 * __uint_as_float(kw << 16) + q1 * __uint_as_float(kw & 0xffff0000u)) * 0.08838834764831845f;
    const float mn = fmaxf(st.m, sc), al = __expf(st.m - mn), p = __expf(sc - mn);
    st.l = st.l * al + p; st.o0 = st.o0 * al + p * __uint_as_float(vw << 16); st.o1 = st.o1 * al + p * __uint_as_float(vw & 0xffff0000u); st.m = mn;
}
__device__ __forceinline__ void phase_mix_naive(Frame& F, unsigned* scan_cnt) {
    const bf16* PROJ = WSP(bf16, WS_PROJ); float* YMIX = WSP(float, WS_YMIX);
    if (NAIVE_DN) { if (F.vcu < 16) dn_chain_naive(F, F.vcu); } else { phase_dn_scan(F); asm volatile("s_waitcnt vmcnt(0)" ::: "memory"); __syncthreads();
        if (blockIdx.x < 32 && F.tid == 0) {
            __builtin_amdgcn_fence(__ATOMIC_RELEASE, "agent"); asm volatile("s_waitcnt vmcnt(0)" ::: "memory"); (void)xb_add(scan_cnt, 1u); } }
    const int gw = F.vcu * NWAVES + F.wave, NGW = F.G * NWAVES, lane = F.lane;
    if (NAIVE_ATTN_A) for (int u = gw; u < T * 4; u += NGW) { const int t = u >> 2, hh = u & 3, b = t >> 12, s = t & (SEQ - 1);
        const unsigned qw = *(const unsigned*)(PROJ + (size_t)t * DINP + COL_AQ + hh * HD + 2 * lane); const float q0 = __uint_as_float(qw << 16), q1 = __uint_as_float(qw & 0xffff0000u);
        AttnAcc st{-1e30f, 0.f, 0.f, 0.f};
        for (int pat = 0; pat < 3; ++pat) { const int dil = pat == 0 ? 1 : (pat == 1 ? 4 : 16);
            for (int dlt = -64; dlt <= 64; ++dlt) { const int sp = s + dil * dlt; if (sp < 0 || sp >= SEQ) continue;
                const bf16* kr = PROJ + (size_t)(b * SEQ + sp) * DINP; attn_key(st, q0, q1, kr + COL_AK + hh * HD, kr + COL_AV + hh * HD, lane); } }
        const float inv = 1.0f / st.l; *(float2*)(YMIX + (size_t)t * DM + hh * HD + 2 * lane) = make_float2(st.o0 * inv, st.o1 * inv); }
    if (NAIVE_ATTN_B) for (int u = gw; u < T * 8; u += NGW) { const int t = u >> 3, hq = u & 7, kvh = hq >> 2, b = t >> 12;
        const unsigned qw = *(const unsigned*)(PROJ + (size_t)t * DINP + COL_BQ + hq * HD + 2 * lane); const float q0 = __uint_as_float(qw << 16), q1 = __uint_as_float(qw & 0xffff0000u);
        AttnAcc st{-1e30f, 0.f, 0.f, 0.f};
        const bf16* kr = PROJ + (size_t)(b * SEQ) * DINP;
        for (int j = 0; j < SEQ; ++j, kr += DINP) attn_key(st, q0, q1, kr + COL_BK + kvh * HD, kr + COL_BV + kvh * HD, lane);
        const float inv = 1.0f / st.l; *(float2*)(YMIX + (size_t)t * DM + 512 + hq * HD + 2 * lane) = make_float2(st.o0 * inv, st.o1 * inv); }
}


__device__ __forceinline__ void phase_attn_b(Frame& F, char* lds_gen) {
    const bf16* PROJ = WSP(bf16, WS_PROJ); float* YMIX = WSP(float, WS_YMIX);
    for (int u = F.vcu; u < BATCH * 8 * 16; u += F.G) {
        const int b = u >> 7, kvh = (u >> 6) & 1, hq = kvh * 4 + ((u >> 4) & 3), qb = u & 15;
        const bf16* Qb = PROJ + (size_t)(b * SEQ + qb * 256) * DINP + COL_BQ + hq * HD;
        const bf16* Kh = PROJ + (size_t)(b * SEQ) * DINP + COL_BK + kvh * HD;
        const bf16* Vh = PROJ + (size_t)(b * SEQ) * DINP + COL_BV + kvh * HD;
        float* Ob = YMIX + (size_t)(b * SEQ + qb * 256) * DM + 512 + hq * HD;
        attn::attn_dense_body<attn::bf16>(Qb, Kh, Vh, Ob, SEQ, lds_gen, F.wave);
        __syncthreads();
    }
}


constexpr size_t WS_OPA = WS_TMP;
constexpr size_t WS_LSE = WS_TMP + (size_t)3 * T * 512 * 4;
__device__ __forceinline__ void phase_attn_a(Frame& F) {
    using namespace dn;
    constexpr int K_OFF = 0, VT_OFF = 69632;
    LAS unsigned char* L = F.lds;
    const int wave = F.wave;
    if (F.G > 64 && blockIdx.x < 32) return;
    const int ufirst = F.G > 64 ? (int)blockIdx.x - 32 : (int)blockIdx.x, ustep = F.G > 64 ? F.G - 32 : F.G;
    for (int u = ufirst; u < 768; u += ustep) {
        int tid_ = wave * 64 + lane_id(); asm volatile("" : "+v"(tid_));
        const int tid = tid_, lane = tid & 63, g4 = lane >> 4, l15 = lane & 15;
        GAS unsigned char* wsq_ = (GAS unsigned char*)F.ws; asm volatile("" : "+s"(wsq_)); unsigned char* wsq = (unsigned char*)wsq_;
        const bf16* PROJ = (const bf16*)(wsq + WS_PROJ);
        const int p = u >> 8, rem = u & 255, b = rem >> 7, hh = (rem >> 5) & 3, w32 = rem & 31;
        const int dsh = 2 * p, dil = 1 << dsh, Lf = SEQ >> dsh, nblk = Lf >> 7;
        const int r = w32 / nblk, i0 = (w32 % nblk) * 128;
        const bf16* base = PROJ + (size_t)(b * SEQ + r) * DINP + hh * HD;
        const size_t jstride = (size_t)dil * DINP;
        __syncthreads();
#pragma unroll
        for (int q = 0; q < 8; ++q) { const int id = tid + 512 * q, row = id >> 4, c16 = id & 15, j = i0 - 64 + row;
            u32x4 v = {0u, 0u, 0u, 0u}; if (j >= 0 && j < Lf) v = *(const u32x4*)(base + (size_t)j * jstride + COL_AK + c16 * 8);
            *(LAS u32x4*)(L + K_OFF + row * 272 + c16 * 16) = v; }
#pragma unroll
        for (int g = 0; g < 8; ++g) { const int kk0 = 32 * wave + 4 * g; unsigned rv[4];
#pragma unroll
            for (int m = 0; m < 4; ++m) { const int j = i0 - 64 + kk0 + m; rv[m] = (j >= 0 && j < Lf) ? *(const unsigned*)(base + (size_t)j * jstride + COL_AV + 2 * lane) : 0u; }
            u32x2 lo, hi; lo.x = (rv[0] & 0xffffu) | (rv[1] << 16); lo.y = (rv[2] & 0xffffu) | (rv[3] << 16); hi.x = (rv[0] >> 16) | (rv[1] & 0xffff0000u); hi.y = (rv[2] >> 16) | (rv[3] & 0xffff0000u);
            *(LAS u32x2*)(L + VT_OFF + (2 * lane) * 528 + kk0 * 2) = lo; *(LAS u32x2*)(L + VT_OFF + (2 * lane + 1) * 528 + kk0 * 2) = hi; }
        const int iq = i0 + 16 * wave + l15;
        bf16x8 qf[4];
#pragma unroll
        for (int kb = 0; kb < 4; ++kb) qf[kb] = *(const bf16x8*)(base + (size_t)iq * jstride + COL_AQ + 32 * kb + 8 * g4);
        __syncthreads();
        f32x4 sc[9];
        const LAS unsigned char* kb_ = L + K_OFF + (16 * wave + l15) * 272 + g4 * 16;
#pragma unroll
        for (int kt = 0; kt < 9; ++kt) { sc[kt] = (f32x4){0.f, 0.f, 0.f, 0.f};
#pragma unroll
            for (int kb = 0; kb < 4; ++kb) sc[kt] = mfma16(*(const LAS bf16x8*)(kb_ + kt * 4352 + kb * 64), qf[kb], sc[kt]); }
        constexpr float C = 0.08838834764831845f * 1.4426950408889634f;
        float mx = -3.0e38f;
#pragma unroll
        for (int kt = 0; kt < 9; ++kt)
#pragma unroll
            for (int rr = 0; rr < 4; ++rr) { const int dlt = -64 + 16 * kt + 4 * g4 + rr - l15, j = iq + dlt; const bool ok = dlt >= -64 && dlt <= 64 && j >= 0 && j < Lf;
                sc[kt][rr] = ok ? sc[kt][rr] : -3.0e38f; mx = fmaxf(mx, sc[kt][rr]); }
        mx = fmaxf(mx, __shfl_xor(mx, 16)); mx = fmaxf(mx, __shfl_xor(mx, 32));
        float lsum = 0.f; const float mC = mx * C;
#pragma unroll
        for (int kt = 0; kt < 9; ++kt)
#pragma unroll
            for (int rr = 0; rr < 4; ++rr) { const float pv = sc[kt][rr] > -1.0e38f ? __builtin_amdgcn_exp2f(sc[kt][rr] * C - mC) : 0.f; sc[kt][rr] = pv; lsum += pv; }
        lsum += __shfl_xor(lsum, 16); lsum += __shfl_xor(lsum, 32);
        f32x4 o[8];
#pragma unroll
        for (int dt = 0; dt < 8; ++dt) o[dt] = (f32x4){0.f, 0.f, 0.f, 0.f};
        const LAS unsigned char* vb_ = L + VT_OFF + l15 * 528 + (16 * wave + 4 * g4) * 2;
#pragma unroll
        for (int pp = 0; pp < 5; ++pp) { u32x4 bw; bw.x = cvtpk(sc[2 * pp][0], sc[2 * pp][1]); bw.y = cvtpk(sc[2 * pp][2], sc[2 * pp][3]);
            if (pp < 4) { bw.z = cvtpk(sc[2 * pp + 1][0], sc[2 * pp + 1][1]); bw.w = cvtpk(sc[2 * pp + 1][2], sc[2 * pp + 1][3]); } else { bw.z = 0u; bw.w = 0u; }
            const bf16x8 bfrag = *reinterpret_cast<bf16x8*>(&bw);
#pragma unroll
            for (int dt = 0; dt < 8; ++dt) { const u32x2 a0 = *(const LAS u32x2*)(vb_ + dt * 8448 + pp * 64); u32x2 a1 = {0u, 0u}; if (pp < 4) a1 = *(const LAS u32x2*)(vb_ + dt * 8448 + pp * 64 + 32);
                u32x4 aw; aw.x = a0.x; aw.y = a0.y; aw.z = a1.x; aw.w = a1.y; o[dt] = mfma16(*reinterpret_cast<bf16x8*>(&aw), bfrag, o[dt]); } }
        const float inv = 1.0f / lsum;
        const size_t t = (size_t)b * SEQ + (size_t)iq * dil + r;
        bf16* OP = (bf16*)(wsq + WS_OPA) + ((size_t)p * T + t) * 512 + hh * HD + 4 * g4;
#pragma unroll
        for (int dt = 0; dt < 8; ++dt) { u32x2 w; w.x = cvtpk(o[dt][0] * inv, o[dt][1] * inv); w.y = cvtpk(o[dt][2] * inv, o[dt][3] * inv); *(u32x2*)(OP + 16 * dt) = w; }
        if (g4 == 0) ((float*)(wsq + WS_LSE))[((size_t)p * T + t) * 4 + hh] = mx * 0.08838834764831845f + __logf(lsum);
    }
}

__device__ __forceinline__ void phase_ynorm(Frame& F, int l, bool naive_dn) {
    const bf16* PROJ = WSP(bf16, WS_PROJ); float* YMIX = WSP(float, WS_YMIX); bf16* Y = WSP(bf16, WS_Y); const float* DO = WSP(float, WS_DO);
    const float* ga = GIN(7) + (size_t)l * 512; const float* gb = GIN(8) + (size_t)l * 1024; const float* gn = GIN(11) + (size_t)l * HD;
    const int gw = F.vcu * NWAVES + F.wave, NGW = F.G * NWAVES, lane = F.lane;
    for (int t = gw; t < T; t += NGW) {
        if (naive_dn) {
#pragma unroll
            for (int hh = 0; hh < 4; ++hh) { const size_t o = (size_t)t * 512 + hh * HD; const float o0 = DO[o + lane] + DO[(size_t)T * 512 + o + lane], o1 = DO[o + lane + 64] + DO[(size_t)T * 512 + o + lane + 64];
                const float rs = rsqrtf(wave_sum(o0 * o0 + o1 * o1) * (1.0f / HD) + EPS);
                const float z0 = bf2f(PROJ[(size_t)t * DINP + COL_CZ + hh * HD + lane]), z1 = bf2f(PROJ[(size_t)t * DINP + COL_CZ + hh * HD + lane + 64]);
                Y[(size_t)t * DM + 1536 + hh * HD + lane] = (bf16)f2bf(o0 * rs * gn[lane] * siluf_(z0)); Y[(size_t)t * DM + 1536 + hh * HD + lane + 64] = (bf16)f2bf(o1 * rs * gn[lane + 64] * siluf_(z1)); }
        }
        const float* yr = YMIX + (size_t)t * DM; bf16* yo = Y + (size_t)t * DM;
        f32x4 bq[4];
#pragma unroll
        for (int j = 0; j < 4; ++j) bq[j] = *(const f32x4*)(yr + 512 + 256 * j + 4 * lane);
        { f32x4 a0, a1;
          if (NAIVE_ATTN_A) { a0 = *(const f32x4*)(yr + 4 * lane); a1 = *(const f32x4*)(yr + 256 + 4 * lane); }
          else { const bf16* OPA = WSP(bf16, WS_OPA); const float* LSE = WSP(float, WS_LSE); const int h0 = lane >> 5;
              float l0[3], l1[3];
#pragma unroll
              for (int p = 0; p < 3; ++p) { l0[p] = LSE[((size_t)p * T + t) * 4 + h0]; l1[p] = LSE[((size_t)p * T + t) * 4 + 2 + h0]; }
              const float m0 = fmaxf(l0[0], fmaxf(l0[1], l0[2])), m1 = fmaxf(l1[0], fmaxf(l1[1], l1[2]));
              float w0[3], w1[3], s0 = 0.f, s1 = 0.f;
#pragma unroll
              for (int p = 0; p < 3; ++p) { w0[p] = __expf(l0[p] - m0); w1[p] = __expf(l1[p] - m1); s0 += w0[p]; s1 += w1[p]; }
              a0 = (f32x4){0.f, 0.f, 0.f, 0.f}; a1 = a0;
#pragma unroll
              for (int p = 0; p < 3; ++p) { const u32x2 x0 = *(const u32x2*)(OPA + ((size_t)p * T + t) * 512 + 4 * lane), x1 = *(const u32x2*)(OPA + ((size_t)p * T + t) * 512 + 256 + 4 * lane);
                  const f32x4 f0 = {__uint_as_float(x0.x << 16), __uint_as_float(x0.x & 0xffff0000u), __uint_as_float(x0.y << 16), __uint_as_float(x0.y & 0xffff0000u)}, f1 = {__uint_as_float(x1.x << 16), __uint_as_float(x1.x & 0xffff0000u), __uint_as_float(x1.y << 16), __uint_as_float(x1.y & 0xffff0000u)};
                  a0 += f0 * (w0[p] / s0); a1 += f1 * (w1[p] / s1); } }
          const float rs = rsqrtf(wave_sum((a0.x * a0.x + a0.y * a0.y) + (a0.z * a0.z + a0.w * a0.w) + (a1.x * a1.x + a1.y * a1.y) + (a1.z * a1.z + a1.w * a1.w)) * (1.0f / 512) + EPS);
          const f32x4 g0 = *(const f32x4*)(ga + 4 * lane), g1 = *(const f32x4*)(ga + 256 + 4 * lane); a0 = a0 * rs * g0; a1 = a1 * rs * g1;
          u32x2 o; o.x = pk2(a0.x, a0.y); o.y = pk2(a0.z, a0.w); *(u32x2*)(yo + 4 * lane) = o; o.x = pk2(a1.x, a1.y); o.y = pk2(a1.z, a1.w); *(u32x2*)(yo + 256 + 4 * lane) = o; }
        { f32x4 a[4]; float ss = 0.f;
#pragma unroll
          for (int j = 0; j < 4; ++j) { a[j] = bq[j]; ss += (a[j].x * a[j].x + a[j].y * a[j].y) + (a[j].z * a[j].z + a[j].w * a[j].w); }
          const float rs = rsqrtf(wave_sum(ss) * (1.0f / 1024) + EPS);
#pragma unroll
          for (int j = 0; j < 4; ++j) { const f32x4 g = *(const f32x4*)(gb + 256 * j + 4 * lane); a[j] = a[j] * rs * g; u32x2 o; o.x = pk2(a[j].x, a[j].y); o.y = pk2(a[j].z, a[j].w); *(u32x2*)(yo + 512 + 256 * j + 4 * lane) = o; } }
    }
}

__device__ __forceinline__ void phase_select(Frame& F) {
    const float* AFF = WSP(float, WS_AFF); int* SELI = WSP(int, WS_SELI); float* SELG = WSP(float, WS_SELG); int* SLOT = WSP(int, WS_SLOT); float* SELR = WSP(float, WS_SELR); const float* RS2 = WSP(float, WS_RS) + T;
    LAS unsigned* key = (LAS unsigned*)F.lds;
    LAS unsigned* hist = key + 4096;
    LAS unsigned* ctl = hist + 256;
    LAS unsigned* scan = ctl + 8;
    const int tid = F.tid;
    for (int u = F.vcu; u < BATCH * NE; u += F.G) {
        const int b = u / NE, e = u % NE;
        __syncthreads();
        for (int i = tid; i < SEQ; i += NTHR) key[i] = __float_as_uint(AFF[(size_t)(b * SEQ + i) * 16 + e]);
        if (tid == 0) { ctl[0] = 0u; ctl[2] = CAP; }
        __syncthreads();
        for (int pass = 3; pass >= 0; --pass) {
            const int shift = pass * 8; const unsigned hmask = pass == 3 ? 0u : ~((1u << (shift + 8)) - 1u);
            if (tid < 256) hist[tid] = 0u;
            __syncthreads();
            const unsigned prefix = ctl[0];
            for (int i = tid; i < SEQ; i += NTHR) { const unsigned k = key[i]; if ((k & hmask) == (prefix & hmask)) __hip_atomic_fetch_add(hist + ((k >> shift) & 255u), 1u, __ATOMIC_RELAXED, __HIP_MEMORY_SCOPE_WORKGROUP); }
            __syncthreads();
            if (tid < 64) {
                const unsigned want = ctl[2]; const unsigned c0 = hist[4 * tid], c1 = hist[4 * tid + 1], c2 = hist[4 * tid + 2], c3 = hist[4 * tid + 3]; const unsigned sl = (c0 + c1) + (c2 + c3);
                unsigned suf = sl;
#pragma unroll
                for (int o = 1; o < 64; o <<= 1) { const unsigned tv = __shfl_down(suf, o); if (tid + o < 64) suf += tv; }
                unsigned cum = suf - sl;
                int bsel = -1; unsigned cb = 0;
                if (cum < want && cum + c3 >= want) { bsel = 3; cb = cum; } cum += c3;
                if (bsel < 0 && cum < want && cum + c2 >= want) { bsel = 2; cb = cum; } cum += c2;
                if (bsel < 0 && cum < want && cum + c1 >= want) { bsel = 1; cb = cum; } cum += c1;
                if (bsel < 0 && cum < want && cum + c0 >= want) { bsel = 0; cb = cum; }
                if (bsel >= 0) { ctl[0] = prefix | ((unsigned)(4 * tid + bsel) << shift); ctl[2] = want - cb; } }
            __syncthreads();
        }
        const unsigned thr = ctl[0], want_eq = ctl[2];
        unsigned cg = 0, ce = 0;
#pragma unroll
        for (int j = 0; j < 8; ++j) { const unsigned k = key[8 * tid + j]; cg += k > thr; ce += k == thr; }
        scan[tid] = cg; scan[512 + tid] = ce;
        __syncthreads();
        if (tid < 64) { unsigned sg = 0, se = 0;
            unsigned lg[8], le[8];
#pragma unroll
            for (int j = 0; j < 8; ++j) { lg[j] = scan[8 * tid + j]; le[j] = scan[512 + 8 * tid + j]; sg += lg[j]; se += le[j]; }
            unsigned pg = sg, pe = se;
#pragma unroll
            for (int o = 1; o < 64; o <<= 1) { const unsigned tg = __shfl_up(pg, o), te = __shfl_up(pe, o); if (tid >= o) { pg += tg; pe += te; } }
            unsigned bg = pg - sg, be = pe - se;
#pragma unroll
            for (int j = 0; j < 8; ++j) { scan[8 * tid + j] = bg; scan[512 + 8 * tid + j] = be; bg += lg[j]; be += le[j]; }
        }
        __syncthreads();
        unsigned pg = scan[tid], pe = scan[512 + tid];
#pragma unroll
        for (int j = 0; j < 8; ++j) { const int i = 8 * tid + j; const unsigned k = key[i]; int slot = -1;
            if (k > thr) { slot = (int)(pg + (pe < want_eq ? pe : want_eq)); pg++; }
            else if (k == thr) { if (pe < want_eq) slot = (int)(pg + pe); pe++; }
            SLOT[(size_t)(b * NE + e) * SEQ + i] = slot;
            if (slot >= 0) { SELI[(size_t)(b * NE + e) * CAP + slot] = i; SELG[(size_t)e * 1024 + b * CAP + slot] = __uint_as_float(k); SELR[(size_t)e * 1024 + b * CAP + slot] = RS2[b * SEQ + i]; } }
    }
}
__device__ __forceinline__ void phase_gather(Frame& F) {
    const int* SELI = WSP(int, WS_SELI); const bf16* HN = WSP(bf16, WS_HN); bf16* XS = WSP(bf16, WS_XS);
    const int gw = F.vcu * NWAVES + F.wave, NGW = F.G * NWAVES, lane = F.lane;
    for (int r = gw; r < NE * 1024; r += NGW) { const int e = r >> 10, q = r & 1023, b = q >> 9, slot = q & 511; const int i = SELI[(size_t)(b * NE + e) * CAP + slot];
        const u32x4* src = (const u32x4*)(HN + (size_t)(b * SEQ + i) * DM); u32x4* dst = (u32x4*)(XS + (size_t)r * DM);
#pragma unroll
        for (int j = 0; j < 4; ++j) dst[lane + 64 * j] = src[lane + 64 * j]; }
}
#define ADD_BF4(V, W) do { (V).x += __uint_as_float((W).x << 16); (V).y += __uint_as_float((W).x & 0xffff0000u); (V).z += __uint_as_float((W).y << 16); (V).w += __uint_as_float((W).y & 0xffff0000u); } while (0)
__device__ __forceinline__ void phase_combine(Frame& F) {
    const bf16* H = WSP(bf16, WS_H); bf16* H1 = WSP(bf16, WS_HN); float* RS3 = WSP(float, WS_RS) + 2 * T; const int* SLOT = WSP(int, WS_SLOT); const bf16* YEXP = WSP(bf16, WS_YEXP);
    const int gw = F.vcu * NWAVES + F.wave, NGW = F.G * NWAVES, lane = F.lane;
    int nslot = -1; u32x2 hw[8];
    if (gw < T) { nslot = lane < NE ? SLOT[(size_t)((gw >> 12) * NE + lane) * SEQ + (gw & (SEQ - 1))] : -1;
#pragma unroll
        for (int j = 0; j < 8; ++j) hw[j] = *(const u32x2*)(H + (size_t)gw * DM + 4 * lane + 256 * j); }
    for (int t = gw; t < T; t += NGW) { const int b = t >> 12;
        const int myslot = nslot; f32x4 v[8];
#pragma unroll
        for (int j = 0; j < 8; ++j) { v[j].x = __uint_as_float(hw[j].x << 16); v[j].y = __uint_as_float(hw[j].x & 0xffff0000u); v[j].z = __uint_as_float(hw[j].y << 16); v[j].w = __uint_as_float(hw[j].y & 0xffff0000u); }
        const int tn = t + NGW;
        if (tn < T) { nslot = lane < NE ? SLOT[(size_t)((tn >> 12) * NE + lane) * SEQ + (tn & (SEQ - 1))] : -1;
#pragma unroll
            for (int j = 0; j < 8; ++j) hw[j] = *(const u32x2*)(H + (size_t)tn * DM + 4 * lane + 256 * j); }
        unsigned long long mask = __ballot(myslot >= 0);
        while (mask) {
            const int e0 = __builtin_ctzll(mask); mask &= mask - 1; const int s0 = __builtin_amdgcn_readlane(myslot, e0);
            const bool h1 = mask != 0; int e1 = e0, s1 = s0; if (h1) { e1 = __builtin_ctzll(mask); mask &= mask - 1; s1 = __builtin_amdgcn_readlane(myslot, e1); }
            const bool h2 = mask != 0; int e2 = e0, s2 = s0; if (h2) { e2 = __builtin_ctzll(mask); mask &= mask - 1; s2 = __builtin_amdgcn_readlane(myslot, e2); }
            const bf16* y0 = YEXP + (size_t)(e0 * 1024 + b * CAP + s0) * DM + 4 * lane; const bf16* y1 = YEXP + (size_t)(e1 * 1024 + b * CAP + s1) * DM + 4 * lane; const bf16* y2 = YEXP + (size_t)(e2 * 1024 + b * CAP + s2) * DM + 4 * lane;
            u32x2 w0[8], w1[8], w2[8];
#pragma unroll
            for (int j = 0; j < 8; ++j) w0[j] = *(const u32x2*)(y0 + 256 * j);
            if (h1) {
#pragma unroll
                for (int j = 0; j < 8; ++j) w1[j] = *(const u32x2*)(y1 + 256 * j); }
            if (h2) {
#pragma unroll
                for (int j = 0; j < 8; ++j) w2[j] = *(const u32x2*)(y2 + 256 * j); }
#pragma unroll
            for (int j = 0; j < 8; ++j) ADD_BF4(v[j], w0[j]);
            if (h1) {
#pragma unroll
                for (int j = 0; j < 8; ++j) ADD_BF4(v[j], w1[j]); }
            if (h2) {
#pragma unroll
                for (int j = 0; j < 8; ++j) ADD_BF4(v[j], w2[j]); }
        }
        float ss = 0.f;
#pragma unroll
        for (int j = 0; j < 8; ++j) { u32x2 w; w.x = pk2(v[j].x, v[j].y); w.y = pk2(v[j].z, v[j].w); *(u32x2*)(H1 + (size_t)t * DM + 4 * lane + 256 * j) = w; ss += (v[j].x * v[j].x + v[j].y * v[j].y) + (v[j].z * v[j].z + v[j].w * v[j].w); }
        const float rs = rsqrtf(wave_sum(ss) * (1.0f / DM) + EPS); if (lane == 0) RS3[t] = rs;
    }
}
#undef ADD_BF4
__device__ __forceinline__ void phase_final(Frame& F, float oscale) {
    const bf16* H = WSP(bf16, WS_H); const float* gain = GIN(21);
    const int gw = F.vcu * NWAVES + F.wave, NGW = F.G * NWAVES, lane = F.lane;
    for (int t = gw; t < T; t += NGW) { const bf16* hr = H + (size_t)t * DM; f32x4 v[8]; float ss = 0.f;
#pragma unroll
        for (int j = 0; j < 8; ++j) { const u32x2 w = *(const u32x2*)(hr + 4 * lane + 256 * j); v[j].x = __uint_as_float(w.x << 16); v[j].y = __uint_as_float(w.x & 0xffff0000u); v[j].z = __uint_as_float(w.y << 16); v[j].w = __uint_as_float(w.y & 0xffff0000u); ss += (v[j].x * v[j].x + v[j].y * v[j].y) + (v[j].z * v[j].z + v[j].w * v[j].w); }
        const float rs = rsqrtf(wave_sum(ss) * (1.0f / DM) + EPS);
#pragma unroll
        for (int j = 0; j < 8; ++j) { const f32x4 g = *(const f32x4*)(gain + 4 * lane + 256 * j); *(f32x4*)(F.out + (size_t)t * DM + 4 * lane + 256 * j) = v[j] * (rs * oscale) * g; } }
}


#ifdef DBG_CHECKSUM
constexpr int CW_SUM = 8192;
constexpr size_t WS_PREV = WS_DQ;
__device__ __forceinline__ void dbg_checksum(Frame& F) {
    struct Buf { size_t off, bytes; };
    const Buf bufs[9] = {{WS_TL, (size_t)T * 16 * 4}, {WS_PROJ, (size_t)T * DINP * 2}, {WS_CM, (size_t)16 * 64 * 16384 * 2}, {WS_CN, (size_t)16 * 64 * 16384 * 2}, {WS_CP, (size_t)16 * 64 * 8192 * 2},
                         {WS_CR, (size_t)16 * 64 * 8192 * 4}, {WS_CS, (size_t)16 * 64 * 16384 * 2}, {WS_Y, (size_t)T * DM * 2}, {WS_H, (size_t)T * DM * 4}};
    const size_t gt = (size_t)F.vcu * NTHR + F.tid, NT = (size_t)F.G * NTHR;
#pragma unroll 1
    for (int k = 0; k < 9; ++k) { const unsigned* p = (const unsigned*)(F.ws + bufs[k].off); unsigned a = 0;
        for (size_t i = gt; i < bufs[k].bytes / 4; i += NT) a += p[i] * (unsigned)(2654435761u + 2u * (unsigned)(i & 1023));
#pragma unroll
        for (int o = 1; o < 64; o <<= 1) a += __shfl_xor(a, o);
        if (F.lane == 0) __hip_atomic_fetch_add((unsigned*)(F.ws + WS_CTL) + CW_SUM + k, a, __ATOMIC_RELAXED, __HIP_MEMORY_SCOPE_AGENT); }
}
__device__ __forceinline__ unsigned dbg_compare(Frame& F) {
    const unsigned* cur = (const unsigned*)(F.ws + WS_CTL) + CW_SUM; const unsigned* prev = (const unsigned*)(F.ws + WS_PREV);
    unsigned code = 0;
    if (__hip_atomic_load(prev, __ATOMIC_RELAXED, __HIP_MEMORY_SCOPE_AGENT) == 0x600DF00Du) {
#pragma unroll 1
        for (int k = 0; k < 9; ++k) if (__hip_atomic_load(prev + 1 + k, __ATOMIC_RELAXED, __HIP_MEMORY_SCOPE_AGENT) != __hip_atomic_load(cur + k, __ATOMIC_RELAXED, __HIP_MEMORY_SCOPE_AGENT)) code |= 1u << k; }
    return code;
}
__device__ __forceinline__ void dbg_store_prev(Frame& F) {
    if (F.vcu == 0 && F.tid == 0) { const unsigned* cur = (const unsigned*)(F.ws + WS_CTL) + CW_SUM; unsigned* prev = (unsigned*)(F.ws + WS_PREV);
        for (int k = 0; k < 9; ++k) __hip_atomic_store(prev + 1 + k, __hip_atomic_load(cur + k, __ATOMIC_RELAXED, __HIP_MEMORY_SCOPE_AGENT), __ATOMIC_RELAXED, __HIP_MEMORY_SCOPE_AGENT);
        __hip_atomic_store(prev, 0x600DF00Du, __ATOMIC_RELAXED, __HIP_MEMORY_SCOPE_AGENT); }
}
#endif

struct EpiStoreBf16 { bf16* C; int ldc; __device__ __forceinline__ void operator()(int m, int n, float v) const { C[(size_t)m * ldc + n] = (bf16)f2bf(v); } };
struct EpiStoreF32 { float* C; int ldc; __device__ __forceinline__ void operator()(int m, int n, float v) const { C[(size_t)m * ldc + n] = v; } };
struct EpiResid { float* H; __device__ __forceinline__ void operator()(int m, int n, float v) const { H[(size_t)m * DM + n] += v; } };
struct EpiDown { bf16* C; const float* gate; __device__ __forceinline__ void operator()(int m, int n, float v) const { C[(size_t)m * DM + n] = (bf16)f2bf(v * gate[m]); } };
struct EpiPle { float* H; const bf16* PL; __device__ __forceinline__ void operator()(int m, int n, float v) const { H[(size_t)m * DM + n] += sigmoidf_(v) * bf2f(PL[(size_t)m * DM + n]); } };

#ifndef NAIVE_GEMM
#define NAIVE_GEMM 0
#endif
constexpr int NPL = 14;
constexpr int NPHASES = 1 + DEPTH * NPL + 1;
struct Args { const float* in[22]; float* out; unsigned char* ws; int ph_lo, ph_hi; };

#ifndef ONLY
#define ONLY -1
#endif
#ifndef MASK
#define MASK 0xFFFF
#endif
#define EN(j) ((ONLY < 0 || ONLY == (j)) && ((MASK >> (j)) & 1))
#ifndef REPMASK
#define REPMASK 0
#endif
#define NREP(b) (((REPMASK >> (b)) & 1) ? 2 : 1)
#define REPEAT(b) for (int rep_ = 0; rep_ < NREP(b); ++rep_, __syncthreads())
#define IN(k) (lo <= (k) && (k) < hi)
#define INL(j) (EN((j) + 1) && IN(pb + (j)) && seam(pb + (j)))
#define LAUNDER() do { GAS unsigned char* w_ = (GAS unsigned char*)args.ws; int t_ = wave0 * 64 + lane_id(); const float* const __attribute__((address_space(4)))* i_ = (const float* const __attribute__((address_space(4)))*)__builtin_amdgcn_kernarg_segment_ptr(); int v_ = vcu0, g_ = (int)gridDim.x; asm volatile("" : "+s"(w_), "+v"(t_), "+s"(i_), "+s"(v_), "+s"(g_)); F.ws = (unsigned char*)w_; F.tid = t_; F.lane = t_ & 63; F.wave = wave0; F.in = i_; F.vcu = v_; F.G = g_; } while (0)
#define seam(k) (((k) > lo) ? (bar_sync(bar, (unsigned*)(args.ws + WS_CTL) + CW_BAR), true) : true)

template <int l>
__device__ __forceinline__ void layer_phases(Frame& F, const Args& args, XcdBarrier& bar, const int lo, const int hi, const int vcu0, unsigned char* lds_raw, const int wave0) {
        const int pb = 1 + l * NPL;
#define wl (F.ws + WS_W + (size_t)l * SZ_LAYERW)
        if (INL(0)) REPEAT(1) { LAUNDER(); phase_norm<1>(F, WSP(float, WS_WTL) + (size_t)(2 * l) * 16 * DM, WSP(float, WS_TL), WSP(float, WS_RS)); }
        if (INL(1)) REPEAT(2) { LAUNDER();
#if NAIVE_GEMM
            EpiStoreBf16 E{WSP(bf16, WS_PROJ), DINP}; naive_gemm(F, WSP(bf16, WS_HN), DM, (const bf16*)(wl + OFF_WIN), DM, T, DINP, DM, E);
#else
            { pg8::Gemm g{WSP(bf16, WS_H), (const bf16*)(wl + OFF_WIN), T, DINP, DM}; pg8::StaticOrder S; S.init(T, DINP, F.G, (int)blockIdx.x); pg8::EpiBf16Rs E{WSP(bf16, WS_PROJ), DINP, WSP(float, WS_RS)};
              pg8::gemm_phase<pg8::EpiBf16Rs, pg8::StaticOrder>(F.lds, g, S, E, nullptr, F.wave); }
            if (F.G == 256) { LAUNDER(); pg8::Gemm g{WSP(bf16, WS_PB) + (size_t)l * T * PLE, (const bf16*)(wl + OFF_WP), T, DM, PLE}; pg8::TailOrder S{(int)blockIdx.x, 128}; pg8::EpiBf16 E{WSP(bf16, WS_PL), DM};
              pg8::gemm_phase<pg8::EpiBf16, pg8::TailOrder>(F.lds, g, S, E, nullptr, F.wave); }
#endif
        }
        if (INL(2)) { REPEAT(3) { LAUNDER(); if (NAIVE_DN) phase_dn_prep_naive(F, l); else phase_dn_chunk(F, l); } __syncthreads(); LAUNDER(); phase_post(F, l); }
        if (INL(3)) { REPEAT(4) { LAUNDER(); phase_mix_naive(F, (unsigned*)(F.ws + WS_CTL) + CW_SCAN + 64 * l); } if (!NAIVE_ATTN_A) REPEAT(5) { __syncthreads(); LAUNDER(); phase_attn_a(F); } if (!NAIVE_ATTN_B) REPEAT(6) { __syncthreads(); LAUNDER(); phase_attn_b(F, (char*)lds_raw); }
            if (!NAIVE_DN && F.G == 256 && blockIdx.x >= 32) { __syncthreads(); LAUNDER();
                unsigned* cnt = (unsigned*)(F.ws + WS_CTL) + CW_SCAN + 64 * l;
                if (F.tid == 0) { while (xb_ld(cnt) < 32u) __builtin_amdgcn_s_sleep(1); __builtin_amdgcn_fence(__ATOMIC_ACQUIRE, "agent"); asm volatile("s_waitcnt vmcnt(0)" ::: "memory"); }
                __syncthreads();
                const int n = (int)blockIdx.x - 32, first = n >= 96 ? n - 96 : 384 + n, step = n >= 96 ? 128 : 96, end = n >= 96 ? 384 : 512;
                phase_dn_out(F, l, first, step, end); } }
        if (INL(4)) { LAUNDER(); if (!NAIVE_DN && F.G != 256) { phase_dn_out(F, l, F.vcu, F.G, 512); __syncthreads(); LAUNDER(); } REPEAT(8) phase_ynorm(F, l, NAIVE_DN != 0); }
        if (INL(5)) { LAUNDER();
#if NAIVE_GEMM
            EpiResid E{WSP(float, WS_H)}; naive_gemm(F, WSP(bf16, WS_Y), DM, (const bf16*)(wl + OFF_WOUT), DM, T, DM, DM, E);
#else
            pg8::Gemm g{WSP(bf16, WS_Y), (const bf16*)(wl + OFF_WOUT), T, DM, DM}; pg8::StaticOrder S; S.init(T, DM, F.G, (int)blockIdx.x); pg8::EpiResidBf16 E{WSP(bf16, WS_H), DM};
            pg8::gemm_phase<pg8::EpiResidBf16, pg8::StaticOrder>(F.lds, g, S, E, nullptr, F.wave);
#endif
        }
        if (INL(6)) REPEAT(9) { LAUNDER(); phase_norm<2>(F, WSP(float, WS_WTL) + (size_t)(2 * l + 1) * 16 * DM, WSP(float, WS_AFF), WSP(float, WS_RS) + T); }
        if (INL(7)) REPEAT(10) { LAUNDER(); phase_select(F); }
        if (NAIVE_GEMM && INL(8)) REPEAT(11) { LAUNDER(); phase_gather(F); }
        if (INL(9)) REPEAT(12) { LAUNDER();
#if NAIVE_GEMM
            for (int e = 0; e < NE; ++e) { EpiStoreF32 E{WSP(float, WS_TMP) + (size_t)e * 1024 * 2048, 2048};
                naive_gemm(F, WSP(bf16, WS_XS) + (size_t)e * 1024 * DM, DM, (const bf16*)(wl + OFF_WGU) + (size_t)e * 2048 * DM, DM, 1024, 2048, DM, E); }
            { EpiStoreBf16 E{WSP(bf16, WS_PL), DM}; naive_gemm(F, WSP(bf16, WS_PB) + (size_t)l * T * PLE, PLE, (const bf16*)(wl + OFF_WP), PLE, T, DM, PLE, E); }
#else
            { pg8::Gemm g{WSP(bf16, WS_H), (const bf16*)(wl + OFF_WGU), NE * 1024, NE * 2048, DM}; pg8::GroupedGatherOrder S{F.G, F.vcu, WSP(int, WS_SELI)}; pg8::EpiGateUp E{WSP(bf16, WS_HID), WSP(float, WS_SELR)};
              pg8::gemm_phase<pg8::EpiGateUp, pg8::GroupedGatherOrder>(F.lds, g, S, E, nullptr, F.wave); }
#endif
        }
#if !NAIVE_GEMM
        if (F.G != 256 && INL(10)) REPEAT(13) { LAUNDER(); pg8::Gemm g{WSP(bf16, WS_PB) + (size_t)l * T * PLE, (const bf16*)(wl + OFF_WP), T, DM, PLE}; pg8::StaticOrder S; S.init(T, DM, F.G, (int)blockIdx.x); pg8::EpiBf16 E{WSP(bf16, WS_PL), DM};
              pg8::gemm_phase<pg8::EpiBf16, pg8::StaticOrder>(F.lds, g, S, E, nullptr, F.wave); }
#endif
        if (NAIVE_GEMM && INL(10)) {
            const float* TMP = WSP(float, WS_TMP); bf16* HID = WSP(bf16, WS_HID);
            for (size_t i = (size_t)F.vcu * NTHR + F.tid; i < (size_t)NE * 1024 * EFF; i += (size_t)F.G * NTHR) { const size_t r = i >> 10; const int f = (int)(i & 1023);
                const float gt = TMP[r * 2048 + (f >> 7) * 256 + (f & 127)], up = TMP[r * 2048 + (f >> 7) * 256 + 128 + (f & 127)]; HID[i] = (bf16)f2bf(siluf_(gt) * up); }
        }
        if (INL(11)) REPEAT(14) { LAUNDER();
#if NAIVE_GEMM
            for (int e = 0; e < NE; ++e) { EpiDown E{WSP(bf16, WS_YEXP) + (size_t)e * 1024 * DM, WSP(float, WS_SELG) + (size_t)e * 1024};
                naive_gemm(F, WSP(bf16, WS_HID) + (size_t)e * 1024 * EFF, EFF, (const bf16*)(wl + OFF_WD) + (size_t)e * 2048 * EFF, EFF, 1024, DM, EFF, E); }
#else
            pg8::Gemm g{WSP(bf16, WS_HID), (const bf16*)(wl + OFF_WD), NE * 1024, NE * 2048, EFF}; pg8::GroupedOrder S{F.G, F.vcu}; pg8::EpiDownBf16 E{WSP(bf16, WS_YEXP), WSP(float, WS_SELG)};
            pg8::gemm_phase<pg8::EpiDownBf16, pg8::GroupedOrder>(F.lds, g, S, E, nullptr, F.wave);
#endif
        }
        if (INL(12)) { LAUNDER(); phase_combine(F); }
        if (INL(13)) { LAUNDER();
#if NAIVE_GEMM
            EpiPle E{WSP(float, WS_H), WSP(bf16, WS_PL)}; naive_gemm(F, WSP(bf16, WS_HN), DM, (const bf16*)(wl + OFF_WPG), DM, T, DM, DM, E);
#else
            pg8::Gemm g{WSP(bf16, WS_HN), (const bf16*)(wl + OFF_WPG), T, DM, DM}; pg8::StaticOrder S; S.init(T, DM, F.G, (int)blockIdx.x); pg8::EpiPleBf16 E{WSP(bf16, WS_HN), WSP(bf16, WS_H), WSP(bf16, WS_PL), WSP(float, WS_RS) + 2 * T};
            pg8::gemm_phase<pg8::EpiPleBf16, pg8::StaticOrder>(F.lds, g, S, E, nullptr, F.wave);
#endif
        }
}

__global__ void __launch_bounds__(NTHR, 2) mk_fwd(Args args) {
    extern __shared__ __attribute__((aligned(16))) unsigned char lds_raw[];
    Frame F;
    F.lds = (LAS unsigned char*)lds_raw;
    const int wave0 = __builtin_amdgcn_readfirstlane((int)threadIdx.x >> 6);
    F.wave = wave0; F.tid = wave0 * 64 + lane_id(); F.lane = F.tid & 63;
    F.G = gridDim.x; { const int bx = blockIdx.x; F.vcu = (F.G % 8 == 0) ? (bx % 8) * (F.G / 8) + bx / 8 : bx; }
    const int vcu0 = F.vcu;
    F.in = (const float* const __attribute__((address_space(4)))*)__builtin_amdgcn_kernarg_segment_ptr(); F.out = args.out; F.ws = args.ws;
    const int lo = args.ph_lo, hi = args.ph_hi;
    volatile LAS unsigned* misc = (volatile LAS unsigned*)(F.lds + LDS_MISC);
#ifdef CHECK_NAN_FILL
    for (int i = F.tid; i < LDS_MISC / 4; i += NTHR) ((LAS unsigned*)F.lds)[i] = 0xffffffffu;
    __syncthreads();
#endif
    if (F.tid < 4) misc[F.tid] = 0u;
    __syncthreads();
    XcdBarrier bar; bar.bar = (unsigned*)(args.ws + WS_CTL) + CW_BAR; bar.x = 0; bar.st = misc; bar.w0 = wave0;
    if (hi - lo > 1) bar = xcd_barrier_post((unsigned*)(args.ws + WS_CTL) + CW_BAR, misc, wave0);
    if (EN(0) && IN(0)) REPEAT(0) phase_prologue(F);
    layer_phases<0>(F, args, bar, lo, hi, vcu0, lds_raw, wave0);
    layer_phases<1>(F, args, bar, lo, hi, vcu0, lds_raw, wave0);
    layer_phases<2>(F, args, bar, lo, hi, vcu0, lds_raw, wave0);
    layer_phases<3>(F, args, bar, lo, hi, vcu0, lds_raw, wave0);
#ifdef DBG_CHECKSUM
    if (IN(NPHASES - 1)) { xcd_barrier(bar); LAUNDER(); dbg_checksum(F); xcd_barrier(bar); const unsigned code = dbg_compare(F); xcd_barrier(bar); dbg_store_prev(F); phase_final(F, 1.0f + (float)code); }
#else
    if (EN(15) && IN(NPHASES - 1) && seam(NPHASES - 1)) phase_final(F, 1.0f);
#endif
#undef IN
#undef INL
#undef seam
#undef wl
}

extern "C" void kernel_launch(void* const* d_in, const int* in_sizes, int n_in, void* d_out, int out_size, void* d_ws, size_t ws_size, hipStream_t stream) {
    static int grid = 0;
    if (grid == 0) {
        if (n_in != 22 || out_size != T * DM || ws_size < WS_END) { fprintf(stderr, "kernel_launch: unexpected shapes (n_in %d out %d ws %zu need %zu)\n", n_in, out_size, ws_size, (size_t)WS_END); grid = -1; return; }
        int dev = 0, cus = 0;
        if (hipGetDevice(&dev) != hipSuccess || hipDeviceGetAttribute(&cus, hipDeviceAttributeMultiprocessorCount, dev) != hipSuccess) { grid = -1; return; }
        if (hipFuncSetAttribute((const void*)mk_fwd, hipFuncAttributeMaxDynamicSharedMemorySize, LDS_BYTES) != hipSuccess) { fprintf(stderr, "kernel_launch: hipFuncSetAttribute failed\n"); grid = -1; return; }
        grid = cus;
    }
    if (grid < 0) return;
    Args a{};
    for (int i = 0; i < 22; ++i) a.in[i] = (const float*)d_in[i];
    a.out = (float*)d_out; a.ws = (unsigned char*)d_ws;
    if (hipMemsetAsync((char*)d_ws + WS_CTL, 0, CTL_BYTES, stream) != hipSuccess) { fprintf(stderr, "kernel_launch: memset failed\n"); return; }
#if N_LAUNCH_PER_PHASE
    for (int ph = 0; ph < NPHASES; ++ph) {
        a.ph_lo = ph; a.ph_hi = ph + 1;
        hipLaunchKernelGGL(mk_fwd, dim3(grid), dim3(NTHR), LDS_BYTES, stream, a);
    }
#else
    a.ph_lo = 0; a.ph_hi = NPHASES;
    hipLaunchKernelGGL(mk_fwd, dim3(grid), dim3(NTHR), LDS_BYTES, stream, a);
#endif
}
```

```cpp
#include <hip/hip_runtime.h>
#include <cstdio>
#include <cstdint>

#define LAS __attribute__((address_space(3)))
#define GAS __attribute__((address_space(1)))
typedef unsigned short bf16;
typedef float f32x4 __attribute__((ext_vector_type(4)));
typedef unsigned u32x4 __attribute__((ext_vector_type(4)));
typedef unsigned u32x2 __attribute__((ext_vector_type(2)));
typedef short bf16x8 __attribute__((ext_vector_type(8)));

constexpr int BATCH = 2, SEQ = 4096, T = BATCH * SEQ, DM = 2048, DEPTH = 4, HD = 128;
constexpr int DIN = 5136, DINP = 5120;
constexpr int COL_AQ = 0, COL_AK = 512, COL_AV = 1024, COL_BQ = 1536, COL_BK = 2560, COL_BV = 2816, COL_CQKV = 3072, COL_CZ = 4608;
constexpr int NE = 16, CAP = 512, EFF = 1024, PLE = 256;
constexpr float EPS = 1e-6f;
constexpr int NWAVES = 8, NTHR = 512;
constexpr int LDS_BYTES = 147456, LDS_MISC = 147456 - 256;
constexpr int CW_SCAN = 32768;
constexpr int CW_BAR = 4096;

constexpr size_t al256(size_t x) { return (x + 255) / 256 * 256; }
constexpr size_t WS_CTL = 0, CTL_BYTES = 1u << 20;
constexpr size_t SZ_WIN = (size_t)DINP * DM * 2, SZ_WOUT = (size_t)DM * DM * 2, SZ_WGU = (size_t)NE * 2048 * DM * 2, SZ_WD = (size_t)NE * DM * EFF * 2, SZ_WPG = (size_t)DM * DM * 2, SZ_WP = (size_t)DM * PLE * 2;
constexpr size_t SZ_LAYERW = SZ_WIN + SZ_WOUT + SZ_WGU + SZ_WD + SZ_WPG + SZ_WP;
constexpr size_t OFF_WIN = 0, OFF_WOUT = OFF_WIN + SZ_WIN, OFF_WGU = OFF_WOUT + SZ_WOUT, OFF_WD = OFF_WGU + SZ_WGU, OFF_WPG = OFF_WD + SZ_WD, OFF_WP = OFF_WPG + SZ_WPG;
constexpr size_t WS_W = WS_CTL + CTL_BYTES;
constexpr size_t WS_PB = WS_W + DEPTH * SZ_LAYERW;
constexpr size_t WS_TABA = WS_PB + (size_t)DEPTH * T * PLE * 2;
constexpr size_t WS_TABB = WS_TABA + (size_t)SEQ * 16 * 8;
constexpr size_t WS_H = al256(WS_TABB + 64 * 32 * 8);
constexpr size_t WS_HN = WS_H + (size_t)T * DM * 4;
constexpr size_t WS_TL = WS_HN + (size_t)T * DM * 2;
constexpr size_t WS_PROJ = WS_TL + (size_t)T * 16 * 4;
constexpr size_t WS_YMIX = WS_PROJ + (size_t)T * DINP * 2;
constexpr size_t WS_Y = WS_YMIX + (size_t)T * DM * 4;
constexpr size_t WS_AFF = WS_Y + (size_t)T * DM * 2;
constexpr size_t WS_SELI = WS_AFF + (size_t)T * 16 * 4;
constexpr size_t WS_SELG = WS_SELI + (size_t)BATCH * NE * CAP * 4;
constexpr size_t WS_SLOT = WS_SELG + (size_t)BATCH * NE * CAP * 4;
constexpr size_t WS_XS = WS_SLOT + (size_t)BATCH * NE * SEQ * 4;
constexpr size_t WS_HID = WS_XS + (size_t)NE * 1024 * DM * 2;
constexpr size_t WS_YEXP = WS_HID + (size_t)NE * 1024 * EFF * 2;
constexpr size_t WS_PL = WS_YEXP + (size_t)NE * 1024 * DM * 2;
constexpr size_t WS_DQ = WS_PL + (size_t)T * DM * 2;
constexpr size_t WS_DK = WS_DQ + (size_t)T * 512 * 4;
constexpr size_t WS_DV = WS_DK + (size_t)T * 512 * 4;
constexpr size_t WS_DB = WS_DV + (size_t)T * 512 * 4;
constexpr size_t WS_DG = WS_DB + (size_t)2 * T * 4 * 4;
constexpr size_t WS_DO = WS_DG + (size_t)2 * T * 4 * 4;
constexpr size_t WS_TMP = al256(WS_DO + (size_t)2 * T * 512 * 4);
constexpr size_t WS_CM = WS_TMP + (size_t)NE * 1024 * 2048 * 4;
constexpr size_t WS_CN = WS_CM + (size_t)16 * 64 * 128 * 128 * 2;
constexpr size_t WS_CS = WS_CN + (size_t)16 * 64 * 128 * 128 * 2;
constexpr size_t WS_CP = WS_CS + (size_t)16 * 64 * 128 * 128 * 2;
constexpr size_t WS_CR = WS_CP + (size_t)16 * 64 * 64 * 128 * 2;
constexpr size_t WS_END = WS_CR + (size_t)16 * 64 * 64 * 128 * 4;
constexpr size_t WS_RS = WS_XS;
constexpr size_t WS_SELR = WS_XS + (size_t)3 * T * 4;
constexpr size_t WS_WTL = WS_SELR + (size_t)NE * 1024 * 4;
static_assert(WS_END < 2140000000ull, "workspace map");

__device__ const double INV_A[16] = {1.0, 0.44036660267178046, 0.19392274474868576, 0.08539710028576561, 0.03760603093086393, 0.016560440080994443, 0.0072926647372171085, 0.003211445994752591, 0.0014142135623730952, 0.000622772421914596, 0.0002742481756762073, 0.00012076973741146504, 5.318295896944988e-05, 2.341999896140934e-05, 1.0313385377212458e-05, 4.5416704806078695e-06};
__device__ const double INV_B[32] = {1.0, 0.7498942093324559, 0.5623413251903491, 0.4216965034285822, 0.31622776601683794, 0.23713737056616552, 0.1778279410038923, 0.1333521432163324, 0.09999999999999999, 0.07498942093324558, 0.056234132519034905, 0.042169650342858224, 0.03162277660168379, 0.023713737056616554, 0.01778279410038923, 0.013335214321633239, 0.01, 0.007498942093324559, 0.005623413251903491, 0.004216965034285822, 0.0031622776601683794, 0.002371373705661655, 0.0017782794100389228, 0.0013335214321633238, 0.001, 0.0007498942093324559, 0.000562341325190349, 0.00042169650342858224, 0.00031622776601683794, 0.00023713737056616554, 0.0001778279410038923, 0.0001333521432163324};

#ifndef N_LAUNCH_PER_PHASE
#define N_LAUNCH_PER_PHASE 0
#endif
#ifndef NAIVE_DN
#define NAIVE_DN 0
#endif
#ifndef NAIVE_ATTN_A
#define NAIVE_ATTN_A 0
#endif
#ifndef NAIVE_ATTN_B
#define NAIVE_ATTN_B 0
#endif
__device__ __forceinline__ int lane_id() { int l; asm volatile("v_mbcnt_lo_u32_b32 %0, -1, 0\n\tv_mbcnt_hi_u32_b32 %0, -1, %0" : "=v"(l)); return l; }
#define TIDX(w0) ((w0) * 64 + lane_id())
__device__ __forceinline__ float bperm(float v, int src_lane) { return __int_as_float(__builtin_amdgcn_ds_bpermute(src_lane << 2, __float_as_int(v))); }
typedef __bf16 bf16v2_t __attribute__((ext_vector_type(2)));
typedef float f32v2_t __attribute__((ext_vector_type(2)));
__device__ __forceinline__ unsigned cvt_pk_rne(float lo, float hi) { const f32v2_t v = {lo, hi}; return __builtin_bit_cast(unsigned, __builtin_convertvector(v, bf16v2_t)); }
__device__ __forceinline__ float bf2f(bf16 b) { return __uint_as_float(((unsigned)b) << 16); }
__device__ __forceinline__ unsigned f2bf(float f) { unsigned u = __float_as_uint(f); return (u + 0x7fffu + ((u >> 16) & 1u)) >> 16; }
__device__ __forceinline__ unsigned pk2(float lo, float hi) { return cvt_pk_rne(lo, hi); }
__device__ __forceinline__ float wave_sum(float v) {
#pragma unroll
    for (int o = 1; o < 64; o <<= 1) v += __shfl_xor(v, o);
    return v;
}
__device__ __forceinline__ float wave_max(float v) {
#pragma unroll
    for (int o = 1; o < 64; o <<= 1) v = fmaxf(v, __shfl_xor(v, o));
    return v;
}
__device__ __forceinline__ float sigmoidf_(float x) { return __builtin_amdgcn_rcpf(1.0f + __expf(-x)); }
__device__ __forceinline__ float siluf_(float x) { return x * __builtin_amdgcn_rcpf(1.0f + __expf(-x)); }
__device__ __forceinline__ float softplusf_(float x) { const float e = __expf(-fabsf(x)); const float lg = e < 1e-3f ? e * (1.0f - 0.5f * e + 0.33333333f * e * e) : __logf(1.0f + e); return fmaxf(x, 0.f) + lg; }
__device__ __forceinline__ void sincos_d(double a, float& c, float& s) {
    const double q = rint(a * 0.63661977236758134308);
    const double r = (a - q * 1.57079632679489655800) - q * 6.12323399573676603587e-17;
    const double r2 = r * r;
    double sp = 1.0 / 6227020800.0; sp = sp * r2 * -1.0 + 1.0 / 39916800.0; sp = sp * -r2 + 1.0 / 362880.0; sp = sp * -r2 + 1.0 / 5040.0; sp = sp * -r2 + 1.0 / 120.0; sp = sp * -r2 + 1.0 / 6.0; sp = sp * -r2 + 1.0;
    const double sr = r * sp;
    double cp = 1.0 / 87178291200.0; cp = cp * -r2 + 1.0 / 479001600.0; cp = cp * -r2 + 1.0 / 3628800.0; cp = cp * -r2 + 1.0 / 40320.0; cp = cp * -r2 + 1.0 / 720.0; cp = cp * -r2 + 1.0 / 24.0; cp = cp * -r2 + 0.5; cp = cp * -r2 + 1.0;
    const double cr = cp;
    const long long qi = (long long)q; const int m = (int)(qi & 3);
    double cs, sn;
    if (m == 0) { cs = cr; sn = sr; } else if (m == 1) { cs = -sr; sn = cr; } else if (m == 2) { cs = -cr; sn = -sr; } else { cs = sr; sn = -cr; }
    c = (float)cs; s = (float)sn;
}


#define XB_TMO      128
#define XB_XCNT(j)  (256  + 64 * (j))
#define XB_XSUB(j)  (1280 + 64 * (j))
#define XB_XGEN(j)  (2304 + 64 * (j))
#define XB_TOP      3328
#define XB_TOPGEN   3392
#define XCD_BAR_WORDS 3456
#define XB_SPIN_CAP (1u << 22)

__device__ __forceinline__ unsigned xb_ld(unsigned* p)              { return __hip_atomic_load(p, __ATOMIC_RELAXED, __HIP_MEMORY_SCOPE_AGENT); }
__device__ __forceinline__ unsigned xb_add(unsigned* p, unsigned v) { return __hip_atomic_fetch_add(p, v, __ATOMIC_RELAXED, __HIP_MEMORY_SCOPE_AGENT); }
__device__ __forceinline__ unsigned xb_xcc_id() { return (unsigned)__builtin_amdgcn_s_getreg((3 << 11) | 20) & 0xFu; }
#define XB_SPIN(cond, bar) do { unsigned _sp = 0; while (cond) { __builtin_amdgcn_s_sleep(1); \
    if ((++_sp & 255u) == 0u) { if (xb_ld(&(bar)[XB_TMO])) break; if (_sp > XB_SPIN_CAP) { atomicAdd(&(bar)[XB_TMO], 1u); break; } } } } while (0)

struct XcdBarrier {
    unsigned* bar; unsigned x; int w0;
    volatile LAS unsigned* st;
};

__device__ __forceinline__ XcdBarrier xcd_barrier_post(unsigned* bar, volatile LAS unsigned* st, int w0) {
    XcdBarrier b; b.bar = bar; b.x = xb_xcc_id(); b.st = st; b.w0 = w0;
    if (TIDX(w0) == 0) (void)xb_add(&bar[XB_XCNT(b.x)], 1u);
    return b;
}
__device__ __forceinline__ void xcd_barrier_complete(unsigned* bar, unsigned x, unsigned& nloc, unsigned& nx) {
    const unsigned G = gridDim.x * gridDim.y * gridDim.z;
    unsigned sum, cnt, mine, sp = 0u;
    for (;;) {
        sum = 0u; cnt = 0u; mine = 0u;
#pragma unroll
        for (unsigned j = 0; j < 16; ++j) { const unsigned c = xb_ld(&bar[XB_XCNT(j)]); sum += c; cnt += (c > 0u) ? 1u : 0u; mine = (j == x) ? c : mine; }
        if (sum == G) break;
        __builtin_amdgcn_s_sleep(1);
        if ((++sp & 255u) == 0u) { if (xb_ld(&bar[XB_TMO])) break; if (sp > XB_SPIN_CAP) { atomicAdd(&bar[XB_TMO], 1u); break; } }
    }
    nloc = mine > 0u ? mine : 1u; nx = cnt > 0u ? cnt : 1u;
}

__device__ __forceinline__ void xcd_barrier(const XcdBarrier& b) {
    asm volatile("s_waitcnt vmcnt(0)" ::: "memory");
    __syncthreads();
    if (TIDX(b.w0) == 0) {
        unsigned* bar = b.bar;
        __builtin_amdgcn_s_waitcnt(0);
        unsigned nloc = b.st[0], nx = b.st[1];
        if (nloc == 0u) { xcd_barrier_complete(bar, b.x, nloc, nx); b.st[0] = nloc; b.st[1] = nx; }
        const unsigned old = xb_add(&bar[XB_XSUB(b.x)], 1u);
        const unsigned gen = old / nloc;
        if (old + 1u == (gen + 1u) * nloc) {
            __builtin_amdgcn_fence(__ATOMIC_RELEASE, "agent");
            asm volatile("s_waitcnt vmcnt(0)" ::: "memory");
            const unsigned og = xb_add(&bar[XB_TOP], 1u);
            const unsigned tg = og / nx;
            if (og + 1u == (tg + 1u) * nx) xb_add(&bar[XB_TOPGEN], 1u);
            else XB_SPIN(xb_ld(&bar[XB_TOPGEN]) == tg, bar);
            __builtin_amdgcn_fence(__ATOMIC_ACQUIRE, "agent");
            xb_add(&bar[XB_XGEN(b.x)], 1u);
            asm volatile("s_waitcnt vmcnt(0)" ::: "memory");
        } else {
            XB_SPIN(xb_ld(&bar[XB_XGEN(b.x)]) == gen, bar);
            __builtin_amdgcn_fence(__ATOMIC_ACQUIRE, "agent");
            asm volatile("s_waitcnt vmcnt(0)" ::: "memory");
        }
    }
    __syncthreads();
}

__device__ __forceinline__ void bar_sync(XcdBarrier& b, unsigned* words) { GAS unsigned* w = (GAS unsigned*)words; asm volatile("" : "+s"(w)); b.bar = (unsigned*)w; xcd_barrier(b); }

#define GIN(k) ((const float*)(const GAS float*)F.in[k])
struct Frame {
    LAS unsigned char* lds;
    int tid, lane, wave, vcu, G;
    const float* const __attribute__((address_space(4)))* in;
    float* out;
    unsigned char* ws;
};
#define WSP(type, off) ((type*)(F.ws + (off)))

template <bool GAM>
__device__ __forceinline__ void transpose_item(const float* __restrict__ W, int ldw, bf16* __restrict__ WT, int ldt, int k0, int n0, size_t drow0, LAS unsigned* scr, int lane, const float* __restrict__ gam) {
    const float* src = W + (size_t)k0 * ldw + n0 + lane;
    unsigned g0 = 0u, g1 = 0u;
    if (GAM) { const u32x2 gp = *(const u32x2*)(gam + k0 + 2 * lane); g0 = gp.x; g1 = gp.y; }
#pragma unroll 8
    for (int kk = 0; kk < 64; ++kk) { float v0 = __builtin_nontemporal_load(src + (size_t)(2 * kk) * ldw), v1 = __builtin_nontemporal_load(src + (size_t)(2 * kk + 1) * ldw);
        if (GAM) { v0 *= __uint_as_float(__builtin_amdgcn_readlane(g0, kk)); v1 *= __uint_as_float(__builtin_amdgcn_readlane(g1, kk)); }
        scr[lane * 65 + kk] = pk2(v0, v1); }
    asm volatile("s_waitcnt lgkmcnt(0)" ::: "memory");
    const int c = lane & 15;
#pragma unroll
    for (int j = 0; j < 16; ++j) { const int n = (lane >> 4) + 4 * j; const LAS unsigned* sp = scr + n * 65 + 4 * c;
        u32x4 o; o.x = sp[0]; o.y = sp[1]; o.z = sp[2]; o.w = sp[3];
        __builtin_nontemporal_store(o, (u32x4*)(WT + (drow0 + n) * (size_t)ldt + k0 + 8 * c)); }
    asm volatile("s_waitcnt lgkmcnt(0)" ::: "memory");
}
__device__ __forceinline__ void phase_prologue(Frame& F) {
    LAS unsigned* scr = (LAS unsigned*)(F.lds + F.wave * 16640);
    const int gw = F.vcu * NWAVES + F.wave, NGW = F.G * NWAVES;
    constexpr int I_IN = 16 * 80, I_OUT = 16 * 32, I_G = 16 * 16 * 16, I_D = 16 * 8 * 32, I_P = 2 * 32, I_PG = 16 * 32;
    constexpr int I_LAYER = I_IN + I_OUT + 2 * I_G + I_D + I_P + I_PG;
    for (int it = gw; it < DEPTH * I_LAYER; it += NGW) {
        const int l = it / I_LAYER; int r = it % I_LAYER;
#define wl (F.ws + WS_W + (size_t)l * SZ_LAYERW)
        if (r < I_IN) { const int kb = r / 80, nb = r % 80; transpose_item<true>(GIN(3) + (size_t)l * DM * DIN, DIN, (bf16*)(wl + OFF_WIN), DM, kb * 128, nb * 64, (size_t)nb * 64, scr, F.lane, GIN(2) + (size_t)l * DM); continue; } r -= I_IN;
        if (r < I_OUT) { const int kb = r / 32, nb = r % 32; transpose_item<false>(GIN(12) + (size_t)l * DM * DM, DM, (bf16*)(wl + OFF_WOUT), DM, kb * 128, nb * 64, (size_t)nb * 64, scr, F.lane, nullptr); continue; } r -= I_OUT;
        if (r < 2 * I_G) { const int up = r / I_G; r %= I_G; const int e = r / 256, q = r % 256, kb = q / 16, nb = q % 16, n0 = nb * 64;
            const float* src = (up ? GIN(16) : GIN(15)) + ((size_t)(l * NE + e) * DM) * EFF;
            transpose_item<true>(src, EFF, (bf16*)(wl + OFF_WGU), DM, kb * 128, n0, (size_t)e * 2048 + (n0 / 128) * 256 + (n0 % 128) + up * 128, scr, F.lane, GIN(13) + (size_t)l * DM); continue; } r -= 2 * I_G;
        if (r < I_D) { const int e = r / 256, q = r % 256, kb = q / 32, nb = q % 32;
            transpose_item<false>(GIN(17) + ((size_t)(l * NE + e) * EFF) * DM, DM, (bf16*)(wl + OFF_WD), EFF, kb * 128, nb * 64, (size_t)e * 2048 + nb * 64, scr, F.lane, nullptr); continue; } r -= I_D;
        if (r < I_P) { const int kb = r / 32, nb = r % 32; transpose_item<false>(GIN(19) + (size_t)l * PLE * DM, DM, (bf16*)(wl + OFF_WP), PLE, kb * 128, nb * 64, (size_t)nb * 64, scr, F.lane, nullptr); continue; } r -= I_P;
        { const int kb = r / 32, nb = r % 32; transpose_item<true>(GIN(20) + (size_t)l * DM * DM, DM, (bf16*)(wl + OFF_WPG), DM, kb * 128, nb * 64, (size_t)nb * 64, scr, F.lane, GIN(18) + (size_t)l * DM); }
    }
    const size_t gt = (size_t)F.vcu * NTHR + (size_t)(F.wave * 64 + lane_id()), NT = (size_t)F.G * NTHR;
    { const f32x4* src = (const f32x4*)GIN(1); u32x2* dst = WSP(u32x2, WS_PB);
      for (size_t i = gt; i < (size_t)DEPTH * T * PLE / 4; i += NT) { const f32x4 v = src[i]; u32x2 o; o.x = pk2(v.x, v.y); o.y = pk2(v.z, v.w); dst[i] = o; } }
    { const f32x4* src = (const f32x4*)GIN(0); u32x2* dst = WSP(u32x2, WS_H);
      for (size_t i = gt; i < (size_t)T * DM / 4; i += NT) { const f32x4 v = src[i]; u32x2 o; o.x = pk2(v.x, v.y); o.y = pk2(v.z, v.w); dst[i] = o; } }
#ifdef CHECK_NAN_FILL
    { u32x4* dst = WSP(u32x4, WS_CM); const u32x4 nn = {0xffffffffu, 0xffffffffu, 0xffffffffu, 0xffffffffu};
      for (size_t i = gt; i < (WS_END - WS_CM) / 16; i += NT) dst[i] = nn;
      u32x4* d2 = WSP(u32x4, WS_YMIX); for (size_t i = gt; i < (WS_XS - WS_YMIX) / 16; i += NT) d2[i] = nn; }
#endif
    { float* dst = WSP(float, WS_WTL);
      for (size_t i = gt; i < (size_t)DEPTH * 2 * 16 * DM; i += NT) { const int ls = (int)(i >> 15), l = ls >> 1, sset = ls & 1, k = (int)(i >> 4) & (DM - 1), c = (int)i & 15;
          const float* w = sset ? GIN(14) + (size_t)l * DM * NE : GIN(3) + (size_t)l * DM * DIN + DINP; const int ldw = sset ? NE : DIN; const float* g = (sset ? GIN(13) : GIN(2)) + (size_t)l * DM;
          dst[((size_t)ls * 16 + c) * DM + k] = g[k] * w[(size_t)k * ldw + c]; } }
    { float2* ta = WSP(float2, WS_TABA); for (size_t i = gt; i < (size_t)SEQ * 16; i += NT) { const int s = (int)(i >> 4), j = (int)(i & 15); float c, sn; sincos_d((double)s * INV_A[j], c, sn); ta[i] = make_float2(c, sn); }
      float2* tb = WSP(float2, WS_TABB); for (size_t i = gt; i < 64 * 32; i += NT) { const int s = (int)(i >> 5), j = (int)(i & 31); float c, sn; sincos_d((double)s * INV_B[j], c, sn); tb[i] = make_float2(c, sn); } }
}

template <int MODE>
__device__ __forceinline__ void phase_norm(Frame& F, const float* __restrict__ wtg, float* __restrict__ out16, float* __restrict__ rsout) {
    const bf16* H = WSP(bf16, WS_H);
    LAS float* wT = (LAS float*)F.lds;
#pragma unroll 1
    for (int h = 0; h < 2; ++h) { f32x4 st[8];
#pragma unroll
      for (int i = 0; i < 8; ++i) st[i] = *(const f32x4*)(wtg + 4 * (F.tid + NTHR * (8 * h + i)));
#pragma unroll
      for (int i = 0; i < 8; ++i) *(LAS f32x4*)(wT + 4 * (F.tid + NTHR * (8 * h + i))) = st[i]; }
    __syncthreads();
    const int gw = F.vcu * NWAVES + F.wave, NGW = F.G * NWAVES, lane = F.lane;
    for (int r0 = gw * 4; r0 < T; r0 += NGW * 4) {
        f32x4 v[4][8];
#pragma unroll
        for (int rr = 0; rr < 4; ++rr) { const bf16* hr = H + (size_t)(r0 + rr) * DM; float ss = 0.f;
#pragma unroll
            for (int j = 0; j < 8; ++j) { const u32x2 hw = *(const u32x2*)(hr + 4 * lane + 256 * j); v[rr][j].x = __uint_as_float(hw.x << 16); v[rr][j].y = __uint_as_float(hw.x & 0xffff0000u); v[rr][j].z = __uint_as_float(hw.y << 16); v[rr][j].w = __uint_as_float(hw.y & 0xffff0000u); ss += (v[rr][j].x * v[rr][j].x + v[rr][j].y * v[rr][j].y) + (v[rr][j].z * v[rr][j].z + v[rr][j].w * v[rr][j].w); }
            const float rs = rsqrtf(wave_sum(ss) * (1.0f / DM) + EPS); if (lane == 0) rsout[r0 + rr] = rs;
#pragma unroll
            for (int j = 0; j < 8; ++j) v[rr][j] = v[rr][j] * rs; }
        float a[64];
#pragma unroll
        for (int c = 0; c < 16; ++c) { float p0 = 0.f, p1 = 0.f, p2 = 0.f, p3 = 0.f; asm volatile("" ::: "memory");
#pragma unroll
            for (int j = 0; j < 8; ++j) { const f32x4 w = *(const LAS f32x4*)(wT + c * DM + 4 * lane + 256 * j);
                p0 += (v[0][j].x * w.x + v[0][j].y * w.y) + (v[0][j].z * w.z + v[0][j].w * w.w); p1 += (v[1][j].x * w.x + v[1][j].y * w.y) + (v[1][j].z * w.z + v[1][j].w * w.w);
                p2 += (v[2][j].x * w.x + v[2][j].y * w.y) + (v[2][j].z * w.z + v[2][j].w * w.w); p3 += (v[3][j].x * w.x + v[3][j].y * w.y) + (v[3][j].z * w.z + v[3][j].w * w.w); }
            a[c] = p0; a[16 + c] = p1; a[32 + c] = p2; a[48 + c] = p3; }
#define TR_STEP(N, M) _Pragma("unroll") for (int k = 0; k < (N) / 2; ++k) { const bool up = (lane & (M)) != 0; const float keep = up ? a[k + (N) / 2] : a[k], send = up ? a[k] : a[k + (N) / 2]; a[k] = keep + __shfl_xor(send, (M)); }
        TR_STEP(64, 32) TR_STEP(32, 16) TR_STEP(16, 8) TR_STEP(8, 4) TR_STEP(4, 2) TR_STEP(2, 1)
#undef TR_STEP
        float mine = a[0];
        if (MODE == 2) { float m = mine; m = fmaxf(m, __shfl_xor(m, 1)); m = fmaxf(m, __shfl_xor(m, 2)); m = fmaxf(m, __shfl_xor(m, 4)); m = fmaxf(m, __shfl_xor(m, 8));
            const float e = expf(mine - m); float sden = e; sden += __shfl_xor(sden, 1); sden += __shfl_xor(sden, 2); sden += __shfl_xor(sden, 4); sden += __shfl_xor(sden, 8); mine = e / sden; }
        out16[(size_t)r0 * 16 + lane] = mine;
    }
}

namespace pg8 {
#define PG8_LAS __attribute__((address_space(3)))
typedef unsigned short bf16_t;
typedef short bf16x8 __attribute__((ext_vector_type(8)));
typedef float f32x4 __attribute__((ext_vector_type(4)));
typedef unsigned u32x4 __attribute__((ext_vector_type(4)));
constexpr int BM = 256, BK = 64, HALF = 128, HTB = HALF * BK * 2, STAGE_BYTES = 8 * HTB, NXCD = 8, WGM = 8;
__host__ __device__ __forceinline__ int lds_byte(int r, int c) { const int st = (r >> 4) * 2 + (c >> 5), rr = r & 15, cc = c & 31, ob = rr * 64 + cc * 2; return st * 1024 + (ob ^ (((ob >> 9) & 1) << 5)); }
__host__ __device__ __forceinline__ void stage_rc(int b, int& R, int& C) { const int st = b / 1024, sb = b % 1024, swz = sb ^ (((sb >> 9) & 1) << 5); R = (st >> 1) * 16 + swz / 64; C = (st & 1) * 32 + (swz % 64) / 2; }
__host__ __device__ __forceinline__ int perm32(int rho) { const int n = rho >> 4, i = rho & 15; return 8 * (i >> 2) + 4 * n + (i & 3); }
struct Unit { int pm, pn; };
struct Gemm { const bf16_t* A; const bf16_t* Bt; int M, N, K; };
struct StaticOrder {
    static constexpr bool GATHER = false;
    int nM, nN, nwg, G, c;
    __host__ __device__ void init(int M, int N, int G_, int c_) { nM = M / BM; nN = N / BM; nwg = nM * nN; G = G_; c = c_; }
    __host__ __device__ bool next(int i, Unit& u) const {
        const long L = (long)i * G + c; if (L >= nwg) return false;
        int wgid = (int)L; { const int q = nwg / NXCD, r = nwg % NXCD, xcd = wgid % NXCD, off = wgid / NXCD; wgid = (xcd < r ? xcd * (q + 1) : r * (q + 1) + (xcd - r) * q) + off; }
        const int nig = WGM * nN, gid = wgid / nig, fm = gid * WGM, gsz = (nM - fm) < WGM ? (nM - fm) : WGM;
        u.pm = fm + ((wgid % nig) % gsz); u.pn = (wgid % nig) / gsz; return true;
    }
    __device__ __forceinline__ void a_ready(const Unit&) const {}
    __device__ __forceinline__ void done(const Unit&) const {}
};
struct TailOrder {
    static constexpr bool GATHER = false;
    int c, first;
    __device__ bool next(int i, Unit& u) const { if (c < first || c >= first + 128 || i >= 2) return false; const int L = (c - first) * 2 + i; u.pm = L >> 3; u.pn = L & 7; return true; }
    __device__ __forceinline__ void a_ready(const Unit&) const {}
    __device__ __forceinline__ void done(const Unit&) const {}
};
struct ShadowOrder {
    static constexpr bool GATHER = false;
    int c;
    __device__ bool next(int i, Unit& u) const { const int L = c + 224 * i; if (c < 0 || L >= 256) return false; u.pm = L >> 3; u.pn = L & 7; return true; }
    __device__ __forceinline__ void a_ready(const Unit&) const {}
    __device__ __forceinline__ void done(const Unit&) const {}
};
struct GroupedOrder {
    static constexpr bool GATHER = false;
    int G, c;
    __device__ bool next(int i, Unit& u) const { const int L = i * G + c; if (L >= 512) return false; const int e = L >> 5, w = L & 31; u.pm = 4 * e + (w & 3); u.pn = 8 * e + (w >> 2); return true; }
    __device__ __forceinline__ void a_ready(const Unit&) const {}
    __device__ __forceinline__ void done(const Unit&) const {}
};
struct GroupedGatherOrder {
    static constexpr bool GATHER = true;
    int G, c; const int* seli;
    __device__ bool next(int i, Unit& u) const { const int L = i * G + c; if (L >= 512) return false; const int e = L >> 5, w = L & 31; u.pm = 4 * e + (w & 3); u.pn = 8 * e + (w >> 2); return true; }
    __device__ __forceinline__ int arow(const Unit& u, int r) const { const int row = u.pm * 256 + r, e = row >> 10, q = row & 1023, b = q >> 9, slot = q & 511; return b * 4096 + seli[(b * 16 + e) * 512 + slot]; }
    __device__ __forceinline__ void a_ready(const Unit&) const {}
    __device__ __forceinline__ void done(const Unit&) const {}
};
__device__ __forceinline__ unsigned cvt_pk_bf16(float lo, float hi) { return cvt_pk_rne(lo, hi); }
struct EpiBf16 {
    static constexpr bool PERM = true, AFTER_DRAIN = false;
    bf16_t* O; int ldc;
    __device__ __forceinline__ void operator()(const f32x4 (&acc)[2][2][4][2], const Unit& u, int wr, int wc, int fr, int fq) const {
        const int row0 = u.pm * BM + wr * 64 + fr, col0 = u.pn * BM + wc * 32 + 8 * fq;
        asm volatile("s_nop 15\n\ts_nop 7" ::: "memory");
#pragma unroll
        for (int ai = 0; ai < 2; ++ai)
#pragma unroll
            for (int m = 0; m < 4; ++m) { bf16_t* rowp = O + (size_t)(row0 + ai * HALF + m * 16) * ldc + col0;
#pragma unroll
                for (int bj = 0; bj < 2; ++bj) { const f32x4 v0 = acc[ai][bj][m][0], v1 = acc[ai][bj][m][1];
                    u32x4 w; w.x = cvt_pk_bf16(v0[0], v0[1]); w.y = cvt_pk_bf16(v0[2], v0[3]); w.z = cvt_pk_bf16(v1[0], v1[1]); w.w = cvt_pk_bf16(v1[2], v1[3]);
                    *(u32x4*)(rowp + bj * HALF) = w; } }
    }
};
__device__ __forceinline__ float bfe(const u32x4& w, int e) { const unsigned x = w[e >> 1]; return __uint_as_float((e & 1) ? (x & 0xffff0000u) : (x << 16)); }
struct EpiBf16Rs {
    static constexpr bool PERM = true, AFTER_DRAIN = false;
    bf16_t* O; int ldc; const float* rs;
    __device__ __forceinline__ void operator()(const f32x4 (&acc)[2][2][4][2], const Unit& u, int wr, int wc, int fr, int fq) const {
        const int row0 = u.pm * BM + wr * 64 + fr, col0 = u.pn * BM + wc * 32 + 8 * fq;
#pragma unroll
        for (int ai = 0; ai < 2; ++ai)
#pragma unroll
            for (int m = 0; m < 4; ++m) { const int row = row0 + ai * HALF + m * 16; const float s = rs[row]; bf16_t* rowp = O + (size_t)row * ldc + col0;
#pragma unroll
                for (int bj = 0; bj < 2; ++bj) { const f32x4 v0 = acc[ai][bj][m][0] * s, v1 = acc[ai][bj][m][1] * s;
                    u32x4 w; w.x = cvt_pk_bf16(v0[0], v0[1]); w.y = cvt_pk_bf16(v0[2], v0[3]); w.z = cvt_pk_bf16(v1[0], v1[1]); w.w = cvt_pk_bf16(v1[2], v1[3]);
                    *(u32x4*)(rowp + bj * HALF) = w; } }
    }
};
struct EpiResidBf16 {
    static constexpr bool PERM = true, AFTER_DRAIN = false;
    bf16_t* H; int ldc;
    __device__ __forceinline__ void operator()(const f32x4 (&acc)[2][2][4][2], const Unit& u, int wr, int wc, int fr, int fq) const {
        const int row0 = u.pm * BM + wr * 64 + fr, col0 = u.pn * BM + wc * 32 + 8 * fq;
#pragma unroll
        for (int ai = 0; ai < 2; ++ai)
#pragma unroll
            for (int m = 0; m < 4; ++m) { bf16_t* rowp = H + (size_t)(row0 + ai * HALF + m * 16) * ldc + col0;
                u32x4 h[2];
#pragma unroll
                for (int bj = 0; bj < 2; ++bj) h[bj] = *(const u32x4*)(rowp + bj * HALF);
#pragma unroll
                for (int bj = 0; bj < 2; ++bj) { const f32x4 v0 = acc[ai][bj][m][0], v1 = acc[ai][bj][m][1];
                    u32x4 w; w.x = cvt_pk_bf16(bfe(h[bj], 0) + v0[0], bfe(h[bj], 1) + v0[1]); w.y = cvt_pk_bf16(bfe(h[bj], 2) + v0[2], bfe(h[bj], 3) + v0[3]);
                    w.z = cvt_pk_bf16(bfe(h[bj], 4) + v1[0], bfe(h[bj], 5) + v1[1]); w.w = cvt_pk_bf16(bfe(h[bj], 6) + v1[2], bfe(h[bj], 7) + v1[3]);
                    *(u32x4*)(rowp + bj * HALF) = w; }
                asm volatile("" ::: "memory"); }
    }
};
struct EpiPleBf16 {
    static constexpr bool PERM = true, AFTER_DRAIN = false;
    const bf16_t* Hin; bf16_t* Hout; const bf16_t* PL; const float* rs;
    __device__ __forceinline__ void operator()(const f32x4 (&acc)[2][2][4][2], const Unit& u, int wr, int wc, int fr, int fq) const {
        const int row0 = u.pm * BM + wr * 64 + fr, col0 = u.pn * BM + wc * 32 + 8 * fq;
#pragma unroll
        for (int ai = 0; ai < 2; ++ai)
#pragma unroll
            for (int m = 0; m < 4; ++m) { const int row = row0 + ai * HALF + m * 16; const float s = rs[row]; const size_t off = (size_t)row * 2048 + col0;
                u32x4 h[2], p[2];
#pragma unroll
                for (int bj = 0; bj < 2; ++bj) { h[bj] = *(const u32x4*)(Hin + off + bj * HALF); p[bj] = *(const u32x4*)(PL + off + bj * HALF); }
#pragma unroll
                for (int bj = 0; bj < 2; ++bj) { float o[8];
#pragma unroll
                    for (int e = 0; e < 8; ++e) { const float a = acc[ai][bj][m][e >> 2][e & 3] * s; o[e] = bfe(h[bj], e) + __builtin_amdgcn_rcpf(1.0f + __expf(-a)) * bfe(p[bj], e); }
                    u32x4 w; w.x = cvt_pk_bf16(o[0], o[1]); w.y = cvt_pk_bf16(o[2], o[3]); w.z = cvt_pk_bf16(o[4], o[5]); w.w = cvt_pk_bf16(o[6], o[7]);
                    *(u32x4*)(Hout + off + bj * HALF) = w; }
                asm volatile("" ::: "memory"); }
    }
};
struct EpiResidF32 {
    static constexpr bool PERM = false, AFTER_DRAIN = false;
    float* H; int ldc;
    __device__ __forceinline__ void operator()(const f32x4 (&acc)[2][2][4][2], const Unit& u, int wr, int wc, int fr, int fq) const {
        const int row0 = u.pm * BM + wr * 64 + fr, col0 = u.pn * BM + wc * 32 + 4 * fq;
#pragma unroll
        for (int ai = 0; ai < 2; ++ai)
#pragma unroll
            for (int m = 0; m < 4; ++m) { float* rowp = H + (size_t)(row0 + ai * HALF + m * 16) * ldc + col0;
                f32x4 h[2][2];
#pragma unroll
                for (int bj = 0; bj < 2; ++bj)
#pragma unroll
                    for (int n = 0; n < 2; ++n) h[bj][n] = *(const f32x4*)(rowp + bj * HALF + n * 16);
#pragma unroll
                for (int bj = 0; bj < 2; ++bj)
#pragma unroll
                    for (int n = 0; n < 2; ++n) *(f32x4*)(rowp + bj * HALF + n * 16) = h[bj][n] + acc[ai][bj][m][n];
                asm volatile("" ::: "memory"); }
    }
};
struct EpiGateUp {
    static constexpr bool PERM = true, AFTER_DRAIN = false;
    bf16_t* HID; const float* selr;
    __device__ __forceinline__ void operator()(const f32x4 (&acc)[2][2][4][2], const Unit& u, int wr, int wc, int fr, int fq) const {
        const int row0 = u.pm * BM + wr * 64 + fr, col0 = (u.pn & 7) * 128 + wc * 32 + 8 * fq;
#pragma unroll
        for (int ai = 0; ai < 2; ++ai)
#pragma unroll
            for (int m = 0; m < 4; ++m) { float o[8]; const float s = selr[row0 + ai * HALF + m * 16];
#pragma unroll
                for (int n = 0; n < 2; ++n)
#pragma unroll
                    for (int j = 0; j < 4; ++j) { const float g = acc[ai][0][m][n][j] * s, up = acc[ai][1][m][n][j] * s; o[4 * n + j] = g * __builtin_amdgcn_rcpf(1.0f + __expf(-g)) * up; }
                u32x4 w; w.x = cvt_pk_bf16(o[0], o[1]); w.y = cvt_pk_bf16(o[2], o[3]); w.z = cvt_pk_bf16(o[4], o[5]); w.w = cvt_pk_bf16(o[6], o[7]);
                *(u32x4*)(HID + (size_t)(row0 + ai * HALF + m * 16) * 1024 + col0) = w; }
    }
};
struct EpiDownBf16 {
    static constexpr bool PERM = true, AFTER_DRAIN = false;
    bf16_t* O; const float* gate;
    __device__ __forceinline__ void operator()(const f32x4 (&acc)[2][2][4][2], const Unit& u, int wr, int wc, int fr, int fq) const {
        const int row0 = u.pm * BM + wr * 64 + fr, col0 = (u.pn & 7) * BM + wc * 32 + 8 * fq;
#pragma unroll
        for (int ai = 0; ai < 2; ++ai)
#pragma unroll
            for (int m = 0; m < 4; ++m) { const int row = row0 + ai * HALF + m * 16; const float gt = gate[row]; bf16_t* rowp = O + (size_t)row * 2048 + col0;
#pragma unroll
                for (int bj = 0; bj < 2; ++bj) { const f32x4 v0 = acc[ai][bj][m][0] * gt, v1 = acc[ai][bj][m][1] * gt;
                    u32x4 w; w.x = cvt_pk_bf16(v0[0], v0[1]); w.y = cvt_pk_bf16(v0[2], v0[3]); w.z = cvt_pk_bf16(v1[0], v1[1]); w.w = cvt_pk_bf16(v1[2], v1[3]);
                    *(u32x4*)(rowp + bj * HALF) = w; } }
    }
};
struct EpiPleF32 {
    static constexpr bool PERM = false, AFTER_DRAIN = false;
    float* H; const bf16_t* PL;
    __device__ __forceinline__ void operator()(const f32x4 (&acc)[2][2][4][2], const Unit& u, int wr, int wc, int fr, int fq) const {
        typedef unsigned u32x2v __attribute__((ext_vector_type(2)));
        const int row0 = u.pm * BM + wr * 64 + fr, col0 = u.pn * BM + wc * 32 + 4 * fq;
#pragma unroll
        for (int ai = 0; ai < 2; ++ai)
#pragma unroll
            for (int m = 0; m < 4; ++m) { const size_t off = (size_t)(row0 + ai * HALF + m * 16) * 2048 + col0;
                f32x4 h[2][2]; u32x2v p[2][2];
#pragma unroll
                for (int bj = 0; bj < 2; ++bj)
#pragma unroll
                    for (int n = 0; n < 2; ++n) { h[bj][n] = *(const f32x4*)(H + off + bj * HALF + n * 16); p[bj][n] = *(const u32x2v*)(PL + off + bj * HALF + n * 16); }
#pragma unroll
                for (int bj = 0; bj < 2; ++bj)
#pragma unroll
                    for (int n = 0; n < 2; ++n) { const f32x4 a = acc[ai][bj][m][n]; f32x4 pl; pl[0] = __uint_as_float(p[bj][n].x << 16); pl[1] = __uint_as_float(p[bj][n].x & 0xffff0000u); pl[2] = __uint_as_float(p[bj][n].y << 16); pl[3] = __uint_as_float(p[bj][n].y & 0xffff0000u);
                        f32x4 o;
#pragma unroll
                        for (int j = 0; j < 4; ++j) o[j] = h[bj][n][j] + __builtin_amdgcn_rcpf(1.0f + __expf(-a[j])) * pl[j];
                        *(f32x4*)(H + off + bj * HALF + n * 16) = o; }
                asm volatile("" ::: "memory"); }
    }
};
template <class Epi, class Sched, bool STAMP = false>
__device__ __forceinline__ void gemm_phase(PG8_LAS unsigned char* lds, const Gemm g, const Sched& S, const Epi& E, unsigned long long* stamps, const int wave0) {
    int tid_ = wave0 * 64 + lane_id(); asm volatile("" : "+v"(tid_));
    const int tid = tid_, wid = __builtin_amdgcn_readfirstlane(tid >> 6), lane = tid & 63, wr = wid >> 2, wc = wid & 3, fr = lane & 15, fq = lane >> 4;
    const int K = g.K, nt = K / BK;
    int ts_lo = 0, ts_hi = 0, nts = 0; const unsigned long long rt_entry = STAMP ? (unsigned long long)wall_clock64() : 0ull;
#define PG8_STAMP() do { if (STAMP && wid == 0 && nts < 64) { const unsigned long long _c = (unsigned long long)clock64(); \
        ts_lo = (lane == nts) ? (int)(unsigned)_c : ts_lo; ts_hi = (lane == nts) ? (int)(unsigned)(_c >> 32) : ts_hi; ++nts; } } while (0)
    PG8_STAMP();
    unsigned voffA[2], voffB[2];
    unsigned gvc[2][2] = {{0u, 0u}, {0u, 0u}}, gvn[2][2] = {{0u, 0u}, {0u, 0u}}; int gR[2] = {0, 0}, gC[2] = {0, 0};
#pragma unroll
    for (int i = 0; i < 2; ++i) { int R, C; stage_rc(tid * 16 + i * 8192, R, C); const int Rb = Epi::PERM ? ((R & ~31) + perm32(R & 31)) : R;
        voffA[i] = (unsigned)(R * K + C) * 2u; voffB[i] = (unsigned)(Rb * K + C) * 2u; gR[i] = R; gC[i] = C; }
    const size_t kstep = (size_t)(BK * 2);
    const size_t hstep = (size_t)HALF * K * 2;
    const size_t tstep = 2 * hstep;
    const unsigned ldsw = (unsigned)wid * 1024u;
    const int aoff = lds_byte(wr * 64 + fr, fq * 8), boff = lds_byte(wc * 32 + fr, fq * 8);
#define PG8_SA(b, h) (((b) * 2 + (h)) * HTB)
#define PG8_SB(b, h) ((4 + (b) * 2 + (h)) * HTB)
#define PG8_STAGE(bufoff, gbase, voff) do { _Pragma("unroll") for (int _i = 0; _i < 2; ++_i) \
        __builtin_amdgcn_global_load_lds((const unsigned*)((const char*)(gbase) + (voff)[_i]), (PG8_LAS unsigned*)(lds + (bufoff) + ldsw + _i * 8192), 16, 0, 0); } while (0)
#define PG8_STAGE_A(bufoff, gbase, h, un) do { if constexpr (Sched::GATHER) { unsigned _o[2]; _o[0] = (un) ? gvn[h][0] : gvc[h][0]; _o[1] = (un) ? gvn[h][1] : gvc[h][1]; PG8_STAGE(bufoff, gbase, _o); } \
        else { PG8_STAGE(bufoff, (gbase) + ((h) ? hstep : (size_t)0), voffA); } } while (0)
#define PG8_GOFF(dst, u) do { _Pragma("unroll") for (int _h = 0; _h < 2; ++_h) _Pragma("unroll") for (int _i = 0; _i < 2; ++_i) dst[_h][_i] = ((unsigned)S.arow(u, _h * HALF + gR[_i]) * (unsigned)K + (unsigned)gC[_i]) * 2u; } while (0)
#define PG8_LDA(dst, b, h) do { _Pragma("unroll") for (int m = 0; m < 4; ++m) _Pragma("unroll") for (int k = 0; k < 2; ++k) dst[m][k] = *(const PG8_LAS bf16x8*)(lds + PG8_SA(b, h) + aoff + m * 2048 + k * 1024); } while (0)
#define PG8_LDB(dst, b, h) do { _Pragma("unroll") for (int n = 0; n < 2; ++n) _Pragma("unroll") for (int k = 0; k < 2; ++k) dst[n][k] = *(const PG8_LAS bf16x8*)(lds + PG8_SB(b, h) + boff + n * 2048 + k * 1024); } while (0)
#define PG8_MMA(ai, bj, At, Bt) do { __builtin_amdgcn_s_setprio(1); _Pragma("unroll") for (int m = 0; m < 4; ++m) _Pragma("unroll") for (int n = 0; n < 2; ++n) _Pragma("unroll") for (int k = 0; k < 2; ++k) \
        acc[ai][bj][m][n] = __builtin_amdgcn_mfma_f32_16x16x32_bf16(Bt[n][k], At[m][k], acc[ai][bj][m][n], 0, 0, 0); __builtin_amdgcn_s_setprio(0); } while (0)
#define PG8_WAIT_V(n) asm volatile("s_waitcnt vmcnt(" #n ")" ::: "memory")
#define PG8_WAIT_L(n) asm volatile("s_waitcnt lgkmcnt(" #n ")" ::: "memory")
#define PG8_BAR __builtin_amdgcn_s_barrier()
#define PG8_SCHED __builtin_amdgcn_sched_barrier(0)
    Unit cur, nxt; int ui = 0;
    if (!S.next(0, cur)) return;
    f32x4 acc[2][2][4][2];
#pragma unroll
    for (int a = 0; a < 2; ++a)
#pragma unroll
        for (int b = 0; b < 2; ++b)
#pragma unroll
            for (int m = 0; m < 4; ++m)
#pragma unroll
                for (int n = 0; n < 2; ++n) acc[a][b][m][n] = (f32x4){0.f, 0.f, 0.f, 0.f};
    bf16x8 At[4][2], B0[2][2], B1[2][2];
    const char* cA = (const char*)g.A + (Sched::GATHER ? (size_t)0 : (size_t)cur.pm * tstep); const char* cB = (const char*)g.Bt + (size_t)cur.pn * tstep;
    if constexpr (Sched::GATHER) PG8_GOFF(gvc, cur);
    S.a_ready(cur);
    PG8_STAGE(PG8_SB(0, 0), cB, voffB); PG8_STAGE_A(PG8_SA(0, 0), cA, 0, false); PG8_STAGE(PG8_SB(0, 1), cB + hstep, voffB); PG8_STAGE_A(PG8_SA(0, 1), cA, 1, false);
    if (wr == 1) PG8_BAR;
    PG8_WAIT_V(4); PG8_BAR;
    PG8_STAGE(PG8_SB(1, 0), cB + kstep, voffB); PG8_STAGE_A(PG8_SA(1, 0), cA + kstep, 0, false); PG8_STAGE(PG8_SB(1, 1), cB + hstep + kstep, voffB);
    PG8_WAIT_V(6); PG8_BAR;
    PG8_STAMP();
    for (;;) {
        const bool has_next = S.next(ui + 1, nxt);
        if constexpr (Sched::GATHER) { if (has_next) PG8_GOFF(gvn, nxt); }
        const char* nA = (has_next && !Sched::GATHER) ? (const char*)g.A + (size_t)nxt.pm * tstep : cA; const char* nB = has_next ? (const char*)g.Bt + (size_t)nxt.pn * tstep : cB;
        for (int t = 0; t < nt; t += 2) {
            const bool last = (t == nt - 2);
            const char* a1 = cA + (size_t)(t + 1) * kstep;
            const char* a2 = last ? nA : cA + (size_t)(t + 2) * kstep; const char* b2 = last ? nB : cB + (size_t)(t + 2) * kstep;
            const char* a3 = a2 + kstep; const char* b3 = b2 + kstep;
            if (last && has_next) S.a_ready(nxt);
            const bool un = last && has_next;
            PG8_LDB(B0, 0, 0); PG8_SCHED; PG8_LDA(At, 0, 0); PG8_STAGE_A(PG8_SA(1, 1), a1, 1, false);
            PG8_WAIT_L(8); PG8_BAR; PG8_WAIT_L(0); PG8_MMA(0, 0, At, B0); PG8_BAR; PG8_SCHED;
            PG8_LDB(B1, 0, 1); PG8_STAGE(PG8_SB(0, 0), b2, voffB);
            PG8_BAR; PG8_WAIT_L(0); PG8_MMA(0, 1, At, B1); PG8_BAR;
            PG8_LDA(At, 0, 1); PG8_STAGE_A(PG8_SA(0, 0), a2, 0, un);
            PG8_BAR; PG8_WAIT_L(0); PG8_MMA(1, 0, At, B0); PG8_BAR; PG8_SCHED;
            PG8_STAGE(PG8_SB(0, 1), b2 + hstep, voffB);
            PG8_WAIT_V(6); PG8_BAR; PG8_MMA(1, 1, At, B1); PG8_BAR;
            PG8_LDB(B0, 1, 0); PG8_SCHED; PG8_LDA(At, 1, 0); PG8_STAGE_A(PG8_SA(0, 1), a2, 1, un);
            PG8_WAIT_L(8); PG8_BAR; PG8_WAIT_L(0); PG8_MMA(0, 0, At, B0); PG8_BAR; PG8_SCHED;
            PG8_LDB(B1, 1, 1); PG8_STAGE(PG8_SB(1, 0), b3, voffB);
            PG8_BAR; PG8_WAIT_L(0); PG8_MMA(0, 1, At, B1); PG8_BAR;
            PG8_LDA(At, 1, 1); PG8_STAGE_A(PG8_SA(1, 0), a3, 0, un);
            PG8_BAR; PG8_WAIT_L(0); PG8_MMA(1, 0, At, B0); PG8_BAR; PG8_SCHED;
            PG8_STAGE(PG8_SB(1, 1), b3 + hstep, voffB);
            PG8_WAIT_V(6); PG8_BAR; PG8_MMA(1, 1, At, B1); PG8_BAR;
        }
        PG8_STAMP();
        if constexpr (!Epi::AFTER_DRAIN) { E(acc, cur, wr, wc, fr, fq); S.done(cur); }
        PG8_STAMP();
        if (!has_next) break;
#pragma unroll
        for (int a = 0; a < 2; ++a)
#pragma unroll
            for (int b = 0; b < 2; ++b)
#pragma unroll
                for (int m = 0; m < 4; ++m)
#pragma unroll
                    for (int n = 0; n < 2; ++n) acc[a][b][m][n] = (f32x4){0.f, 0.f, 0.f, 0.f};
        cur = nxt; cA = nA; cB = nB; ++ui;
        if constexpr (Sched::GATHER) { _Pragma("unroll") for (int _h = 0; _h < 2; ++_h) _Pragma("unroll") for (int _i = 0; _i < 2; ++_i) gvc[_h][_i] = gvn[_h][_i]; }
    }
    PG8_WAIT_V(0);
    if (wr == 0) PG8_BAR;
    PG8_BAR;
    if constexpr (Epi::AFTER_DRAIN) { E.fused(acc, cur, wr, wc, fr, fq, lds, wid, lane); S.done(cur); }
    PG8_STAMP();
    if (STAMP && wid == 0) { stamps[lane] = lane < nts ? (((unsigned long long)(unsigned)ts_hi << 32) | (unsigned)ts_lo) : 0ull;
        if (lane == 62) stamps[62] = rt_entry; if (lane == 63) stamps[63] = (unsigned long long)wall_clock64(); }
#undef PG8_STAMP
#undef PG8_SA
#undef PG8_SB
#undef PG8_STAGE
#undef PG8_STAGE_A
#undef PG8_GOFF
#undef PG8_LDA
#undef PG8_LDB
#undef PG8_MMA
#undef PG8_WAIT_V
#undef PG8_WAIT_L
#undef PG8_BAR
#undef PG8_SCHED
}
}


namespace attn {
using bf16 = unsigned short;
constexpr int   D = 128, NW = 8, QBLK = 32, KVBLK = 64;
constexpr float SCALE = 0.088388347648318440f;
constexpr float THR = 8.f;
constexpr int SDEPTH = 1;
constexpr int LDQ = 5120, LDK = 5120, LDO = 2048;
constexpr size_t SHM_V = KVBLK * D * 2, SHM_K = KVBLK * D * 2, SHM_ATTN = 2 * SHM_V + 2 * SHM_K + NW * 64 * 4;
using bf16x8 = __attribute__((ext_vector_type(8))) short;
using s16x4  = __attribute__((ext_vector_type(4))) short;
using f32x16 = __attribute__((ext_vector_type(16))) float;
using f32x8  = __attribute__((ext_vector_type(8))) float;
using u32x4  = __attribute__((ext_vector_type(4))) unsigned;
#define KSWZ(row, colB) ((row) * 256 + ((colB) ^ (((row) & 7) << 4)))
#define SBAR() __builtin_amdgcn_sched_barrier(0)
__device__ __forceinline__ int crow(int r, int hi) { return (r & 3) + 8 * (r >> 2) + 4 * hi; }
__device__ __forceinline__ unsigned cvtpk(float lo, float hi) { return cvt_pk_rne(lo, hi); }
template <typename TIn> struct Stage;
template <> struct Stage<bf16>  { using T = bf16x8;
  __device__ static __forceinline__ T ld8(const bf16* p) { return *reinterpret_cast<const bf16x8*>(p); }
  __device__ static __forceinline__ bf16x8 tobf(T x) { return x; } };
template <> struct Stage<float> { using T = f32x8;
  __device__ static __forceinline__ T ld8(const float* p) { return *reinterpret_cast<const f32x8*>(p); }
  __device__ static __forceinline__ bf16x8 tobf(T x) {
    u32x4 w = {cvtpk(x[0], x[1]), cvtpk(x[2], x[3]), cvtpk(x[4], x[5]), cvtpk(x[6], x[7])}; return *reinterpret_cast<bf16x8*>(&w); } };

__device__ __forceinline__ void partialSM(f32x16& p0, f32x16& p1, float& m_reg, float& mn, float& alpha) {
  constexpr float C = SCALE * 1.4426950408889634f;
  float pmax = p0[0]; for (int r = 1; r < 16; ++r) pmax = fmaxf(pmax, p0[r]); for (int r = 0; r < 16; ++r) pmax = fmaxf(pmax, p1[r]);
  { auto rr = __builtin_amdgcn_permlane32_swap(__float_as_uint(pmax), __float_as_uint(pmax), false, false);
    pmax = fmaxf(__uint_as_float(rr[0]), __uint_as_float(rr[1])); }
  if (__builtin_expect(__all(pmax - m_reg <= THR / SCALE), 1)) { mn = m_reg; alpha = 1.f; }
  else { mn = fmaxf(m_reg, pmax); alpha = __builtin_amdgcn_exp2f((m_reg - mn) * C); m_reg = mn; }
  float mnC = -mn * C;
  for (int r = 0; r < 16; ++r) p0[r] = fmaf(p0[r], C, mnC); for (int r = 0; r < 16; ++r) p1[r] = fmaf(p1[r], C, mnC);
  for (int r = 0; r < 16; ++r) p0[r] = __builtin_amdgcn_exp2f(p0[r]);
}
__device__ __forceinline__ void finishSM(f32x16& p0, f32x16& p1, float alpha, float& l_reg, bf16x8& pa0, bf16x8& pa1, bf16x8& pa2, bf16x8& pa3) {
  for (int r = 0; r < 16; ++r) p1[r] = __builtin_amdgcn_exp2f(p1[r]);
  float ps = 0; for (int r = 0; r < 16; ++r) ps += p0[r]; for (int r = 0; r < 16; ++r) ps += p1[r];
  { auto rr = __builtin_amdgcn_permlane32_swap(__float_as_uint(ps), __float_as_uint(ps), false, false);
    ps = __uint_as_float(rr[0]) + __uint_as_float(rr[1]); }
  l_reg = l_reg * alpha + ps;
#define PK4(P, BASE, OUT) do { unsigned a0 = cvtpk(P[BASE + 0], P[BASE + 1]), a1 = cvtpk(P[BASE + 2], P[BASE + 3]);   \
    unsigned b0 = cvtpk(P[BASE + 4], P[BASE + 5]), b1 = cvtpk(P[BASE + 6], P[BASE + 7]);                              \
    auto r0 = __builtin_amdgcn_permlane32_swap(a0, b0, false, false); auto r1 = __builtin_amdgcn_permlane32_swap(a1, b1, false, false); \
    u32x4 w = {r0[0], r1[0], r0[1], r1[1]}; OUT = *reinterpret_cast<bf16x8*>(&w); } while (0)
  PK4(p0, 0, pa0); PK4(p0, 8, pa1); PK4(p1, 0, pa2); PK4(p1, 8, pa3);
#undef PK4
}
__device__ __forceinline__ void qkt(f32x16& p0, f32x16& p1, const bf16* Ks, const bf16x8* qr, int r32, int hi) {
  p0 = f32x16{}; p1 = f32x16{};
  for (int d0 = 0; d0 < 8; ++d0) { int cb = (d0 * 16 + hi * 8) * 2;
    bf16x8 b0 = *reinterpret_cast<const bf16x8*>((const char*)Ks + KSWZ(r32, cb));
    bf16x8 b1 = *reinterpret_cast<const bf16x8*>((const char*)Ks + KSWZ(32 + r32, cb));
    p0 = __builtin_amdgcn_mfma_f32_32x32x16_bf16(b0, qr[d0], p0, 0, 0, 0);
    p1 = __builtin_amdgcn_mfma_f32_32x32x16_bf16(b1, qr[d0], p1, 0, 0, 0); }
}
__device__ __forceinline__ int v_st(int k, int c) { const int kk = (k & ~0xC) | ((k & 4) << 1) | ((k & 8) >> 1); return ((kk >> 3) * 4 + (c >> 5)) * 512 + ((kk & 7) * 32 + (c & 31)) * 2; }
__device__ __forceinline__ int v_rd_base(int lane) { return ((lane & 3) << 3) | (((lane >> 2) & 3) << 6) | (((lane >> 4) & 1) << 5) | (((lane >> 5) & 1) << 8); }
constexpr int v_rd_off(int d0, int ks, int half) { return d0 * 512 + ks * 4096 + half * 2048; }
template <int OFF> __device__ __forceinline__ s16x4 tr_read(int vb) {
  s16x4 r; asm volatile("ds_read_b64_tr_b16 %0, %1 offset:%2" : "=&v"(r) : "v"(vb), "i"(OFF) : "memory"); return r;
}
template <int D0> __device__ __forceinline__ void pv_one(f32x16& od, int vb, bf16x8 pa0, bf16x8 pa1, bf16x8 pa2, bf16x8 pa3) {
  const s16x4 l0 = tr_read<v_rd_off(D0, 0, 0)>(vb), h0 = tr_read<v_rd_off(D0, 0, 1)>(vb), l1 = tr_read<v_rd_off(D0, 1, 0)>(vb), h1 = tr_read<v_rd_off(D0, 1, 1)>(vb);
  const s16x4 l2 = tr_read<v_rd_off(D0, 2, 0)>(vb), h2 = tr_read<v_rd_off(D0, 2, 1)>(vb), l3 = tr_read<v_rd_off(D0, 3, 0)>(vb), h3 = tr_read<v_rd_off(D0, 3, 1)>(vb);
  asm volatile("s_waitcnt lgkmcnt(0)" ::: "memory"); SBAR();
#define PK(L, H) (bf16x8){L[0], L[1], L[2], L[3], H[0], H[1], H[2], H[3]}
  od = __builtin_amdgcn_mfma_f32_32x32x16_bf16(pa0, PK(l0, h0), od, 0, 0, 0);
  od = __builtin_amdgcn_mfma_f32_32x32x16_bf16(pa1, PK(l1, h1), od, 0, 0, 0);
  od = __builtin_amdgcn_mfma_f32_32x32x16_bf16(pa2, PK(l2, h2), od, 0, 0, 0);
  od = __builtin_amdgcn_mfma_f32_32x32x16_bf16(pa3, PK(l3, h3), od, 0, 0, 0);
#undef PK
}
__device__ __forceinline__ void pv_d0(f32x16* o, int vb, bf16x8 pa0, bf16x8 pa1, bf16x8 pa2, bf16x8 pa3) {
  pv_one<0>(o[0], vb, pa0, pa1, pa2, pa3); pv_one<1>(o[1], vb, pa0, pa1, pa2, pa3); pv_one<2>(o[2], vb, pa0, pa1, pa2, pa3); pv_one<3>(o[3], vb, pa0, pa1, pa2, pa3);
}

template <typename TQ>
__device__ __forceinline__ void attn_dense_body(const TQ* __restrict__ Qb, const bf16* __restrict__ Kh, const bf16* __restrict__ Vh,
                                                float* __restrict__ Ob, int seq, char* lds, const int wave0) {
  using St = Stage<bf16>; using SQ = Stage<TQ>;
  int tid_ = wave0 * 64 + lane_id(); asm volatile("" : "+v"(tid_));
  const int tid = tid_, wid = tid >> 6, lane = tid & 63, r32 = lane & 31, hi = lane >> 5;
  bf16* V_lds = (bf16*)lds; bf16* K_lds = (bf16*)(lds + 2 * SHM_V);
  float* ws = (float*)(lds + 2 * SHM_V + 2 * SHM_K) + wid * 64; float* li_l = ws; float* al_l = ws + 32;
  float m_reg = -1e30f, l_reg = 0; f32x16 o[4] = {}; bf16x8 qr[8];
  const TQ* Qw = Qb + (long)(wid * QBLK + r32) * LDQ + hi * 8;
#pragma unroll
  for (int d0 = 0; d0 < 8; ++d0) qr[d0] = SQ::tobf(SQ::ld8(Qw + d0 * 16));
  const int sr = tid >> 4, sc = (tid & 15) * 8, vst0 = v_st(sr, sc), vst1 = v_st(32 + sr, sc);
  const int vb0 = (int)(uintptr_t)V_lds + v_rd_base(lane);
  struct { typename St::T vs0, vs1, ks0, ks1; } sr_[SDEPTH];
#define SLOAD(i, k0) do { sr_[i].vs0 = St::ld8(&Vh[(long)((k0) + sr) * LDK + sc]); sr_[i].vs1 = St::ld8(&Vh[(long)((k0) + 32 + sr) * LDK + sc]); \
    sr_[i].ks0 = St::ld8(&Kh[(long)((k0) + sr) * LDK + sc]); sr_[i].ks1 = St::ld8(&Kh[(long)((k0) + 32 + sr) * LDK + sc]); } while (0)
#define SWRITE(b, i) do { *(bf16x8*)((char*)V_lds + (b) * SHM_V + vst0) = St::tobf(sr_[i].vs0);          \
    *(bf16x8*)((char*)V_lds + (b) * SHM_V + vst1) = St::tobf(sr_[i].vs1); int kc = sc * 2;               \
    *(bf16x8*)((char*)K_lds + (b) * SHM_K + KSWZ(sr, kc)) = St::tobf(sr_[i].ks0);                       \
    *(bf16x8*)((char*)K_lds + (b) * SHM_K + KSWZ(32 + sr, kc)) = St::tobf(sr_[i].ks1); } while (0)
#define SWAIT() do { if constexpr (SDEPTH == 2) asm volatile("s_waitcnt vmcnt(4)" ::: "memory"); else asm volatile("s_waitcnt vmcnt(0)" ::: "memory"); } while (0)
#define RESC(a) do { if (__any((a) < 1.f)) { if (hi == 0) al_l[r32] = (a); asm volatile("s_waitcnt lgkmcnt(0)" ::: "memory"); \
    for (int d = 0; d < 4; ++d) for (int r = 0; r < 16; ++r) o[d][r] *= al_l[crow(r, hi)]; } } while (0)
  f32x16 pA0, pA1, pB0, pB1; float mnA, mnB, alA, alB; bf16x8 pa0, pa1, pa2, pa3; const int NT = seq / KVBLK;
  constexpr int SE = 0, SO = SDEPTH - 1;
  SLOAD(SE, 0); asm volatile("s_waitcnt vmcnt(0)" ::: "memory"); SWRITE(0, SE); __syncthreads();
  qkt(pA0, pA1, K_lds, qr, r32, hi); partialSM(pA0, pA1, m_reg, mnA, alA);
  SLOAD(SO, KVBLK); if constexpr (SDEPTH == 2) { if (2 < NT) SLOAD(SE, 2 * KVBLK); }
  SWAIT(); SWRITE(1, SO); __syncthreads();
  for (int j = 1; j + 1 < NT; j += 2) {
    SBAR(); qkt(pB0, pB1, (bf16*)((char*)K_lds + SHM_K), qr, r32, hi);
    finishSM(pA0, pA1, alA, l_reg, pa0, pa1, pa2, pa3); SBAR();
    SLOAD(SO, (j + SDEPTH) * KVBLK); SBAR();
    pv_d0(o, vb0, pa0, pa1, pa2, pa3); partialSM(pB0, pB1, m_reg, mnB, alB);
    __syncthreads(); SWAIT(); SWRITE(0, SE);
    RESC(alB); __syncthreads();
    SBAR(); qkt(pA0, pA1, K_lds, qr, r32, hi);
    finishSM(pB0, pB1, alB, l_reg, pa0, pa1, pa2, pa3); SBAR();
    if (SDEPTH == 1 || j + 3 < NT) SLOAD(SE, (j + 1 + SDEPTH) * KVBLK); SBAR();
    pv_d0(o, vb0 + (int)SHM_V, pa0, pa1, pa2, pa3); partialSM(pA0, pA1, m_reg, mnA, alA);
    __syncthreads(); SWAIT(); SWRITE(1, SO);
    RESC(alA); __syncthreads();
  }
  SBAR(); qkt(pB0, pB1, (bf16*)((char*)K_lds + SHM_K), qr, r32, hi);
  finishSM(pA0, pA1, alA, l_reg, pa0, pa1, pa2, pa3); SBAR();
  pv_d0(o, vb0, pa0, pa1, pa2, pa3); partialSM(pB0, pB1, m_reg, mnB, alB);
  __syncthreads(); RESC(alB);
  finishSM(pB0, pB1, alB, l_reg, pa0, pa1, pa2, pa3); SBAR();
  pv_d0(o, vb0 + (int)SHM_V, pa0, pa1, pa2, pa3);
  if (hi == 0) li_l[r32] = l_reg; asm volatile("s_waitcnt lgkmcnt(0)" ::: "memory");
  float rli[16];
#pragma unroll
  for (int r = 0; r < 16; ++r) rli[r] = __builtin_amdgcn_rcpf(li_l[crow(r, hi)]);
  float* Ow = Ob + (long)(wid * QBLK) * LDO;
#pragma unroll
  for (int r = 0; r < 16; ++r) { int orow = crow(r, hi);
    for (int d0 = 0; d0 < 4; ++d0) Ow[(long)orow * LDO + d0 * 32 + r32] = o[d0][r] * rli[r]; }
#undef SLOAD
#undef SWRITE
#undef SWAIT
#undef RESC
}

}

template <class Epi>
__device__ __forceinline__ void naive_gemm(Frame& F, const bf16* __restrict__ A, int lda, const bf16* __restrict__ Bt, int ldb, int M, int N, int K, const Epi& epi) {
    LAS float* As = (LAS float*)F.lds;
    LAS float* Bs = As + 32 * 132;
    const int tid = F.tid, tm = tid >> 4, tn = tid & 15;
    const int ntm = M / 128, ntn = N / 64;
    for (int tile = F.vcu; tile < ntm * ntn; tile += F.G) {
        const int pm = tile / ntn, pn = tile % ntn;
        float acc[4][4];
#pragma unroll
        for (int i = 0; i < 4; ++i)
#pragma unroll
            for (int j = 0; j < 4; ++j) acc[i][j] = 0.f;
        for (int k0 = 0; k0 < K; k0 += 32) {
            { const int r = tid >> 2, ks = (tid & 3) * 8; const bf16x8 v = *(const bf16x8*)(A + (size_t)(pm * 128 + r) * lda + k0 + ks);
#pragma unroll
              for (int j = 0; j < 8; ++j) As[(ks + j) * 132 + r] = bf2f((bf16)v[j]); }
            if (tid < 256) { const int r = tid >> 2, ks = (tid & 3) * 8; const bf16x8 v = *(const bf16x8*)(Bt + (size_t)(pn * 64 + r) * ldb + k0 + ks);
#pragma unroll
              for (int j = 0; j < 8; ++j) Bs[(ks + j) * 68 + r] = bf2f((bf16)v[j]); }
            __syncthreads();
#pragma unroll 8
            for (int kk = 0; kk < 32; ++kk) { const f32x4 a = *(const LAS f32x4*)(As + kk * 132 + tm * 4); const f32x4 b = *(const LAS f32x4*)(Bs + kk * 68 + tn * 4);
#pragma unroll
                for (int i = 0; i < 4; ++i)
#pragma unroll
                    for (int j = 0; j < 4; ++j) acc[i][j] = fmaf(a[i], b[j], acc[i][j]); }
            __syncthreads();
        }
#pragma unroll
        for (int i = 0; i < 4; ++i)
#pragma unroll
            for (int j = 0; j < 4; ++j) epi(pm * 128 + tm * 4 + i, pn * 64 + tn * 4 + j, acc[i][j]);
    }
}

__device__ __forceinline__ void phase_post(Frame& F, int l) {
    bf16* PROJ = WSP(bf16, WS_PROJ);
    const float2* TA = WSP(float2, WS_TABA); const float2* TB = WSP(float2, WS_TABB);
    const float* qn = GIN(5) + l * HD; const float* kn = GIN(6) + l * HD;
    const int gw = F.vcu * NWAVES + F.wave, NGW = F.G * NWAVES, lane = F.lane;
    const int sgA = lane >> 3, iA = (lane & 7) * 2, baseA = (sgA < 4 ? COL_AQ + sgA * HD : COL_AK + (sgA - 4) * HD) + iA;
    const int hsel = lane >> 5, q = lane & 31, hf = q >> 4, i2 = (q & 15) * 2, eo = hf * 64 + i2;
    const float gq0 = qn[eo], gq1 = qn[eo + 1], gq2 = qn[eo + 32], gq3 = qn[eo + 33], gk0 = kn[eo], gk1 = kn[eo + 1], gk2 = kn[eo + 32], gk3 = kn[eo + 33];
    for (int t = gw; t < T; t += NGW) {
        const int s = t & (SEQ - 1);
        bf16* row = PROJ + (size_t)t * DINP;
        const unsigned a1 = *(const unsigned*)(row + baseA), a2 = *(const unsigned*)(row + baseA + 16);
        const f32x4 csa = *(const f32x4*)(TA + s * 16 + iA);
        const int pos = hf == 0 ? (s >> 6) : (s & 63); const f32x4 csb = *(const f32x4*)(TB + pos * 32 + i2);
        unsigned b1[5], b2[5];
#pragma unroll
        for (int p = 0; p < 5; ++p) { const int hh = 2 * p + hsel, base = (p < 4 ? COL_BQ + hh * HD : COL_BK + (hh - 8) * HD) + eo; b1[p] = *(const unsigned*)(row + base); b2[p] = *(const unsigned*)(row + base + 32); }
        { const float x1l = __uint_as_float(a1 << 16), x1h = __uint_as_float(a1 & 0xffff0000u), x2l = __uint_as_float(a2 << 16), x2h = __uint_as_float(a2 & 0xffff0000u);
          *(unsigned*)(row + baseA) = pk2(x1l * csa.x - x2l * csa.y, x1h * csa.z - x2h * csa.w); *(unsigned*)(row + baseA + 16) = pk2(x2l * csa.x + x1l * csa.y, x2h * csa.z + x1h * csa.w); }
#pragma unroll
        for (int p = 0; p < 5; ++p) { const int hh = 2 * p + hsel, base = (p < 4 ? COL_BQ + hh * HD : COL_BK + (hh - 8) * HD) + eo;
            float x1l = __uint_as_float(b1[p] << 16), x1h = __uint_as_float(b1[p] & 0xffff0000u), x2l = __uint_as_float(b2[p] << 16), x2h = __uint_as_float(b2[p] & 0xffff0000u);
            float ss = (x1l * x1l + x1h * x1h) + (x2l * x2l + x2h * x2h);
            ss += __shfl_xor(ss, 1); ss += __shfl_xor(ss, 2); ss += __shfl_xor(ss, 4); ss += __shfl_xor(ss, 8); ss += __shfl_xor(ss, 16);
            const float rs = rsqrtf(ss * (1.0f / HD) + EPS);
            x1l = x1l * rs * (p < 4 ? gq0 : gk0); x1h = x1h * rs * (p < 4 ? gq1 : gk1); x2l = x2l * rs * (p < 4 ? gq2 : gk2); x2h = x2h * rs * (p < 4 ? gq3 : gk3);
            *(unsigned*)(row + base) = pk2(x1l * csb.x - x2l * csb.y, x1h * csb.z - x2h * csb.w); *(unsigned*)(row + base + 32) = pk2(x2l * csb.x + x1l * csb.y, x2h * csb.z + x1h * csb.w); }
    }
}
__device__ __forceinline__ void phase_dn_prep_naive(Frame& F, int l) {
    const bf16* PROJ = WSP(bf16, WS_PROJ); const float* TL = WSP(float, WS_TL);
    float* DQ = WSP(float, WS_DQ); float* DK = WSP(float, WS_DK); float* DV = WSP(float, WS_DV); float* DB = WSP(float, WS_DB); float* DG = WSP(float, WS_DG);
    const float* cw = GIN(4) + (size_t)l * 5 * 1536;
    const int gw = F.vcu * NWAVES + F.wave, NGW = F.G * NWAVES, lane = F.lane;
    for (int t = gw; t < T; t += NGW) {
        const int s = t & (SEQ - 1);
#pragma unroll 1
        for (int g = 0; g < 12; ++g) {
            float val[2];
#pragma unroll
            for (int u = 0; u < 2; ++u) { const int c = 128 * g + 64 * u + lane; float a = 0.f;
#pragma unroll
                for (int j = 0; j < 5; ++j) { const int sp = s - 2 + j; if (sp >= 0 && sp < SEQ) a += bf2f(PROJ[(size_t)(t - 2 + j) * DINP + COL_CQKV + c]) * cw[j * 1536 + c]; }
                val[u] = siluf_(a); }
            float* dst = g < 4 ? DQ : (g < 8 ? DK : DV);
            if (g < 8) { const float ss = wave_sum(val[0] * val[0] + val[1] * val[1]); const float rs = rsqrtf(ss + EPS) * (g < 4 ? 0.08838834764831845f : 1.0f); val[0] *= rs; val[1] *= rs; }
            dst[(size_t)t * 512 + (g & 3) * 128 + lane] = val[0]; dst[(size_t)t * 512 + (g & 3) * 128 + 64 + lane] = val[1];
        }
        if (lane < 8) { const int dir = lane >> 2, hh = lane & 3; const float bl = TL[(size_t)t * 16 + dir * 4 + hh], al = TL[(size_t)t * 16 + 8 + dir * 4 + hh];
            const float A = expf(GIN(9)[(l * 2 + dir) * 4 + hh]); const float dtb = GIN(10)[(l * 2 + dir) * 4 + hh];
            DB[((size_t)dir * T + t) * 4 + hh] = sigmoidf_(bl); DG[((size_t)dir * T + t) * 4 + hh] = -A * softplusf_(al + dtb); }
    }
}


namespace dn {
typedef float f32x4 __attribute__((ext_vector_type(4)));
typedef short bf16x8 __attribute__((ext_vector_type(8)));
typedef short bf16x4 __attribute__((ext_vector_type(4)));
constexpr int KB_OFF = 0, QB_OFF = 17408, VB_OFF = 34816;
constexpr int KDT_OFF = 52224, UT_OFF = 70656, WT_OFF = 89088;
constexpr int AM_OFF = 107520;
constexpr int QKM_OFF = 123904;
constexpr int GC_OFF = 133120;
__device__ __forceinline__ unsigned cvtpk(float lo, float hi) { return cvt_pk_rne(lo, hi); }
__device__ __forceinline__ f32x4 mfma16(bf16x8 a, bf16x8 b, f32x4 c) { return __builtin_amdgcn_mfma_f32_16x16x32_bf16(a, b, c, 0, 0, 0); }
__device__ __forceinline__ void mfma_settle() { asm volatile("s_nop 15\n\ts_nop 7" ::: "memory"); }
}

__device__ __forceinline__ void phase_dn_chunk(Frame& F, int l) {
    using namespace dn;
#define WSQ(type, off) ((type*)(wsq + (off)))
    LAS unsigned char* L = F.lds;
    LAS float* GC = (LAS float*)(L + GC_OFF);
    const int wave = F.wave;
    for (int u = F.vcu; u < 1024; u += F.G) {
        int tid_ = wave * 64 + lane_id(); asm volatile("" : "+v"(tid_));
        const int tid = tid_, lane = tid & 63, g4 = lane >> 4, l15 = lane & 15;
        const int dir = u >> 9, b = (u >> 8) & 1, hh = (u >> 6) & 3, c = u & 63;
        const int chain = dir * 8 + b * 4 + hh, cs = dir ? 63 - c : c;
        const size_t ub = (size_t)chain * 64 + cs;
        GAS unsigned char* wsq_ = (GAS unsigned char*)F.ws; asm volatile("" : "+s"(wsq_)); unsigned char* wsq = (unsigned char*)wsq_;
        __syncthreads();
        if (wave == 0) {
            const int pos = dir ? 63 - lane : lane; const size_t t = (size_t)b * SEQ + c * 64 + pos;
            const float* TL = WSQ(float, WS_TL); const float bl = TL[t * 16 + dir * 4 + hh], al = TL[t * 16 + 8 + dir * 4 + hh];
            const float Acoef = expf(GIN(9)[(l * 2 + dir) * 4 + hh]), dtb = GIN(10)[(l * 2 + dir) * 4 + hh];
            float gc = -Acoef * softplusf_(al + dtb);
#pragma unroll
            for (int o = 1; o < 64; o <<= 1) { const float tv = bperm(gc, lane >= o ? lane - o : lane); if (lane >= o) gc += tv; }
            const float glast = bperm(gc, 63);
            const float beta = sigmoidf_(bl), egc = expf(gc); GC[lane] = gc; GC[64 + lane] = beta; GC[128 + lane] = egc; GC[192 + lane] = expf(glast - gc); if (lane == 0) GC[256] = expf(glast); GC[320 + lane] = beta * egc;
        }
        __syncthreads();
#ifndef DBG_NOCONV
        if (tid < 384) {
            const int rg = tid / 48, o = tid % 48, part = o >> 4, oo = o & 15;
            const int chl = part * 512 + hh * 128 + oo * 8;
            const float* cw = GIN(4) + (size_t)l * 5 * 1536;
            const bf16* src = WSQ(bf16, WS_PROJ) + (size_t)(b * SEQ) * DINP + COL_CQKV + chl;
            float w[5][8];
#pragma unroll
            for (int j = 0; j < 5; ++j) { const f32x4 w0 = *(const f32x4*)(cw + j * 1536 + chl), w1 = *(const f32x4*)(cw + j * 1536 + chl + 4);
                w[j][0] = w0.x; w[j][1] = w0.y; w[j][2] = w0.z; w[j][3] = w0.w; w[j][4] = w1.x; w[j][5] = w1.y; w[j][6] = w1.z; w[j][7] = w1.w; }
            bf16x8 xin[12];
#pragma unroll
            for (int dr = 0; dr < 12; ++dr) { const int sq = c * 64 + rg * 8 - 2 + dr; xin[dr] = (bf16x8){0, 0, 0, 0, 0, 0, 0, 0}; if (sq >= 0 && sq < SEQ) xin[dr] = *(const bf16x8*)(src + (size_t)sq * DINP); }
#pragma unroll
            for (int hp = 0; hp < 2; ++hp) {
                float acc[4][8];
#pragma unroll
                for (int r = 0; r < 4; ++r)
#pragma unroll
                    for (int e = 0; e < 8; ++e) acc[r][e] = 0.f;
#pragma unroll
                for (int dr = 0; dr < 8; ++dr) { float xf[8];
#pragma unroll
                        for (int e = 0; e < 8; ++e) xf[e] = bf2f((bf16)xin[4 * hp + dr][e]);
#pragma unroll
                        for (int r = 0; r < 4; ++r) { const int j = dr - r; if (j >= 0 && j < 5) {
#pragma unroll
                            for (int e = 0; e < 8; ++e) acc[r][e] = fmaf(xf[e], w[j][e], acc[r][e]); } } }
#pragma unroll
                for (int r = 0; r < 4; ++r) {
#pragma unroll
                    for (int e = 0; e < 8; ++e) acc[r][e] = siluf_(acc[r][e]);
                    if (part < 2) { float ss = 0.f;
#pragma unroll
                        for (int e = 0; e < 8; ++e) ss = fmaf(acc[r][e], acc[r][e], ss);
                        ss += bperm(ss, lane ^ 1); ss += bperm(ss, lane ^ 2); ss += bperm(ss, lane ^ 4); ss += bperm(ss, lane ^ 8);
                        const float rs = rsqrtf(ss + EPS) * (part == 0 ? 0.08838834764831845f : 1.0f);
#pragma unroll
                        for (int e = 0; e < 8; ++e) acc[r][e] *= rs; }
                    const int i = dir ? 63 - (rg * 8 + hp * 4 + r) : rg * 8 + hp * 4 + r;
                    u32x4 pk; pk.x = cvtpk(acc[r][0], acc[r][1]); pk.y = cvtpk(acc[r][2], acc[r][3]); pk.z = cvtpk(acc[r][4], acc[r][5]); pk.w = cvtpk(acc[r][6], acc[r][7]);
                    *(LAS u32x4*)(L + (part == 0 ? QB_OFF : (part == 1 ? KB_OFF : VB_OFF)) + i * 272 + oo * 16) = pk;
                }
                if (part == 1) {
                    const int ib = dir ? 60 - rg * 8 - hp * 4 : rg * 8 + hp * 4;
                    float kd[4];
#pragma unroll
                    for (int m = 0; m < 4; ++m) kd[m] = GC[192 + ib + m];
#pragma unroll
                    for (int e = 0; e < 8; ++e) { float v4[4];
#pragma unroll
                        for (int m = 0; m < 4; ++m) v4[m] = (dir ? acc[3 - m][e] : acc[m][e]) * kd[m];
                        u32x2 pk; pk.x = cvtpk(v4[0], v4[1]); pk.y = cvtpk(v4[2], v4[3]);
                        *(LAS u32x2*)(L + KDT_OFF + (oo * 8 + e) * 144 + ib * 2) = pk; }
                }
            }
        }
        __syncthreads();
#endif
        { const int sel = wave >> 2, rt = wave & 3;
          f32x4 acc[4];
#pragma unroll
          for (int ct = 0; ct < 4; ++ct) acc[ct] = (f32x4){0.f, 0.f, 0.f, 0.f};
          const LAS unsigned char* ab2 = L + (sel ? QB_OFF : KB_OFF) + (16 * rt + l15) * 272 + g4 * 16; const LAS unsigned char* bb2 = L + KB_OFF + l15 * 272 + g4 * 16;
#pragma unroll
          for (int kb = 0; kb < 4; ++kb) { const bf16x8 a = *(const LAS bf16x8*)(ab2 + kb * 64);
#pragma unroll
              for (int ct = 0; ct < 4; ++ct) { const bf16x8 bb = *(const LAS bf16x8*)(bb2 + ct * 4352 + kb * 64); acc[ct] = mfma16(a, bb, acc[ct]); } }
#pragma unroll
          for (int ct = 0; ct < 4; ++ct)
#pragma unroll
              for (int r = 0; r < 4; ++r) { const int i = 16 * rt + 4 * g4 + r, j = 16 * ct + l15; const float dec = j <= i ? expf(GC[i] - GC[j]) : 0.f; const float val = acc[ct][r] * dec;
                  if (sel == 0) ((LAS float*)(L + AM_OFF))[i * 64 + j] = j < i ? GC[64 + i] * val : 0.f;
                  else ((LAS bf16*)(L + QKM_OFF))[i * 72 + j] = (bf16)f2bf(val); } }
        __syncthreads();
#ifndef DBG_NOSOLVE
        if (tid < 256) {
            const LAS bf16* srcc = (const LAS bf16*)(L + (tid < 128 ? VB_OFF : KB_OFF)) + (tid & 127); const LAS float* scv = GC + (tid < 128 ? 64 : 320);
            LAS unsigned char* xrow = L + (tid < 128 ? UT_OFF + tid * 144 : WT_OFF + (tid - 128) * 144);
            int zoff; asm volatile("v_mov_b32 %0, 0" : "=v"(zoff));
            const LAS float* AM = (const LAS float*)(L + AM_OFF) + zoff;
#pragma unroll
            for (int r = 0; r < 4; ++r) {
                float acc[16];
#pragma unroll
                for (int ii = 0; ii < 16; ++ii) acc[ii] = scv[16 * r + ii] * bf2f(srcc[(16 * r + ii) * 136]);
#pragma unroll 1
                for (int sb = 0; sb < r; ++sb) {
                    const u32x4 x0 = *(const LAS u32x4*)(xrow + sb * 32), x1 = *(const LAS u32x4*)(xrow + sb * 32 + 16); float xs[16];
                    xs[0] = __uint_as_float(x0.x << 16); xs[1] = __uint_as_float(x0.x & 0xffff0000u); xs[2] = __uint_as_float(x0.y << 16); xs[3] = __uint_as_float(x0.y & 0xffff0000u);
                    xs[4] = __uint_as_float(x0.z << 16); xs[5] = __uint_as_float(x0.z & 0xffff0000u); xs[6] = __uint_as_float(x0.w << 16); xs[7] = __uint_as_float(x0.w & 0xffff0000u);
                    xs[8] = __uint_as_float(x1.x << 16); xs[9] = __uint_as_float(x1.x & 0xffff0000u); xs[10] = __uint_as_float(x1.y << 16); xs[11] = __uint_as_float(x1.y & 0xffff0000u);
                    xs[12] = __uint_as_float(x1.z << 16); xs[13] = __uint_as_float(x1.z & 0xffff0000u); xs[14] = __uint_as_float(x1.w << 16); xs[15] = __uint_as_float(x1.w & 0xffff0000u);
#pragma unroll
                    for (int ii = 0; ii < 16; ++ii) { const LAS float* ar = AM + (16 * r + ii) * 64 + 16 * sb; float s0 = 0.f, s1 = 0.f; if ((ii & 3) == 0) asm volatile("" ::: "memory");
#pragma unroll
                        for (int q = 0; q < 4; ++q) { const f32x4 a = *(const LAS f32x4*)(ar + 4 * q); s0 = fmaf(a.x, xs[4 * q], s0); s1 = fmaf(a.y, xs[4 * q + 1], s1); s0 = fmaf(a.z, xs[4 * q + 2], s0); s1 = fmaf(a.w, xs[4 * q + 3], s1); }
                        acc[ii] -= s0 + s1; }
                }
#pragma unroll
                for (int ii = 1; ii < 16; ++ii) { const LAS float* ar = AM + (16 * r + ii) * 64 + 16 * r; float s0 = 0.f, s1 = 0.f;
#pragma unroll
                    for (int q = 0; q < (ii + 3) / 4; ++q) { const f32x4 a = *(const LAS f32x4*)(ar + 4 * q); s0 = fmaf(a.x, acc[4 * q], s0); s1 = fmaf(a.y, acc[4 * q + 1], s1); s0 = fmaf(a.z, acc[4 * q + 2], s0); s1 = fmaf(a.w, acc[4 * q + 3], s1); }
                    acc[ii] -= s0 + s1; }
                u32x4 pk; pk.x = cvtpk(acc[0], acc[1]); pk.y = cvtpk(acc[2], acc[3]); pk.z = cvtpk(acc[4], acc[5]); pk.w = cvtpk(acc[6], acc[7]); *(LAS u32x4*)(xrow + r * 32) = pk;
                pk.x = cvtpk(acc[8], acc[9]); pk.y = cvtpk(acc[10], acc[11]); pk.z = cvtpk(acc[12], acc[13]); pk.w = cvtpk(acc[14], acc[15]); *(LAS u32x4*)(xrow + r * 32 + 16) = pk;
            }
        }
        __syncthreads();
#endif
        { const int sel = wave >> 2, it = wave & 3;
          f32x4 acc[8];
#pragma unroll
          for (int dt = 0; dt < 8; ++dt) acc[dt] = (f32x4){0.f, 0.f, 0.f, 0.f};
          const LAS unsigned char* bb4 = L + QKM_OFF + (16 * it + l15) * 144 + g4 * 16; const LAS unsigned char* ab4 = L + (sel ? UT_OFF : WT_OFF) + l15 * 144 + g4 * 16;
#pragma unroll
          for (int kb = 0; kb < 2; ++kb) { const bf16x8 bb = *(const LAS bf16x8*)(bb4 + kb * 64);
#pragma unroll
              for (int dt = 0; dt < 8; ++dt) { const bf16x8 a = *(const LAS bf16x8*)(ab4 + dt * 2304 + kb * 64); acc[dt] = mfma16(a, bb, acc[dt]); } }
          mfma_settle();
          const int i = 16 * it + l15, trow = dir ? 63 - i : i;
          if (sel == 0) { bf16* CP = WSQ(bf16, WS_CP) + (ub * 64 + trow) * 128; const float eg = GC[128 + i];
#pragma unroll
              for (int dt = 0; dt < 8; ++dt) { const int d = 16 * dt + 4 * g4; const u32x2 qw = *(const LAS u32x2*)(L + QB_OFF + i * 272 + d * 2);
                  const float q0 = __uint_as_float(qw.x << 16), q1 = __uint_as_float(qw.x & 0xffff0000u), q2 = __uint_as_float(qw.y << 16), q3 = __uint_as_float(qw.y & 0xffff0000u);
                  u32x2 o; o.x = cvtpk(q0 * eg - acc[dt][0], q1 * eg - acc[dt][1]); o.y = cvtpk(q2 * eg - acc[dt][2], q3 * eg - acc[dt][3]); *(u32x2*)(CP + 32 * (dt >> 1) + 8 * g4 + 4 * (dt & 1)) = o; } }
          else { float* CR = WSQ(float, WS_CR) + (ub * 64 + trow) * 128;
#pragma unroll
              for (int dt = 0; dt < 8; ++dt) *(f32x4*)(CR + 16 * dt + 4 * g4) = acc[dt]; } }
        { f32x4 acc[8];
#pragma unroll
          for (int ct = 0; ct < 8; ++ct) acc[ct] = (f32x4){0.f, 0.f, 0.f, 0.f};
          const LAS unsigned char* lane_off = L + l15 * 144 + g4 * 16;
#pragma unroll
          for (int kb = 0; kb < 2; ++kb) { const bf16x8 a = *(const LAS bf16x8*)(lane_off + WT_OFF + wave * 2304 + kb * 64);
#pragma unroll
              for (int ct = 0; ct < 8; ++ct) { const bf16x8 bb = *(const LAS bf16x8*)(lane_off + KDT_OFF + ct * 2304 + kb * 64); acc[ct] = mfma16(a, bb, acc[ct]); } }
          mfma_settle();
          bf16* CM = WSQ(bf16, WS_CM) + ub * 16384; const float eg = GC[256];
          const int dpp = 32 * (wave >> 1) + 8 * g4 + 4 * (wave & 1);
#pragma unroll
          for (int ct = 0; ct < 8; ++ct) { const int d = 16 * ct + l15, dp = 16 * wave + 4 * g4; float m[4];
#pragma unroll
              for (int r = 0; r < 4; ++r) m[r] = (d == dp + r ? eg : 0.f) - acc[ct][r];
              u32x2 o; o.x = cvtpk(m[0], m[1]); o.y = cvtpk(m[2], m[3]); *(u32x2*)(CM + (size_t)d * 128 + dpp) = o; }
#pragma unroll
          for (int ct = 0; ct < 8; ++ct) acc[ct] = (f32x4){0.f, 0.f, 0.f, 0.f};
#pragma unroll
          for (int kb = 0; kb < 2; ++kb) { const bf16x8 a = *(const LAS bf16x8*)(lane_off + KDT_OFF + wave * 2304 + kb * 64);
#pragma unroll
              for (int ct = 0; ct < 8; ++ct) { const bf16x8 bb = *(const LAS bf16x8*)(lane_off + UT_OFF + ct * 2304 + kb * 64); acc[ct] = mfma16(a, bb, acc[ct]); } }
          mfma_settle();
          bf16* CN = WSQ(bf16, WS_CN) + ub * 16384;
#pragma unroll
          for (int ct = 0; ct < 8; ++ct) { u32x2 o; o.x = cvtpk(acc[ct][0], acc[ct][1]); o.y = cvtpk(acc[ct][2], acc[ct][3]); *(u32x2*)(CN + ((size_t)(ct * 8 + wave) * 64 + lane) * 4) = o; } }
    }
}
#undef WSQ

#define DN_SCAN_STEP(cs, NS, MS) do {            \
        const LAS unsigned char* Mb = L + ((cs) & 1) * 34816;                                                                                        \
        const int c4 = (cs) + 3 < 64 ? (cs) + 3 : 63, c5 = (cs) + 4 < 64 ? (cs) + 4 : 63;                                                           \
        if (active) {                                                                                                                               \
        bf16* cso = CS + (size_t)(cs) * 16384 + ((size_t)(wv * 8) * 64 + lane) * 4;                                                                  \
        unsigned sp[8][2]; f32x4 acc[8];                                                                                                            \
        _Pragma("unroll") for (int r = 0; r < 8; ++r) { sp[r][0] = cvtpk(S[r][0], S[r][1]); sp[r][1] = cvtpk(S[r][2], S[r][3]); u32x2 o; o.x = sp[r][0]; o.y = sp[r][1]; *(u32x2*)(cso + 256 * r) = o; \
            acc[r][0] = __uint_as_float(NS[r].x << 16); acc[r][1] = __uint_as_float(NS[r].x & 0xffff0000u); acc[r][2] = __uint_as_float(NS[r].y << 16); acc[r][3] = __uint_as_float(NS[r].y & 0xffff0000u); } \
        _Pragma("unroll") for (int r = 0; r < 8; ++r) NS[r] = *(const u32x2*)(CN + (size_t)c4 * 16384 + ((size_t)(wv * 8 + r) * 64 + lane) * 4);         \
        _Pragma("unroll") for (int kb = 0; kb < 4; ++kb) { u32x4 bw; bw.x = sp[2 * kb][0]; bw.y = sp[2 * kb][1]; bw.z = sp[2 * kb + 1][0]; bw.w = sp[2 * kb + 1][1]; const bf16x8 bfrag = *reinterpret_cast<bf16x8*>(&bw); \
            _Pragma("unroll") for (int r = 0; r < 8; ++r)                                                                                           \
                acc[r] = mfma16(*(const LAS bf16x8*)(Mb + (16 * r + l15) * 272 + (32 * kb + 8 * g4) * 2), bfrag, acc[r]); }                            \
        _Pragma("unroll") for (int r = 0; r < 8; ++r) S[r] = acc[r];                                                                                 \
        } else {     \
                                \
          LAS unsigned char* Mn = L + (((cs) + 1) & 1) * 34816;                                                                                      \
          _Pragma("unroll") for (int q = 0; q < 8; ++q) { const int id = tl + 256 * q; *(LAS u32x4*)(Mn + (id >> 4) * 272 + (id & 15) * 16) = MS[q]; }   \
          _Pragma("unroll") for (int q = 0; q < 8; ++q) MS[q] = *(const u32x4*)(CM + (size_t)c5 * 16384 + (size_t)(tl + 256 * q) * 8);                 \
        }                                                                                                                                           \
        asm volatile("s_waitcnt lgkmcnt(0)" ::: "memory"); __builtin_amdgcn_s_barrier(); asm volatile("" ::: "memory");     \
    } while (0)
__device__ __forceinline__ void phase_dn_scan(Frame& F) {
    using namespace dn;
    if (blockIdx.x >= 32) return;
    const int chain = (int)blockIdx.x >> 1, tid = F.tid, lane = F.lane, wave = F.wave, g4 = lane >> 4, l15 = lane & 15;
    const bool active = wave < 4; const int wv = ((int)blockIdx.x & 1) * 4 + (wave & 3);
    const int tl = tid & 255;
    LAS unsigned char* L = F.lds;
    const bf16* CM = WSP(bf16, WS_CM) + (size_t)chain * 64 * 16384; const bf16* CN = WSP(bf16, WS_CN) + (size_t)chain * 64 * 16384; bf16* CS = WSP(bf16, WS_CS) + (size_t)chain * 64 * 16384;
    f32x4 S[8];
#pragma unroll
    for (int r = 0; r < 8; ++r) S[r] = (f32x4){0.f, 0.f, 0.f, 0.f};
    u32x4 m0[8], m1[8], m2[8]; u32x2 n0[8], n1[8], n2[8];
#pragma unroll
    for (int q = 0; q < 8; ++q) { m0[q] = (u32x4){0u, 0u, 0u, 0u}; m1[q] = m0[q]; m2[q] = m0[q]; }
#pragma unroll
    for (int r = 0; r < 8; ++r) { n0[r] = (u32x2){0u, 0u}; n1[r] = n0[r]; n2[r] = n0[r]; }
    __syncthreads();
    if (!active) {
#pragma unroll
        for (int q = 0; q < 8; ++q) { const size_t o = (size_t)(tl + 256 * q) * 8; m0[q] = *(const u32x4*)(CM + o); m1[q] = *(const u32x4*)(CM + 16384 + o); m2[q] = *(const u32x4*)(CM + 2 * 16384 + o); }
#pragma unroll
        for (int q = 0; q < 8; ++q) { const int id = tl + 256 * q; *(LAS u32x4*)(L + (id >> 4) * 272 + (id & 15) * 16) = m0[q]; }
#pragma unroll
        for (int q = 0; q < 8; ++q) m0[q] = *(const u32x4*)(CM + 3 * 16384 + (size_t)(tl + 256 * q) * 8);
    } else {
#pragma unroll
        for (int r = 0; r < 8; ++r) { const size_t o = ((size_t)(wv * 8 + r) * 64 + lane) * 4; n0[r] = *(const u32x2*)(CN + o); n1[r] = *(const u32x2*)(CN + 16384 + o); n2[r] = *(const u32x2*)(CN + 2 * 16384 + o); }
    }
    __syncthreads();
#pragma unroll 1
    for (int cs = 0; cs < 63; cs += 3) {
        DN_SCAN_STEP(cs, n0, m1);
        DN_SCAN_STEP(cs + 1, n1, m2);
        DN_SCAN_STEP(cs + 2, n2, m0);
    }
    DN_SCAN_STEP(63, n0, m1);
}
#undef DN_SCAN_STEP

__device__ __forceinline__ void phase_dn_out(Frame& F, int l, const int ufirst, const int ustep, const int uend) {
    using namespace dn;
    const bf16* PROJ = WSP(bf16, WS_PROJ); bf16* Y = WSP(bf16, WS_Y); const float* gn = GIN(11) + (size_t)l * HD;
    const int lane = F.lane, wave = F.wave, g4 = lane >> 4, l15 = lane & 15, it = wave & 3, vh = wave >> 2;
    LAS float* part = (LAS float*)F.lds;
    for (int u = ufirst; u < uend; u += ustep) {
        const int b = u >> 8, hh = (u >> 6) & 3, c = u & 63;
        f32x4 acc[4];
#pragma unroll
        for (int q = 0; q < 4; ++q) acc[q] = (f32x4){0.f, 0.f, 0.f, 0.f};
#pragma unroll
        for (int dir = 0; dir < 2; ++dir) { const int chain = dir * 8 + b * 4 + hh, cs = dir ? 63 - c : c; const size_t ub = (size_t)chain * 64 + cs;
            const bf16* CP = WSP(bf16, WS_CP) + ub * 8192 + (size_t)(16 * it + l15) * 128 + 8 * g4; const bf16* CS = WSP(bf16, WS_CS) + ub * 16384 + (size_t)lane * 4; const float* CR = WSP(float, WS_CR) + ub * 8192 + (size_t)(16 * it + l15) * 128;
#pragma unroll
            for (int kb = 0; kb < 4; ++kb) { const bf16x8 bb = *(const bf16x8*)(CP + 32 * kb);
#pragma unroll
                for (int q = 0; q < 4; ++q) { const bf16* sp_ = CS + (size_t)((vh * 4 + q) * 8 + 2 * kb) * 256; const u32x2 a0 = *(const u32x2*)sp_, a1 = *(const u32x2*)(sp_ + 256); u32x4 aw; aw.x = a0.x; aw.y = a0.y; aw.z = a1.x; aw.w = a1.y;
                    acc[q] = mfma16(*reinterpret_cast<bf16x8*>(&aw), bb, acc[q]); } }
#pragma unroll
            for (int q = 0; q < 4; ++q) acc[q] += *(const f32x4*)(CR + 16 * (vh * 4 + q) + 4 * g4); }
        float ss = 0.f;
#pragma unroll
        for (int q = 0; q < 4; ++q) ss += (acc[q][0] * acc[q][0] + acc[q][1] * acc[q][1]) + (acc[q][2] * acc[q][2] + acc[q][3] * acc[q][3]);
        ss += __shfl_xor(ss, 16); ss += __shfl_xor(ss, 32);
        const int i = 16 * it + l15; const size_t t = (size_t)b * SEQ + c * 64 + i;
        u32x2 zw4[4]; f32x4 gg4[4];
#pragma unroll
        for (int q = 0; q < 4; ++q) { const int vv = 16 * (vh * 4 + q) + 4 * g4; zw4[q] = *(const u32x2*)(PROJ + t * DINP + COL_CZ + hh * HD + vv); gg4[q] = *(const f32x4*)(gn + vv); }
        __syncthreads();
        if (g4 == 0) part[vh * 64 + 16 * it + l15] = ss;
        __syncthreads();
        const float rs = rsqrtf((part[i] + part[64 + i]) * (1.0f / HD) + EPS);
#pragma unroll
        for (int q = 0; q < 4; ++q) { const int vv = 16 * (vh * 4 + q) + 4 * g4; const u32x2 zw = zw4[q]; const f32x4 gg = gg4[q];
            const float z0 = __uint_as_float(zw.x << 16), z1 = __uint_as_float(zw.x & 0xffff0000u), z2 = __uint_as_float(zw.y << 16), z3 = __uint_as_float(zw.y & 0xffff0000u);
            u32x2 o; o.x = cvtpk(acc[q][0] * rs * gg.x * siluf_(z0), acc[q][1] * rs * gg.y * siluf_(z1)); o.y = cvtpk(acc[q][2] * rs * gg.z * siluf_(z2), acc[q][3] * rs * gg.w * siluf_(z3));
            *(u32x2*)(Y + t * DM + 1536 + hh * HD + vv) = o; }
    }
}

__device__ __forceinline__ void dn_chain_naive(Frame& F, int chain) {
    const int dir = chain >> 3, b = (chain >> 2) & 1, hh = chain & 3;
    const float* DQ = WSP(float, WS_DQ); const float* DK = WSP(float, WS_DK); const float* DV = WSP(float, WS_DV); const float* DB = WSP(float, WS_DB); const float* DG = WSP(float, WS_DG);
    float* DO = WSP(float, WS_DO);
    LAS float* kb = (LAS float*)F.lds; LAS float* qb = kb + 64 * 128; LAS float* vb = qb + 64 * 128; LAS float* bb = vb + 64 * 128; LAS float* gb = bb + 64;
    const int tid = F.tid, v = tid >> 2, kq = tid & 3;
    float S[32];
#pragma unroll
    for (int j = 0; j < 32; ++j) S[j] = 0.f;
    for (int c0 = 0; c0 < SEQ; c0 += 64) {
        __syncthreads();
        for (int idx = tid; idx < 64 * 128; idx += NTHR) { const int i = idx >> 7, d = idx & 127; const int sq = c0 + i, pos = dir ? SEQ - 1 - sq : sq; const size_t o = (size_t)(b * SEQ + pos) * 512 + hh * 128 + d;
            kb[idx] = DK[o]; qb[idx] = DQ[o]; vb[idx] = DV[o]; }
        if (tid < 64) { const int sq = c0 + tid, pos = dir ? SEQ - 1 - sq : sq; const size_t o = ((size_t)dir * T + b * SEQ + pos) * 4 + hh; bb[tid] = DB[o]; gb[tid] = DG[o]; }
        __syncthreads();
        for (int i = 0; i < 64; ++i) {
            const float a = expf(gb[i]), beta = bb[i];
            float ks = 0.f;
#pragma unroll
            for (int j = 0; j < 32; ++j) ks = fmaf(kb[i * 128 + kq * 32 + j], S[j], ks);
            ks += __shfl_xor(ks, 1); ks += __shfl_xor(ks, 2);
            const float vn = beta * (vb[i * 128 + v] - a * ks);
            float o = 0.f;
#pragma unroll
            for (int j = 0; j < 32; ++j) { S[j] = fmaf(kb[i * 128 + kq * 32 + j], vn, a * S[j]); o = fmaf(qb[i * 128 + kq * 32 + j], S[j], o); }
            o += __shfl_xor(o, 1); o += __shfl_xor(o, 2);
            if (kq == 0) { const int sq = c0 + i, pos = dir ? SEQ - 1 - sq : sq; DO[((size_t)dir * T + b * SEQ + pos) * 512 + hh * 128 + v] = o; }
        }
    }
    __syncthreads();
}
struct AttnAcc { float m, l, o0, o1; };
__device__ __forceinline__ void attn_key(AttnAcc& st, float q0, float q1, const bf16* krow, const bf16* vrow, int lane) {
    const unsigned kw = *(const unsigned*)(krow + 2 * lane), vw = *(const unsigned*)(vrow + 2 * lane);
    const float sc = wave_sum(q0 * __uint_as_float(kw << 16) + q1 * __uint_as_float(kw & 0xffff0000u)) * 0.08838834764831845f;
    const float mn = fmaxf(st.m, sc), al = __expf(st.m - mn), p = __expf(sc - mn);
    st.l = st.l * al + p; st.o0 = st.o0 * al + p * __uint_as_float(vw << 16); st.o1 = st.o1 * al + p * __uint_as_float(vw & 0xffff0000u); st.m = mn;
}
__device__ __forceinline__ void phase_mix_naive(Frame& F, unsigned* scan_cnt) {
    const bf16* PROJ = WSP(bf16, WS_PROJ); float* YMIX = WSP(float, WS_YMIX);
    if (NAIVE_DN) { if (F.vcu < 16) dn_chain_naive(F, F.vcu); } else { phase_dn_scan(F); asm volatile("s_waitcnt vmcnt(0)" ::: "memory"); __syncthreads();
        if (blockIdx.x < 32 && F.tid == 0) {
            __builtin_amdgcn_fence(__ATOMIC_RELEASE, "agent"); asm volatile("s_waitcnt vmcnt(0)" ::: "memory"); (void)xb_add(scan_cnt, 1u); } }
    const int gw = F.vcu * NWAVES + F.wave, NGW = F.G * NWAVES, lane = F.lane;
    if (NAIVE_ATTN_A) for (int u = gw; u < T * 4; u += NGW) { const int t = u >> 2, hh = u & 3, b = t >> 12, s = t & (SEQ - 1);
        const unsigned qw = *(const unsigned*)(PROJ + (size_t)t * DINP + COL_AQ + hh * HD + 2 * lane); const float q0 = __uint_as_float(qw << 16), q1 = __uint_as_float(qw & 0xffff0000u);
        AttnAcc st{-1e30f, 0.f, 0.f, 0.f};
        for (int pat = 0; pat < 3; ++pat) { const int dil = pat == 0 ? 1 : (pat == 1 ? 4 : 16);
            for (int dlt = -64; dlt <= 64; ++dlt) { const int sp = s + dil * dlt; if (sp < 0 || sp >= SEQ) continue;
                const bf16* kr = PROJ + (size_t)(b * SEQ + sp) * DINP; attn_key(st, q0, q1, kr + COL_AK + hh * HD, kr + COL_AV + hh * HD, lane); } }
        const float inv = 1.0f / st.l; *(float2*)(YMIX + (size_t)t * DM + hh * HD + 2 * lane) = make_float2(st.o0 * inv, st.o1 * inv); }
    if (NAIVE_ATTN_B) for (int u = gw; u < T * 8; u += NGW) { const int t = u >> 3, hq = u & 7, kvh = hq >> 2, b = t >> 12;
        const unsigned qw = *(const unsigned*)(PROJ + (size_t)t * DINP + COL_BQ + hq * HD + 2 * lane); const float q0 = __uint_as_float(qw << 16), q1 = __uint_as_float(qw & 0xffff0000u);
        AttnAcc st{-1e30f, 0.f, 0.f, 0.f};
        const bf16* kr = PROJ + (size_t)(b * SEQ) * DINP;
        for (int j = 0; j < SEQ; ++j, kr += DINP) attn_key(st, q0, q1, kr + COL_BK + kvh * HD, kr + COL_BV + kvh * HD, lane);
        const float inv = 1.0f / st.l; *(float2*)(YMIX + (size_t)t * DM + 512 + hq * HD + 2 * lane) = make_float2(st.o0 * inv, st.o1 * inv); }
}


__device__ __forceinline__ void phase_attn_b(Frame& F, char* lds_gen) {
    const bf16* PROJ = WSP(bf16, WS_PROJ); float* YMIX = WSP(float, WS_YMIX);
    for (int u = F.vcu; u < BATCH * 8 * 16; u += F.G) {
        const int b = u >> 7, kvh = (u >> 6) & 1, hq = kvh * 4 + ((u >> 4) & 3), qb = u & 15;
        const bf16* Qb = PROJ + (size_t)(b * SEQ + qb * 256) * DINP + COL_BQ + hq * HD;
        const bf16* Kh = PROJ + (size_t)(b * SEQ) * DINP + COL_BK + kvh * HD;
        const bf16* Vh = PROJ + (size_t)(b * SEQ) * DINP + COL_BV + kvh * HD;
        float* Ob = YMIX + (size_t)(b * SEQ + qb * 256) * DM + 512 + hq * HD;
        attn::attn_dense_body<attn::bf16>(Qb, Kh, Vh, Ob, SEQ, lds_gen, F.wave);
        __syncthreads();
    }
}


constexpr size_t WS_OPA = WS_TMP;
constexpr size_t WS_LSE = WS_TMP + (size_t)3 * T * 512 * 4;
__device__ __forceinline__ void phase_attn_a(Frame& F) {
    using namespace dn;
    constexpr int K_OFF = 0, VT_OFF = 69632;
    LAS unsigned char* L = F.lds;
    const int wave = F.wave;
    if (F.G > 64 && blockIdx.x < 32) return;
    const int ufirst = F.G > 64 ? (int)blockIdx.x - 32 : (int)blockIdx.x, ustep = F.G > 64 ? F.G - 32 : F.G;
    for (int u = ufirst; u < 768; u += ustep) {
        int tid_ = wave * 64 + lane_id(); asm volatile("" : "+v"(tid_));
        const int tid = tid_, lane = tid & 63, g4 = lane >> 4, l15 = lane & 15;
        GAS unsigned char* wsq_ = (GAS unsigned char*)F.ws; asm volatile("" : "+s"(wsq_)); unsigned char* wsq = (unsigned char*)wsq_;
        const bf16* PROJ = (const bf16*)(wsq + WS_PROJ);
        const int p = u >> 8, rem = u & 255, b = rem >> 7, hh = (rem >> 5) & 3, w32 = rem & 31;
        const int dsh = 2 * p, dil = 1 << dsh, Lf = SEQ >> dsh, nblk = Lf >> 7;
        const int r = w32 / nblk, i0 = (w32 % nblk) * 128;
        const bf16* base = PROJ + (size_t)(b * SEQ + r) * DINP + hh * HD;
        const size_t jstride = (size_t)dil * DINP;
        __syncthreads();
#pragma unroll
        for (int q = 0; q < 8; ++q) { const int id = tid + 512 * q, row = id >> 4, c16 = id & 15, j = i0 - 64 + row;
            u32x4 v = {0u, 0u, 0u, 0u}; if (j >= 0 && j < Lf) v = *(const u32x4*)(base + (size_t)j * jstride + COL_AK + c16 * 8);
            *(LAS u32x4*)(L + K_OFF + row * 272 + c16 * 16) = v; }
#pragma unroll
        for (int g = 0; g < 8; ++g) { const int kk0 = 32 * wave + 4 * g; unsigned rv[4];
#pragma unroll
            for (int m = 0; m < 4; ++m) { const int j = i0 - 64 + kk0 + m; rv[m] = (j >= 0 && j < Lf) ? *(const unsigned*)(base + (size_t)j * jstride + COL_AV + 2 * lane) : 0u; }
            u32x2 lo, hi; lo.x = (rv[0] & 0xffffu) | (rv[1] << 16); lo.y = (rv[2] & 0xffffu) | (rv[3] << 16); hi.x = (rv[0] >> 16) | (rv[1] & 0xffff0000u); hi.y = (rv[2] >> 16) | (rv[3] & 0xffff0000u);
            *(LAS u32x2*)(L + VT_OFF + (2 * lane) * 528 + kk0 * 2) = lo; *(LAS u32x2*)(L + VT_OFF + (2 * lane + 1) * 528 + kk0 * 2) = hi; }
        const int iq = i0 + 16 * wave + l15;
        bf16x8 qf[4];
#pragma unroll
        for (int kb = 0; kb < 4; ++kb) qf[kb] = *(const bf16x8*)(base + (size_t)iq * jstride + COL_AQ + 32 * kb + 8 * g4);
        __syncthreads();
        f32x4 sc[9];
        const LAS unsigned char* kb_ = L + K_OFF + (16 * wave + l15) * 272 + g4 * 16;
#pragma unroll
        for (int kt = 0; kt < 9; ++kt) { sc[kt] = (f32x4){0.f, 0.f, 0.f, 0.f};
#pragma unroll
            for (int kb = 0; kb < 4; ++kb) sc[kt] = mfma16(*(const LAS bf16x8*)(kb_ + kt * 4352 + kb * 64), qf[kb], sc[kt]); }
        constexpr float C = 0.08838834764831845f * 1.4426950408889634f;
        float mx = -3.0e38f;
#pragma unroll
        for (int kt = 0; kt < 9; ++kt)
#pragma unroll
            for (int rr = 0; rr < 4; ++rr) { const int dlt = -64 + 16 * kt + 4 * g4 + rr - l15, j = iq + dlt; const bool ok = dlt >= -64 && dlt <= 64 && j >= 0 && j < Lf;
                sc[kt][rr] = ok ? sc[kt][rr] : -3.0e38f; mx = fmaxf(mx, sc[kt][rr]); }
        mx = fmaxf(mx, __shfl_xor(mx, 16)); mx = fmaxf(mx, __shfl_xor(mx, 32));
        float lsum = 0.f; const float mC = mx * C;
#pragma unroll
        for (int kt = 0; kt < 9; ++kt)
#pragma unroll
            for (int rr = 0; rr < 4; ++rr) { const float pv = sc[kt][rr] > -1.0e38f ? __builtin_amdgcn_exp2f(sc[kt][rr] * C - mC) : 0.f; sc[kt][rr] = pv; lsum += pv; }
        lsum += __shfl_xor(lsum, 16); lsum += __shfl_xor(lsum, 32);
        f32x4 o[8];
#pragma unroll
        for (int dt = 0; dt < 8; ++dt) o[dt] = (f32x4){0.f, 0.f, 0.f, 0.f};
        const LAS unsigned char* vb_ = L + VT_OFF + l15 * 528 + (16 * wave + 4 * g4) * 2;
#pragma unroll
        for (int pp = 0; pp < 5; ++pp) { u32x4 bw; bw.x = cvtpk(sc[2 * pp][0], sc[2 * pp][1]); bw.y = cvtpk(sc[2 * pp][2], sc[2 * pp][3]);
            if (pp < 4) { bw.z = cvtpk(sc[2 * pp + 1][0], sc[2 * pp + 1][1]); bw.w = cvtpk(sc[2 * pp + 1][2], sc[2 * pp + 1][3]); } else { bw.z = 0u; bw.w = 0u; }
            const bf16x8 bfrag = *reinterpret_cast<bf16x8*>(&bw);
#pragma unroll
            for (int dt = 0; dt < 8; ++dt) { const u32x2 a0 = *(const LAS u32x2*)(vb_ + dt * 8448 + pp * 64); u32x2 a1 = {0u, 0u}; if (pp < 4) a1 = *(const LAS u32x2*)(vb_ + dt * 8448 + pp * 64 + 32);
                u32x4 aw; aw.x = a0.x; aw.y = a0.y; aw.z = a1.x; aw.w = a1.y; o[dt] = mfma16(*reinterpret_cast<bf16x8*>(&aw), bfrag, o[dt]); } }
        const float inv = 1.0f / lsum;
        const size_t t = (size_t)b * SEQ + (size_t)iq * dil + r;
        bf16* OP = (bf16*)(wsq + WS_OPA) + ((size_t)p * T + t) * 512 + hh * HD + 4 * g4;
#pragma unroll
        for (int dt = 0; dt < 8; ++dt) { u32x2 w; w.x = cvtpk(o[dt][0] * inv, o[dt][1] * inv); w.y = cvtpk(o[dt][2] * inv, o[dt][3] * inv); *(u32x2*)(OP + 16 * dt) = w; }
        if (g4 == 0) ((float*)(wsq + WS_LSE))[((size_t)p * T + t) * 4 + hh] = mx * 0.08838834764831845f + __logf(lsum);
    }
}

__device__ __forceinline__ void phase_ynorm(Frame& F, int l, bool naive_dn) {
    const bf16* PROJ = WSP(bf16, WS_PROJ); float* YMIX = WSP(float, WS_YMIX); bf16* Y = WSP(bf16, WS_Y); const float* DO = WSP(float, WS_DO);
    const float* ga = GIN(7) + (size_t)l * 512; const float* gb = GIN(8) + (size_t)l * 1024; const float* gn = GIN(11) + (size_t)l * HD;
    const int gw = F.vcu * NWAVES + F.wave, NGW = F.G * NWAVES, lane = F.lane;
    for (int t = gw; t < T; t += NGW) {
        if (naive_dn) {
#pragma unroll
            for (int hh = 0; hh < 4; ++hh) { const size_t o = (size_t)t * 512 + hh * HD; const float o0 = DO[o + lane] + DO[(size_t)T * 512 + o + lane], o1 = DO[o + lane + 64] + DO[(size_t)T * 512 + o + lane + 64];
                const float rs = rsqrtf(wave_sum(o0 * o0 + o1 * o1) * (1.0f / HD) + EPS);
                const float z0 = bf2f(PROJ[(size_t)t * DINP + COL_CZ + hh * HD + lane]), z1 = bf2f(PROJ[(size_t)t * DINP + COL_CZ + hh * HD + lane + 64]);
                Y[(size_t)t * DM + 1536 + hh * HD + lane] = (bf16)f2bf(o0 * rs * gn[lane] * siluf_(z0)); Y[(size_t)t * DM + 1536 + hh * HD + lane + 64] = (bf16)f2bf(o1 * rs * gn[lane + 64] * siluf_(z1)); }
        }
        const float* yr = YMIX + (size_t)t * DM; bf16* yo = Y + (size_t)t * DM;
        f32x4 bq[4];
#pragma unroll
        for (int j = 0; j < 4; ++j) bq[j] = *(const f32x4*)(yr + 512 + 256 * j + 4 * lane);
        { f32x4 a0, a1;
          if (NAIVE_ATTN_A) { a0 = *(const f32x4*)(yr + 4 * lane); a1 = *(const f32x4*)(yr + 256 + 4 * lane); }
          else { const bf16* OPA = WSP(bf16, WS_OPA); const float* LSE = WSP(float, WS_LSE); const int h0 = lane >> 5;
              float l0[3], l1[3];
#pragma unroll
              for (int p = 0; p < 3; ++p) { l0[p] = LSE[((size_t)p * T + t) * 4 + h0]; l1[p] = LSE[((size_t)p * T + t) * 4 + 2 + h0]; }
              const float m0 = fmaxf(l0[0], fmaxf(l0[1], l0[2])), m1 = fmaxf(l1[0], fmaxf(l1[1], l1[2]));
              float w0[3], w1[3], s0 = 0.f, s1 = 0.f;
#pragma unroll
              for (int p = 0; p < 3; ++p) { w0[p] = __expf(l0[p] - m0); w1[p] = __expf(l1[p] - m1); s0 += w0[p]; s1 += w1[p]; }
              a0 = (f32x4){0.f, 0.f, 0.f, 0.f}; a1 = a0;
#pragma unroll
              for (int p = 0; p < 3; ++p) { const u32x2 x0 = *(const u32x2*)(OPA + ((size_t)p * T + t) * 512 + 4 * lane), x1 = *(const u32x2*)(OPA + ((size_t)p * T + t) * 512 + 256 + 4 * lane);
                  const f32x4 f0 = {__uint_as_float(x0.x << 16), __uint_as_float(x0.x & 0xffff0000u), __uint_as_float(x0.y << 16), __uint_as_float(x0.y & 0xffff0000u)}, f1 = {__uint_as_float(x1.x << 16), __uint_as_float(x1.x & 0xffff0000u), __uint_as_float(x1.y << 16), __uint_as_float(x1.y & 0xffff0000u)};
                  a0 += f0 * (w0[p] / s0); a1 += f1 * (w1[p] / s1); } }
          const float rs = rsqrtf(wave_sum((a0.x * a0.x + a0.y * a0.y) + (a0.z * a0.z + a0.w * a0.w) + (a1.x * a1.x + a1.y * a1.y) + (a1.z * a1.z + a1.w * a1.w)) * (1.0f / 512) + EPS);
          const f32x4 g0 = *(const f32x4*)(ga + 4 * lane), g1 = *(const f32x4*)(ga + 256 + 4 * lane); a0 = a0 * rs * g0; a1 = a1 * rs * g1;
          u32x2 o; o.x = pk2(a0.x, a0.y); o.y = pk2(a0.z, a0.w); *(u32x2*)(yo + 4 * lane) = o; o.x = pk2(a1.x, a1.y); o.y = pk2(a1.z, a1.w); *(u32x2*)(yo + 256 + 4 * lane) = o; }
        { f32x4 a[4]; float ss = 0.f;
#pragma unroll
          for (int j = 0; j < 4; ++j) { a[j] = bq[j]; ss += (a[j].x * a[j].x + a[j].y * a[j].y) + (a[j].z * a[j].z + a[j].w * a[j].w); }
          const float rs = rsqrtf(wave_sum(ss) * (1.0f / 1024) + EPS);
#pragma unroll
          for (int j = 0; j < 4; ++j) { const f32x4 g = *(const f32x4*)(gb + 256 * j + 4 * lane); a[j] = a[j] * rs * g; u32x2 o; o.x = pk2(a[j].x, a[j].y); o.y = pk2(a[j].z, a[j].w); *(u32x2*)(yo + 512 + 256 * j + 4 * lane) = o; } }
    }
}

__device__ __forceinline__ void phase_select(Frame& F) {
    const float* AFF = WSP(float, WS_AFF); int* SELI = WSP(int, WS_SELI); float* SELG = WSP(float, WS_SELG); int* SLOT = WSP(int, WS_SLOT); float* SELR = WSP(float, WS_SELR); const float* RS2 = WSP(float, WS_RS) + T;
    LAS unsigned* key = (LAS unsigned*)F.lds;
    LAS unsigned* hist = key + 4096;
    LAS unsigned* ctl = hist + 256;
    LAS unsigned* scan = ctl + 8;
    const int tid = F.tid;
    for (int u = F.vcu; u < BATCH * NE; u += F.G) {
        const int b = u / NE, e = u % NE;
        __syncthreads();
        for (int i = tid; i < SEQ; i += NTHR) key[i] = __float_as_uint(AFF[(size_t)(b * SEQ + i) * 16 + e]);
        if (tid == 0) { ctl[0] = 0u; ctl[2] = CAP; }
        __syncthreads();
        for (int pass = 3; pass >= 0; --pass) {
            const int shift = pass * 8; const unsigned hmask = pass == 3 ? 0u : ~((1u << (shift + 8)) - 1u);
            if (tid < 256) hist[tid] = 0u;
            __syncthreads();
            const unsigned prefix = ctl[0];
            for (int i = tid; i < SEQ; i += NTHR) { const unsigned k = key[i]; if ((k & hmask) == (prefix & hmask)) __hip_atomic_fetch_add(hist + ((k >> shift) & 255u), 1u, __ATOMIC_RELAXED, __HIP_MEMORY_SCOPE_WORKGROUP); }
            __syncthreads();
            if (tid < 64) {
                const unsigned want = ctl[2]; const unsigned c0 = hist[4 * tid], c1 = hist[4 * tid + 1], c2 = hist[4 * tid + 2], c3 = hist[4 * tid + 3]; const unsigned sl = (c0 + c1) + (c2 + c3);
                unsigned suf = sl;
#pragma unroll
                for (int o = 1; o < 64; o <<= 1) { const unsigned tv = __shfl_down(suf, o); if (tid + o < 64) suf += tv; }
                unsigned cum = suf - sl;
                int bsel = -1; unsigned cb = 0;
                if (cum < want && cum + c3 >= want) { bsel = 3; cb = cum; } cum += c3;
                if (bsel < 0 && cum < want && cum + c2 >= want) { bsel = 2; cb = cum; } cum += c2;
                if (bsel < 0 && cum < want && cum + c1 >= want) { bsel = 1; cb = cum; } cum += c1;
                if (bsel < 0 && cum < want && cum + c0 >= want) { bsel = 0; cb = cum; }
                if (bsel >= 0) { ctl[0] = prefix | ((unsigned)(4 * tid + bsel) << shift); ctl[2] = want - cb; } }
            __syncthreads();
        }
        const unsigned thr = ctl[0], want_eq = ctl[2];
        unsigned cg = 0, ce = 0;
#pragma unroll
        for (int j = 0; j < 8; ++j) { const unsigned k = key[8 * tid + j]; cg += k > thr; ce += k == thr; }
        scan[tid] = cg; scan[512 + tid] = ce;
        __syncthreads();
        if (tid < 64) { unsigned sg = 0, se = 0;
            unsigned lg[8], le[8];
#pragma unroll
            for (int j = 0; j < 8; ++j) { lg[j] = scan[8 * tid + j]; le[j] = scan[512 + 8 * tid + j]; sg += lg[j]; se += le[j]; }
            unsigned pg = sg, pe = se;
#pragma unroll
            for (int o = 1; o < 64; o <<= 1) { const unsigned tg = __shfl_up(pg, o), te = __shfl_up(pe, o); if (tid >= o) { pg += tg; pe += te; } }
            unsigned bg = pg - sg, be = pe - se;
#pragma unroll
            for (int j = 0; j < 8; ++j) { scan[8 * tid + j] = bg; scan[512 + 8 * tid + j] = be; bg += lg[j]; be += le[j]; }
        }
        __syncthreads();
        unsigned pg = scan[tid], pe = scan[512 + tid];
#pragma unroll
        for (int j = 0; j < 8; ++j) { const int i = 8 * tid + j; const unsigned k = key[i]; int slot = -1;
            if (k > thr) { slot = (int)(pg + (pe < want_eq ? pe : want_eq)); pg++; }
            else if (k == thr) { if (pe < want_eq) slot = (int)(pg + pe); pe++; }
            SLOT[(size_t)(b * NE + e) * SEQ + i] = slot;
            if (slot >= 0) { SELI[(size_t)(b * NE + e) * CAP + slot] = i; SELG[(size_t)e * 1024 + b * CAP + slot] = __uint_as_float(k); SELR[(size_t)e * 1024 + b * CAP + slot] = RS2[b * SEQ + i]; } }
    }
}
__device__ __forceinline__ void phase_gather(Frame& F) {
    const int* SELI = WSP(int, WS_SELI); const bf16* HN = WSP(bf16, WS_HN); bf16* XS = WSP(bf16, WS_XS);
    const int gw = F.vcu * NWAVES + F.wave, NGW = F.G * NWAVES, lane = F.lane;
    for (int r = gw; r < NE * 1024; r += NGW) { const int e = r >> 10, q = r & 1023, b = q >> 9, slot = q & 511; const int i = SELI[(size_t)(b * NE + e) * CAP + slot];
        const u32x4* src = (const u32x4*)(HN + (size_t)(b * SEQ + i) * DM); u32x4* dst = (u32x4*)(XS + (size_t)r * DM);
#pragma unroll
        for (int j = 0; j < 4; ++j) dst[lane + 64 * j] = src[lane + 64 * j]; }
}
#define ADD_BF4(V, W) do { (V).x += __uint_as_float((W).x << 16); (V).y += __uint_as_float((W).x & 0xffff0000u); (V).z += __uint_as_float((W).y << 16); (V).w += __uint_as_float((W).y & 0xffff0000u); } while (0)
__device__ __forceinline__ void phase_combine(Frame& F) {
    const bf16* H = WSP(bf16, WS_H); bf16* H1 = WSP(bf16, WS_HN); float* RS3 = WSP(float, WS_RS) + 2 * T; const int* SLOT = WSP(int, WS_SLOT); const bf16* YEXP = WSP(bf16, WS_YEXP);
    const int gw = F.vcu * NWAVES + F.wave, NGW = F.G * NWAVES, lane = F.lane;
    int nslot = -1; u32x2 hw[8];
    if (gw < T) { nslot = lane < NE ? SLOT[(size_t)((gw >> 12) * NE + lane) * SEQ + (gw & (SEQ - 1))] : -1;
#pragma unroll
        for (int j = 0; j < 8; ++j) hw[j] = *(const u32x2*)(H + (size_t)gw * DM + 4 * lane + 256 * j); }
    for (int t = gw; t < T; t += NGW) { const int b = t >> 12;
        const int myslot = nslot; f32x4 v[8];
#pragma unroll
        for (int j = 0; j < 8; ++j) { v[j].x = __uint_as_float(hw[j].x << 16); v[j].y = __uint_as_float(hw[j].x & 0xffff0000u); v[j].z = __uint_as_float(hw[j].y << 16); v[j].w = __uint_as_float(hw[j].y & 0xffff0000u); }
        const int tn = t + NGW;
        if (tn < T) { nslot = lane < NE ? SLOT[(size_t)((tn >> 12) * NE + lane) * SEQ + (tn & (SEQ - 1))] : -1;
#pragma unroll
            for (int j = 0; j < 8; ++j) hw[j] = *(const u32x2*)(H + (size_t)tn * DM + 4 * lane + 256 * j); }
        unsigned long long mask = __ballot(myslot >= 0);
        while (mask) {
            const int e0 = __builtin_ctzll(mask); mask &= mask - 1; const int s0 = __builtin_amdgcn_readlane(myslot, e0);
            const bool h1 = mask != 0; int e1 = e0, s1 = s0; if (h1) { e1 = __builtin_ctzll(mask); mask &= mask - 1; s1 = __builtin_amdgcn_readlane(myslot, e1); }
            const bool h2 = mask != 0; int e2 = e0, s2 = s0; if (h2) { e2 = __builtin_ctzll(mask); mask &= mask - 1; s2 = __builtin_amdgcn_readlane(myslot, e2); }
            const bf16* y0 = YEXP + (size_t)(e0 * 1024 + b * CAP + s0) * DM + 4 * lane; const bf16* y1 = YEXP + (size_t)(e1 * 1024 + b * CAP + s1) * DM + 4 * lane; const bf16* y2 = YEXP + (size_t)(e2 * 1024 + b * CAP + s2) * DM + 4 * lane;
            u32x2 w0[8], w1[8], w2[8];
#pragma unroll
            for (int j = 0; j < 8; ++j) w0[j] = *(const u32x2*)(y0 + 256 * j);
            if (h1) {
#pragma unroll
                for (int j = 0; j < 8; ++j) w1[j] = *(const u32x2*)(y1 + 256 * j); }
            if (h2) {
#pragma unroll
                for (int j = 0; j < 8; ++j) w2[j] = *(const u32x2*)(y2 + 256 * j); }
#pragma unroll
            for (int j = 0; j < 8; ++j) ADD_BF4(v[j], w0[j]);
            if (h1) {
#pragma unroll
                for (int j = 0; j < 8; ++j) ADD_BF4(v[j], w1[j]); }
            if (h2) {
#pragma unroll
                for (int j = 0; j < 8; ++j) ADD_BF4(v[j], w2[j]); }
        }
        float ss = 0.f;
#pragma unroll
        for (int j = 0; j < 8; ++j) { u32x2 w; w.x = pk2(v[j].x, v[j].y); w.y = pk2(v[j].z, v[j].w); *(u32x2*)(H1 + (size_t)t * DM + 4 * lane + 256 * j) = w; ss += (v[j].x * v[j].x + v[j].y * v[j].y) + (v[j].z * v[j].z + v[j].w * v[j].w); }
        const float rs = rsqrtf(wave_sum(ss) * (1.0f / DM) + EPS); if (lane == 0) RS3[t] = rs;
    }
}
#undef ADD_BF4
__device__ __forceinline__ void phase_final(Frame& F, float oscale) {
    const bf16* H = WSP(bf16, WS_H); const float* gain = GIN(21);
    const int gw = F.vcu * NWAVES + F.wave, NGW = F.G * NWAVES, lane = F.lane;
    for (int t = gw; t < T; t += NGW) { const bf16* hr = H + (size_t)t * DM; f32x4 v[8]; float ss = 0.f;
#pragma unroll
        for (int j = 0; j < 8; ++j) { const u32x2 w = *(const u32x2*)(hr + 4 * lane + 256 * j); v[j].x = __uint_as_float(w.x << 16); v[j].y = __uint_as_float(w.x & 0xffff0000u); v[j].z = __uint_as_float(w.y << 16); v[j].w = __uint_as_float(w.y & 0xffff0000u); ss += (v[j].x * v[j].x + v[j].y * v[j].y) + (v[j].z * v[j].z + v[j].w * v[j].w); }
        const float rs = rsqrtf(wave_sum(ss) * (1.0f / DM) + EPS);
#pragma unroll
        for (int j = 0; j < 8; ++j) { const f32x4 g = *(const f32x4*)(gain + 4 * lane + 256 * j); *(f32x4*)(F.out + (size_t)t * DM + 4 * lane + 256 * j) = v[j] * (rs * oscale) * g; } }
}


#ifdef DBG_CHECKSUM
constexpr int CW_SUM = 8192;
constexpr size_t WS_PREV = WS_DQ;
__device__ __forceinline__ void dbg_checksum(Frame& F) {
    struct Buf { size_t off, bytes; };
    const Buf bufs[9] = {{WS_TL, (size_t)T * 16 * 4}, {WS_PROJ, (size_t)T * DINP * 2}, {WS_CM, (size_t)16 * 64 * 16384 * 2}, {WS_CN, (size_t)16 * 64 * 16384 * 2}, {WS_CP, (size_t)16 * 64 * 8192 * 2},
                         {WS_CR, (size_t)16 * 64 * 8192 * 4}, {WS_CS, (size_t)16 * 64 * 16384 * 2}, {WS_Y, (size_t)T * DM * 2}, {WS_H, (size_t)T * DM * 4}};
    const size_t gt = (size_t)F.vcu * NTHR + F.tid, NT = (size_t)F.G * NTHR;
#pragma unroll 1
    for (int k = 0; k < 9; ++k) { const unsigned* p = (const unsigned*)(F.ws + bufs[k].off); unsigned a = 0;
        for (size_t i = gt; i < bufs[k].bytes / 4; i += NT) a += p[i] * (unsigned)(2654435761u + 2u * (unsigned)(i & 1023));
#pragma unroll
        for (int o = 1; o < 64; o <<= 1) a += __shfl_xor(a, o);
        if (F.lane == 0) __hip_atomic_fetch_add((unsigned*)(F.ws + WS_CTL) + CW_SUM + k, a, __ATOMIC_RELAXED, __HIP_MEMORY_SCOPE_AGENT); }
}
__device__ __forceinline__ unsigned dbg_compare(Frame& F) {
    const unsigned* cur = (const unsigned*)(F.ws + WS_CTL) + CW_SUM; const unsigned* prev = (const unsigned*)(F.ws + WS_PREV);
    unsigned code = 0;
    if (__hip_atomic_load(prev, __ATOMIC_RELAXED, __HIP_MEMORY_SCOPE_AGENT) == 0x600DF00Du) {
#pragma unroll 1
        for (int k = 0; k < 9; ++k) if (__hip_atomic_load(prev + 1 + k, __ATOMIC_RELAXED, __HIP_MEMORY_SCOPE_AGENT) != __hip_atomic_load(cur + k, __ATOMIC_RELAXED, __HIP_MEMORY_SCOPE_AGENT)) code |= 1u << k; }
    return code;
}
__device__ __forceinline__ void dbg_store_prev(Frame& F) {
    if (F.vcu == 0 && F.tid == 0) { const unsigned* cur = (const unsigned*)(F.ws + WS_CTL) + CW_SUM; unsigned* prev = (unsigned*)(F.ws + WS_PREV);
        for (int k = 0; k < 9; ++k) __hip_atomic_store(prev + 1 + k, __hip_atomic_load(cur + k, __ATOMIC_RELAXED, __HIP_MEMORY_SCOPE_AGENT), __ATOMIC_RELAXED, __HIP_MEMORY_SCOPE_AGENT);
        __hip_atomic_store(prev, 0x600DF00Du, __ATOMIC_RELAXED, __HIP_MEMORY_SCOPE_AGENT); }
}
#endif

struct EpiStoreBf16 { bf16* C; int ldc; __device__ __forceinline__ void operator()(int m, int n, float v) const { C[(size_t)m * ldc + n] = (bf16)f2bf(v); } };
struct EpiStoreF32 { float* C; int ldc; __device__ __forceinline__ void operator()(int m, int n, float v) const { C[(size_t)m * ldc + n] = v; } };
struct EpiResid { float* H; __device__ __forceinline__ void operator()(int m, int n, float v) const { H[(size_t)m * DM + n] += v; } };
struct EpiDown { bf16* C; const float* gate; __device__ __forceinline__ void operator()(int m, int n, float v) const { C[(size_t)m * DM + n] = (bf16)f2bf(v * gate[m]); } };
struct EpiPle { float* H; const bf16* PL; __device__ __forceinline__ void operator()(int m, int n, float v) const { H[(size_t)m * DM + n] += sigmoidf_(v) * bf2f(PL[(size_t)m * DM + n]); } };

#ifndef NAIVE_GEMM
#define NAIVE_GEMM 0
#endif
constexpr int NPL = 14;
constexpr int NPHASES = 1 + DEPTH * NPL + 1;
struct Args { const float* in[22]; float* out; unsigned char* ws; int ph_lo, ph_hi; };

#ifndef ONLY
#define ONLY -1
#endif
#ifndef MASK
#define MASK 0xFFFF
#endif
#define EN(j) ((ONLY < 0 || ONLY == (j)) && ((MASK >> (j)) & 1))
#ifndef REPMASK
#define REPMASK 0
#endif
#define NREP(b) (((REPMASK >> (b)) & 1) ? 2 : 1)
#define REPEAT(b) for (int rep_ = 0; rep_ < NREP(b); ++rep_, __syncthreads())
#define IN(k) (lo <= (k) && (k) < hi)
#define INL(j) (EN((j) + 1) && IN(pb + (j)) && seam(pb + (j)))
#define LAUNDER() do { GAS unsigned char* w_ = (GAS unsigned char*)args.ws; int t_ = wave0 * 64 + lane_id(); const float* const __attribute__((address_space(4)))* i_ = (const float* const __attribute__((address_space(4)))*)__builtin_amdgcn_kernarg_segment_ptr(); int v_ = vcu0, g_ = (int)gridDim.x; asm volatile("" : "+s"(w_), "+v"(t_), "+s"(i_), "+s"(v_), "+s"(g_)); F.ws = (unsigned char*)w_; F.tid = t_; F.lane = t_ & 63; F.wave = wave0; F.in = i_; F.vcu = v_; F.G = g_; } while (0)
#define seam(k) (((k) > lo) ? (bar_sync(bar, (unsigned*)(args.ws + WS_CTL) + CW_BAR), true) : true)

template <int l>
__device__ __forceinline__ void layer_phases(Frame& F, const Args& args, XcdBarrier& bar, const int lo, const int hi, const int vcu0, unsigned char* lds_raw, const int wave0) {
        const int pb = 1 + l * NPL;
#define wl (F.ws + WS_W + (size_t)l * SZ_LAYERW)
        if (INL(0)) REPEAT(1) { LAUNDER(); phase_norm<1>(F, WSP(float, WS_WTL) + (size_t)(2 * l) * 16 * DM, WSP(float, WS_TL), WSP(float, WS_RS)); }
        if (INL(1)) REPEAT(2) { LAUNDER();
#if NAIVE_GEMM
            EpiStoreBf16 E{WSP(bf16, WS_PROJ), DINP}; naive_gemm(F, WSP(bf16, WS_HN), DM, (const bf16*)(wl + OFF_WIN), DM, T, DINP, DM, E);
#else
            { pg8::Gemm g{WSP(bf16, WS_H), (const bf16*)(wl + OFF_WIN), T, DINP, DM}; pg8::StaticOrder S; S.init(T, DINP, F.G, (int)blockIdx.x); pg8::EpiBf16Rs E{WSP(bf16, WS_PROJ), DINP, WSP(float, WS_RS)};
              pg8::gemm_phase<pg8::EpiBf16Rs, pg8::StaticOrder>(F.lds, g, S, E, nullptr, F.wave); }
#endif
        }
        if (INL(2)) { REPEAT(3) { LAUNDER(); if (NAIVE_DN) phase_dn_prep_naive(F, l); else phase_dn_chunk(F, l); } __syncthreads(); LAUNDER(); phase_post(F, l); }
        if (INL(3)) { REPEAT(4) { LAUNDER(); phase_mix_naive(F, (unsigned*)(F.ws + WS_CTL) + CW_SCAN + 64 * l); } if (!NAIVE_ATTN_A) REPEAT(5) { __syncthreads(); LAUNDER(); phase_attn_a(F); } if (!NAIVE_ATTN_B) REPEAT(6) { __syncthreads(); LAUNDER(); phase_attn_b(F, (char*)lds_raw); }
            if (!NAIVE_DN && F.G == 256 && blockIdx.x >= 32) { __syncthreads(); LAUNDER();
                unsigned* cnt = (unsigned*)(F.ws + WS_CTL) + CW_SCAN + 64 * l;
                if (F.tid == 0) { while (xb_ld(cnt) < 32u) __builtin_amdgcn_s_sleep(1); __builtin_amdgcn_fence(__ATOMIC_ACQUIRE, "agent"); asm volatile("s_waitcnt vmcnt(0)" ::: "memory"); }
                __syncthreads();
                const int n = (int)blockIdx.x - 32, first = n >= 96 ? n - 96 : 384 + n, step = n >= 96 ? 128 : 96, end = n >= 96 ? 384 : 512;
                phase_dn_out(F, l, first, step, end); } }
        if (INL(4)) { LAUNDER(); if (!NAIVE_DN && F.G != 256) { phase_dn_out(F, l, F.vcu, F.G, 512); __syncthreads(); LAUNDER(); } REPEAT(8) phase_ynorm(F, l, NAIVE_DN != 0); }
        if (INL(5)) { LAUNDER();
#if NAIVE_GEMM
            EpiResid E{WSP(float, WS_H)}; naive_gemm(F, WSP(bf16, WS_Y), DM, (const bf16*)(wl + OFF_WOUT), DM, T, DM, DM, E);
#else
            pg8::Gemm g{WSP(bf16, WS_Y), (const bf16*)(wl + OFF_WOUT), T, DM, DM}; pg8::StaticOrder S; S.init(T, DM, F.G, (int)blockIdx.x); pg8::EpiResidBf16 E{WSP(bf16, WS_H), DM};
            pg8::gemm_phase<pg8::EpiResidBf16, pg8::StaticOrder>(F.lds, g, S, E, nullptr, F.wave);
#endif
        }
        if (INL(6)) REPEAT(9) { LAUNDER(); phase_norm<2>(F, WSP(float, WS_WTL) + (size_t)(2 * l + 1) * 16 * DM, WSP(float, WS_AFF), WSP(float, WS_RS) + T); }
        if (INL(7)) REPEAT(10) { LAUNDER(); phase_select(F);
#if !NAIVE_GEMM
            if (F.G == 256 && F.vcu >= 32) { pg8::Gemm g{WSP(bf16, WS_PB) + (size_t)l * T * PLE, (const bf16*)(wl + OFF_WP), T, DM, PLE}; pg8::ShadowOrder S{F.vcu - 32}; pg8::EpiBf16 E{WSP(bf16, WS_PL), DM};
              pg8::gemm_phase<pg8::EpiBf16, pg8::ShadowOrder>(F.lds, g, S, E, nullptr, F.wave); }
#endif
        }
        if (NAIVE_GEMM && INL(8)) REPEAT(11) { LAUNDER(); phase_gather(F); }
        if (INL(9)) REPEAT(12) { LAUNDER();
#if NAIVE_GEMM
            for (int e = 0; e < NE; ++e) { EpiStoreF32 E{WSP(float, WS_TMP) + (size_t)e * 1024 * 2048, 2048};
                naive_gemm(F, WSP(bf16, WS_XS) + (size_t)e * 1024 * DM, DM, (const bf16*)(wl + OFF_WGU) + (size_t)e * 2048 * DM, DM, 1024, 2048, DM, E); }
            { EpiStoreBf16 E{WSP(bf16, WS_PL), DM}; naive_gemm(F, WSP(bf16, WS_PB) + (size_t)l * T * PLE, PLE, (const bf16*)(wl + OFF_WP), PLE, T, DM, PLE, E); }
#else
            { pg8::Gemm g{WSP(bf16, WS_H), (const bf16*)(wl + OFF_WGU), NE * 1024, NE * 2048, DM}; pg8::GroupedGatherOrder S{F.G, F.vcu, WSP(int, WS_SELI)}; pg8::EpiGateUp E{WSP(bf16, WS_HID), WSP(float, WS_SELR)};
              pg8::gemm_phase<pg8::EpiGateUp, pg8::GroupedGatherOrder>(F.lds, g, S, E, nullptr, F.wave); }
#endif
        }
#if !NAIVE_GEMM
        if (F.G != 256 && INL(10)) REPEAT(13) { LAUNDER(); pg8::Gemm g{WSP(bf16, WS_PB) + (size_t)l * T * PLE, (const bf16*)(wl + OFF_WP), T, DM, PLE}; pg8::StaticOrder S; S.init(T, DM, F.G, (int)blockIdx.x); pg8::EpiBf16 E{WSP(bf16, WS_PL), DM};
              pg8::gemm_phase<pg8::EpiBf16, pg8::StaticOrder>(F.lds, g, S, E, nullptr, F.wave); }
#endif
        if (NAIVE_GEMM && INL(10)) {
            const float* TMP = WSP(float, WS_TMP); bf16* HID = WSP(bf16, WS_HID);
            for (size_t i = (size_t)F.vcu * NTHR + F.tid; i < (size_t)NE * 1024 * EFF; i += (size_t)F.G * NTHR) { const size_t r = i >> 10; const int f = (int)(i & 1023);
                const float gt = TMP[r * 2048 + (f >> 7) * 256 + (f & 127)], up = TMP[r * 2048 + (f >> 7) * 256 + 128 + (f & 127)]; HID[i] = (bf16)f2bf(siluf_(gt) * up); }
        }
        if (INL(11)) REPEAT(14) { LAUNDER();
#if NAIVE_GEMM
            for (int e = 0; e < NE; ++e) { EpiDown E{WSP(bf16, WS_YEXP) + (size_t)e * 1024 * DM, WSP(float, WS_SELG) + (size_t)e * 1024};
                naive_gemm(F, WSP(bf16, WS_HID) + (size_t)e * 1024 * EFF, EFF, (const bf16*)(wl + OFF_WD) + (size_t)e * 2048 * EFF, EFF, 1024, DM, EFF, E); }
#else
            pg8::Gemm g{WSP(bf16, WS_HID), (const bf16*)(wl + OFF_WD), NE * 1024, NE * 2048, EFF}; pg8::GroupedOrder S{F.G, F.vcu}; pg8::EpiDownBf16 E{WSP(bf16, WS_YEXP), WSP(float, WS_SELG)};
            pg8::gemm_phase<pg8::EpiDownBf16, pg8::GroupedOrder>(F.lds, g, S, E, nullptr, F.wave);
#endif
        }
        if (INL(12)) { LAUNDER(); phase_combine(F); }
        if (INL(13)) { LAUNDER();
#if NAIVE_GEMM
            EpiPle E{WSP(float, WS_H), WSP(bf16, WS_PL)}; naive_gemm(F, WSP(bf16, WS_HN), DM, (const bf16*)(wl + OFF_WPG), DM, T, DM, DM, E);
#else
            pg8::Gemm g{WSP(bf16, WS_HN), (const bf16*)(wl + OFF_WPG), T, DM, DM}; pg8::StaticOrder S; S.init(T, DM, F.G, (int)blockIdx.x); pg8::EpiPleBf16 E{WSP(bf16, WS_HN), WSP(bf16, WS_H), WSP(bf16, WS_PL), WSP(float, WS_RS) + 2 * T};
            pg8::gemm_phase<pg8::EpiPleBf16, pg8::StaticOrder>(F.lds, g, S, E, nullptr, F.wave);
#endif
        }
}

__global__ void __launch_bounds__(NTHR, 2) mk_fwd(Args args) {
    extern __shared__ __attribute__((aligned(16))) unsigned char lds_raw[];
    Frame F;
    F.lds = (LAS unsigned char*)lds_raw;
    const int wave0 = __builtin_amdgcn_readfirstlane((int)threadIdx.x >> 6);
    F.wave = wave0; F.tid = wave0 * 64 + lane_id(); F.lane = F.tid & 63;
    F.G = gridDim.x; { const int bx = blockIdx.x; F.vcu = (F.G % 8 == 0) ? (bx % 8) * (F.G / 8) + bx / 8 : bx; }
    const int vcu0 = F.vcu;
    F.in = (const float* const __attribute__((address_space(4)))*)__builtin_amdgcn_kernarg_segment_ptr(); F.out = args.out; F.ws = args.ws;
    const int lo = args.ph_lo, hi = args.ph_hi;
    volatile LAS unsigned* misc = (volatile LAS unsigned*)(F.lds + LDS_MISC);
#ifdef CHECK_NAN_FILL
    for (int i = F.tid; i < LDS_MISC / 4; i += NTHR) ((LAS unsigned*)F.lds)[i] = 0xffffffffu;
    __syncthreads();
#endif
    if (F.tid < 4) misc[F.tid] = 0u;
    __syncthreads();
    XcdBarrier bar; bar.bar = (unsigned*)(args.ws + WS_CTL) + CW_BAR; bar.x = 0; bar.st = misc; bar.w0 = wave0;
    if (hi - lo > 1) bar = xcd_barrier_post((unsigned*)(args.ws + WS_CTL) + CW_BAR, misc, wave0);
    if (EN(0) && IN(0)) REPEAT(0) phase_prologue(F);
    layer_phases<0>(F, args, bar, lo, hi, vcu0, lds_raw, wave0);
    layer_phases<1>(F, args, bar, lo, hi, vcu0, lds_raw, wave0);
    layer_phases<2>(F, args, bar, lo, hi, vcu0, lds_raw, wave0);
    layer_phases<3>(F, args, bar, lo, hi, vcu0, lds_raw, wave0);
#ifdef DBG_CHECKSUM
    if (IN(NPHASES - 1)) { xcd_barrier(bar); LAUNDER(); dbg_checksum(F); xcd_barrier(bar); const unsigned code = dbg_compare(F); xcd_barrier(bar); dbg_store_prev(F); phase_final(F, 1.0f + (float)code); }
#else
    if (EN(15) && IN(NPHASES - 1) && seam(NPHASES - 1)) phase_final(F, 1.0f);
#endif
#undef IN
#undef INL
#undef seam
#undef wl
}

extern "C" void kernel_launch(void* const* d_in, const int* in_sizes, int n_in, void* d_out, int out_size, void* d_ws, size_t ws_size, hipStream_t stream) {
    static int grid = 0;
    if (grid == 0) {
        if (n_in != 22 || out_size != T * DM || ws_size < WS_END) { fprintf(stderr, "kernel_launch: unexpected shapes (n_in %d out %d ws %zu need %zu)\n", n_in, out_size, ws_size, (size_t)WS_END); grid = -1; return; }
        int dev = 0, cus = 0;
        if (hipGetDevice(&dev) != hipSuccess || hipDeviceGetAttribute(&cus, hipDeviceAttributeMultiprocessorCount, dev) != hipSuccess) { grid = -1; return; }
        if (hipFuncSetAttribute((const void*)mk_fwd, hipFuncAttributeMaxDynamicSharedMemorySize, LDS_BYTES) != hipSuccess) { fprintf(stderr, "kernel_launch: hipFuncSetAttribute failed\n"); grid = -1; return; }
        grid = cus;
    }
    if (grid < 0) return;
    Args a{};
    for (int i = 0; i < 22; ++i) a.in[i] = (const float*)d_in[i];
    a.out = (float*)d_out; a.ws = (unsigned char*)d_ws;
    if (hipMemsetAsync((char*)d_ws + WS_CTL, 0, CTL_BYTES, stream) != hipSuccess) { fprintf(stderr, "kernel_launch: memset failed\n"); return; }
#if N_LAUNCH_PER_PHASE
    for (int ph = 0; ph < NPHASES; ++ph) {
        a.ph_lo = ph; a.ph_hi = ph + 1;
        hipLaunchKernelGGL(mk_fwd, dim3(grid), dim3(NTHR), LDS_BYTES, stream, a);
    }
#else
    a.ph_lo = 0; a.ph_hi = NPHASES;
    hipLaunchKernelGGL(mk_fwd, dim3(grid), dim3(NTHR), LDS_BYTES, stream, a);
#endif
}
```

```cpp
#include <hip/hip_runtime.h>
#include <cstdio>
#include <cstdint>

#define LAS __attribute__((address_space(3)))
#define GAS __attribute__((address_space(1)))
typedef unsigned short bf16;
typedef float f32x4 __attribute__((ext_vector_type(4)));
typedef unsigned u32x4 __attribute__((ext_vector_type(4)));
typedef unsigned u32x2 __attribute__((ext_vector_type(2)));
typedef short bf16x8 __attribute__((ext_vector_type(8)));

constexpr int BATCH = 2, SEQ = 4096, T = BATCH * SEQ, DM = 2048, DEPTH = 4, HD = 128;
constexpr int DIN = 5136, DINP = 5120;
constexpr int COL_AQ = 0, COL_AK = 512, COL_AV = 1024, COL_BQ = 1536, COL_BK = 2560, COL_BV = 2816, COL_CQKV = 3072, COL_CZ = 4608;
constexpr int NE = 16, CAP = 512, EFF = 1024, PLE = 256;
constexpr float EPS = 1e-6f;
constexpr int NWAVES = 8, NTHR = 512;
constexpr int LDS_BYTES = 147456, LDS_MISC = 147456 - 256;
constexpr int CW_SCAN = 32768;
constexpr int CW_BAR = 4096;

constexpr size_t al256(size_t x) { return (x + 255) / 256 * 256; }
constexpr size_t WS_CTL = 0, CTL_BYTES = 1u << 20;
constexpr size_t SZ_WIN = (size_t)DINP * DM * 2, SZ_WOUT = (size_t)DM * DM * 2, SZ_WGU = (size_t)NE * 2048 * DM * 2, SZ_WD = (size_t)NE * DM * EFF * 2, SZ_WPG = (size_t)DM * DM * 2, SZ_WP = (size_t)DM * PLE * 2;
constexpr size_t SZ_LAYERW = SZ_WIN + SZ_WOUT + SZ_WGU + SZ_WD + SZ_WPG + SZ_WP;
constexpr size_t OFF_WIN = 0, OFF_WOUT = OFF_WIN + SZ_WIN, OFF_WGU = OFF_WOUT + SZ_WOUT, OFF_WD = OFF_WGU + SZ_WGU, OFF_WPG = OFF_WD + SZ_WD, OFF_WP = OFF_WPG + SZ_WPG;
constexpr size_t WS_W = WS_CTL + CTL_BYTES;
constexpr size_t WS_PB = WS_W + DEPTH * SZ_LAYERW;
constexpr size_t WS_TABA = WS_PB + (size_t)DEPTH * T * PLE * 2;
constexpr size_t WS_TABB = WS_TABA + (size_t)SEQ * 16 * 8;
constexpr size_t WS_H = al256(WS_TABB + 64 * 32 * 8);
constexpr size_t WS_HN = WS_H + (size_t)T * DM * 4;
constexpr size_t WS_TL = WS_HN + (size_t)T * DM * 2;
constexpr size_t WS_PROJ = WS_TL + (size_t)T * 16 * 4;
constexpr size_t WS_YMIX = WS_PROJ + (size_t)T * DINP * 2;
constexpr size_t WS_Y = WS_YMIX + (size_t)T * DM * 4;
constexpr size_t WS_AFF = WS_Y + (size_t)T * DM * 2;
constexpr size_t WS_SELI = WS_AFF + (size_t)T * 16 * 4;
constexpr size_t WS_SELG = WS_SELI + (size_t)BATCH * NE * CAP * 4;
constexpr size_t WS_SLOT = WS_SELG + (size_t)BATCH * NE * CAP * 4;
constexpr size_t WS_XS = WS_SLOT + (size_t)BATCH * NE * SEQ * 4;
constexpr size_t WS_HID = WS_XS + (size_t)NE * 1024 * DM * 2;
constexpr size_t WS_YEXP = WS_HID + (size_t)NE * 1024 * EFF * 2;
constexpr size_t WS_PL = WS_YEXP + (size_t)NE * 1024 * DM * 2;
constexpr size_t WS_DQ = WS_PL + (size_t)T * DM * 2;
constexpr size_t WS_DK = WS_DQ + (size_t)T * 512 * 4;
constexpr size_t WS_DV = WS_DK + (size_t)T * 512 * 4;
constexpr size_t WS_DB = WS_DV + (size_t)T * 512 * 4;
constexpr size_t WS_DG = WS_DB + (size_t)2 * T * 4 * 4;
constexpr size_t WS_DO = WS_DG + (size_t)2 * T * 4 * 4;
constexpr size_t WS_TMP = al256(WS_DO + (size_t)2 * T * 512 * 4);
constexpr size_t WS_CM = WS_TMP + (size_t)NE * 1024 * 2048 * 4;
constexpr size_t WS_CN = WS_CM + (size_t)16 * 64 * 128 * 128 * 2;
constexpr size_t WS_CS = WS_CN + (size_t)16 * 64 * 128 * 128 * 2;
constexpr size_t WS_CP = WS_CS + (size_t)16 * 64 * 128 * 128 * 2;
constexpr size_t WS_CR = WS_CP + (size_t)16 * 64 * 64 * 128 * 2;
constexpr size_t WS_END = WS_CR + (size_t)16 * 64 * 64 * 128 * 4;
constexpr size_t WS_RS = WS_XS;
constexpr size_t WS_SELR = WS_XS + (size_t)3 * T * 4;
constexpr size_t WS_WTL = WS_SELR + (size_t)NE * 1024 * 4;
static_assert(WS_END < 2140000000ull, "workspace map");

__device__ const double INV_A[16] = {1.0, 0.44036660267178046, 0.19392274474868576, 0.08539710028576561, 0.03760603093086393, 0.016560440080994443, 0.0072926647372171085, 0.003211445994752591, 0.0014142135623730952, 0.000622772421914596, 0.0002742481756762073, 0.00012076973741146504, 5.318295896944988e-05, 2.341999896140934e-05, 1.0313385377212458e-05, 4.5416704806078695e-06};
__device__ const double INV_B[32] = {1.0, 0.7498942093324559, 0.5623413251903491, 0.4216965034285822, 0.31622776601683794, 0.23713737056616552, 0.1778279410038923, 0.1333521432163324, 0.09999999999999999, 0.07498942093324558, 0.056234132519034905, 0.042169650342858224, 0.03162277660168379, 0.023713737056616554, 0.01778279410038923, 0.013335214321633239, 0.01, 0.007498942093324559, 0.005623413251903491, 0.004216965034285822, 0.0031622776601683794, 0.002371373705661655, 0.0017782794100389228, 0.0013335214321633238, 0.001, 0.0007498942093324559, 0.000562341325190349, 0.00042169650342858224, 0.00031622776601683794, 0.00023713737056616554, 0.0001778279410038923, 0.0001333521432163324};

#ifndef N_LAUNCH_PER_PHASE
#define N_LAUNCH_PER_PHASE 0
#endif
#ifndef NAIVE_DN
#define NAIVE_DN 0
#endif
#ifndef NAIVE_ATTN_A
#define NAIVE_ATTN_A 0
#endif
#ifndef NAIVE_ATTN_B
#define NAIVE_ATTN_B 0
#endif
__device__ __forceinline__ int lane_id() { int l; asm volatile("v_mbcnt_lo_u32_b32 %0, -1, 0\n\tv_mbcnt_hi_u32_b32 %0, -1, %0" : "=v"(l)); return l; }
#define TIDX(w0) ((w0) * 64 + lane_id())
__device__ __forceinline__ float bperm(float v, int src_lane) { return __int_as_float(__builtin_amdgcn_ds_bpermute(src_lane << 2, __float_as_int(v))); }
typedef __bf16 bf16v2_t __attribute__((ext_vector_type(2)));
typedef float f32v2_t __attribute__((ext_vector_type(2)));
__device__ __forceinline__ unsigned cvt_pk_rne(float lo, float hi) { const f32v2_t v = {lo, hi}; return __builtin_bit_cast(unsigned, __builtin_convertvector(v, bf16v2_t)); }
__device__ __forceinline__ float bf2f(bf16 b) { return __uint_as_float(((unsigned)b) << 16); }
__device__ __forceinline__ unsigned f2bf(float f) { unsigned u = __float_as_uint(f); return (u + 0x7fffu + ((u >> 16) & 1u)) >> 16; }
__device__ __forceinline__ unsigned pk2(float lo, float hi) { return cvt_pk_rne(lo, hi); }
__device__ __forceinline__ float wave_sum(float v) {
#pragma unroll
    for (int o = 1; o < 64; o <<= 1) v += __shfl_xor(v, o);
    return v;
}
__device__ __forceinline__ float wave_max(float v) {
#pragma unroll
    for (int o = 1; o < 64; o <<= 1) v = fmaxf(v, __shfl_xor(v, o));
    return v;
}
__device__ __forceinline__ float sigmoidf_(float x) { return __builtin_amdgcn_rcpf(1.0f + __expf(-x)); }
__device__ __forceinline__ float siluf_(float x) { return x * __builtin_amdgcn_rcpf(1.0f + __expf(-x)); }
__device__ __forceinline__ float softplusf_(float x) { const float e = __expf(-fabsf(x)); const float lg = e < 1e-3f ? e * (1.0f - 0.5f * e + 0.33333333f * e * e) : __logf(1.0f + e); return fmaxf(x, 0.f) + lg; }
__device__ __forceinline__ void sincos_d(double a, float& c, float& s) {
    const double q = rint(a * 0.63661977236758134308);
    const double r = (a - q * 1.57079632679489655800) - q * 6.12323399573676603587e-17;
    const double r2 = r * r;
    double sp = 1.0 / 6227020800.0; sp = sp * r2 * -1.0 + 1.0 / 39916800.0; sp = sp * -r2 + 1.0 / 362880.0; sp = sp * -r2 + 1.0 / 5040.0; sp = sp * -r2 + 1.0 / 120.0; sp = sp * -r2 + 1.0 / 6.0; sp = sp * -r2 + 1.0;
    const double sr = r * sp;
    double cp = 1.0 / 87178291200.0; cp = cp * -r2 + 1.0 / 479001600.0; cp = cp * -r2 + 1.0 / 3628800.0; cp = cp * -r2 + 1.0 / 40320.0; cp = cp * -r2 + 1.0 / 720.0; cp = cp * -r2 + 1.0 / 24.0; cp = cp * -r2 + 0.5; cp = cp * -r2 + 1.0;
    const double cr = cp;
    const long long qi = (long long)q; const int m = (int)(qi & 3);
    double cs, sn;
    if (m == 0) { cs = cr; sn = sr; } else if (m == 1) { cs = -sr; sn = cr; } else if (m == 2) { cs = -cr; sn = -sr; } else { cs = sr; sn = -cr; }
    c = (float)cs; s = (float)sn;
}


#define XB_TMO      128
#define XB_XCNT(j)  (256  + 64 * (j))
#define XB_XSUB(j)  (1280 + 64 * (j))
#define XB_XGEN(j)  (2304 + 64 * (j))
#define XB_TOP      3328
#define XB_TOPGEN   3392
#define XCD_BAR_WORDS 3456
#define XB_SPIN_CAP (1u << 22)

__device__ __forceinline__ unsigned xb_ld(unsigned* p)              { return __hip_atomic_load(p, __ATOMIC_RELAXED, __HIP_MEMORY_SCOPE_AGENT); }
__device__ __forceinline__ unsigned xb_add(unsigned* p, unsigned v) { return __hip_atomic_fetch_add(p, v, __ATOMIC_RELAXED, __HIP_MEMORY_SCOPE_AGENT); }
__device__ __forceinline__ unsigned xb_xcc_id() { return (unsigned)__builtin_amdgcn_s_getreg((3 << 11) | 20) & 0xFu; }
#define XB_SPIN(cond, bar) do { unsigned _sp = 0; while (cond) { __builtin_amdgcn_s_sleep(1); \
    if ((++_sp & 255u) == 0u) { if (xb_ld(&(bar)[XB_TMO])) break; if (_sp > XB_SPIN_CAP) { atomicAdd(&(bar)[XB_TMO], 1u); break; } } } } while (0)

struct XcdBarrier {
    unsigned* bar; unsigned x; int w0;
    volatile LAS unsigned* st;
};

__device__ __forceinline__ XcdBarrier xcd_barrier_post(unsigned* bar, volatile LAS unsigned* st, int w0) {
    XcdBarrier b; b.bar = bar; b.x = xb_xcc_id(); b.st = st; b.w0 = w0;
    if (TIDX(w0) == 0) (void)xb_add(&bar[XB_XCNT(b.x)], 1u);
    return b;
}
__device__ __forceinline__ void xcd_barrier_complete(unsigned* bar, unsigned x, unsigned& nloc, unsigned& nx) {
    const unsigned G = gridDim.x * gridDim.y * gridDim.z;
    unsigned sum, cnt, mine, sp = 0u;
    for (;;) {
        sum = 0u; cnt = 0u; mine = 0u;
#pragma unroll
        for (unsigned j = 0; j < 16; ++j) { const unsigned c = xb_ld(&bar[XB_XCNT(j)]); sum += c; cnt += (c > 0u) ? 1u : 0u; mine = (j == x) ? c : mine; }
        if (sum == G) break;
        __builtin_amdgcn_s_sleep(1);
        if ((++sp & 255u) == 0u) { if (xb_ld(&bar[XB_TMO])) break; if (sp > XB_SPIN_CAP) { atomicAdd(&bar[XB_TMO], 1u); break; } }
    }
    nloc = mine > 0u ? mine : 1u; nx = cnt > 0u ? cnt : 1u;
}

__device__ __forceinline__ void xcd_barrier(const XcdBarrier& b) {
    asm volatile("s_waitcnt vmcnt(0)" ::: "memory");
    __syncthreads();
    if (TIDX(b.w0) == 0) {
        unsigned* bar = b.bar;
        __builtin_amdgcn_s_waitcnt(0);
        unsigned nloc = b.st[0], nx = b.st[1];
        if (nloc == 0u) { xcd_barrier_complete(bar, b.x, nloc, nx); b.st[0] = nloc; b.st[1] = nx; }
        const unsigned old = xb_add(&bar[XB_XSUB(b.x)], 1u);
        const unsigned gen = old / nloc;
        if (old + 1u == (gen + 1u) * nloc) {
            __builtin_amdgcn_fence(__ATOMIC_RELEASE, "agent");
            asm volatile("s_waitcnt vmcnt(0)" ::: "memory");
            const unsigned og = xb_add(&bar[XB_TOP], 1u);
            const unsigned tg = og / nx;
            if (og + 1u == (tg + 1u) * nx) xb_add(&bar[XB_TOPGEN], 1u);
            else XB_SPIN(xb_ld(&bar[XB_TOPGEN]) == tg, bar);
            __builtin_amdgcn_fence(__ATOMIC_ACQUIRE, "agent");
            xb_add(&bar[XB_XGEN(b.x)], 1u);
            asm volatile("s_waitcnt vmcnt(0)" ::: "memory");
        } else {
            XB_SPIN(xb_ld(&bar[XB_XGEN(b.x)]) == gen, bar);
            __builtin_amdgcn_fence(__ATOMIC_ACQUIRE, "agent");
            asm volatile("s_waitcnt vmcnt(0)" ::: "memory");
        }
    }
    __syncthreads();
}

__device__ __forceinline__ void bar_sync(XcdBarrier& b, unsigned* words) { GAS unsigned* w = (GAS unsigned*)words; asm volatile("" : "+s"(w)); b.bar = (unsigned*)w; xcd_barrier(b); }

#define GIN(k) ((const float*)(const GAS float*)F.in[k])
struct Frame {
    LAS unsigned char* lds;
    int tid, lane, wave, vcu, G;
    const float* const __attribute__((address_space(4)))* in;
    float* out;
    unsigned char* ws;
};
#define WSP(type, off) ((type*)(F.ws + (off)))

template <bool GAM>
__device__ __forceinline__ void transpose_item(const float* __restrict__ W, int ldw, bf16* __restrict__ WT, int ldt, int k0, int n0, size_t drow0, LAS unsigned* scr, int lane, const float* __restrict__ gam) {
    const float* src = W + (size_t)k0 * ldw + n0 + lane;
    unsigned g0 = 0u, g1 = 0u;
    if (GAM) { const u32x2 gp = *(const u32x2*)(gam + k0 + 2 * lane); g0 = gp.x; g1 = gp.y; }
#pragma unroll 8
    for (int kk = 0; kk < 64; ++kk) { float v0 = __builtin_nontemporal_load(src + (size_t)(2 * kk) * ldw), v1 = __builtin_nontemporal_load(src + (size_t)(2 * kk + 1) * ldw);
        if (GAM) { v0 *= __uint_as_float(__builtin_amdgcn_readlane(g0, kk)); v1 *= __uint_as_float(__builtin_amdgcn_readlane(g1, kk)); }
        scr[lane * 65 + kk] = pk2(v0, v1); }
    asm volatile("s_waitcnt lgkmcnt(0)" ::: "memory");
    const int c = lane & 15;
#pragma unroll
    for (int j = 0; j < 16; ++j) { const int n = (lane >> 4) + 4 * j; const LAS unsigned* sp = scr + n * 65 + 4 * c;
        u32x4 o; o.x = sp[0]; o.y = sp[1]; o.z = sp[2]; o.w = sp[3];
        __builtin_nontemporal_store(o, (u32x4*)(WT + (drow0 + n) * (size_t)ldt + k0 + 8 * c)); }
    asm volatile("s_waitcnt lgkmcnt(0)" ::: "memory");
}
__device__ __forceinline__ void phase_prologue(Frame& F) {
    LAS unsigned* scr = (LAS unsigned*)(F.lds + F.wave * 16640);
    const int gw = F.vcu * NWAVES + F.wave, NGW = F.G * NWAVES;
    constexpr int I_IN = 16 * 80, I_OUT = 16 * 32, I_G = 16 * 16 * 16, I_D = 16 * 8 * 32, I_P = 2 * 32, I_PG = 16 * 32;
    constexpr int I_LAYER = I_IN + I_OUT + 2 * I_G + I_D + I_P + I_PG;
    for (int it = gw; it < DEPTH * I_LAYER; it += NGW) {
        const int l = it / I_LAYER; int r = it % I_LAYER;
#define wl (F.ws + WS_W + (size_t)l * SZ_LAYERW)
        if (r < I_IN) { const int kb = r / 80, nb = r % 80; transpose_item<true>(GIN(3) + (size_t)l * DM * DIN, DIN, (bf16*)(wl + OFF_WIN), DM, kb * 128, nb * 64, (size_t)nb * 64, scr, F.lane, GIN(2) + (size_t)l * DM); continue; } r -= I_IN;
        if (r < I_OUT) { const int kb = r / 32, nb = r % 32; transpose_item<false>(GIN(12) + (size_t)l * DM * DM, DM, (bf16*)(wl + OFF_WOUT), DM, kb * 128, nb * 64, (size_t)nb * 64, scr, F.lane, nullptr); continue; } r -= I_OUT;
        if (r < 2 * I_G) { const int up = r / I_G; r %= I_G; const int e = r / 256, q = r % 256, kb = q / 16, nb = q % 16, n0 = nb * 64;
            const float* src = (up ? GIN(16) : GIN(15)) + ((size_t)(l * NE + e) * DM) * EFF;
            transpose_item<true>(src, EFF, (bf16*)(wl + OFF_WGU), DM, kb * 128, n0, (size_t)e * 2048 + (n0 / 128) * 256 + (n0 % 128) + up * 128, scr, F.lane, GIN(13) + (size_t)l * DM); continue; } r -= 2 * I_G;
        if (r < I_D) { const int e = r / 256, q = r % 256, kb = q / 32, nb = q % 32;
            transpose_item<false>(GIN(17) + ((size_t)(l * NE + e) * EFF) * DM, DM, (bf16*)(wl + OFF_WD), EFF, kb * 128, nb * 64, (size_t)e * 2048 + nb * 64, scr, F.lane, nullptr); continue; } r -= I_D;
        if (r < I_P) { const int kb = r / 32, nb = r % 32; transpose_item<false>(GIN(19) + (size_t)l * PLE * DM, DM, (bf16*)(wl + OFF_WP), PLE, kb * 128, nb * 64, (size_t)nb * 64, scr, F.lane, nullptr); continue; } r -= I_P;
        { const int kb = r / 32, nb = r % 32; transpose_item<true>(GIN(20) + (size_t)l * DM * DM, DM, (bf16*)(wl + OFF_WPG), DM, kb * 128, nb * 64, (size_t)nb * 64, scr, F.lane, GIN(18) + (size_t)l * DM); }
    }
    const size_t gt = (size_t)F.vcu * NTHR + (size_t)(F.wave * 64 + lane_id()), NT = (size_t)F.G * NTHR;
    { const f32x4* src = (const f32x4*)GIN(1); u32x2* dst = WSP(u32x2, WS_PB);
      for (size_t i = gt; i < (size_t)DEPTH * T * PLE / 4; i += NT) { const f32x4 v = src[i]; u32x2 o; o.x = pk2(v.x, v.y); o.y = pk2(v.z, v.w); dst[i] = o; } }
    { const f32x4* src = (const f32x4*)GIN(0); u32x2* dst = WSP(u32x2, WS_H);
      for (size_t i = gt; i < (size_t)T * DM / 4; i += NT) { const f32x4 v = src[i]; u32x2 o; o.x = pk2(v.x, v.y); o.y = pk2(v.z, v.w); dst[i] = o; } }
#ifdef CHECK_NAN_FILL
    { u32x4* dst = WSP(u32x4, WS_CM); const u32x4 nn = {0xffffffffu, 0xffffffffu, 0xffffffffu, 0xffffffffu};
      for (size_t i = gt; i < (WS_END - WS_CM) / 16; i += NT) dst[i] = nn;
      u32x4* d2 = WSP(u32x4, WS_YMIX); for (size_t i = gt; i < (WS_XS - WS_YMIX) / 16; i += NT) d2[i] = nn; }
#endif
    { float* dst = WSP(float, WS_WTL);
      for (size_t i = gt; i < (size_t)DEPTH * 2 * 16 * DM; i += NT) { const int ls = (int)(i >> 15), l = ls >> 1, sset = ls & 1, k = (int)(i >> 4) & (DM - 1), c = (int)i & 15;
          const float* w = sset ? GIN(14) + (size_t)l * DM * NE : GIN(3) + (size_t)l * DM * DIN + DINP; const int ldw = sset ? NE : DIN; const float* g = (sset ? GIN(13) : GIN(2)) + (size_t)l * DM;
          dst[((size_t)ls * 16 + c) * DM + k] = g[k] * w[(size_t)k * ldw + c]; } }
    { float2* ta = WSP(float2, WS_TABA); for (size_t i = gt; i < (size_t)SEQ * 16; i += NT) { const int s = (int)(i >> 4), j = (int)(i & 15); float c, sn; sincos_d((double)s * INV_A[j], c, sn); ta[i] = make_float2(c, sn); }
      float2* tb = WSP(float2, WS_TABB); for (size_t i = gt; i < 64 * 32; i += NT) { const int s = (int)(i >> 5), j = (int)(i & 31); float c, sn; sincos_d((double)s * INV_B[j], c, sn); tb[i] = make_float2(c, sn); } }
}

template <int MODE>
__device__ __forceinline__ void phase_norm(Frame& F, const float* __restrict__ wtg, float* __restrict__ out16, float* __restrict__ rsout) {
    const bf16* H = WSP(bf16, WS_H);
    LAS float* wT = (LAS float*)F.lds;
#pragma unroll 1
    for (int h = 0; h < 2; ++h) { f32x4 st[8];
#pragma unroll
      for (int i = 0; i < 8; ++i) st[i] = *(const f32x4*)(wtg + 4 * (F.tid + NTHR * (8 * h + i)));
#pragma unroll
      for (int i = 0; i < 8; ++i) *(LAS f32x4*)(wT + 4 * (F.tid + NTHR * (8 * h + i))) = st[i]; }
    __syncthreads();
    const int gw = F.vcu * NWAVES + F.wave, NGW = F.G * NWAVES, lane = F.lane;
    for (int r0 = gw * 4; r0 < T; r0 += NGW * 4) {
        f32x4 v[4][8];
#pragma unroll
        for (int rr = 0; rr < 4; ++rr) { const bf16* hr = H + (size_t)(r0 + rr) * DM; float ss = 0.f;
#pragma unroll
            for (int j = 0; j < 8; ++j) { const u32x2 hw = *(const u32x2*)(hr + 4 * lane + 256 * j); v[rr][j].x = __uint_as_float(hw.x << 16); v[rr][j].y = __uint_as_float(hw.x & 0xffff0000u); v[rr][j].z = __uint_as_float(hw.y << 16); v[rr][j].w = __uint_as_float(hw.y & 0xffff0000u); ss += (v[rr][j].x * v[rr][j].x + v[rr][j].y * v[rr][j].y) + (v[rr][j].z * v[rr][j].z + v[rr][j].w * v[rr][j].w); }
            const float rs = rsqrtf(wave_sum(ss) * (1.0f / DM) + EPS); if (lane == 0) rsout[r0 + rr] = rs;
#pragma unroll
            for (int j = 0; j < 8; ++j) v[rr][j] = v[rr][j] * rs; }
        float a[64];
#pragma unroll
        for (int c = 0; c < 16; ++c) { float p0 = 0.f, p1 = 0.f, p2 = 0.f, p3 = 0.f; asm volatile("" ::: "memory");
#pragma unroll
            for (int j = 0; j < 8; ++j) { const f32x4 w = *(const LAS f32x4*)(wT + c * DM + 4 * lane + 256 * j);
                p0 += (v[0][j].x * w.x + v[0][j].y * w.y) + (v[0][j].z * w.z + v[0][j].w * w.w); p1 += (v[1][j].x * w.x + v[1][j].y * w.y) + (v[1][j].z * w.z + v[1][j].w * w.w);
                p2 += (v[2][j].x * w.x + v[2][j].y * w.y) + (v[2][j].z * w.z + v[2][j].w * w.w); p3 += (v[3][j].x * w.x + v[3][j].y * w.y) + (v[3][j].z * w.z + v[3][j].w * w.w); }
            a[c] = p0; a[16 + c] = p1; a[32 + c] = p2; a[48 + c] = p3; }
#define TR_STEP(N, M) _Pragma("unroll") for (int k = 0; k < (N) / 2; ++k) { const bool up = (lane & (M)) != 0; const float keep = up ? a[k + (N) / 2] : a[k], send = up ? a[k] : a[k + (N) / 2]; a[k] = keep + __shfl_xor(send, (M)); }
        TR_STEP(64, 32) TR_STEP(32, 16) TR_STEP(16, 8) TR_STEP(8, 4) TR_STEP(4, 2) TR_STEP(2, 1)
#undef TR_STEP
        float mine = a[0];
        if (MODE == 2) { float m = mine; m = fmaxf(m, __shfl_xor(m, 1)); m = fmaxf(m, __shfl_xor(m, 2)); m = fmaxf(m, __shfl_xor(m, 4)); m = fmaxf(m, __shfl_xor(m, 8));
            const float e = expf(mine - m); float sden = e; sden += __shfl_xor(sden, 1); sden += __shfl_xor(sden, 2); sden += __shfl_xor(sden, 4); sden += __shfl_xor(sden, 8); mine = e / sden; }
        if (MODE == 2) out16[((size_t)((r0 >> 12) * 16 + (lane & 15))) * SEQ + (r0 & (SEQ - 1)) + (lane >> 4)] = mine;
        else out16[(size_t)r0 * 16 + lane] = mine;
    }
}

namespace pg8 {
#define PG8_LAS __attribute__((address_space(3)))
typedef unsigned short bf16_t;
typedef short bf16x8 __attribute__((ext_vector_type(8)));
typedef float f32x4 __attribute__((ext_vector_type(4)));
typedef unsigned u32x4 __attribute__((ext_vector_type(4)));
constexpr int BM = 256, BK = 64, HALF = 128, HTB = HALF * BK * 2, STAGE_BYTES = 8 * HTB, NXCD = 8, WGM = 8;
__host__ __device__ __forceinline__ int lds_byte(int r, int c) { const int st = (r >> 4) * 2 + (c >> 5), rr = r & 15, cc = c & 31, ob = rr * 64 + cc * 2; return st * 1024 + (ob ^ (((ob >> 9) & 1) << 5)); }
__host__ __device__ __forceinline__ void stage_rc(int b, int& R, int& C) { const int st = b / 1024, sb = b % 1024, swz = sb ^ (((sb >> 9) & 1) << 5); R = (st >> 1) * 16 + swz / 64; C = (st & 1) * 32 + (swz % 64) / 2; }
__host__ __device__ __forceinline__ int perm32(int rho) { const int n = rho >> 4, i = rho & 15; return 8 * (i >> 2) + 4 * n + (i & 3); }
struct Unit { int pm, pn; };
struct Gemm { const bf16_t* A; const bf16_t* Bt; int M, N, K; };
struct StaticOrder {
    static constexpr bool GATHER = false;
    int nM, nN, nwg, G, c;
    __host__ __device__ void init(int M, int N, int G_, int c_) { nM = M / BM; nN = N / BM; nwg = nM * nN; G = G_; c = c_; }
    __host__ __device__ bool next(int i, Unit& u) const {
        const long L = (long)i * G + c; if (L >= nwg) return false;
        int wgid = (int)L; { const int q = nwg / NXCD, r = nwg % NXCD, xcd = wgid % NXCD, off = wgid / NXCD; wgid = (xcd < r ? xcd * (q + 1) : r * (q + 1) + (xcd - r) * q) + off; }
        const int nig = WGM * nN, gid = wgid / nig, fm = gid * WGM, gsz = (nM - fm) < WGM ? (nM - fm) : WGM;
        u.pm = fm + ((wgid % nig) % gsz); u.pn = (wgid % nig) / gsz; return true;
    }
    __device__ __forceinline__ void a_ready(const Unit&) const {}
    __device__ __forceinline__ void done(const Unit&) const {}
};
struct TailOrder {
    static constexpr bool GATHER = false;
    int c, first;
    __device__ bool next(int i, Unit& u) const { if (c < first || c >= first + 128 || i >= 2) return false; const int L = (c - first) * 2 + i; u.pm = L >> 3; u.pn = L & 7; return true; }
    __device__ __forceinline__ void a_ready(const Unit&) const {}
    __device__ __forceinline__ void done(const Unit&) const {}
};
struct ShadowOrder {
    static constexpr bool GATHER = false;
    int c;
    __device__ bool next(int i, Unit& u) const { const int L = c + 224 * i; if (c < 0 || L >= 256) return false; u.pm = L >> 3; u.pn = L & 7; return true; }
    __device__ __forceinline__ void a_ready(const Unit&) const {}
    __device__ __forceinline__ void done(const Unit&) const {}
};
struct GroupedOrder {
    static constexpr bool GATHER = false;
    int G, c;
    __device__ bool next(int i, Unit& u) const { const int L = i * G + c; if (L >= 512) return false; const int e = L >> 5, w = L & 31; u.pm = 4 * e + (w & 3); u.pn = 8 * e + (w >> 2); return true; }
    __device__ __forceinline__ void a_ready(const Unit&) const {}
    __device__ __forceinline__ void done(const Unit&) const {}
};
struct GroupedGatherOrder {
    static constexpr bool GATHER = true;
    int G, c; const int* seli;
    __device__ bool next(int i, Unit& u) const { const int L = i * G + c; if (L >= 512) return false; const int e = L >> 5, w = L & 31; u.pm = 4 * e + (w & 3); u.pn = 8 * e + (w >> 2); return true; }
    __device__ __forceinline__ int arow(const Unit& u, int r) const { const int row = u.pm * 256 + r, e = row >> 10, q = row & 1023, b = q >> 9, slot = q & 511; return b * 4096 + seli[(b * 16 + e) * 512 + slot]; }
    __device__ __forceinline__ void a_ready(const Unit&) const {}
    __device__ __forceinline__ void done(const Unit&) const {}
};
__device__ __forceinline__ unsigned cvt_pk_bf16(float lo, float hi) { return cvt_pk_rne(lo, hi); }
struct EpiBf16 {
    static constexpr bool PERM = true, AFTER_DRAIN = false;
    bf16_t* O; int ldc;
    __device__ __forceinline__ void operator()(const f32x4 (&acc)[2][2][4][2], const Unit& u, int wr, int wc, int fr, int fq) const {
        const int row0 = u.pm * BM + wr * 64 + fr, col0 = u.pn * BM + wc * 32 + 8 * fq;
        asm volatile("s_nop 15\n\ts_nop 7" ::: "memory");
#pragma unroll
        for (int ai = 0; ai < 2; ++ai)
#pragma unroll
            for (int m = 0; m < 4; ++m) { bf16_t* rowp = O + (size_t)(row0 + ai * HALF + m * 16) * ldc + col0;
#pragma unroll
                for (int bj = 0; bj < 2; ++bj) { const f32x4 v0 = acc[ai][bj][m][0], v1 = acc[ai][bj][m][1];
                    u32x4 w; w.x = cvt_pk_bf16(v0[0], v0[1]); w.y = cvt_pk_bf16(v0[2], v0[3]); w.z = cvt_pk_bf16(v1[0], v1[1]); w.w = cvt_pk_bf16(v1[2], v1[3]);
                    *(u32x4*)(rowp + bj * HALF) = w; } }
    }
};
__device__ __forceinline__ float bfe(const u32x4& w, int e) { const unsigned x = w[e >> 1]; return __uint_as_float((e & 1) ? (x & 0xffff0000u) : (x << 16)); }
struct EpiBf16Rs {
    static constexpr bool PERM = true, AFTER_DRAIN = false;
    bf16_t* O; int ldc; const float* rs;
    __device__ __forceinline__ void operator()(const f32x4 (&acc)[2][2][4][2], const Unit& u, int wr, int wc, int fr, int fq) const {
        const int row0 = u.pm * BM + wr * 64 + fr, col0 = u.pn * BM + wc * 32 + 8 * fq;
#pragma unroll
        for (int ai = 0; ai < 2; ++ai)
#pragma unroll
            for (int m = 0; m < 4; ++m) { const int row = row0 + ai * HALF + m * 16; const float s = rs[row]; bf16_t* rowp = O + (size_t)row * ldc + col0;
#pragma unroll
                for (int bj = 0; bj < 2; ++bj) { const f32x4 v0 = acc[ai][bj][m][0] * s, v1 = acc[ai][bj][m][1] * s;
                    u32x4 w; w.x = cvt_pk_bf16(v0[0], v0[1]); w.y = cvt_pk_bf16(v0[2], v0[3]); w.z = cvt_pk_bf16(v1[0], v1[1]); w.w = cvt_pk_bf16(v1[2], v1[3]);
                    *(u32x4*)(rowp + bj * HALF) = w; } }
    }
};
struct EpiResidBf16 {
    static constexpr bool PERM = true, AFTER_DRAIN = false;
    bf16_t* H; int ldc;
    __device__ __forceinline__ void operator()(const f32x4 (&acc)[2][2][4][2], const Unit& u, int wr, int wc, int fr, int fq) const {
        const int row0 = u.pm * BM + wr * 64 + fr, col0 = u.pn * BM + wc * 32 + 8 * fq;
#pragma unroll
        for (int ai = 0; ai < 2; ++ai)
#pragma unroll
            for (int m = 0; m < 4; ++m) { bf16_t* rowp = H + (size_t)(row0 + ai * HALF + m * 16) * ldc + col0;
                u32x4 h[2];
#pragma unroll
                for (int bj = 0; bj < 2; ++bj) h[bj] = *(const u32x4*)(rowp + bj * HALF);
#pragma unroll
                for (int bj = 0; bj < 2; ++bj) { const f32x4 v0 = acc[ai][bj][m][0], v1 = acc[ai][bj][m][1];
                    u32x4 w; w.x = cvt_pk_bf16(bfe(h[bj], 0) + v0[0], bfe(h[bj], 1) + v0[1]); w.y = cvt_pk_bf16(bfe(h[bj], 2) + v0[2], bfe(h[bj], 3) + v0[3]);
                    w.z = cvt_pk_bf16(bfe(h[bj], 4) + v1[0], bfe(h[bj], 5) + v1[1]); w.w = cvt_pk_bf16(bfe(h[bj], 6) + v1[2], bfe(h[bj], 7) + v1[3]);
                    *(u32x4*)(rowp + bj * HALF) = w; }
                asm volatile("" ::: "memory"); }
    }
};
struct EpiPleBf16 {
    static constexpr bool PERM = true, AFTER_DRAIN = false;
    const bf16_t* Hin; bf16_t* Hout; const bf16_t* PL; const float* rs;
    __device__ __forceinline__ void operator()(const f32x4 (&acc)[2][2][4][2], const Unit& u, int wr, int wc, int fr, int fq) const {
        const int row0 = u.pm * BM + wr * 64 + fr, col0 = u.pn * BM + wc * 32 + 8 * fq;
#pragma unroll
        for (int ai = 0; ai < 2; ++ai)
#pragma unroll
            for (int m = 0; m < 4; ++m) { const int row = row0 + ai * HALF + m * 16; const float s = rs[row]; const size_t off = (size_t)row * 2048 + col0;
                u32x4 h[2], p[2];
#pragma unroll
                for (int bj = 0; bj < 2; ++bj) { h[bj] = *(const u32x4*)(Hin + off + bj * HALF); p[bj] = *(const u32x4*)(PL + off + bj * HALF); }
#pragma unroll
                for (int bj = 0; bj < 2; ++bj) { float o[8];
#pragma unroll
                    for (int e = 0; e < 8; ++e) { const float a = acc[ai][bj][m][e >> 2][e & 3] * s; o[e] = bfe(h[bj], e) + __builtin_amdgcn_rcpf(1.0f + __expf(-a)) * bfe(p[bj], e); }
                    u32x4 w; w.x = cvt_pk_bf16(o[0], o[1]); w.y = cvt_pk_bf16(o[2], o[3]); w.z = cvt_pk_bf16(o[4], o[5]); w.w = cvt_pk_bf16(o[6], o[7]);
                    *(u32x4*)(Hout + off + bj * HALF) = w; }
                asm volatile("" ::: "memory"); }
    }
};
struct EpiResidF32 {
    static constexpr bool PERM = false, AFTER_DRAIN = false;
    float* H; int ldc;
    __device__ __forceinline__ void operator()(const f32x4 (&acc)[2][2][4][2], const Unit& u, int wr, int wc, int fr, int fq) const {
        const int row0 = u.pm * BM + wr * 64 + fr, col0 = u.pn * BM + wc * 32 + 4 * fq;
#pragma unroll
        for (int ai = 0; ai < 2; ++ai)
#pragma unroll
            for (int m = 0; m < 4; ++m) { float* rowp = H + (size_t)(row0 + ai * HALF + m * 16) * ldc + col0;
                f32x4 h[2][2];
#pragma unroll
                for (int bj = 0; bj < 2; ++bj)
#pragma unroll
                    for (int n = 0; n < 2; ++n) h[bj][n] = *(const f32x4*)(rowp + bj * HALF + n * 16);
#pragma unroll
                for (int bj = 0; bj < 2; ++bj)
#pragma unroll
                    for (int n = 0; n < 2; ++n) *(f32x4*)(rowp + bj * HALF + n * 16) = h[bj][n] + acc[ai][bj][m][n];
                asm volatile("" ::: "memory"); }
    }
};
struct EpiGateUp {
    static constexpr bool PERM = true, AFTER_DRAIN = false;
    bf16_t* HID; const float* selr;
    __device__ __forceinline__ void operator()(const f32x4 (&acc)[2][2][4][2], const Unit& u, int wr, int wc, int fr, int fq) const {
        const int row0 = u.pm * BM + wr * 64 + fr, col0 = (u.pn & 7) * 128 + wc * 32 + 8 * fq;
#pragma unroll
        for (int ai = 0; ai < 2; ++ai)
#pragma unroll
            for (int m = 0; m < 4; ++m) { float o[8]; const float s = selr[row0 + ai * HALF + m * 16];
#pragma unroll
                for (int n = 0; n < 2; ++n)
#pragma unroll
                    for (int j = 0; j < 4; ++j) { const float g = acc[ai][0][m][n][j] * s, up = acc[ai][1][m][n][j] * s; o[4 * n + j] = g * __builtin_amdgcn_rcpf(1.0f + __expf(-g)) * up; }
                u32x4 w; w.x = cvt_pk_bf16(o[0], o[1]); w.y = cvt_pk_bf16(o[2], o[3]); w.z = cvt_pk_bf16(o[4], o[5]); w.w = cvt_pk_bf16(o[6], o[7]);
                *(u32x4*)(HID + (size_t)(row0 + ai * HALF + m * 16) * 1024 + col0) = w; }
    }
};
struct EpiDownBf16 {
    static constexpr bool PERM = true, AFTER_DRAIN = false;
    bf16_t* O; const float* gate;
    __device__ __forceinline__ void operator()(const f32x4 (&acc)[2][2][4][2], const Unit& u, int wr, int wc, int fr, int fq) const {
        const int row0 = u.pm * BM + wr * 64 + fr, col0 = (u.pn & 7) * BM + wc * 32 + 8 * fq;
#pragma unroll
        for (int ai = 0; ai < 2; ++ai)
#pragma unroll
            for (int m = 0; m < 4; ++m) { const int row = row0 + ai * HALF + m * 16; const float gt = gate[row]; bf16_t* rowp = O + (size_t)row * 2048 + col0;
#pragma unroll
                for (int bj = 0; bj < 2; ++bj) { const f32x4 v0 = acc[ai][bj][m][0] * gt, v1 = acc[ai][bj][m][1] * gt;
                    u32x4 w; w.x = cvt_pk_bf16(v0[0], v0[1]); w.y = cvt_pk_bf16(v0[2], v0[3]); w.z = cvt_pk_bf16(v1[0], v1[1]); w.w = cvt_pk_bf16(v1[2], v1[3]);
                    *(u32x4*)(rowp + bj * HALF) = w; } }
    }
};
struct EpiPleF32 {
    static constexpr bool PERM = false, AFTER_DRAIN = false;
    float* H; const bf16_t* PL;
    __device__ __forceinline__ void operator()(const f32x4 (&acc)[2][2][4][2], const Unit& u, int wr, int wc, int fr, int fq) const {
        typedef unsigned u32x2v __attribute__((ext_vector_type(2)));
        const int row0 = u.pm * BM + wr * 64 + fr, col0 = u.pn * BM + wc * 32 + 4 * fq;
#pragma unroll
        for (int ai = 0; ai < 2; ++ai)
#pragma unroll
            for (int m = 0; m < 4; ++m) { const size_t off = (size_t)(row0 + ai * HALF + m * 16) * 2048 + col0;
                f32x4 h[2][2]; u32x2v p[2][2];
#pragma unroll
                for (int bj = 0; bj < 2; ++bj)
#pragma unroll
                    for (int n = 0; n < 2; ++n) { h[bj][n] = *(const f32x4*)(H + off + bj * HALF + n * 16); p[bj][n] = *(const u32x2v*)(PL + off + bj * HALF + n * 16); }
#pragma unroll
                for (int bj = 0; bj < 2; ++bj)
#pragma unroll
                    for (int n = 0; n < 2; ++n) { const f32x4 a = acc[ai][bj][m][n]; f32x4 pl; pl[0] = __uint_as_float(p[bj][n].x << 16); pl[1] = __uint_as_float(p[bj][n].x & 0xffff0000u); pl[2] = __uint_as_float(p[bj][n].y << 16); pl[3] = __uint_as_float(p[bj][n].y & 0xffff0000u);
                        f32x4 o;
#pragma unroll
                        for (int j = 0; j < 4; ++j) o[j] = h[bj][n][j] + __builtin_amdgcn_rcpf(1.0f + __expf(-a[j])) * pl[j];
                        *(f32x4*)(H + off + bj * HALF + n * 16) = o; }
                asm volatile("" ::: "memory"); }
    }
};
template <class Epi, class Sched, bool STAMP = false>
__device__ __forceinline__ void gemm_phase(PG8_LAS unsigned char* lds, const Gemm g, const Sched& S, const Epi& E, unsigned long long* stamps, const int wave0) {
    int tid_ = wave0 * 64 + lane_id(); asm volatile("" : "+v"(tid_));
    const int tid = tid_, wid = __builtin_amdgcn_readfirstlane(tid >> 6), lane = tid & 63, wr = wid >> 2, wc = wid & 3, fr = lane & 15, fq = lane >> 4;
    const int K = g.K, nt = K / BK;
    int ts_lo = 0, ts_hi = 0, nts = 0; const unsigned long long rt_entry = STAMP ? (unsigned long long)wall_clock64() : 0ull;
#define PG8_STAMP() do { if (STAMP && wid == 0 && nts < 64) { const unsigned long long _c = (unsigned long long)clock64(); \
        ts_lo = (lane == nts) ? (int)(unsigned)_c : ts_lo; ts_hi = (lane == nts) ? (int)(unsigned)(_c >> 32) : ts_hi; ++nts; } } while (0)
    PG8_STAMP();
    unsigned voffA[2], voffB[2];
    unsigned gvc[2][2] = {{0u, 0u}, {0u, 0u}}, gvn[2][2] = {{0u, 0u}, {0u, 0u}}; int gR[2] = {0, 0}, gC[2] = {0, 0};
#pragma unroll
    for (int i = 0; i < 2; ++i) { int R, C; stage_rc(tid * 16 + i * 8192, R, C); const int Rb = Epi::PERM ? ((R & ~31) + perm32(R & 31)) : R;
        voffA[i] = (unsigned)(R * K + C) * 2u; voffB[i] = (unsigned)(Rb * K + C) * 2u; gR[i] = R; gC[i] = C; }
    const size_t kstep = (size_t)(BK * 2);
    const size_t hstep = (size_t)HALF * K * 2;
    const size_t tstep = 2 * hstep;
    const unsigned ldsw = (unsigned)wid * 1024u;
    const int aoff = lds_byte(wr * 64 + fr, fq * 8), boff = lds_byte(wc * 32 + fr, fq * 8);
#define PG8_SA(b, h) (((b) * 2 + (h)) * HTB)
#define PG8_SB(b, h) ((4 + (b) * 2 + (h)) * HTB)
#define PG8_STAGE(bufoff, gbase, voff) do { _Pragma("unroll") for (int _i = 0; _i < 2; ++_i) \
        __builtin_amdgcn_global_load_lds((const unsigned*)((const char*)(gbase) + (voff)[_i]), (PG8_LAS unsigned*)(lds + (bufoff) + ldsw + _i * 8192), 16, 0, 0); } while (0)
#define PG8_STAGE_A(bufoff, gbase, h, un) do { if constexpr (Sched::GATHER) { unsigned _o[2]; _o[0] = (un) ? gvn[h][0] : gvc[h][0]; _o[1] = (un) ? gvn[h][1] : gvc[h][1]; PG8_STAGE(bufoff, gbase, _o); } \
        else { PG8_STAGE(bufoff, (gbase) + ((h) ? hstep : (size_t)0), voffA); } } while (0)
#define PG8_GOFF(dst, u) do { _Pragma("unroll") for (int _h = 0; _h < 2; ++_h) _Pragma("unroll") for (int _i = 0; _i < 2; ++_i) dst[_h][_i] = ((unsigned)S.arow(u, _h * HALF + gR[_i]) * (unsigned)K + (unsigned)gC[_i]) * 2u; } while (0)
#define PG8_LDA(dst, b, h) do { _Pragma("unroll") for (int m = 0; m < 4; ++m) _Pragma("unroll") for (int k = 0; k < 2; ++k) dst[m][k] = *(const PG8_LAS bf16x8*)(lds + PG8_SA(b, h) + aoff + m * 2048 + k * 1024); } while (0)
#define PG8_LDB(dst, b, h) do { _Pragma("unroll") for (int n = 0; n < 2; ++n) _Pragma("unroll") for (int k = 0; k < 2; ++k) dst[n][k] = *(const PG8_LAS bf16x8*)(lds + PG8_SB(b, h) + boff + n * 2048 + k * 1024); } while (0)
#define PG8_MMA(ai, bj, At, Bt) do { __builtin_amdgcn_s_setprio(1); _Pragma("unroll") for (int m = 0; m < 4; ++m) _Pragma("unroll") for (int n = 0; n < 2; ++n) _Pragma("unroll") for (int k = 0; k < 2; ++k) \
        acc[ai][bj][m][n] = __builtin_amdgcn_mfma_f32_16x16x32_bf16(Bt[n][k], At[m][k], acc[ai][bj][m][n], 0, 0, 0); __builtin_amdgcn_s_setprio(0); } while (0)
#define PG8_WAIT_V(n) asm volatile("s_waitcnt vmcnt(" #n ")" ::: "memory")
#define PG8_WAIT_L(n) asm volatile("s_waitcnt lgkmcnt(" #n ")" ::: "memory")
#define PG8_BAR __builtin_amdgcn_s_barrier()
#define PG8_SCHED __builtin_amdgcn_sched_barrier(0)
    Unit cur, nxt; int ui = 0;
    if (!S.next(0, cur)) return;
    f32x4 acc[2][2][4][2];
#pragma unroll
    for (int a = 0; a < 2; ++a)
#pragma unroll
        for (int b = 0; b < 2; ++b)
#pragma unroll
            for (int m = 0; m < 4; ++m)
#pragma unroll
                for (int n = 0; n < 2; ++n) acc[a][b][m][n] = (f32x4){0.f, 0.f, 0.f, 0.f};
    bf16x8 At[4][2], B0[2][2], B1[2][2];
    const char* cA = (const char*)g.A + (Sched::GATHER ? (size_t)0 : (size_t)cur.pm * tstep); const char* cB = (const char*)g.Bt + (size_t)cur.pn * tstep;
    if constexpr (Sched::GATHER) PG8_GOFF(gvc, cur);
    S.a_ready(cur);
    PG8_STAGE(PG8_SB(0, 0), cB, voffB); PG8_STAGE_A(PG8_SA(0, 0), cA, 0, false); PG8_STAGE(PG8_SB(0, 1), cB + hstep, voffB); PG8_STAGE_A(PG8_SA(0, 1), cA, 1, false);
    if (wr == 1) PG8_BAR;
    PG8_WAIT_V(4); PG8_BAR;
    PG8_STAGE(PG8_SB(1, 0), cB + kstep, voffB); PG8_STAGE_A(PG8_SA(1, 0), cA + kstep, 0, false); PG8_STAGE(PG8_SB(1, 1), cB + hstep + kstep, voffB);
    PG8_WAIT_V(6); PG8_BAR;
    PG8_STAMP();
    for (;;) {
        const bool has_next = S.next(ui + 1, nxt);
        if constexpr (Sched::GATHER) { if (has_next) PG8_GOFF(gvn, nxt); }
        const char* nA = (has_next && !Sched::GATHER) ? (const char*)g.A + (size_t)nxt.pm * tstep : cA; const char* nB = has_next ? (const char*)g.Bt + (size_t)nxt.pn * tstep : cB;
        for (int t = 0; t < nt; t += 2) {
            const bool last = (t == nt - 2);
            const char* a1 = cA + (size_t)(t + 1) * kstep;
            const char* a2 = last ? nA : cA + (size_t)(t + 2) * kstep; const char* b2 = last ? nB : cB + (size_t)(t + 2) * kstep;
            const char* a3 = a2 + kstep; const char* b3 = b2 + kstep;
            if (last && has_next) S.a_ready(nxt);
            const bool un = last && has_next;
            PG8_LDB(B0, 0, 0); PG8_SCHED; PG8_LDA(At, 0, 0); PG8_STAGE_A(PG8_SA(1, 1), a1, 1, false);
            PG8_WAIT_L(8); PG8_BAR; PG8_WAIT_L(0); PG8_MMA(0, 0, At, B0); PG8_BAR; PG8_SCHED;
            PG8_LDB(B1, 0, 1); PG8_STAGE(PG8_SB(0, 0), b2, voffB);
            PG8_BAR; PG8_WAIT_L(0); PG8_MMA(0, 1, At, B1); PG8_BAR;
            PG8_LDA(At, 0, 1); PG8_STAGE_A(PG8_SA(0, 0), a2, 0, un);
            PG8_BAR; PG8_WAIT_L(0); PG8_MMA(1, 0, At, B0); PG8_BAR; PG8_SCHED;
            PG8_STAGE(PG8_SB(0, 1), b2 + hstep, voffB);
            PG8_WAIT_V(6); PG8_BAR; PG8_MMA(1, 1, At, B1); PG8_BAR;
            PG8_LDB(B0, 1, 0); PG8_SCHED; PG8_LDA(At, 1, 0); PG8_STAGE_A(PG8_SA(0, 1), a2, 1, un);
            PG8_WAIT_L(8); PG8_BAR; PG8_WAIT_L(0); PG8_MMA(0, 0, At, B0); PG8_BAR; PG8_SCHED;
            PG8_LDB(B1, 1, 1); PG8_STAGE(PG8_SB(1, 0), b3, voffB);
            PG8_BAR; PG8_WAIT_L(0); PG8_MMA(0, 1, At, B1); PG8_BAR;
            PG8_LDA(At, 1, 1); PG8_STAGE_A(PG8_SA(1, 0), a3, 0, un);
            PG8_BAR; PG8_WAIT_L(0); PG8_MMA(1, 0, At, B0); PG8_BAR; PG8_SCHED;
            PG8_STAGE(PG8_SB(1, 1), b3 + hstep, voffB);
            PG8_WAIT_V(6); PG8_BAR; PG8_MMA(1, 1, At, B1); PG8_BAR;
        }
        PG8_STAMP();
        if constexpr (!Epi::AFTER_DRAIN) { E(acc, cur, wr, wc, fr, fq); S.done(cur); }
        PG8_STAMP();
        if (!has_next) break;
#pragma unroll
        for (int a = 0; a < 2; ++a)
#pragma unroll
            for (int b = 0; b < 2; ++b)
#pragma unroll
                for (int m = 0; m < 4; ++m)
#pragma unroll
                    for (int n = 0; n < 2; ++n) acc[a][b][m][n] = (f32x4){0.f, 0.f, 0.f, 0.f};
        cur = nxt; cA = nA; cB = nB; ++ui;
        if constexpr (Sched::GATHER) { _Pragma("unroll") for (int _h = 0; _h < 2; ++_h) _Pragma("unroll") for (int _i = 0; _i < 2; ++_i) gvc[_h][_i] = gvn[_h][_i]; }
    }
    PG8_WAIT_V(0);
    if (wr == 0) PG8_BAR;
    PG8_BAR;
    if constexpr (Epi::AFTER_DRAIN) { E.fused(acc, cur, wr, wc, fr, fq, lds, wid, lane); S.done(cur); }
    PG8_STAMP();
    if (STAMP && wid == 0) { stamps[lane] = lane < nts ? (((unsigned long long)(unsigned)ts_hi << 32) | (unsigned)ts_lo) : 0ull;
        if (lane == 62) stamps[62] = rt_entry; if (lane == 63) stamps[63] = (unsigned long long)wall_clock64(); }
#undef PG8_STAMP
#undef PG8_SA
#undef PG8_SB
#undef PG8_STAGE
#undef PG8_STAGE_A
#undef PG8_GOFF
#undef PG8_LDA
#undef PG8_LDB
#undef PG8_MMA
#undef PG8_WAIT_V
#undef PG8_WAIT_L
#undef PG8_BAR
#undef PG8_SCHED
}
}


namespace attn {
using bf16 = unsigned short;
constexpr int   D = 128, NW = 8, QBLK = 32, KVBLK = 64;
constexpr float SCALE = 0.088388347648318440f;
constexpr float THR = 8.f;
constexpr int SDEPTH = 1;
constexpr int LDQ = 5120, LDK = 5120, LDO = 2048;
constexpr size_t SHM_V = KVBLK * D * 2, SHM_K = KVBLK * D * 2, SHM_ATTN = 2 * SHM_V + 2 * SHM_K + NW * 64 * 4;
using bf16x8 = __attribute__((ext_vector_type(8))) short;
using s16x4  = __attribute__((ext_vector_type(4))) short;
using f32x16 = __attribute__((ext_vector_type(16))) float;
using f32x8  = __attribute__((ext_vector_type(8))) float;
using u32x4  = __attribute__((ext_vector_type(4))) unsigned;
#define KSWZ(row, colB) ((row) * 256 + ((colB) ^ (((row) & 7) << 4)))
#define SBAR() __builtin_amdgcn_sched_barrier(0)
__device__ __forceinline__ int crow(int r, int hi) { return (r & 3) + 8 * (r >> 2) + 4 * hi; }
__device__ __forceinline__ unsigned cvtpk(float lo, float hi) { return cvt_pk_rne(lo, hi); }
template <typename TIn> struct Stage;
template <> struct Stage<bf16>  { using T = bf16x8;
  __device__ static __forceinline__ T ld8(const bf16* p) { return *reinterpret_cast<const bf16x8*>(p); }
  __device__ static __forceinline__ bf16x8 tobf(T x) { return x; } };
template <> struct Stage<float> { using T = f32x8;
  __device__ static __forceinline__ T ld8(const float* p) { return *reinterpret_cast<const f32x8*>(p); }
  __device__ static __forceinline__ bf16x8 tobf(T x) {
    u32x4 w = {cvtpk(x[0], x[1]), cvtpk(x[2], x[3]), cvtpk(x[4], x[5]), cvtpk(x[6], x[7])}; return *reinterpret_cast<bf16x8*>(&w); } };

__device__ __forceinline__ void partialSM(f32x16& p0, f32x16& p1, float& m_reg, float& mn, float& alpha) {
  constexpr float C = SCALE * 1.4426950408889634f;
  float pmax = p0[0]; for (int r = 1; r < 16; ++r) pmax = fmaxf(pmax, p0[r]); for (int r = 0; r < 16; ++r) pmax = fmaxf(pmax, p1[r]);
  { auto rr = __builtin_amdgcn_permlane32_swap(__float_as_uint(pmax), __float_as_uint(pmax), false, false);
    pmax = fmaxf(__uint_as_float(rr[0]), __uint_as_float(rr[1])); }
  if (__builtin_expect(__all(pmax - m_reg <= THR / SCALE), 1)) { mn = m_reg; alpha = 1.f; }
  else { mn = fmaxf(m_reg, pmax); alpha = __builtin_amdgcn_exp2f((m_reg - mn) * C); m_reg = mn; }
  float mnC = -mn * C;
  for (int r = 0; r < 16; ++r) p0[r] = fmaf(p0[r], C, mnC); for (int r = 0; r < 16; ++r) p1[r] = fmaf(p1[r], C, mnC);
  for (int r = 0; r < 16; ++r) p0[r] = __builtin_amdgcn_exp2f(p0[r]);
}
__device__ __forceinline__ void finishSM(f32x16& p0, f32x16& p1, float alpha, float& l_reg, bf16x8& pa0, bf16x8& pa1, bf16x8& pa2, bf16x8& pa3) {
  for (int r = 0; r < 16; ++r) p1[r] = __builtin_amdgcn_exp2f(p1[r]);
  float ps = 0; for (int r = 0; r < 16; ++r) ps += p0[r]; for (int r = 0; r < 16; ++r) ps += p1[r];
  { auto rr = __builtin_amdgcn_permlane32_swap(__float_as_uint(ps), __float_as_uint(ps), false, false);
    ps = __uint_as_float(rr[0]) + __uint_as_float(rr[1]); }
  l_reg = l_reg * alpha + ps;
#define PK4(P, BASE, OUT) do { unsigned a0 = cvtpk(P[BASE + 0], P[BASE + 1]), a1 = cvtpk(P[BASE + 2], P[BASE + 3]);   \
    unsigned b0 = cvtpk(P[BASE + 4], P[BASE + 5]), b1 = cvtpk(P[BASE + 6], P[BASE + 7]);                              \
    auto r0 = __builtin_amdgcn_permlane32_swap(a0, b0, false, false); auto r1 = __builtin_amdgcn_permlane32_swap(a1, b1, false, false); \
    u32x4 w = {r0[0], r1[0], r0[1], r1[1]}; OUT = *reinterpret_cast<bf16x8*>(&w); } while (0)
  PK4(p0, 0, pa0); PK4(p0, 8, pa1); PK4(p1, 0, pa2); PK4(p1, 8, pa3);
#undef PK4
}
__device__ __forceinline__ void qkt(f32x16& p0, f32x16& p1, const bf16* Ks, const bf16x8* qr, int r32, int hi) {
  p0 = f32x16{}; p1 = f32x16{};
  for (int d0 = 0; d0 < 8; ++d0) { int cb = (d0 * 16 + hi * 8) * 2;
    bf16x8 b0 = *reinterpret_cast<const bf16x8*>((const char*)Ks + KSWZ(r32, cb));
    bf16x8 b1 = *reinterpret_cast<const bf16x8*>((const char*)Ks + KSWZ(32 + r32, cb));
    p0 = __builtin_amdgcn_mfma_f32_32x32x16_bf16(b0, qr[d0], p0, 0, 0, 0);
    p1 = __builtin_amdgcn_mfma_f32_32x32x16_bf16(b1, qr[d0], p1, 0, 0, 0); }
}
__device__ __forceinline__ int v_st(int k, int c) { const int kk = (k & ~0xC) | ((k & 4) << 1) | ((k & 8) >> 1); return ((kk >> 3) * 4 + (c >> 5)) * 512 + ((kk & 7) * 32 + (c & 31)) * 2; }
__device__ __forceinline__ int v_rd_base(int lane) { return ((lane & 3) << 3) | (((lane >> 2) & 3) << 6) | (((lane >> 4) & 1) << 5) | (((lane >> 5) & 1) << 8); }
constexpr int v_rd_off(int d0, int ks, int half) { return d0 * 512 + ks * 4096 + half * 2048; }
template <int OFF> __device__ __forceinline__ s16x4 tr_read(int vb) {
  s16x4 r; asm volatile("ds_read_b64_tr_b16 %0, %1 offset:%2" : "=&v"(r) : "v"(vb), "i"(OFF) : "memory"); return r;
}
template <int D0> __device__ __forceinline__ void pv_one(f32x16& od, int vb, bf16x8 pa0, bf16x8 pa1, bf16x8 pa2, bf16x8 pa3) {
  const s16x4 l0 = tr_read<v_rd_off(D0, 0, 0)>(vb), h0 = tr_read<v_rd_off(D0, 0, 1)>(vb), l1 = tr_read<v_rd_off(D0, 1, 0)>(vb), h1 = tr_read<v_rd_off(D0, 1, 1)>(vb);
  const s16x4 l2 = tr_read<v_rd_off(D0, 2, 0)>(vb), h2 = tr_read<v_rd_off(D0, 2, 1)>(vb), l3 = tr_read<v_rd_off(D0, 3, 0)>(vb), h3 = tr_read<v_rd_off(D0, 3, 1)>(vb);
  asm volatile("s_waitcnt lgkmcnt(0)" ::: "memory"); SBAR();
#define PK(L, H) (bf16x8){L[0], L[1], L[2], L[3], H[0], H[1], H[2], H[3]}
  od = __builtin_amdgcn_mfma_f32_32x32x16_bf16(pa0, PK(l0, h0), od, 0, 0, 0);
  od = __builtin_amdgcn_mfma_f32_32x32x16_bf16(pa1, PK(l1, h1), od, 0, 0, 0);
  od = __builtin_amdgcn_mfma_f32_32x32x16_bf16(pa2, PK(l2, h2), od, 0, 0, 0);
  od = __builtin_amdgcn_mfma_f32_32x32x16_bf16(pa3, PK(l3, h3), od, 0, 0, 0);
#undef PK
}
__device__ __forceinline__ void pv_d0(f32x16* o, int vb, bf16x8 pa0, bf16x8 pa1, bf16x8 pa2, bf16x8 pa3) {
  pv_one<0>(o[0], vb, pa0, pa1, pa2, pa3); pv_one<1>(o[1], vb, pa0, pa1, pa2, pa3); pv_one<2>(o[2], vb, pa0, pa1, pa2, pa3); pv_one<3>(o[3], vb, pa0, pa1, pa2, pa3);
}

template <typename TQ>
__device__ __forceinline__ void attn_dense_body(const TQ* __restrict__ Qb, const bf16* __restrict__ Kh, const bf16* __restrict__ Vh,
                                                float* __restrict__ Ob, int seq, char* lds, const int wave0) {
  using St = Stage<bf16>; using SQ = Stage<TQ>;
  int tid_ = wave0 * 64 + lane_id(); asm volatile("" : "+v"(tid_));
  const int tid = tid_, wid = tid >> 6, lane = tid & 63, r32 = lane & 31, hi = lane >> 5;
  bf16* V_lds = (bf16*)lds; bf16* K_lds = (bf16*)(lds + 2 * SHM_V);
  float* ws = (float*)(lds + 2 * SHM_V + 2 * SHM_K) + wid * 64; float* li_l = ws; float* al_l = ws + 32;
  float m_reg = -1e30f, l_reg = 0; f32x16 o[4] = {}; bf16x8 qr[8];
  const TQ* Qw = Qb + (long)(wid * QBLK + r32) * LDQ + hi * 8;
#pragma unroll
  for (int d0 = 0; d0 < 8; ++d0) qr[d0] = SQ::tobf(SQ::ld8(Qw + d0 * 16));
  const int sr = tid >> 4, sc = (tid & 15) * 8, vst0 = v_st(sr, sc), vst1 = v_st(32 + sr, sc);
  const int vb0 = (int)(uintptr_t)V_lds + v_rd_base(lane);
  struct { typename St::T vs0, vs1, ks0, ks1; } sr_[SDEPTH];
#define SLOAD(i, k0) do { sr_[i].vs0 = St::ld8(&Vh[(long)((k0) + sr) * LDK + sc]); sr_[i].vs1 = St::ld8(&Vh[(long)((k0) + 32 + sr) * LDK + sc]); \
    sr_[i].ks0 = St::ld8(&Kh[(long)((k0) + sr) * LDK + sc]); sr_[i].ks1 = St::ld8(&Kh[(long)((k0) + 32 + sr) * LDK + sc]); } while (0)
#define SWRITE(b, i) do { *(bf16x8*)((char*)V_lds + (b) * SHM_V + vst0) = St::tobf(sr_[i].vs0);          \
    *(bf16x8*)((char*)V_lds + (b) * SHM_V + vst1) = St::tobf(sr_[i].vs1); int kc = sc * 2;               \
    *(bf16x8*)((char*)K_lds + (b) * SHM_K + KSWZ(sr, kc)) = St::tobf(sr_[i].ks0);                       \
    *(bf16x8*)((char*)K_lds + (b) * SHM_K + KSWZ(32 + sr, kc)) = St::tobf(sr_[i].ks1); } while (0)
#define SWAIT() do { if constexpr (SDEPTH == 2) asm volatile("s_waitcnt vmcnt(4)" ::: "memory"); else asm volatile("s_waitcnt vmcnt(0)" ::: "memory"); } while (0)
#define RESC(a) do { if (__any((a) < 1.f)) { if (hi == 0) al_l[r32] = (a); asm volatile("s_waitcnt lgkmcnt(0)" ::: "memory"); \
    for (int d = 0; d < 4; ++d) for (int r = 0; r < 16; ++r) o[d][r] *= al_l[crow(r, hi)]; } } while (0)
  f32x16 pA0, pA1, pB0, pB1; float mnA, mnB, alA, alB; bf16x8 pa0, pa1, pa2, pa3; const int NT = seq / KVBLK;
  constexpr int SE = 0, SO = SDEPTH - 1;
  SLOAD(SE, 0); asm volatile("s_waitcnt vmcnt(0)" ::: "memory"); SWRITE(0, SE); __syncthreads();
  qkt(pA0, pA1, K_lds, qr, r32, hi); partialSM(pA0, pA1, m_reg, mnA, alA);
  SLOAD(SO, KVBLK); if constexpr (SDEPTH == 2) { if (2 < NT) SLOAD(SE, 2 * KVBLK); }
  SWAIT(); SWRITE(1, SO); __syncthreads();
  for (int j = 1; j + 1 < NT; j += 2) {
    SBAR(); qkt(pB0, pB1, (bf16*)((char*)K_lds + SHM_K), qr, r32, hi);
    finishSM(pA0, pA1, alA, l_reg, pa0, pa1, pa2, pa3); SBAR();
    SLOAD(SO, (j + SDEPTH) * KVBLK); SBAR();
    pv_d0(o, vb0, pa0, pa1, pa2, pa3); partialSM(pB0, pB1, m_reg, mnB, alB);
    __syncthreads(); SWAIT(); SWRITE(0, SE);
    RESC(alB); __syncthreads();
    SBAR(); qkt(pA0, pA1, K_lds, qr, r32, hi);
    finishSM(pB0, pB1, alB, l_reg, pa0, pa1, pa2, pa3); SBAR();
    if (SDEPTH == 1 || j + 3 < NT) SLOAD(SE, (j + 1 + SDEPTH) * KVBLK); SBAR();
    pv_d0(o, vb0 + (int)SHM_V, pa0, pa1, pa2, pa3); partialSM(pA0, pA1, m_reg, mnA, alA);
    __syncthreads(); SWAIT(); SWRITE(1, SO);
    RESC(alA); __syncthreads();
  }
  SBAR(); qkt(pB0, pB1, (bf16*)((char*)K_lds + SHM_K), qr, r32, hi);
  finishSM(pA0, pA1, alA, l_reg, pa0, pa1, pa2, pa3); SBAR();
  pv_d0(o, vb0, pa0, pa1, pa2, pa3); partialSM(pB0, pB1, m_reg, mnB, alB);
  __syncthreads(); RESC(alB);
  finishSM(pB0, pB1, alB, l_reg, pa0, pa1, pa2, pa3); SBAR();
  pv_d0(o, vb0 + (int)SHM_V, pa0, pa1, pa2, pa3);
  if (hi == 0) li_l[r32] = l_reg; asm volatile("s_waitcnt lgkmcnt(0)" ::: "memory");
  float rli[16];
#pragma unroll
  for (int r = 0; r < 16; ++r) rli[r] = __builtin_amdgcn_rcpf(li_l[crow(r, hi)]);
  float* Ow = Ob + (long)(wid * QBLK) * LDO;
#pragma unroll
  for (int r = 0; r < 16; ++r) { int orow = crow(r, hi);
    for (int d0 = 0; d0 < 4; ++d0) Ow[(long)orow * LDO + d0 * 32 + r32] = o[d0][r] * rli[r]; }
#undef SLOAD
#undef SWRITE
#undef SWAIT
#undef RESC
}

}

template <class Epi>
__device__ __forceinline__ void naive_gemm(Frame& F, const bf16* __restrict__ A, int lda, const bf16* __restrict__ Bt, int ldb, int M, int N, int K, const Epi& epi) {
    LAS float* As = (LAS float*)F.lds;
    LAS float* Bs = As + 32 * 132;
    const int tid = F.tid, tm = tid >> 4, tn = tid & 15;
    const int ntm = M / 128, ntn = N / 64;
    for (int tile = F.vcu; tile < ntm * ntn; tile += F.G) {
        const int pm = tile / ntn, pn = tile % ntn;
        float acc[4][4];
#pragma unroll
        for (int i = 0; i < 4; ++i)
#pragma unroll
            for (int j = 0; j < 4; ++j) acc[i][j] = 0.f;
        for (int k0 = 0; k0 < K; k0 += 32) {
            { const int r = tid >> 2, ks = (tid & 3) * 8; const bf16x8 v = *(const bf16x8*)(A + (size_t)(pm * 128 + r) * lda + k0 + ks);
#pragma unroll
              for (int j = 0; j < 8; ++j) As[(ks + j) * 132 + r] = bf2f((bf16)v[j]); }
            if (tid < 256) { const int r = tid >> 2, ks = (tid & 3) * 8; const bf16x8 v = *(const bf16x8*)(Bt + (size_t)(pn * 64 + r) * ldb + k0 + ks);
#pragma unroll
              for (int j = 0; j < 8; ++j) Bs[(ks + j) * 68 + r] = bf2f((bf16)v[j]); }
            __syncthreads();
#pragma unroll 8
            for (int kk = 0; kk < 32; ++kk) { const f32x4 a = *(const LAS f32x4*)(As + kk * 132 + tm * 4); const f32x4 b = *(const LAS f32x4*)(Bs + kk * 68 + tn * 4);
#pragma unroll
                for (int i = 0; i < 4; ++i)
#pragma unroll
                    for (int j = 0; j < 4; ++j) acc[i][j] = fmaf(a[i], b[j], acc[i][j]); }
            __syncthreads();
        }
#pragma unroll
        for (int i = 0; i < 4; ++i)
#pragma unroll
            for (int j = 0; j < 4; ++j) epi(pm * 128 + tm * 4 + i, pn * 64 + tn * 4 + j, acc[i][j]);
    }
}

__device__ __forceinline__ void phase_post(Frame& F, int l) {
    bf16* PROJ = WSP(bf16, WS_PROJ);
    const float2* TA = WSP(float2, WS_TABA); const float2* TB = WSP(float2, WS_TABB);
    const float* qn = GIN(5) + l * HD; const float* kn = GIN(6) + l * HD;
    const int gw = F.vcu * NWAVES + F.wave, NGW = F.G * NWAVES, lane = F.lane;
    const int sgA = lane >> 3, iA = (lane & 7) * 2, baseA = (sgA < 4 ? COL_AQ + sgA * HD : COL_AK + (sgA - 4) * HD) + iA;
    const int hsel = lane >> 5, q = lane & 31, hf = q >> 4, i2 = (q & 15) * 2, eo = hf * 64 + i2;
    const float gq0 = qn[eo], gq1 = qn[eo + 1], gq2 = qn[eo + 32], gq3 = qn[eo + 33], gk0 = kn[eo], gk1 = kn[eo + 1], gk2 = kn[eo + 32], gk3 = kn[eo + 33];
    for (int t = gw; t < T; t += NGW) {
        const int s = t & (SEQ - 1);
        bf16* row = PROJ + (size_t)t * DINP;
        const unsigned a1 = *(const unsigned*)(row + baseA), a2 = *(const unsigned*)(row + baseA + 16);
        const f32x4 csa = *(const f32x4*)(TA + s * 16 + iA);
        const int pos = hf == 0 ? (s >> 6) : (s & 63); const f32x4 csb = *(const f32x4*)(TB + pos * 32 + i2);
        unsigned b1[5], b2[5];
#pragma unroll
        for (int p = 0; p < 5; ++p) { const int hh = 2 * p + hsel, base = (p < 4 ? COL_BQ + hh * HD : COL_BK + (hh - 8) * HD) + eo; b1[p] = *(const unsigned*)(row + base); b2[p] = *(const unsigned*)(row + base + 32); }
        { const float x1l = __uint_as_float(a1 << 16), x1h = __uint_as_float(a1 & 0xffff0000u), x2l = __uint_as_float(a2 << 16), x2h = __uint_as_float(a2 & 0xffff0000u);
          *(unsigned*)(row + baseA) = pk2(x1l * csa.x - x2l * csa.y, x1h * csa.z - x2h * csa.w); *(unsigned*)(row + baseA + 16) = pk2(x2l * csa.x + x1l * csa.y, x2h * csa.z + x1h * csa.w); }
#pragma unroll
        for (int p = 0; p < 5; ++p) { const int hh = 2 * p + hsel, base = (p < 4 ? COL_BQ + hh * HD : COL_BK + (hh - 8) * HD) + eo;
            float x1l = __uint_as_float(b1[p] << 16), x1h = __uint_as_float(b1[p] & 0xffff0000u), x2l = __uint_as_float(b2[p] << 16), x2h = __uint_as_float(b2[p] & 0xffff0000u);
            float ss = (x1l * x1l + x1h * x1h) + (x2l * x2l + x2h * x2h);
            ss += __shfl_xor(ss, 1); ss += __shfl_xor(ss, 2); ss += __shfl_xor(ss, 4); ss += __shfl_xor(ss, 8); ss += __shfl_xor(ss, 16);
            const float rs = rsqrtf(ss * (1.0f / HD) + EPS);
            x1l = x1l * rs * (p < 4 ? gq0 : gk0); x1h = x1h * rs * (p < 4 ? gq1 : gk1); x2l = x2l * rs * (p < 4 ? gq2 : gk2); x2h = x2h * rs * (p < 4 ? gq3 : gk3);
            *(unsigned*)(row + base) = pk2(x1l * csb.x - x2l * csb.y, x1h * csb.z - x2h * csb.w); *(unsigned*)(row + base + 32) = pk2(x2l * csb.x + x1l * csb.y, x2h * csb.z + x1h * csb.w); }
    }
}
__device__ __forceinline__ void phase_dn_prep_naive(Frame& F, int l) {
    const bf16* PROJ = WSP(bf16, WS_PROJ); const float* TL = WSP(float, WS_TL);
    float* DQ = WSP(float, WS_DQ); float* DK = WSP(float, WS_DK); float* DV = WSP(float, WS_DV); float* DB = WSP(float, WS_DB); float* DG = WSP(float, WS_DG);
    const float* cw = GIN(4) + (size_t)l * 5 * 1536;
    const int gw = F.vcu * NWAVES + F.wave, NGW = F.G * NWAVES, lane = F.lane;
    for (int t = gw; t < T; t += NGW) {
        const int s = t & (SEQ - 1);
#pragma unroll 1
        for (int g = 0; g < 12; ++g) {
            float val[2];
#pragma unroll
            for (int u = 0; u < 2; ++u) { const int c = 128 * g + 64 * u + lane; float a = 0.f;
#pragma unroll
                for (int j = 0; j < 5; ++j) { const int sp = s - 2 + j; if (sp >= 0 && sp < SEQ) a += bf2f(PROJ[(size_t)(t - 2 + j) * DINP + COL_CQKV + c]) * cw[j * 1536 + c]; }
                val[u] = siluf_(a); }
            float* dst = g < 4 ? DQ : (g < 8 ? DK : DV);
            if (g < 8) { const float ss = wave_sum(val[0] * val[0] + val[1] * val[1]); const float rs = rsqrtf(ss + EPS) * (g < 4 ? 0.08838834764831845f : 1.0f); val[0] *= rs; val[1] *= rs; }
            dst[(size_t)t * 512 + (g & 3) * 128 + lane] = val[0]; dst[(size_t)t * 512 + (g & 3) * 128 + 64 + lane] = val[1];
        }
        if (lane < 8) { const int dir = lane >> 2, hh = lane & 3; const float bl = TL[(size_t)t * 16 + dir * 4 + hh], al = TL[(size_t)t * 16 + 8 + dir * 4 + hh];
            const float A = expf(GIN(9)[(l * 2 + dir) * 4 + hh]); const float dtb = GIN(10)[(l * 2 + dir) * 4 + hh];
            DB[((size_t)dir * T + t) * 4 + hh] = sigmoidf_(bl); DG[((size_t)dir * T + t) * 4 + hh] = -A * softplusf_(al + dtb); }
    }
}


namespace dn {
typedef float f32x4 __attribute__((ext_vector_type(4)));
typedef short bf16x8 __attribute__((ext_vector_type(8)));
typedef short bf16x4 __attribute__((ext_vector_type(4)));
constexpr int KB_OFF = 0, QB_OFF = 17408, VB_OFF = 34816;
constexpr int KDT_OFF = 52224, UT_OFF = 70656, WT_OFF = 89088;
constexpr int AM_OFF = 107520;
constexpr int QKM_OFF = 123904;
constexpr int GC_OFF = 133120;
__device__ __forceinline__ unsigned cvtpk(float lo, float hi) { return cvt_pk_rne(lo, hi); }
__device__ __forceinline__ f32x4 mfma16(bf16x8 a, bf16x8 b, f32x4 c) { return __builtin_amdgcn_mfma_f32_16x16x32_bf16(a, b, c, 0, 0, 0); }
__device__ __forceinline__ void mfma_settle() { asm volatile("s_nop 15\n\ts_nop 7" ::: "memory"); }
}

__device__ __forceinline__ void phase_dn_chunk(Frame& F, int l) {
    using namespace dn;
#define WSQ(type, off) ((type*)(wsq + (off)))
    LAS unsigned char* L = F.lds;
    LAS float* GC = (LAS float*)(L + GC_OFF);
    const int wave = F.wave;
    for (int u = F.vcu; u < 1024; u += F.G) {
        int tid_ = wave * 64 + lane_id(); asm volatile("" : "+v"(tid_));
        const int tid = tid_, lane = tid & 63, g4 = lane >> 4, l15 = lane & 15;
        const int dir = u >> 9, b = (u >> 8) & 1, hh = (u >> 6) & 3, c = u & 63;
        const int chain = dir * 8 + b * 4 + hh, cs = dir ? 63 - c : c;
        const size_t ub = (size_t)chain * 64 + cs;
        GAS unsigned char* wsq_ = (GAS unsigned char*)F.ws; asm volatile("" : "+s"(wsq_)); unsigned char* wsq = (unsigned char*)wsq_;
        __syncthreads();
        if (wave == 0) {
            const int pos = dir ? 63 - lane : lane; const size_t t = (size_t)b * SEQ + c * 64 + pos;
            const float* TL = WSQ(float, WS_TL); const float bl = TL[t * 16 + dir * 4 + hh], al = TL[t * 16 + 8 + dir * 4 + hh];
            const float Acoef = expf(GIN(9)[(l * 2 + dir) * 4 + hh]), dtb = GIN(10)[(l * 2 + dir) * 4 + hh];
            float gc = -Acoef * softplusf_(al + dtb);
#pragma unroll
            for (int o = 1; o < 64; o <<= 1) { const float tv = bperm(gc, lane >= o ? lane - o : lane); if (lane >= o) gc += tv; }
            const float glast = bperm(gc, 63);
            const float beta = sigmoidf_(bl), egc = expf(gc); GC[lane] = gc; GC[64 + lane] = beta; GC[128 + lane] = egc; GC[192 + lane] = expf(glast - gc); if (lane == 0) GC[256] = expf(glast); GC[320 + lane] = beta * egc;
        }
        __syncthreads();
#ifndef DBG_NOCONV
        if (tid < 384) {
            const int rg = tid / 48, o = tid % 48, part = o >> 4, oo = o & 15;
            const int chl = part * 512 + hh * 128 + oo * 8;
            const float* cw = GIN(4) + (size_t)l * 5 * 1536;
            const bf16* src = WSQ(bf16, WS_PROJ) + (size_t)(b * SEQ) * DINP + COL_CQKV + chl;
            float w[5][8];
#pragma unroll
            for (int j = 0; j < 5; ++j) { const f32x4 w0 = *(const f32x4*)(cw + j * 1536 + chl), w1 = *(const f32x4*)(cw + j * 1536 + chl + 4);
                w[j][0] = w0.x; w[j][1] = w0.y; w[j][2] = w0.z; w[j][3] = w0.w; w[j][4] = w1.x; w[j][5] = w1.y; w[j][6] = w1.z; w[j][7] = w1.w; }
            bf16x8 xin[12];
#pragma unroll
            for (int dr = 0; dr < 12; ++dr) { const int sq = c * 64 + rg * 8 - 2 + dr; xin[dr] = (bf16x8){0, 0, 0, 0, 0, 0, 0, 0}; if (sq >= 0 && sq < SEQ) xin[dr] = *(const bf16x8*)(src + (size_t)sq * DINP); }
#pragma unroll
            for (int hp = 0; hp < 2; ++hp) {
                float acc[4][8];
#pragma unroll
                for (int r = 0; r < 4; ++r)
#pragma unroll
                    for (int e = 0; e < 8; ++e) acc[r][e] = 0.f;
#pragma unroll
                for (int dr = 0; dr < 8; ++dr) { float xf[8];
#pragma unroll
                        for (int e = 0; e < 8; ++e) xf[e] = bf2f((bf16)xin[4 * hp + dr][e]);
#pragma unroll
                        for (int r = 0; r < 4; ++r) { const int j = dr - r; if (j >= 0 && j < 5) {
#pragma unroll
                            for (int e = 0; e < 8; ++e) acc[r][e] = fmaf(xf[e], w[j][e], acc[r][e]); } } }
#pragma unroll
                for (int r = 0; r < 4; ++r) {
#pragma unroll
                    for (int e = 0; e < 8; ++e) acc[r][e] = siluf_(acc[r][e]);
                    if (part < 2) { float ss = 0.f;
#pragma unroll
                        for (int e = 0; e < 8; ++e) ss = fmaf(acc[r][e], acc[r][e], ss);
                        ss += bperm(ss, lane ^ 1); ss += bperm(ss, lane ^ 2); ss += bperm(ss, lane ^ 4); ss += bperm(ss, lane ^ 8);
                        const float rs = rsqrtf(ss + EPS) * (part == 0 ? 0.08838834764831845f : 1.0f);
#pragma unroll
                        for (int e = 0; e < 8; ++e) acc[r][e] *= rs; }
                    const int i = dir ? 63 - (rg * 8 + hp * 4 + r) : rg * 8 + hp * 4 + r;
                    u32x4 pk; pk.x = cvtpk(acc[r][0], acc[r][1]); pk.y = cvtpk(acc[r][2], acc[r][3]); pk.z = cvtpk(acc[r][4], acc[r][5]); pk.w = cvtpk(acc[r][6], acc[r][7]);
                    *(LAS u32x4*)(L + (part == 0 ? QB_OFF : (part == 1 ? KB_OFF : VB_OFF)) + i * 272 + oo * 16) = pk;
                }
                if (part == 1) {
                    const int ib = dir ? 60 - rg * 8 - hp * 4 : rg * 8 + hp * 4;
                    float kd[4];
#pragma unroll
                    for (int m = 0; m < 4; ++m) kd[m] = GC[192 + ib + m];
#pragma unroll
                    for (int e = 0; e < 8; ++e) { float v4[4];
#pragma unroll
                        for (int m = 0; m < 4; ++m) v4[m] = (dir ? acc[3 - m][e] : acc[m][e]) * kd[m];
                        u32x2 pk; pk.x = cvtpk(v4[0], v4[1]); pk.y = cvtpk(v4[2], v4[3]);
                        *(LAS u32x2*)(L + KDT_OFF + (oo * 8 + e) * 144 + ib * 2) = pk; }
                }
            }
        }
        __syncthreads();
#endif
        { const int sel = wave >> 2, rt = wave & 3;
          f32x4 acc[4];
#pragma unroll
          for (int ct = 0; ct < 4; ++ct) acc[ct] = (f32x4){0.f, 0.f, 0.f, 0.f};
          const LAS unsigned char* ab2 = L + (sel ? QB_OFF : KB_OFF) + (16 * rt + l15) * 272 + g4 * 16; const LAS unsigned char* bb2 = L + KB_OFF + l15 * 272 + g4 * 16;
#pragma unroll
          for (int kb = 0; kb < 4; ++kb) { const bf16x8 a = *(const LAS bf16x8*)(ab2 + kb * 64);
#pragma unroll
              for (int ct = 0; ct < 4; ++ct) { const bf16x8 bb = *(const LAS bf16x8*)(bb2 + ct * 4352 + kb * 64); acc[ct] = mfma16(a, bb, acc[ct]); } }
#pragma unroll
          for (int ct = 0; ct < 4; ++ct)
#pragma unroll
              for (int r = 0; r < 4; ++r) { const int i = 16 * rt + 4 * g4 + r, j = 16 * ct + l15; const float dec = j <= i ? expf(GC[i] - GC[j]) : 0.f; const float val = acc[ct][r] * dec;
                  if (sel == 0) ((LAS float*)(L + AM_OFF))[i * 64 + j] = j < i ? GC[64 + i] * val : 0.f;
                  else ((LAS bf16*)(L + QKM_OFF))[i * 72 + j] = (bf16)f2bf(val); } }
        __syncthreads();
#ifndef DBG_NOSOLVE
        if (tid < 256) {
            const LAS bf16* srcc = (const LAS bf16*)(L + (tid < 128 ? VB_OFF : KB_OFF)) + (tid & 127); const LAS float* scv = GC + (tid < 128 ? 64 : 320);
            LAS unsigned char* xrow = L + (tid < 128 ? UT_OFF + tid * 144 : WT_OFF + (tid - 128) * 144);
            int zoff; asm volatile("v_mov_b32 %0, 0" : "=v"(zoff));
            const LAS float* AM = (const LAS float*)(L + AM_OFF) + zoff;
#pragma unroll
            for (int r = 0; r < 4; ++r) {
                float acc[16];
#pragma unroll
                for (int ii = 0; ii < 16; ++ii) acc[ii] = scv[16 * r + ii] * bf2f(srcc[(16 * r + ii) * 136]);
#pragma unroll 1
                for (int sb = 0; sb < r; ++sb) {
                    const u32x4 x0 = *(const LAS u32x4*)(xrow + sb * 32), x1 = *(const LAS u32x4*)(xrow + sb * 32 + 16); float xs[16];
                    xs[0] = __uint_as_float(x0.x << 16); xs[1] = __uint_as_float(x0.x & 0xffff0000u); xs[2] = __uint_as_float(x0.y << 16); xs[3] = __uint_as_float(x0.y & 0xffff0000u);
                    xs[4] = __uint_as_float(x0.z << 16); xs[5] = __uint_as_float(x0.z & 0xffff0000u); xs[6] = __uint_as_float(x0.w << 16); xs[7] = __uint_as_float(x0.w & 0xffff0000u);
                    xs[8] = __uint_as_float(x1.x << 16); xs[9] = __uint_as_float(x1.x & 0xffff0000u); xs[10] = __uint_as_float(x1.y << 16); xs[11] = __uint_as_float(x1.y & 0xffff0000u);
                    xs[12] = __uint_as_float(x1.z << 16); xs[13] = __uint_as_float(x1.z & 0xffff0000u); xs[14] = __uint_as_float(x1.w << 16); xs[15] = __uint_as_float(x1.w & 0xffff0000u);
#pragma unroll
                    for (int ii = 0; ii < 16; ++ii) { const LAS float* ar = AM + (16 * r + ii) * 64 + 16 * sb; float s0 = 0.f, s1 = 0.f; if ((ii & 3) == 0) asm volatile("" ::: "memory");
#pragma unroll
                        for (int q = 0; q < 4; ++q) { const f32x4 a = *(const LAS f32x4*)(ar + 4 * q); s0 = fmaf(a.x, xs[4 * q], s0); s1 = fmaf(a.y, xs[4 * q + 1], s1); s0 = fmaf(a.z, xs[4 * q + 2], s0); s1 = fmaf(a.w, xs[4 * q + 3], s1); }
                        acc[ii] -= s0 + s1; }
                }
#pragma unroll
                for (int ii = 1; ii < 16; ++ii) { const LAS float* ar = AM + (16 * r + ii) * 64 + 16 * r; float s0 = 0.f, s1 = 0.f;
#pragma unroll
                    for (int q = 0; q < (ii + 3) / 4; ++q) { const f32x4 a = *(const LAS f32x4*)(ar + 4 * q); s0 = fmaf(a.x, acc[4 * q], s0); s1 = fmaf(a.y, acc[4 * q + 1], s1); s0 = fmaf(a.z, acc[4 * q + 2], s0); s1 = fmaf(a.w, acc[4 * q + 3], s1); }
                    acc[ii] -= s0 + s1; }
                u32x4 pk; pk.x = cvtpk(acc[0], acc[1]); pk.y = cvtpk(acc[2], acc[3]); pk.z = cvtpk(acc[4], acc[5]); pk.w = cvtpk(acc[6], acc[7]); *(LAS u32x4*)(xrow + r * 32) = pk;
                pk.x = cvtpk(acc[8], acc[9]); pk.y = cvtpk(acc[10], acc[11]); pk.z = cvtpk(acc[12], acc[13]); pk.w = cvtpk(acc[14], acc[15]); *(LAS u32x4*)(xrow + r * 32 + 16) = pk;
            }
        }
        __syncthreads();
#endif
        { const int sel = wave >> 2, it = wave & 3;
          f32x4 acc[8];
#pragma unroll
          for (int dt = 0; dt < 8; ++dt) acc[dt] = (f32x4){0.f, 0.f, 0.f, 0.f};
          const LAS unsigned char* bb4 = L + QKM_OFF + (16 * it + l15) * 144 + g4 * 16; const LAS unsigned char* ab4 = L + (sel ? UT_OFF : WT_OFF) + l15 * 144 + g4 * 16;
#pragma unroll
          for (int kb = 0; kb < 2; ++kb) { const bf16x8 bb = *(const LAS bf16x8*)(bb4 + kb * 64);
#pragma unroll
              for (int dt = 0; dt < 8; ++dt) { const bf16x8 a = *(const LAS bf16x8*)(ab4 + dt * 2304 + kb * 64); acc[dt] = mfma16(a, bb, acc[dt]); } }
          mfma_settle();
          const int i = 16 * it + l15, trow = dir ? 63 - i : i;
          if (sel == 0) { bf16* CP = WSQ(bf16, WS_CP) + (ub * 64 + trow) * 128; const float eg = GC[128 + i];
#pragma unroll
              for (int dt = 0; dt < 8; ++dt) { const int d = 16 * dt + 4 * g4; const u32x2 qw = *(const LAS u32x2*)(L + QB_OFF + i * 272 + d * 2);
                  const float q0 = __uint_as_float(qw.x << 16), q1 = __uint_as_float(qw.x & 0xffff0000u), q2 = __uint_as_float(qw.y << 16), q3 = __uint_as_float(qw.y & 0xffff0000u);
                  u32x2 o; o.x = cvtpk(q0 * eg - acc[dt][0], q1 * eg - acc[dt][1]); o.y = cvtpk(q2 * eg - acc[dt][2], q3 * eg - acc[dt][3]); *(u32x2*)(CP + 32 * (dt >> 1) + 8 * g4 + 4 * (dt & 1)) = o; } }
          else { float* CR = WSQ(float, WS_CR) + (ub * 64 + trow) * 128;
#pragma unroll
              for (int dt = 0; dt < 8; ++dt) *(f32x4*)(CR + 16 * dt + 4 * g4) = acc[dt]; } }
        { f32x4 acc[8];
#pragma unroll
          for (int ct = 0; ct < 8; ++ct) acc[ct] = (f32x4){0.f, 0.f, 0.f, 0.f};
          const LAS unsigned char* lane_off = L + l15 * 144 + g4 * 16;
#pragma unroll
          for (int kb = 0; kb < 2; ++kb) { const bf16x8 a = *(const LAS bf16x8*)(lane_off + WT_OFF + wave * 2304 + kb * 64);
#pragma unroll
              for (int ct = 0; ct < 8; ++ct) { const bf16x8 bb = *(const LAS bf16x8*)(lane_off + KDT_OFF + ct * 2304 + kb * 64); acc[ct] = mfma16(a, bb, acc[ct]); } }
          mfma_settle();
          bf16* CM = WSQ(bf16, WS_CM) + ub * 16384; const float eg = GC[256];
          const int dpp = 32 * (wave >> 1) + 8 * g4 + 4 * (wave & 1);
#pragma unroll
          for (int ct = 0; ct < 8; ++ct) { const int d = 16 * ct + l15, dp = 16 * wave + 4 * g4; float m[4];
#pragma unroll
              for (int r = 0; r < 4; ++r) m[r] = (d == dp + r ? eg : 0.f) - acc[ct][r];
              u32x2 o; o.x = cvtpk(m[0], m[1]); o.y = cvtpk(m[2], m[3]); *(u32x2*)(CM + (size_t)d * 128 + dpp) = o; }
#pragma unroll
          for (int ct = 0; ct < 8; ++ct) acc[ct] = (f32x4){0.f, 0.f, 0.f, 0.f};
#pragma unroll
          for (int kb = 0; kb < 2; ++kb) { const bf16x8 a = *(const LAS bf16x8*)(lane_off + KDT_OFF + wave * 2304 + kb * 64);
#pragma unroll
              for (int ct = 0; ct < 8; ++ct) { const bf16x8 bb = *(const LAS bf16x8*)(lane_off + UT_OFF + ct * 2304 + kb * 64); acc[ct] = mfma16(a, bb, acc[ct]); } }
          mfma_settle();
          bf16* CN = WSQ(bf16, WS_CN) + ub * 16384;
#pragma unroll
          for (int ct = 0; ct < 8; ++ct) { u32x2 o; o.x = cvtpk(acc[ct][0], acc[ct][1]); o.y = cvtpk(acc[ct][2], acc[ct][3]); *(u32x2*)(CN + ((size_t)(ct * 8 + wave) * 64 + lane) * 4) = o; } }
    }
}
#undef WSQ

#define DN_SCAN_STEP(cs, NS, MS) do {            \
        const LAS unsigned char* Mb = L + ((cs) & 1) * 34816;                                                                                        \
        const int c4 = (cs) + 3 < 64 ? (cs) + 3 : 63, c5 = (cs) + 4 < 64 ? (cs) + 4 : 63;                                                           \
        if (active) {                                                                                                                               \
        bf16* cso = CS + (size_t)(cs) * 16384 + ((size_t)(wv * 8) * 64 + lane) * 4;                                                                  \
        unsigned sp[8][2]; f32x4 acc[8];                                                                                                            \
        _Pragma("unroll") for (int r = 0; r < 8; ++r) { sp[r][0] = cvtpk(S[r][0], S[r][1]); sp[r][1] = cvtpk(S[r][2], S[r][3]); u32x2 o; o.x = sp[r][0]; o.y = sp[r][1]; *(u32x2*)(cso + 256 * r) = o; \
            acc[r][0] = __uint_as_float(NS[r].x << 16); acc[r][1] = __uint_as_float(NS[r].x & 0xffff0000u); acc[r][2] = __uint_as_float(NS[r].y << 16); acc[r][3] = __uint_as_float(NS[r].y & 0xffff0000u); } \
        _Pragma("unroll") for (int r = 0; r < 8; ++r) NS[r] = *(const u32x2*)(CN + (size_t)c4 * 16384 + ((size_t)(wv * 8 + r) * 64 + lane) * 4);         \
        _Pragma("unroll") for (int kb = 0; kb < 4; ++kb) { u32x4 bw; bw.x = sp[2 * kb][0]; bw.y = sp[2 * kb][1]; bw.z = sp[2 * kb + 1][0]; bw.w = sp[2 * kb + 1][1]; const bf16x8 bfrag = *reinterpret_cast<bf16x8*>(&bw); \
            _Pragma("unroll") for (int r = 0; r < 8; ++r)                                                                                           \
                acc[r] = mfma16(*(const LAS bf16x8*)(Mb + (16 * r + l15) * 272 + (32 * kb + 8 * g4) * 2), bfrag, acc[r]); }                            \
        _Pragma("unroll") for (int r = 0; r < 8; ++r) S[r] = acc[r];                                                                                 \
        } else {     \
                                \
          LAS unsigned char* Mn = L + (((cs) + 1) & 1) * 34816;                                                                                      \
          _Pragma("unroll") for (int q = 0; q < 8; ++q) { const int id = tl + 256 * q; *(LAS u32x4*)(Mn + (id >> 4) * 272 + (id & 15) * 16) = MS[q]; }   \
          _Pragma("unroll") for (int q = 0; q < 8; ++q) MS[q] = *(const u32x4*)(CM + (size_t)c5 * 16384 + (size_t)(tl + 256 * q) * 8);                 \
        }                                                                                                                                           \
        asm volatile("s_waitcnt lgkmcnt(0)" ::: "memory"); __builtin_amdgcn_s_barrier(); asm volatile("" ::: "memory");     \
    } while (0)
__device__ __forceinline__ void phase_dn_scan(Frame& F) {
    using namespace dn;
    if (blockIdx.x >= 32) return;
    const int chain = (int)blockIdx.x >> 1, tid = F.tid, lane = F.lane, wave = F.wave, g4 = lane >> 4, l15 = lane & 15;
    const bool active = wave < 4; const int wv = ((int)blockIdx.x & 1) * 4 + (wave & 3);
    const int tl = tid & 255;
    LAS unsigned char* L = F.lds;
    const bf16* CM = WSP(bf16, WS_CM) + (size_t)chain * 64 * 16384; const bf16* CN = WSP(bf16, WS_CN) + (size_t)chain * 64 * 16384; bf16* CS = WSP(bf16, WS_CS) + (size_t)chain * 64 * 16384;
    f32x4 S[8];
#pragma unroll
    for (int r = 0; r < 8; ++r) S[r] = (f32x4){0.f, 0.f, 0.f, 0.f};
    u32x4 m0[8], m1[8], m2[8]; u32x2 n0[8], n1[8], n2[8];
#pragma unroll
    for (int q = 0; q < 8; ++q) { m0[q] = (u32x4){0u, 0u, 0u, 0u}; m1[q] = m0[q]; m2[q] = m0[q]; }
#pragma unroll
    for (int r = 0; r < 8; ++r) { n0[r] = (u32x2){0u, 0u}; n1[r] = n0[r]; n2[r] = n0[r]; }
    __syncthreads();
    if (!active) {
#pragma unroll
        for (int q = 0; q < 8; ++q) { const size_t o = (size_t)(tl + 256 * q) * 8; m0[q] = *(const u32x4*)(CM + o); m1[q] = *(const u32x4*)(CM + 16384 + o); m2[q] = *(const u32x4*)(CM + 2 * 16384 + o); }
#pragma unroll
        for (int q = 0; q < 8; ++q) { const int id = tl + 256 * q; *(LAS u32x4*)(L + (id >> 4) * 272 + (id & 15) * 16) = m0[q]; }
#pragma unroll
        for (int q = 0; q < 8; ++q) m0[q] = *(const u32x4*)(CM + 3 * 16384 + (size_t)(tl + 256 * q) * 8);
    } else {
#pragma unroll
        for (int r = 0; r < 8; ++r) { const size_t o = ((size_t)(wv * 8 + r) * 64 + lane) * 4; n0[r] = *(const u32x2*)(CN + o); n1[r] = *(const u32x2*)(CN + 16384 + o); n2[r] = *(const u32x2*)(CN + 2 * 16384 + o); }
    }
    __syncthreads();
#pragma unroll 1
    for (int cs = 0; cs < 63; cs += 3) {
        DN_SCAN_STEP(cs, n0, m1);
        DN_SCAN_STEP(cs + 1, n1, m2);
        DN_SCAN_STEP(cs + 2, n2, m0);
    }
    DN_SCAN_STEP(63, n0, m1);
}
#undef DN_SCAN_STEP

__device__ __forceinline__ void phase_dn_out(Frame& F, int l, const int ufirst, const int ustep, const int uend) {
    using namespace dn;
    const bf16* PROJ = WSP(bf16, WS_PROJ); bf16* Y = WSP(bf16, WS_Y); const float* gn = GIN(11) + (size_t)l * HD;
    const int lane = F.lane, wave = F.wave, g4 = lane >> 4, l15 = lane & 15, it = wave & 3, vh = wave >> 2;
    LAS float* part = (LAS float*)F.lds;
    for (int u = ufirst; u < uend; u += ustep) {
        const int b = u >> 8, hh = (u >> 6) & 3, c = u & 63;
        f32x4 acc[4];
#pragma unroll
        for (int q = 0; q < 4; ++q) acc[q] = (f32x4){0.f, 0.f, 0.f, 0.f};
#pragma unroll
        for (int dir = 0; dir < 2; ++dir) { const int chain = dir * 8 + b * 4 + hh, cs = dir ? 63 - c : c; const size_t ub = (size_t)chain * 64 + cs;
            const bf16* CP = WSP(bf16, WS_CP) + ub * 8192 + (size_t)(16 * it + l15) * 128 + 8 * g4; const bf16* CS = WSP(bf16, WS_CS) + ub * 16384 + (size_t)lane * 4; const float* CR = WSP(float, WS_CR) + ub * 8192 + (size_t)(16 * it + l15) * 128;
#pragma unroll
            for (int kb = 0; kb < 4; ++kb) { const bf16x8 bb = *(const bf16x8*)(CP + 32 * kb);
#pragma unroll
                for (int q = 0; q < 4; ++q) { const bf16* sp_ = CS + (size_t)((vh * 4 + q) * 8 + 2 * kb) * 256; const u32x2 a0 = *(const u32x2*)sp_, a1 = *(const u32x2*)(sp_ + 256); u32x4 aw; aw.x = a0.x; aw.y = a0.y; aw.z = a1.x; aw.w = a1.y;
                    acc[q] = mfma16(*reinterpret_cast<bf16x8*>(&aw), bb, acc[q]); } }
#pragma unroll
            for (int q = 0; q < 4; ++q) acc[q] += *(const f32x4*)(CR + 16 * (vh * 4 + q) + 4 * g4); }
        float ss = 0.f;
#pragma unroll
        for (int q = 0; q < 4; ++q) ss += (acc[q][0] * acc[q][0] + acc[q][1] * acc[q][1]) + (acc[q][2] * acc[q][2] + acc[q][3] * acc[q][3]);
        ss += __shfl_xor(ss, 16); ss += __shfl_xor(ss, 32);
        const int i = 16 * it + l15; const size_t t = (size_t)b * SEQ + c * 64 + i;
        u32x2 zw4[4]; f32x4 gg4[4];
#pragma unroll
        for (int q = 0; q < 4; ++q) { const int vv = 16 * (vh * 4 + q) + 4 * g4; zw4[q] = *(const u32x2*)(PROJ + t * DINP + COL_CZ + hh * HD + vv); gg4[q] = *(const f32x4*)(gn + vv); }
        __syncthreads();
        if (g4 == 0) part[vh * 64 + 16 * it + l15] = ss;
        __syncthreads();
        const float rs = rsqrtf((part[i] + part[64 + i]) * (1.0f / HD) + EPS);
#pragma unroll
        for (int q = 0; q < 4; ++q) { const int vv = 16 * (vh * 4 + q) + 4 * g4; const u32x2 zw = zw4[q]; const f32x4 gg = gg4[q];
            const float z0 = __uint_as_float(zw.x << 16), z1 = __uint_as_float(zw.x & 0xffff0000u), z2 = __uint_as_float(zw.y << 16), z3 = __uint_as_float(zw.y & 0xffff0000u);
            u32x2 o; o.x = cvtpk(acc[q][0] * rs * gg.x * siluf_(z0), acc[q][1] * rs * gg.y * siluf_(z1)); o.y = cvtpk(acc[q][2] * rs * gg.z * siluf_(z2), acc[q][3] * rs * gg.w * siluf_(z3));
            *(u32x2*)(Y + t * DM + 1536 + hh * HD + vv) = o; }
    }
}

__device__ __forceinline__ void dn_chain_naive(Frame& F, int chain) {
    const int dir = chain >> 3, b = (chain >> 2) & 1, hh = chain & 3;
    const float* DQ = WSP(float, WS_DQ); const float* DK = WSP(float, WS_DK); const float* DV = WSP(float, WS_DV); const float* DB = WSP(float, WS_DB); const float* DG = WSP(float, WS_DG);
    float* DO = WSP(float, WS_DO);
    LAS float* kb = (LAS float*)F.lds; LAS float* qb = kb + 64 * 128; LAS float* vb = qb + 64 * 128; LAS float* bb = vb + 64 * 128; LAS float* gb = bb + 64;
    const int tid = F.tid, v = tid >> 2, kq = tid & 3;
    float S[32];
#pragma unroll
    for (int j = 0; j < 32; ++j) S[j] = 0.f;
    for (int c0 = 0; c0 < SEQ; c0 += 64) {
        __syncthreads();
        for (int idx = tid; idx < 64 * 128; idx += NTHR) { const int i = idx >> 7, d = idx & 127; const int sq = c0 + i, pos = dir ? SEQ - 1 - sq : sq; const size_t o = (size_t)(b * SEQ + pos) * 512 + hh * 128 + d;
            kb[idx] = DK[o]; qb[idx] = DQ[o]; vb[idx] = DV[o]; }
        if (tid < 64) { const int sq = c0 + tid, pos = dir ? SEQ - 1 - sq : sq; const size_t o = ((size_t)dir * T + b * SEQ + pos) * 4 + hh; bb[tid] = DB[o]; gb[tid] = DG[o]; }
        __syncthreads();
        for (int i = 0; i < 64; ++i) {
            const float a = expf(gb[i]), beta = bb[i];
            float ks = 0.f;
#pragma unroll
            for (int j = 0; j < 32; ++j) ks = fmaf(kb[i * 128 + kq * 32 + j], S[j], ks);
            ks += __shfl_xor(ks, 1); ks += __shfl_xor(ks, 2);
            const float vn = beta * (vb[i * 128 + v] - a * ks);
            float o = 0.f;
#pragma unroll
            for (int j = 0; j < 32; ++j) { S[j] = fmaf(kb[i * 128 + kq * 32 + j], vn, a * S[j]); o = fmaf(qb[i * 128 + kq * 32 + j], S[j], o); }
            o += __shfl_xor(o, 1); o += __shfl_xor(o, 2);
            if (kq == 0) { const int sq = c0 + i, pos = dir ? SEQ - 1 - sq : sq; DO[((size_t)dir * T + b * SEQ + pos) * 512 + hh * 128 + v] = o; }
        }
    }
    __syncthreads();
}
struct AttnAcc { float m, l, o0, o1; };
__device__ __forceinline__ void attn_key(AttnAcc& st, float q0, float q1, const bf16* krow, const bf16* vrow, int lane) {
    const unsigned kw = *(const unsigned*)(krow + 2 * lane), vw = *(const unsigned*)(vrow + 2 * lane);
    const float sc = wave_sum(q0 * __uint_as_float(kw << 16) + q1 * __uint_as_float(kw & 0xffff0000u)) * 0.08838834764831845f;
    const float mn = fmaxf(st.m, sc), al = __expf(st.m - mn), p = __expf(sc - mn);
    st.l = st.l * al + p; st.o0 = st.o0 * al + p * __uint_as_float(vw << 16); st.o1 = st.o1 * al + p * __uint_as_float(vw & 0xffff0000u); st.m = mn;
}
__device__ __forceinline__ void phase_mix_naive(Frame& F, unsigned* scan_cnt) {
    const bf16* PROJ = WSP(bf16, WS_PROJ); float* YMIX = WSP(float, WS_YMIX);
    if (NAIVE_DN) { if (F.vcu < 16) dn_chain_naive(F, F.vcu); } else { phase_dn_scan(F); asm volatile("s_waitcnt vmcnt(0)" ::: "memory"); __syncthreads();
        if (blockIdx.x < 32 && F.tid == 0) {
            __builtin_amdgcn_fence(__ATOMIC_RELEASE, "agent"); asm volatile("s_waitcnt vmcnt(0)" ::: "memory"); (void)xb_add(scan_cnt, 1u); } }
    const int gw = F.vcu * NWAVES + F.wave, NGW = F.G * NWAVES, lane = F.lane;
    if (NAIVE_ATTN_A) for (int u = gw; u < T * 4; u += NGW) { const int t = u >> 2, hh = u & 3, b = t >> 12, s = t & (SEQ - 1);
        const unsigned qw = *(const unsigned*)(PROJ + (size_t)t * DINP + COL_AQ + hh * HD + 2 * lane); const float q0 = __uint_as_float(qw << 16), q1 = __uint_as_float(qw & 0xffff0000u);
        AttnAcc st{-1e30f, 0.f, 0.f, 0.f};
        for (int pat = 0; pat < 3; ++pat) { const int dil = pat == 0 ? 1 : (pat == 1 ? 4 : 16);
            for (int dlt = -64; dlt <= 64; ++dlt) { const int sp = s + dil * dlt; if (sp < 0 || sp >= SEQ) continue;
                const bf16* kr = PROJ + (size_t)(b * SEQ + sp) * DINP; attn_key(st, q0, q1, kr + COL_AK + hh * HD, kr + COL_AV + hh * HD, lane); } }
        const float inv = 1.0f / st.l; *(float2*)(YMIX + (size_t)t * DM + hh * HD + 2 * lane) = make_float2(st.o0 * inv, st.o1 * inv); }
    if (NAIVE_ATTN_B) for (int u = gw; u < T * 8; u += NGW) { const int t = u >> 3, hq = u & 7, kvh = hq >> 2, b = t >> 12;
        const unsigned qw = *(const unsigned*)(PROJ + (size_t)t * DINP + COL_BQ + hq * HD + 2 * lane); const float q0 = __uint_as_float(qw << 16), q1 = __uint_as_float(qw & 0xffff0000u);
        AttnAcc st{-1e30f, 0.f, 0.f, 0.f};
        const bf16* kr = PROJ + (size_t)(b * SEQ) * DINP;
        for (int j = 0; j < SEQ; ++j, kr += DINP) attn_key(st, q0, q1, kr + COL_BK + kvh * HD, kr + COL_BV + kvh * HD, lane);
        const float inv = 1.0f / st.l; *(float2*)(YMIX + (size_t)t * DM + 512 + hq * HD + 2 * lane) = make_float2(st.o0 * inv, st.o1 * inv); }
}


__device__ __forceinline__ void phase_attn_b(Frame& F, char* lds_gen) {
    const bf16* PROJ = WSP(bf16, WS_PROJ); float* YMIX = WSP(float, WS_YMIX);
    for (int u = F.vcu; u < BATCH * 8 * 16; u += F.G) {
        const int b = u >> 7, kvh = (u >> 6) & 1, hq = kvh * 4 + ((u >> 4) & 3), qb = u & 15;
        const bf16* Qb = PROJ + (size_t)(b * SEQ + qb * 256) * DINP + COL_BQ + hq * HD;
        const bf16* Kh = PROJ + (size_t)(b * SEQ) * DINP + COL_BK + kvh * HD;
        const bf16* Vh = PROJ + (size_t)(b * SEQ) * DINP + COL_BV + kvh * HD;
        float* Ob = YMIX + (size_t)(b * SEQ + qb * 256) * DM + 512 + hq * HD;
        attn::attn_dense_body<attn::bf16>(Qb, Kh, Vh, Ob, SEQ, lds_gen, F.wave);
        __syncthreads();
    }
}


constexpr size_t WS_OPA = WS_TMP;
constexpr size_t WS_LSE = WS_TMP + (size_t)3 * T * 512 * 4;
__device__ __forceinline__ void phase_attn_a(Frame& F) {
    using namespace dn;
    constexpr int K_OFF = 0, VT_OFF = 69632;
    LAS unsigned char* L = F.lds;
    const int wave = F.wave;
    if (F.G > 64 && blockIdx.x < 32) return;
    const int ufirst = F.G > 64 ? (int)blockIdx.x - 32 : (int)blockIdx.x, ustep = F.G > 64 ? F.G - 32 : F.G;
    for (int u = ufirst; u < 768; u += ustep) {
        int tid_ = wave * 64 + lane_id(); asm volatile("" : "+v"(tid_));
        const int tid = tid_, lane = tid & 63, g4 = lane >> 4, l15 = lane & 15;
        GAS unsigned char* wsq_ = (GAS unsigned char*)F.ws; asm volatile("" : "+s"(wsq_)); unsigned char* wsq = (unsigned char*)wsq_;
        const bf16* PROJ = (const bf16*)(wsq + WS_PROJ);
        const int p = u >> 8, rem = u & 255, b = rem >> 7, hh = (rem >> 5) & 3, w32 = rem & 31;
        const int dsh = 2 * p, dil = 1 << dsh, Lf = SEQ >> dsh, nblk = Lf >> 7;
        const int r = w32 / nblk, i0 = (w32 % nblk) * 128;
        const bf16* base = PROJ + (size_t)(b * SEQ + r) * DINP + hh * HD;
        const size_t jstride = (size_t)dil * DINP;
        __syncthreads();
#pragma unroll
        for (int q = 0; q < 8; ++q) { const int id = tid + 512 * q, row = id >> 4, c16 = id & 15, j = i0 - 64 + row;
            u32x4 v = {0u, 0u, 0u, 0u}; if (j >= 0 && j < Lf) v = *(const u32x4*)(base + (size_t)j * jstride + COL_AK + c16 * 8);
            *(LAS u32x4*)(L + K_OFF + row * 272 + c16 * 16) = v; }
#pragma unroll
        for (int g = 0; g < 8; ++g) { const int kk0 = 32 * wave + 4 * g; unsigned rv[4];
#pragma unroll
            for (int m = 0; m < 4; ++m) { const int j = i0 - 64 + kk0 + m; rv[m] = (j >= 0 && j < Lf) ? *(const unsigned*)(base + (size_t)j * jstride + COL_AV + 2 * lane) : 0u; }
            u32x2 lo, hi; lo.x = (rv[0] & 0xffffu) | (rv[1] << 16); lo.y = (rv[2] & 0xffffu) | (rv[3] << 16); hi.x = (rv[0] >> 16) | (rv[1] & 0xffff0000u); hi.y = (rv[2] >> 16) | (rv[3] & 0xffff0000u);
            *(LAS u32x2*)(L + VT_OFF + (2 * lane) * 528 + kk0 * 2) = lo; *(LAS u32x2*)(L + VT_OFF + (2 * lane + 1) * 528 + kk0 * 2) = hi; }
        const int iq = i0 + 16 * wave + l15;
        bf16x8 qf[4];
#pragma unroll
        for (int kb = 0; kb < 4; ++kb) qf[kb] = *(const bf16x8*)(base + (size_t)iq * jstride + COL_AQ + 32 * kb + 8 * g4);
        __syncthreads();
        f32x4 sc[9];
        const LAS unsigned char* kb_ = L + K_OFF + (16 * wave + l15) * 272 + g4 * 16;
#pragma unroll
        for (int kt = 0; kt < 9; ++kt) { sc[kt] = (f32x4){0.f, 0.f, 0.f, 0.f};
#pragma unroll
            for (int kb = 0; kb < 4; ++kb) sc[kt] = mfma16(*(const LAS bf16x8*)(kb_ + kt * 4352 + kb * 64), qf[kb], sc[kt]); }
        constexpr float C = 0.08838834764831845f * 1.4426950408889634f;
        float mx = -3.0e38f;
#pragma unroll
        for (int kt = 0; kt < 9; ++kt)
#pragma unroll
            for (int rr = 0; rr < 4; ++rr) { const int dlt = -64 + 16 * kt + 4 * g4 + rr - l15, j = iq + dlt; const bool ok = dlt >= -64 && dlt <= 64 && j >= 0 && j < Lf;
                sc[kt][rr] = ok ? sc[kt][rr] : -3.0e38f; mx = fmaxf(mx, sc[kt][rr]); }
        mx = fmaxf(mx, __shfl_xor(mx, 16)); mx = fmaxf(mx, __shfl_xor(mx, 32));
        float lsum = 0.f; const float mC = mx * C;
#pragma unroll
        for (int kt = 0; kt < 9; ++kt)
#pragma unroll
            for (int rr = 0; rr < 4; ++rr) { const float pv = sc[kt][rr] > -1.0e38f ? __builtin_amdgcn_exp2f(sc[kt][rr] * C - mC) : 0.f; sc[kt][rr] = pv; lsum += pv; }
        lsum += __shfl_xor(lsum, 16); lsum += __shfl_xor(lsum, 32);
        f32x4 o[8];
#pragma unroll
        for (int dt = 0; dt < 8; ++dt) o[dt] = (f32x4){0.f, 0.f, 0.f, 0.f};
        const LAS unsigned char* vb_ = L + VT_OFF + l15 * 528 + (16 * wave + 4 * g4) * 2;
#pragma unroll
        for (int pp = 0; pp < 5; ++pp) { u32x4 bw; bw.x = cvtpk(sc[2 * pp][0], sc[2 * pp][1]); bw.y = cvtpk(sc[2 * pp][2], sc[2 * pp][3]);
            if (pp < 4) { bw.z = cvtpk(sc[2 * pp + 1][0], sc[2 * pp + 1][1]); bw.w = cvtpk(sc[2 * pp + 1][2], sc[2 * pp + 1][3]); } else { bw.z = 0u; bw.w = 0u; }
            const bf16x8 bfrag = *reinterpret_cast<bf16x8*>(&bw);
#pragma unroll
            for (int dt = 0; dt < 8; ++dt) { const u32x2 a0 = *(const LAS u32x2*)(vb_ + dt * 8448 + pp * 64); u32x2 a1 = {0u, 0u}; if (pp < 4) a1 = *(const LAS u32x2*)(vb_ + dt * 8448 + pp * 64 + 32);
                u32x4 aw; aw.x = a0.x; aw.y = a0.y; aw.z = a1.x; aw.w = a1.y; o[dt] = mfma16(*reinterpret_cast<bf16x8*>(&aw), bfrag, o[dt]); } }
        const float inv = 1.0f / lsum;
        const size_t t = (size_t)b * SEQ + (size_t)iq * dil + r;
        bf16* OP = (bf16*)(wsq + WS_OPA) + ((size_t)p * T + t) * 512 + hh * HD + 4 * g4;
#pragma unroll
        for (int dt = 0; dt < 8; ++dt) { u32x2 w; w.x = cvtpk(o[dt][0] * inv, o[dt][1] * inv); w.y = cvtpk(o[dt][2] * inv, o[dt][3] * inv); *(u32x2*)(OP + 16 * dt) = w; }
        if (g4 == 0) ((float*)(wsq + WS_LSE))[((size_t)p * T + t) * 4 + hh] = mx * 0.08838834764831845f + __logf(lsum);
    }
}

__device__ __forceinline__ void phase_ynorm(Frame& F, int l, bool naive_dn) {
    const bf16* PROJ = WSP(bf16, WS_PROJ); float* YMIX = WSP(float, WS_YMIX); bf16* Y = WSP(bf16, WS_Y); const float* DO = WSP(float, WS_DO);
    const float* ga = GIN(7) + (size_t)l * 512; const float* gb = GIN(8) + (size_t)l * 1024; const float* gn = GIN(11) + (size_t)l * HD;
    const int gw = F.vcu * NWAVES + F.wave, NGW = F.G * NWAVES, lane = F.lane;
    for (int t = gw; t < T; t += NGW) {
        if (naive_dn) {
#pragma unroll
            for (int hh = 0; hh < 4; ++hh) { const size_t o = (size_t)t * 512 + hh * HD; const float o0 = DO[o + lane] + DO[(size_t)T * 512 + o + lane], o1 = DO[o + lane + 64] + DO[(size_t)T * 512 + o + lane + 64];
                const float rs = rsqrtf(wave_sum(o0 * o0 + o1 * o1) * (1.0f / HD) + EPS);
                const float z0 = bf2f(PROJ[(size_t)t * DINP + COL_CZ + hh * HD + lane]), z1 = bf2f(PROJ[(size_t)t * DINP + COL_CZ + hh * HD + lane + 64]);
                Y[(size_t)t * DM + 1536 + hh * HD + lane] = (bf16)f2bf(o0 * rs * gn[lane] * siluf_(z0)); Y[(size_t)t * DM + 1536 + hh * HD + lane + 64] = (bf16)f2bf(o1 * rs * gn[lane + 64] * siluf_(z1)); }
        }
        const float* yr = YMIX + (size_t)t * DM; bf16* yo = Y + (size_t)t * DM;
        f32x4 bq[4];
#pragma unroll
        for (int j = 0; j < 4; ++j) bq[j] = *(const f32x4*)(yr + 512 + 256 * j + 4 * lane);
        { f32x4 a0, a1;
          if (NAIVE_ATTN_A) { a0 = *(const f32x4*)(yr + 4 * lane); a1 = *(const f32x4*)(yr + 256 + 4 * lane); }
          else { const bf16* OPA = WSP(bf16, WS_OPA); const float* LSE = WSP(float, WS_LSE); const int h0 = lane >> 5;
              float l0[3], l1[3];
#pragma unroll
              for (int p = 0; p < 3; ++p) { l0[p] = LSE[((size_t)p * T + t) * 4 + h0]; l1[p] = LSE[((size_t)p * T + t) * 4 + 2 + h0]; }
              const float m0 = fmaxf(l0[0], fmaxf(l0[1], l0[2])), m1 = fmaxf(l1[0], fmaxf(l1[1], l1[2]));
              float w0[3], w1[3], s0 = 0.f, s1 = 0.f;
#pragma unroll
              for (int p = 0; p < 3; ++p) { w0[p] = __expf(l0[p] - m0); w1[p] = __expf(l1[p] - m1); s0 += w0[p]; s1 += w1[p]; }
              a0 = (f32x4){0.f, 0.f, 0.f, 0.f}; a1 = a0;
#pragma unroll
              for (int p = 0; p < 3; ++p) { const u32x2 x0 = *(const u32x2*)(OPA + ((size_t)p * T + t) * 512 + 4 * lane), x1 = *(const u32x2*)(OPA + ((size_t)p * T + t) * 512 + 256 + 4 * lane);
                  const f32x4 f0 = {__uint_as_float(x0.x << 16), __uint_as_float(x0.x & 0xffff0000u), __uint_as_float(x0.y << 16), __uint_as_float(x0.y & 0xffff0000u)}, f1 = {__uint_as_float(x1.x << 16), __uint_as_float(x1.x & 0xffff0000u), __uint_as_float(x1.y << 16), __uint_as_float(x1.y & 0xffff0000u)};
                  a0 += f0 * (w0[p] / s0); a1 += f1 * (w1[p] / s1); } }
          const float rs = rsqrtf(wave_sum((a0.x * a0.x + a0.y * a0.y) + (a0.z * a0.z + a0.w * a0.w) + (a1.x * a1.x + a1.y * a1.y) + (a1.z * a1.z + a1.w * a1.w)) * (1.0f / 512) + EPS);
          const f32x4 g0 = *(const f32x4*)(ga + 4 * lane), g1 = *(const f32x4*)(ga + 256 + 4 * lane); a0 = a0 * rs * g0; a1 = a1 * rs * g1;
          u32x2 o; o.x = pk2(a0.x, a0.y); o.y = pk2(a0.z, a0.w); *(u32x2*)(yo + 4 * lane) = o; o.x = pk2(a1.x, a1.y); o.y = pk2(a1.z, a1.w); *(u32x2*)(yo + 256 + 4 * lane) = o; }
        { f32x4 a[4]; float ss = 0.f;
#pragma unroll
          for (int j = 0; j < 4; ++j) { a[j] = bq[j]; ss += (a[j].x * a[j].x + a[j].y * a[j].y) + (a[j].z * a[j].z + a[j].w * a[j].w); }
          const float rs = rsqrtf(wave_sum(ss) * (1.0f / 1024) + EPS);
#pragma unroll
          for (int j = 0; j < 4; ++j) { const f32x4 g = *(const f32x4*)(gb + 256 * j + 4 * lane); a[j] = a[j] * rs * g; u32x2 o; o.x = pk2(a[j].x, a[j].y); o.y = pk2(a[j].z, a[j].w); *(u32x2*)(yo + 512 + 256 * j + 4 * lane) = o; } }
    }
}

__device__ __forceinline__ void phase_select(Frame& F) {
    const float* AFF = WSP(float, WS_AFF); int* SELI = WSP(int, WS_SELI); float* SELG = WSP(float, WS_SELG); int* SLOT = WSP(int, WS_SLOT); float* SELR = WSP(float, WS_SELR); const float* RS2 = WSP(float, WS_RS) + T;
    LAS unsigned* key = (LAS unsigned*)F.lds;
    LAS unsigned* hist = key + 4096;
    LAS unsigned* ctl = hist + 256;
    LAS unsigned* scan = ctl + 8;
    const int tid = F.tid;
    for (int u = F.vcu; u < BATCH * NE; u += F.G) {
        const int b = u / NE, e = u % NE;
        __syncthreads();
        for (int i = tid; i < SEQ; i += NTHR) key[i] = __float_as_uint(AFF[(size_t)(b * NE + e) * SEQ + i]);
        if (tid == 0) { ctl[0] = 0u; ctl[2] = CAP; }
        __syncthreads();
        for (int pass = 3; pass >= 0; --pass) {
            const int shift = pass * 8; const unsigned hmask = pass == 3 ? 0u : ~((1u << (shift + 8)) - 1u);
            if (tid < 256) hist[tid] = 0u;
            __syncthreads();
            const unsigned prefix = ctl[0];
            if (pass == 3) {
                for (int i = tid; i < SEQ; i += NTHR) { const unsigned bin = key[i] >> 24; unsigned long long rem = __ballot(1);
                    while (rem) { const int leader = __builtin_ctzll(rem); const unsigned v = (unsigned)__builtin_amdgcn_readlane((int)bin, leader); const unsigned long long m = __ballot(bin == v) & rem;
                        if ((tid & 63) == leader) __hip_atomic_fetch_add(hist + v, (unsigned)__builtin_popcountll(m), __ATOMIC_RELAXED, __HIP_MEMORY_SCOPE_WORKGROUP);
                        rem &= ~m; } }
            } else
            for (int i = tid; i < SEQ; i += NTHR) { const unsigned k = key[i]; if ((k & hmask) == (prefix & hmask)) __hip_atomic_fetch_add(hist + ((k >> shift) & 255u), 1u, __ATOMIC_RELAXED, __HIP_MEMORY_SCOPE_WORKGROUP); }
            __syncthreads();
            if (tid < 64) {
                const unsigned want = ctl[2]; const unsigned c0 = hist[4 * tid], c1 = hist[4 * tid + 1], c2 = hist[4 * tid + 2], c3 = hist[4 * tid + 3]; const unsigned sl = (c0 + c1) + (c2 + c3);
                unsigned suf = sl;
#pragma unroll
                for (int o = 1; o < 64; o <<= 1) { const unsigned tv = __shfl_down(suf, o); if (tid + o < 64) suf += tv; }
                unsigned cum = suf - sl;
                int bsel = -1; unsigned cb = 0;
                if (cum < want && cum + c3 >= want) { bsel = 3; cb = cum; } cum += c3;
                if (bsel < 0 && cum < want && cum + c2 >= want) { bsel = 2; cb = cum; } cum += c2;
                if (bsel < 0 && cum < want && cum + c1 >= want) { bsel = 1; cb = cum; } cum += c1;
                if (bsel < 0 && cum < want && cum + c0 >= want) { bsel = 0; cb = cum; }
                if (bsel >= 0) { ctl[0] = prefix | ((unsigned)(4 * tid + bsel) << shift); ctl[2] = want - cb; } }
            __syncthreads();
        }
        const unsigned thr = ctl[0], want_eq = ctl[2];
        unsigned cg = 0, ce = 0;
#pragma unroll
        for (int j = 0; j < 8; ++j) { const unsigned k = key[8 * tid + j]; cg += k > thr; ce += k == thr; }
        scan[tid] = cg; scan[512 + tid] = ce;
        __syncthreads();
        if (tid < 64) { unsigned sg = 0, se = 0;
            unsigned lg[8], le[8];
#pragma unroll
            for (int j = 0; j < 8; ++j) { lg[j] = scan[8 * tid + j]; le[j] = scan[512 + 8 * tid + j]; sg += lg[j]; se += le[j]; }
            unsigned pg = sg, pe = se;
#pragma unroll
            for (int o = 1; o < 64; o <<= 1) { const unsigned tg = __shfl_up(pg, o), te = __shfl_up(pe, o); if (tid >= o) { pg += tg; pe += te; } }
            unsigned bg = pg - sg, be = pe - se;
#pragma unroll
            for (int j = 0; j < 8; ++j) { scan[8 * tid + j] = bg; scan[512 + 8 * tid + j] = be; bg += lg[j]; be += le[j]; }
        }
        __syncthreads();
        unsigned pg = scan[tid], pe = scan[512 + tid];
#pragma unroll
        for (int j = 0; j < 8; ++j) { const int i = 8 * tid + j; const unsigned k = key[i]; int slot = -1;
            if (k > thr) { slot = (int)(pg + (pe < want_eq ? pe : want_eq)); pg++; }
            else if (k == thr) { if (pe < want_eq) slot = (int)(pg + pe); pe++; }
            SLOT[(size_t)(b * NE + e) * SEQ + i] = slot;
            if (slot >= 0) { SELI[(size_t)(b * NE + e) * CAP + slot] = i; SELG[(size_t)e * 1024 + b * CAP + slot] = __uint_as_float(k); SELR[(size_t)e * 1024 + b * CAP + slot] = RS2[b * SEQ + i]; } }
    }
}
__device__ __forceinline__ void phase_gather(Frame& F) {
    const int* SELI = WSP(int, WS_SELI); const bf16* HN = WSP(bf16, WS_HN); bf16* XS = WSP(bf16, WS_XS);
    const int gw = F.vcu * NWAVES + F.wave, NGW = F.G * NWAVES, lane = F.lane;
    for (int r = gw; r < NE * 1024; r += NGW) { const int e = r >> 10, q = r & 1023, b = q >> 9, slot = q & 511; const int i = SELI[(size_t)(b * NE + e) * CAP + slot];
        const u32x4* src = (const u32x4*)(HN + (size_t)(b * SEQ + i) * DM); u32x4* dst = (u32x4*)(XS + (size_t)r * DM);
#pragma unroll
        for (int j = 0; j < 4; ++j) dst[lane + 64 * j] = src[lane + 64 * j]; }
}
#define ADD_BF4(V, W) do { (V).x += __uint_as_float((W).x << 16); (V).y += __uint_as_float((W).x & 0xffff0000u); (V).z += __uint_as_float((W).y << 16); (V).w += __uint_as_float((W).y & 0xffff0000u); } while (0)
__device__ __forceinline__ void phase_combine(Frame& F) {
    const bf16* H = WSP(bf16, WS_H); bf16* H1 = WSP(bf16, WS_HN); float* RS3 = WSP(float, WS_RS) + 2 * T; const int* SLOT = WSP(int, WS_SLOT); const bf16* YEXP = WSP(bf16, WS_YEXP);
    const int gw = F.vcu * NWAVES + F.wave, NGW = F.G * NWAVES, lane = F.lane;
    int nslot = -1; u32x2 hw[8];
    if (gw < T) { nslot = lane < NE ? SLOT[(size_t)((gw >> 12) * NE + lane) * SEQ + (gw & (SEQ - 1))] : -1;
#pragma unroll
        for (int j = 0; j < 8; ++j) hw[j] = *(const u32x2*)(H + (size_t)gw * DM + 4 * lane + 256 * j); }
    for (int t = gw; t < T; t += NGW) { const int b = t >> 12;
        const int myslot = nslot; f32x4 v[8];
#pragma unroll
        for (int j = 0; j < 8; ++j) { v[j].x = __uint_as_float(hw[j].x << 16); v[j].y = __uint_as_float(hw[j].x & 0xffff0000u); v[j].z = __uint_as_float(hw[j].y << 16); v[j].w = __uint_as_float(hw[j].y & 0xffff0000u); }
        const int tn = t + NGW;
        if (tn < T) { nslot = lane < NE ? SLOT[(size_t)((tn >> 12) * NE + lane) * SEQ + (tn & (SEQ - 1))] : -1;
#pragma unroll
            for (int j = 0; j < 8; ++j) hw[j] = *(const u32x2*)(H + (size_t)tn * DM + 4 * lane + 256 * j); }
        unsigned long long mask = __ballot(myslot >= 0);
        while (mask) {
            const int e0 = __builtin_ctzll(mask); mask &= mask - 1; const int s0 = __builtin_amdgcn_readlane(myslot, e0);
            const bool h1 = mask != 0; int e1 = e0, s1 = s0; if (h1) { e1 = __builtin_ctzll(mask); mask &= mask - 1; s1 = __builtin_amdgcn_readlane(myslot, e1); }
            const bool h2 = mask != 0; int e2 = e0, s2 = s0; if (h2) { e2 = __builtin_ctzll(mask); mask &= mask - 1; s2 = __builtin_amdgcn_readlane(myslot, e2); }
            const bf16* y0 = YEXP + (size_t)(e0 * 1024 + b * CAP + s0) * DM + 4 * lane; const bf16* y1 = YEXP + (size_t)(e1 * 1024 + b * CAP + s1) * DM + 4 * lane; const bf16* y2 = YEXP + (size_t)(e2 * 1024 + b * CAP + s2) * DM + 4 * lane;
            u32x2 w0[8], w1[8], w2[8];
#pragma unroll
            for (int j = 0; j < 8; ++j) w0[j] = *(const u32x2*)(y0 + 256 * j);
            if (h1) {
#pragma unroll
                for (int j = 0; j < 8; ++j) w1[j] = *(const u32x2*)(y1 + 256 * j); }
            if (h2) {
#pragma unroll
                for (int j = 0; j < 8; ++j) w2[j] = *(const u32x2*)(y2 + 256 * j); }
#pragma unroll
            for (int j = 0; j < 8; ++j) ADD_BF4(v[j], w0[j]);
            if (h1) {
#pragma unroll
                for (int j = 0; j < 8; ++j) ADD_BF4(v[j], w1[j]); }
            if (h2) {
#pragma unroll
                for (int j = 0; j < 8; ++j) ADD_BF4(v[j], w2[j]); }
        }
        float ss = 0.f;
#pragma unroll
        for (int j = 0; j < 8; ++j) { u32x2 w; w.x = pk2(v[j].x, v[j].y); w.y = pk2(v[j].z, v[j].w); *(u32x2*)(H1 + (size_t)t * DM + 4 * lane + 256 * j) = w; ss += (v[j].x * v[j].x + v[j].y * v[j].y) + (v[j].z * v[j].z + v[j].w * v[j].w); }
        const float rs = rsqrtf(wave_sum(ss) * (1.0f / DM) + EPS); if (lane == 0) RS3[t] = rs;
    }
}
#undef ADD_BF4
__device__ __forceinline__ void phase_final(Frame& F, float oscale) {
    const bf16* H = WSP(bf16, WS_H); const float* gain = GIN(21);
    const int gw = F.vcu * NWAVES + F.wave, NGW = F.G * NWAVES, lane = F.lane;
    for (int t = gw; t < T; t += NGW) { const bf16* hr = H + (size_t)t * DM; f32x4 v[8]; float ss = 0.f;
#pragma unroll
        for (int j = 0; j < 8; ++j) { const u32x2 w = *(const u32x2*)(hr + 4 * lane + 256 * j); v[j].x = __uint_as_float(w.x << 16); v[j].y = __uint_as_float(w.x & 0xffff0000u); v[j].z = __uint_as_float(w.y << 16); v[j].w = __uint_as_float(w.y & 0xffff0000u); ss += (v[j].x * v[j].x + v[j].y * v[j].y) + (v[j].z * v[j].z + v[j].w * v[j].w); }
        const float rs = rsqrtf(wave_sum(ss) * (1.0f / DM) + EPS);
#pragma unroll
        for (int j = 0; j < 8; ++j) { const f32x4 g = *(const f32x4*)(gain + 4 * lane + 256 * j); *(f32x4*)(F.out + (size_t)t * DM + 4 * lane + 256 * j) = v[j] * (rs * oscale) * g; } }
}


#ifdef DBG_CHECKSUM
constexpr int CW_SUM = 8192;
constexpr size_t WS_PREV = WS_DQ;
__device__ __forceinline__ void dbg_checksum(Frame& F) {
    struct Buf { size_t off, bytes; };
    const Buf bufs[9] = {{WS_TL, (size_t)T * 16 * 4}, {WS_PROJ, (size_t)T * DINP * 2}, {WS_CM, (size_t)16 * 64 * 16384 * 2}, {WS_CN, (size_t)16 * 64 * 16384 * 2}, {WS_CP, (size_t)16 * 64 * 8192 * 2},
                         {WS_CR, (size_t)16 * 64 * 8192 * 4}, {WS_CS, (size_t)16 * 64 * 16384 * 2}, {WS_Y, (size_t)T * DM * 2}, {WS_H, (size_t)T * DM * 4}};
    const size_t gt = (size_t)F.vcu * NTHR + F.tid, NT = (size_t)F.G * NTHR;
#pragma unroll 1
    for (int k = 0; k < 9; ++k) { const unsigned* p = (const unsigned*)(F.ws + bufs[k].off); unsigned a = 0;
        for (size_t i = gt; i < bufs[k].bytes / 4; i += NT) a += p[i] * (unsigned)(2654435761u + 2u * (unsigned)(i & 1023));
#pragma unroll
        for (int o = 1; o < 64; o <<= 1) a += __shfl_xor(a, o);
        if (F.lane == 0) __hip_atomic_fetch_add((unsigned*)(F.ws + WS_CTL) + CW_SUM + k, a, __ATOMIC_RELAXED, __HIP_MEMORY_SCOPE_AGENT); }
}
__device__ __forceinline__ unsigned dbg_compare(Frame& F) {
    const unsigned* cur = (const unsigned*)(F.ws + WS_CTL) + CW_SUM; const unsigned* prev = (const unsigned*)(F.ws + WS_PREV);
    unsigned code = 0;
    if (__hip_atomic_load(prev, __ATOMIC_RELAXED, __HIP_MEMORY_SCOPE_AGENT) == 0x600DF00Du) {
#pragma unroll 1
        for (int k = 0; k < 9; ++k) if (__hip_atomic_load(prev + 1 + k, __ATOMIC_RELAXED, __HIP_MEMORY_SCOPE_AGENT) != __hip_atomic_load(cur + k, __ATOMIC_RELAXED, __HIP_MEMORY_SCOPE_AGENT)) code |= 1u << k; }
    return code;
}
__device__ __forceinline__ void dbg_store_prev(Frame& F) {
    if (F.vcu == 0 && F.tid == 0) { const unsigned* cur = (const unsigned*)(F.ws + WS_CTL) + CW_SUM; unsigned* prev = (unsigned*)(F.ws + WS_PREV);
        for (int k = 0; k < 9; ++k) __hip_atomic_store(prev + 1 + k, __hip_atomic_load(cur + k, __ATOMIC_RELAXED, __HIP_MEMORY_SCOPE_AGENT), __ATOMIC_RELAXED, __HIP_MEMORY_SCOPE_AGENT);
        __hip_atomic_store(prev, 0x600DF00Du, __ATOMIC_RELAXED, __HIP_MEMORY_SCOPE_AGENT); }
}
#endif

struct EpiStoreBf16 { bf16* C; int ldc; __device__ __forceinline__ void operator()(int m, int n, float v) const { C[(size_t)m * ldc + n] = (bf16)f2bf(v); } };
struct EpiStoreF32 { float* C; int ldc; __device__ __forceinline__ void operator()(int m, int n, float v) const { C[(size_t)m * ldc + n] = v; } };
struct EpiResid { float* H; __device__ __forceinline__ void operator()(int m, int n, float v) const { H[(size_t)m * DM + n] += v; } };
struct EpiDown { bf16* C; const float* gate; __device__ __forceinline__ void operator()(int m, int n, float v) const { C[(size_t)m * DM + n] = (bf16)f2bf(v * gate[m]); } };
struct EpiPle { float* H; const bf16* PL; __device__ __forceinline__ void operator()(int m, int n, float v) const { H[(size_t)m * DM + n] += sigmoidf_(v) * bf2f(PL[(size_t)m * DM + n]); } };

#ifndef NAIVE_GEMM
#define NAIVE_GEMM 0
#endif
constexpr int NPL = 14;
constexpr int NPHASES = 1 + DEPTH * NPL + 1;
struct Args { const float* in[22]; float* out; unsigned char* ws; int ph_lo, ph_hi; };

#ifndef ONLY
#define ONLY -1
#endif
#ifndef MASK
#define MASK 0xFFFF
#endif
#define EN(j) ((ONLY < 0 || ONLY == (j)) && ((MASK >> (j)) & 1))
#ifndef REPMASK
#define REPMASK 0
#endif
#define NREP(b) (((REPMASK >> (b)) & 1) ? 2 : 1)
#define REPEAT(b) for (int rep_ = 0; rep_ < NREP(b); ++rep_, __syncthreads())
#define IN(k) (lo <= (k) && (k) < hi)
#define INL(j) (EN((j) + 1) && IN(pb + (j)) && seam(pb + (j)))
#define LAUNDER() do { GAS unsigned char* w_ = (GAS unsigned char*)args.ws; int t_ = wave0 * 64 + lane_id(); const float* const __attribute__((address_space(4)))* i_ = (const float* const __attribute__((address_space(4)))*)__builtin_amdgcn_kernarg_segment_ptr(); int v_ = vcu0, g_ = (int)gridDim.x; asm volatile("" : "+s"(w_), "+v"(t_), "+s"(i_), "+s"(v_), "+s"(g_)); F.ws = (unsigned char*)w_; F.tid = t_; F.lane = t_ & 63; F.wave = wave0; F.in = i_; F.vcu = v_; F.G = g_; } while (0)
#define seam(k) (((k) > lo) ? (bar_sync(bar, (unsigned*)(args.ws + WS_CTL) + CW_BAR), true) : true)

template <int l>
__device__ __forceinline__ void layer_phases(Frame& F, const Args& args, XcdBarrier& bar, const int lo, const int hi, const int vcu0, unsigned char* lds_raw, const int wave0) {
        const int pb = 1 + l * NPL;
#define wl (F.ws + WS_W + (size_t)l * SZ_LAYERW)
        if (INL(0)) REPEAT(1) { LAUNDER(); phase_norm<1>(F, WSP(float, WS_WTL) + (size_t)(2 * l) * 16 * DM, WSP(float, WS_TL), WSP(float, WS_RS)); }
        if (INL(1)) REPEAT(2) { LAUNDER();
#if NAIVE_GEMM
            EpiStoreBf16 E{WSP(bf16, WS_PROJ), DINP}; naive_gemm(F, WSP(bf16, WS_HN), DM, (const bf16*)(wl + OFF_WIN), DM, T, DINP, DM, E);
#else
            { pg8::Gemm g{WSP(bf16, WS_H), (const bf16*)(wl + OFF_WIN), T, DINP, DM}; pg8::StaticOrder S; S.init(T, DINP, F.G, (int)blockIdx.x); pg8::EpiBf16Rs E{WSP(bf16, WS_PROJ), DINP, WSP(float, WS_RS)};
              pg8::gemm_phase<pg8::EpiBf16Rs, pg8::StaticOrder>(F.lds, g, S, E, nullptr, F.wave); }
#endif
        }
        if (INL(2)) { REPEAT(3) { LAUNDER(); if (NAIVE_DN) phase_dn_prep_naive(F, l); else phase_dn_chunk(F, l); } __syncthreads(); LAUNDER(); phase_post(F, l); }
        if (INL(3)) { REPEAT(4) { LAUNDER(); phase_mix_naive(F, (unsigned*)(F.ws + WS_CTL) + CW_SCAN + 64 * l); } if (!NAIVE_ATTN_A) REPEAT(5) { __syncthreads(); LAUNDER(); phase_attn_a(F); } if (!NAIVE_ATTN_B) REPEAT(6) { __syncthreads(); LAUNDER(); phase_attn_b(F, (char*)lds_raw); }
            if (!NAIVE_DN && F.G == 256 && blockIdx.x >= 32) { __syncthreads(); LAUNDER();
                unsigned* cnt = (unsigned*)(F.ws + WS_CTL) + CW_SCAN + 64 * l;
                if (F.tid == 0) { while (xb_ld(cnt) < 32u) __builtin_amdgcn_s_sleep(1); __builtin_amdgcn_fence(__ATOMIC_ACQUIRE, "agent"); asm volatile("s_waitcnt vmcnt(0)" ::: "memory"); }
                __syncthreads();
                const int n = (int)blockIdx.x - 32, first = n >= 96 ? n - 96 : 384 + n, step = n >= 96 ? 128 : 96, end = n >= 96 ? 384 : 512;
                phase_dn_out(F, l, first, step, end); } }
        if (INL(4)) { LAUNDER(); if (!NAIVE_DN && F.G != 256) { phase_dn_out(F, l, F.vcu, F.G, 512); __syncthreads(); LAUNDER(); } REPEAT(8) phase_ynorm(F, l, NAIVE_DN != 0); }
        if (INL(5)) { LAUNDER();
#if NAIVE_GEMM
            EpiResid E{WSP(float, WS_H)}; naive_gemm(F, WSP(bf16, WS_Y), DM, (const bf16*)(wl + OFF_WOUT), DM, T, DM, DM, E);
#else
            pg8::Gemm g{WSP(bf16, WS_Y), (const bf16*)(wl + OFF_WOUT), T, DM, DM}; pg8::StaticOrder S; S.init(T, DM, F.G, (int)blockIdx.x); pg8::EpiResidBf16 E{WSP(bf16, WS_H), DM};
            pg8::gemm_phase<pg8::EpiResidBf16, pg8::StaticOrder>(F.lds, g, S, E, nullptr, F.wave);
#endif
        }
        if (INL(6)) REPEAT(9) { LAUNDER(); phase_norm<2>(F, WSP(float, WS_WTL) + (size_t)(2 * l + 1) * 16 * DM, WSP(float, WS_AFF), WSP(float, WS_RS) + T); }
        if (INL(7)) REPEAT(10) { LAUNDER(); phase_select(F);
#if !NAIVE_GEMM
            if (F.G == 256 && F.vcu >= 32) { pg8::Gemm g{WSP(bf16, WS_PB) + (size_t)l * T * PLE, (const bf16*)(wl + OFF_WP), T, DM, PLE}; pg8::ShadowOrder S{F.vcu - 32}; pg8::EpiBf16 E{WSP(bf16, WS_PL), DM};
              pg8::gemm_phase<pg8::EpiBf16, pg8::ShadowOrder>(F.lds, g, S, E, nullptr, F.wave); }
#endif
        }
        if (NAIVE_GEMM && INL(8)) REPEAT(11) { LAUNDER(); phase_gather(F); }
        if (INL(9)) REPEAT(12) { LAUNDER();
#if NAIVE_GEMM
            for (int e = 0; e < NE; ++e) { EpiStoreF32 E{WSP(float, WS_TMP) + (size_t)e * 1024 * 2048, 2048};
                naive_gemm(F, WSP(bf16, WS_XS) + (size_t)e * 1024 * DM, DM, (const bf16*)(wl + OFF_WGU) + (size_t)e * 2048 * DM, DM, 1024, 2048, DM, E); }
            { EpiStoreBf16 E{WSP(bf16, WS_PL), DM}; naive_gemm(F, WSP(bf16, WS_PB) + (size_t)l * T * PLE, PLE, (const bf16*)(wl + OFF_WP), PLE, T, DM, PLE, E); }
#else
            { pg8::Gemm g{WSP(bf16, WS_H), (const bf16*)(wl + OFF_WGU), NE * 1024, NE * 2048, DM}; pg8::GroupedGatherOrder S{F.G, F.vcu, WSP(int, WS_SELI)}; pg8::EpiGateUp E{WSP(bf16, WS_HID), WSP(float, WS_SELR)};
              pg8::gemm_phase<pg8::EpiGateUp, pg8::GroupedGatherOrder>(F.lds, g, S, E, nullptr, F.wave); }
#endif
        }
#if !NAIVE_GEMM
        if (F.G != 256 && INL(10)) REPEAT(13) { LAUNDER(); pg8::Gemm g{WSP(bf16, WS_PB) + (size_t)l * T * PLE, (const bf16*)(wl + OFF_WP), T, DM, PLE}; pg8::StaticOrder S; S.init(T, DM, F.G, (int)blockIdx.x); pg8::EpiBf16 E{WSP(bf16, WS_PL), DM};
              pg8::gemm_phase<pg8::EpiBf16, pg8::StaticOrder>(F.lds, g, S, E, nullptr, F.wave); }
#endif
        if (NAIVE_GEMM && INL(10)) {
            const float* TMP = WSP(float, WS_TMP); bf16* HID = WSP(bf16, WS_HID);
            for (size_t i = (size_t)F.vcu * NTHR + F.tid; i < (size_t)NE * 1024 * EFF; i += (size_t)F.G * NTHR) { const size_t r = i >> 10; const int f = (int)(i & 1023);
                const float gt = TMP[r * 2048 + (f >> 7) * 256 + (f & 127)], up = TMP[r * 2048 + (f >> 7) * 256 + 128 + (f & 127)]; HID[i] = (bf16)f2bf(siluf_(gt) * up); }
        }
        if (INL(11)) REPEAT(14) { LAUNDER();
#if NAIVE_GEMM
            for (int e = 0; e < NE; ++e) { EpiDown E{WSP(bf16, WS_YEXP) + (size_t)e * 1024 * DM, WSP(float, WS_SELG) + (size_t)e * 1024};
                naive_gemm(F, WSP(bf16, WS_HID) + (size_t)e * 1024 * EFF, EFF, (const bf16*)(wl + OFF_WD) + (size_t)e * 2048 * EFF, EFF, 1024, DM, EFF, E); }
#else
            pg8::Gemm g{WSP(bf16, WS_HID), (const bf16*)(wl + OFF_WD), NE * 1024, NE * 2048, EFF}; pg8::GroupedOrder S{F.G, F.vcu}; pg8::EpiDownBf16 E{WSP(bf16, WS_YEXP), WSP(float, WS_SELG)};
            pg8::gemm_phase<pg8::EpiDownBf16, pg8::GroupedOrder>(F.lds, g, S, E, nullptr, F.wave);
#endif
        }
        if (INL(12)) { LAUNDER(); phase_combine(F); }
        if (INL(13)) { LAUNDER();
#if NAIVE_GEMM
            EpiPle E{WSP(float, WS_H), WSP(bf16, WS_PL)}; naive_gemm(F, WSP(bf16, WS_HN), DM, (const bf16*)(wl + OFF_WPG), DM, T, DM, DM, E);
#else
            pg8::Gemm g{WSP(bf16, WS_HN), (const bf16*)(wl + OFF_WPG), T, DM, DM}; pg8::StaticOrder S; S.init(T, DM, F.G, (int)blockIdx.x); pg8::EpiPleBf16 E{WSP(bf16, WS_HN), WSP(bf16, WS_H), WSP(bf16, WS_PL), WSP(float, WS_RS) + 2 * T};
            pg8::gemm_phase<pg8::EpiPleBf16, pg8::StaticOrder>(F.lds, g, S, E, nullptr, F.wave);
#endif
        }
}

__global__ void __launch_bounds__(NTHR, 2) mk_fwd(Args args) {
    extern __shared__ __attribute__((aligned(16))) unsigned char lds_raw[];
    Frame F;
    F.lds = (LAS unsigned char*)lds_raw;
    const int wave0 = __builtin_amdgcn_readfirstlane((int)threadIdx.x >> 6);
    F.wave = wave0; F.tid = wave0 * 64 + lane_id(); F.lane = F.tid & 63;
    F.G = gridDim.x; { const int bx = blockIdx.x; F.vcu = (F.G % 8 == 0) ? (bx % 8) * (F.G / 8) + bx / 8 : bx; }
    const int vcu0 = F.vcu;
    F.in = (const float* const __attribute__((address_space(4)))*)__builtin_amdgcn_kernarg_segment_ptr(); F.out = args.out; F.ws = args.ws;
    const int lo = args.ph_lo, hi = args.ph_hi;
    volatile LAS unsigned* misc = (volatile LAS unsigned*)(F.lds + LDS_MISC);
#ifdef CHECK_NAN_FILL
    for (int i = F.tid; i < LDS_MISC / 4; i += NTHR) ((LAS unsigned*)F.lds)[i] = 0xffffffffu;
    __syncthreads();
#endif
    if (F.tid < 4) misc[F.tid] = 0u;
    __syncthreads();
    XcdBarrier bar; bar.bar = (unsigned*)(args.ws + WS_CTL) + CW_BAR; bar.x = 0; bar.st = misc; bar.w0 = wave0;
    if (hi - lo > 1) bar = xcd_barrier_post((unsigned*)(args.ws + WS_CTL) + CW_BAR, misc, wave0);
    if (EN(0) && IN(0)) REPEAT(0) phase_prologue(F);
    layer_phases<0>(F, args, bar, lo, hi, vcu0, lds_raw, wave0);
    layer_phases<1>(F, args, bar, lo, hi, vcu0, lds_raw, wave0);
    layer_phases<2>(F, args, bar, lo, hi, vcu0, lds_raw, wave0);
    layer_phases<3>(F, args, bar, lo, hi, vcu0, lds_raw, wave0);
#ifdef DBG_CHECKSUM
    if (IN(NPHASES - 1)) { xcd_barrier(bar); LAUNDER(); dbg_checksum(F); xcd_barrier(bar); const unsigned code = dbg_compare(F); xcd_barrier(bar); dbg_store_prev(F); phase_final(F, 1.0f + (float)code); }
#else
    if (EN(15) && IN(NPHASES - 1) && seam(NPHASES - 1)) phase_final(F, 1.0f);
#endif
#undef IN
#undef INL
#undef seam
#undef wl
}

extern "C" void kernel_launch(void* const* d_in, const int* in_sizes, int n_in, void* d_out, int out_size, void* d_ws, size_t ws_size, hipStream_t stream) {
    static int grid = 0;
    if (grid == 0) {
        if (n_in != 22 || out_size != T * DM || ws_size < WS_END) { fprintf(stderr, "kernel_launch: unexpected shapes (n_in %d out %d ws %zu need %zu)\n", n_in, out_size, ws_size, (size_t)WS_END); grid = -1; return; }
        int dev = 0, cus = 0;
        if (hipGetDevice(&dev) != hipSuccess || hipDeviceGetAttribute(&cus, hipDeviceAttributeMultiprocessorCount, dev) != hipSuccess) { grid = -1; return; }
        if (hipFuncSetAttribute((const void*)mk_fwd, hipFuncAttributeMaxDynamicSharedMemorySize, LDS_BYTES) != hipSuccess) { fprintf(stderr, "kernel_launch: hipFuncSetAttribute failed\n"); grid = -1; return; }
        grid = cus;
    }
    if (grid < 0) return;
    Args a{};
    for (int i = 0; i < 22; ++i) a.in[i] = (const float*)d_in[i];
    a.out = (float*)d_out; a.ws = (unsigned char*)d_ws;
    if (hipMemsetAsync((char*)d_ws + WS_CTL, 0, CTL_BYTES, stream) != hipSuccess) { fprintf(stderr, "kernel_launch: memset failed\n"); return; }
#if N_LAUNCH_PER_PHASE
    for (int ph = 0; ph < NPHASES; ++ph) {
        a.ph_lo = ph; a.ph_hi = ph + 1;
        hipLaunchKernelGGL(mk_fwd, dim3(grid), dim3(NTHR), LDS_BYTES, stream, a);
    }
#else
    a.ph_lo = 0; a.ph_hi = NPHASES;
    hipLaunchKernelGGL(mk_fwd, dim3(grid), dim3(NTHR), LDS_BYTES, stream, a);
#endif
}
```

```cpp
#include <hip/hip_runtime.h>
#include <cstdio>
#include <cstdint>

#define LAS __attribute__((address_space(3)))
#define GAS __attribute__((address_space(1)))
typedef unsigned short bf16;
typedef float f32x4 __attribute__((ext_vector_type(4)));
typedef unsigned u32x4 __attribute__((ext_vector_type(4)));
typedef unsigned u32x2 __attribute__((ext_vector_type(2)));
typedef short bf16x8 __attribute__((ext_vector_type(8)));

constexpr int BATCH = 2, SEQ = 4096, T = BATCH * SEQ, DM = 2048, DEPTH = 4, HD = 128;
constexpr int DIN = 5136, DINP = 5120;
constexpr int COL_AQ = 0, COL_AK = 512, COL_AV = 1024, COL_BQ = 1536, COL_BK = 2560, COL_BV = 2816, COL_CQKV = 3072, COL_CZ = 4608;
constexpr int NE = 16, CAP = 512, EFF = 1024, PLE = 256;
constexpr float EPS = 1e-6f;
constexpr int NWAVES = 8, NTHR = 512;
constexpr int LDS_BYTES = 147456, LDS_MISC = 147456 - 256;
constexpr int CW_SCAN = 32768;
constexpr int CW_BAR = 4096;

constexpr size_t al256(size_t x) { return (x + 255) / 256 * 256; }
constexpr size_t WS_CTL = 0, CTL_BYTES = 1u << 20;
constexpr size_t SZ_WIN = (size_t)DINP * DM * 2, SZ_WOUT = (size_t)DM * DM * 2, SZ_WGU = (size_t)NE * 2048 * DM * 2, SZ_WD = (size_t)NE * DM * EFF * 2, SZ_WPG = (size_t)DM * DM * 2, SZ_WP = (size_t)DM * PLE * 2;
constexpr size_t SZ_LAYERW = SZ_WIN + SZ_WOUT + SZ_WGU + SZ_WD + SZ_WPG + SZ_WP;
constexpr size_t OFF_WIN = 0, OFF_WOUT = OFF_WIN + SZ_WIN, OFF_WGU = OFF_WOUT + SZ_WOUT, OFF_WD = OFF_WGU + SZ_WGU, OFF_WPG = OFF_WD + SZ_WD, OFF_WP = OFF_WPG + SZ_WPG;
constexpr size_t WS_W = WS_CTL + CTL_BYTES;
constexpr size_t WS_PB = WS_W + DEPTH * SZ_LAYERW;
constexpr size_t WS_TABA = WS_PB + (size_t)DEPTH * T * PLE * 2;
constexpr size_t WS_TABB = WS_TABA + (size_t)SEQ * 16 * 8;
constexpr size_t WS_H = al256(WS_TABB + 64 * 32 * 8);
constexpr size_t WS_HN = WS_H + (size_t)T * DM * 4;
constexpr size_t WS_TL = WS_HN + (size_t)T * DM * 2;
constexpr size_t WS_PROJ = WS_TL + (size_t)T * 16 * 4;
constexpr size_t WS_YMIX = WS_PROJ + (size_t)T * DINP * 2;
constexpr size_t WS_Y = WS_YMIX + (size_t)T * DM * 4;
constexpr size_t WS_AFF = WS_Y + (size_t)T * DM * 2;
constexpr size_t WS_SELI = WS_AFF + (size_t)T * 16 * 4;
constexpr size_t WS_SELG = WS_SELI + (size_t)BATCH * NE * CAP * 4;
constexpr size_t WS_SLOT = WS_SELG + (size_t)BATCH * NE * CAP * 4;
constexpr size_t WS_XS = WS_SLOT + (size_t)BATCH * NE * SEQ * 4;
constexpr size_t WS_HID = WS_XS + (size_t)NE * 1024 * DM * 2;
constexpr size_t WS_YEXP = WS_HID + (size_t)NE * 1024 * EFF * 2;
constexpr size_t WS_PL = WS_YEXP + (size_t)NE * 1024 * DM * 2;
constexpr size_t WS_DQ = WS_PL + (size_t)T * DM * 2;
constexpr size_t WS_DK = WS_DQ + (size_t)T * 512 * 4;
constexpr size_t WS_DV = WS_DK + (size_t)T * 512 * 4;
constexpr size_t WS_DB = WS_DV + (size_t)T * 512 * 4;
constexpr size_t WS_DG = WS_DB + (size_t)2 * T * 4 * 4;
constexpr size_t WS_DO = WS_DG + (size_t)2 * T * 4 * 4;
constexpr size_t WS_TMP = al256(WS_DO + (size_t)2 * T * 512 * 4);
constexpr size_t WS_CM = WS_TMP + (size_t)NE * 1024 * 2048 * 4;
constexpr size_t WS_CN = WS_CM + (size_t)16 * 64 * 128 * 128 * 2;
constexpr size_t WS_CS = WS_CN + (size_t)16 * 64 * 128 * 128 * 2;
constexpr size_t WS_CP = WS_CS + (size_t)16 * 64 * 128 * 128 * 2;
constexpr size_t WS_CR = WS_CP + (size_t)16 * 64 * 64 * 128 * 2;
constexpr size_t WS_END = WS_CR + (size_t)16 * 64 * 64 * 128 * 4;
constexpr size_t WS_RS = WS_XS;
constexpr size_t WS_SELR = WS_XS + (size_t)3 * T * 4;
constexpr size_t WS_WTL = WS_SELR + (size_t)NE * 1024 * 4;
static_assert(WS_END < 2140000000ull, "workspace map");

__device__ const double INV_A[16] = {1.0, 0.44036660267178046, 0.19392274474868576, 0.08539710028576561, 0.03760603093086393, 0.016560440080994443, 0.0072926647372171085, 0.003211445994752591, 0.0014142135623730952, 0.000622772421914596, 0.0002742481756762073, 0.00012076973741146504, 5.318295896944988e-05, 2.341999896140934e-05, 1.0313385377212458e-05, 4.5416704806078695e-06};
__device__ const double INV_B[32] = {1.0, 0.7498942093324559, 0.5623413251903491, 0.4216965034285822, 0.31622776601683794, 0.23713737056616552, 0.1778279410038923, 0.1333521432163324, 0.09999999999999999, 0.07498942093324558, 0.056234132519034905, 0.042169650342858224, 0.03162277660168379, 0.023713737056616554, 0.01778279410038923, 0.013335214321633239, 0.01, 0.007498942093324559, 0.005623413251903491, 0.004216965034285822, 0.0031622776601683794, 0.002371373705661655, 0.0017782794100389228, 0.0013335214321633238, 0.001, 0.0007498942093324559, 0.000562341325190349, 0.00042169650342858224, 0.00031622776601683794, 0.00023713737056616554, 0.0001778279410038923, 0.0001333521432163324};

#ifndef N_LAUNCH_PER_PHASE
#define N_LAUNCH_PER_PHASE 0
#endif
#ifndef NAIVE_DN
#define NAIVE_DN 0
#endif
#ifndef NAIVE_ATTN_A
#define NAIVE_ATTN_A 0
#endif
#ifndef NAIVE_ATTN_B
#define NAIVE_ATTN_B 0
#endif
__device__ __forceinline__ int lane_id() { int l; asm volatile("v_mbcnt_lo_u32_b32 %0, -1, 0\n\tv_mbcnt_hi_u32_b32 %0, -1, %0" : "=v"(l)); return l; }
#define TIDX(w0) ((w0) * 64 + lane_id())
__device__ __forceinline__ float bperm(float v, int src_lane) { return __int_as_float(__builtin_amdgcn_ds_bpermute(src_lane << 2, __float_as_int(v))); }
typedef __bf16 bf16v2_t __attribute__((ext_vector_type(2)));
typedef float f32v2_t __attribute__((ext_vector_type(2)));
__device__ __forceinline__ unsigned cvt_pk_rne(float lo, float hi) { const f32v2_t v = {lo, hi}; return __builtin_bit_cast(unsigned, __builtin_convertvector(v, bf16v2_t)); }
__device__ __forceinline__ float bf2f(bf16 b) { return __uint_as_float(((unsigned)b) << 16); }
__device__ __forceinline__ unsigned f2bf(float f) { unsigned u = __float_as_uint(f); return (u + 0x7fffu + ((u >> 16) & 1u)) >> 16; }
__device__ __forceinline__ unsigned pk2(float lo, float hi) { return cvt_pk_rne(lo, hi); }
__device__ __forceinline__ float wave_sum(float v) {
#pragma unroll
    for (int o = 1; o < 64; o <<= 1) v += __shfl_xor(v, o);
    return v;
}
__device__ __forceinline__ float wave_max(float v) {
#pragma unroll
    for (int o = 1; o < 64; o <<= 1) v = fmaxf(v, __shfl_xor(v, o));
    return v;
}
__device__ __forceinline__ float sigmoidf_(float x) { return __builtin_amdgcn_rcpf(1.0f + __expf(-x)); }
__device__ __forceinline__ float siluf_(float x) { return x * __builtin_amdgcn_rcpf(1.0f + __expf(-x)); }
__device__ __forceinline__ float softplusf_(float x) { const float e = __expf(-fabsf(x)); const float lg = e < 1e-3f ? e * (1.0f - 0.5f * e + 0.33333333f * e * e) : __logf(1.0f + e); return fmaxf(x, 0.f) + lg; }
__device__ __forceinline__ void sincos_d(double a, float& c, float& s) {
    const double q = rint(a * 0.63661977236758134308);
    const double r = (a - q * 1.57079632679489655800) - q * 6.12323399573676603587e-17;
    const double r2 = r * r;
    double sp = 1.0 / 6227020800.0; sp = sp * r2 * -1.0 + 1.0 / 39916800.0; sp = sp * -r2 + 1.0 / 362880.0; sp = sp * -r2 + 1.0 / 5040.0; sp = sp * -r2 + 1.0 / 120.0; sp = sp * -r2 + 1.0 / 6.0; sp = sp * -r2 + 1.0;
    const double sr = r * sp;
    double cp = 1.0 / 87178291200.0; cp = cp * -r2 + 1.0 / 479001600.0; cp = cp * -r2 + 1.0 / 3628800.0; cp = cp * -r2 + 1.0 / 40320.0; cp = cp * -r2 + 1.0 / 720.0; cp = cp * -r2 + 1.0 / 24.0; cp = cp * -r2 + 0.5; cp = cp * -r2 + 1.0;
    const double cr = cp;
    const long long qi = (long long)q; const int m = (int)(qi & 3);
    double cs, sn;
    if (m == 0) { cs = cr; sn = sr; } else if (m == 1) { cs = -sr; sn = cr; } else if (m == 2) { cs = -cr; sn = -sr; } else { cs = sr; sn = -cr; }
    c = (float)cs; s = (float)sn;
}


#define XB_TMO      128
#define XB_XCNT(j)  (256  + 64 * (j))
#define XB_XSUB(j)  (1280 + 64 * (j))
#define XB_XGEN(j)  (2304 + 64 * (j))
#define XB_TOP      3328
#define XB_TOPGEN   3392
#define XCD_BAR_WORDS 3456
#define XB_SPIN_CAP (1u << 22)

__device__ __forceinline__ unsigned xb_ld(unsigned* p)              { return __hip_atomic_load(p, __ATOMIC_RELAXED, __HIP_MEMORY_SCOPE_AGENT); }
__device__ __forceinline__ unsigned xb_add(unsigned* p, unsigned v) { return __hip_atomic_fetch_add(p, v, __ATOMIC_RELAXED, __HIP_MEMORY_SCOPE_AGENT); }
__device__ __forceinline__ unsigned xb_xcc_id() { return (unsigned)__builtin_amdgcn_s_getreg((3 << 11) | 20) & 0xFu; }
#define XB_SPIN(cond, bar) do { unsigned _sp = 0; while (cond) { __builtin_amdgcn_s_sleep(1); \
    if ((++_sp & 255u) == 0u) { if (xb_ld(&(bar)[XB_TMO])) break; if (_sp > XB_SPIN_CAP) { atomicAdd(&(bar)[XB_TMO], 1u); break; } } } } while (0)

struct XcdBarrier {
    unsigned* bar; unsigned x; int w0;
    volatile LAS unsigned* st;
};

__device__ __forceinline__ XcdBarrier xcd_barrier_post(unsigned* bar, volatile LAS unsigned* st, int w0) {
    XcdBarrier b; b.bar = bar; b.x = xb_xcc_id(); b.st = st; b.w0 = w0;
    if (TIDX(w0) == 0) (void)xb_add(&bar[XB_XCNT(b.x)], 1u);
    return b;
}
__device__ __forceinline__ void xcd_barrier_complete(unsigned* bar, unsigned x, unsigned& nloc, unsigned& nx) {
    const unsigned G = gridDim.x * gridDim.y * gridDim.z;
    unsigned sum, cnt, mine, sp = 0u;
    for (;;) {
        sum = 0u; cnt = 0u; mine = 0u;
#pragma unroll
        for (unsigned j = 0; j < 16; ++j) { const unsigned c = xb_ld(&bar[XB_XCNT(j)]); sum += c; cnt += (c > 0u) ? 1u : 0u; mine = (j == x) ? c : mine; }
        if (sum == G) break;
        __builtin_amdgcn_s_sleep(1);
        if ((++sp & 255u) == 0u) { if (xb_ld(&bar[XB_TMO])) break; if (sp > XB_SPIN_CAP) { atomicAdd(&bar[XB_TMO], 1u); break; } }
    }
    nloc = mine > 0u ? mine : 1u; nx = cnt > 0u ? cnt : 1u;
}

__device__ __forceinline__ void xcd_barrier(const XcdBarrier& b) {
    asm volatile("s_waitcnt vmcnt(0)" ::: "memory");
    __syncthreads();
    if (TIDX(b.w0) == 0) {
        unsigned* bar = b.bar;
        __builtin_amdgcn_s_waitcnt(0);
        unsigned nloc = b.st[0], nx = b.st[1];
        if (nloc == 0u) { xcd_barrier_complete(bar, b.x, nloc, nx); b.st[0] = nloc; b.st[1] = nx; }
        const unsigned old = xb_add(&bar[XB_XSUB(b.x)], 1u);
        const unsigned gen = old / nloc;
        if (old + 1u == (gen + 1u) * nloc) {
            __builtin_amdgcn_fence(__ATOMIC_RELEASE, "agent");
            asm volatile("s_waitcnt vmcnt(0)" ::: "memory");
            const unsigned og = xb_add(&bar[XB_TOP], 1u);
            const unsigned tg = og / nx;
            if (og + 1u == (tg + 1u) * nx) xb_add(&bar[XB_TOPGEN], 1u);
            else XB_SPIN(xb_ld(&bar[XB_TOPGEN]) == tg, bar);
            __builtin_amdgcn_fence(__ATOMIC_ACQUIRE, "agent");
            xb_add(&bar[XB_XGEN(b.x)], 1u);
            asm volatile("s_waitcnt vmcnt(0)" ::: "memory");
        } else {
            XB_SPIN(xb_ld(&bar[XB_XGEN(b.x)]) == gen, bar);
            __builtin_amdgcn_fence(__ATOMIC_ACQUIRE, "agent");
            asm volatile("s_waitcnt vmcnt(0)" ::: "memory");
        }
    }
    __syncthreads();
}

__device__ __forceinline__ void bar_sync(XcdBarrier& b, unsigned* words) { GAS unsigned* w = (GAS unsigned*)words; asm volatile("" : "+s"(w)); b.bar = (unsigned*)w; xcd_barrier(b); }

#define GIN(k) ((const float*)(const GAS float*)F.in[k])
struct Frame {
    LAS unsigned char* lds;
    int tid, lane, wave, vcu, G;
    const float* const __attribute__((address_space(4)))* in;
    float* out;
    unsigned char* ws;
};
#define WSP(type, off) ((type*)(F.ws + (off)))

template <bool GAM>
__device__ __forceinline__ void transpose_item(const float* __restrict__ W, int ldw, bf16* __restrict__ WT, int ldt, int k0, int n0, size_t drow0, LAS unsigned* scr, int lane, const float* __restrict__ gam) {
    const float* src = W + (size_t)k0 * ldw + n0 + lane;
    unsigned g0 = 0u, g1 = 0u;
    if (GAM) { const u32x2 gp = *(const u32x2*)(gam + k0 + 2 * lane); g0 = gp.x; g1 = gp.y; }
#pragma unroll 8
    for (int kk = 0; kk < 64; ++kk) { float v0 = __builtin_nontemporal_load(src + (size_t)(2 * kk) * ldw), v1 = __builtin_nontemporal_load(src + (size_t)(2 * kk + 1) * ldw);
        if (GAM) { v0 *= __uint_as_float(__builtin_amdgcn_readlane(g0, kk)); v1 *= __uint_as_float(__builtin_amdgcn_readlane(g1, kk)); }
        scr[lane * 65 + kk] = pk2(v0, v1); }
    asm volatile("s_waitcnt lgkmcnt(0)" ::: "memory");
    const int c = lane & 15;
#pragma unroll
    for (int j = 0; j < 16; ++j) { const int n = (lane >> 4) + 4 * j; const LAS unsigned* sp = scr + n * 65 + 4 * c;
        u32x4 o; o.x = sp[0]; o.y = sp[1]; o.z = sp[2]; o.w = sp[3];
        __builtin_nontemporal_store(o, (u32x4*)(WT + (drow0 + n) * (size_t)ldt + k0 + 8 * c)); }
    asm volatile("s_waitcnt lgkmcnt(0)" ::: "memory");
}
__device__ __forceinline__ void phase_prologue(Frame& F) {
    LAS unsigned* scr = (LAS unsigned*)(F.lds + F.wave * 16640);
    const int gw = F.vcu * NWAVES + F.wave, NGW = F.G * NWAVES;
    constexpr int I_IN = 16 * 80, I_OUT = 16 * 32, I_G = 16 * 16 * 16, I_D = 16 * 8 * 32, I_P = 2 * 32, I_PG = 16 * 32;
    constexpr int I_LAYER = I_IN + I_OUT + 2 * I_G + I_D + I_P + I_PG;
    for (int it = gw; it < DEPTH * I_LAYER; it += NGW) {
        const int l = it / I_LAYER; int r = it % I_LAYER;
#define wl (F.ws + WS_W + (size_t)l * SZ_LAYERW)
        if (r < I_IN) { const int kb = r / 80, nb = r % 80; transpose_item<true>(GIN(3) + (size_t)l * DM * DIN, DIN, (bf16*)(wl + OFF_WIN), DM, kb * 128, nb * 64, (size_t)nb * 64, scr, F.lane, GIN(2) + (size_t)l * DM); continue; } r -= I_IN;
        if (r < I_OUT) { const int kb = r / 32, nb = r % 32; transpose_item<false>(GIN(12) + (size_t)l * DM * DM, DM, (bf16*)(wl + OFF_WOUT), DM, kb * 128, nb * 64, (size_t)nb * 64, scr, F.lane, nullptr); continue; } r -= I_OUT;
        if (r < 2 * I_G) { const int up = r / I_G; r %= I_G; const int e = r / 256, q = r % 256, kb = q / 16, nb = q % 16, n0 = nb * 64;
            const float* src = (up ? GIN(16) : GIN(15)) + ((size_t)(l * NE + e) * DM) * EFF;
            transpose_item<true>(src, EFF, (bf16*)(wl + OFF_WGU), DM, kb * 128, n0, (size_t)e * 2048 + (n0 / 128) * 256 + (n0 % 128) + up * 128, scr, F.lane, GIN(13) + (size_t)l * DM); continue; } r -= 2 * I_G;
        if (r < I_D) { const int e = r / 256, q = r % 256, kb = q / 32, nb = q % 32;
            transpose_item<false>(GIN(17) + ((size_t)(l * NE + e) * EFF) * DM, DM, (bf16*)(wl + OFF_WD), EFF, kb * 128, nb * 64, (size_t)e * 2048 + nb * 64, scr, F.lane, nullptr); continue; } r -= I_D;
        if (r < I_P) { const int kb = r / 32, nb = r % 32; transpose_item<false>(GIN(19) + (size_t)l * PLE * DM, DM, (bf16*)(wl + OFF_WP), PLE, kb * 128, nb * 64, (size_t)nb * 64, scr, F.lane, nullptr); continue; } r -= I_P;
        { const int kb = r / 32, nb = r % 32; transpose_item<true>(GIN(20) + (size_t)l * DM * DM, DM, (bf16*)(wl + OFF_WPG), DM, kb * 128, nb * 64, (size_t)nb * 64, scr, F.lane, GIN(18) + (size_t)l * DM); }
    }
    const size_t gt = (size_t)F.vcu * NTHR + (size_t)(F.wave * 64 + lane_id()), NT = (size_t)F.G * NTHR;
    { const f32x4* src = (const f32x4*)GIN(1); u32x2* dst = WSP(u32x2, WS_PB);
      constexpr size_t N = (size_t)DEPTH * T * PLE / 4;
      for (size_t i0 = gt; i0 < N; i0 += 8 * NT) { f32x4 v[8];
#pragma unroll
          for (int k = 0; k < 8; ++k) { const size_t i = i0 + k * NT; v[k] = (f32x4){0.f, 0.f, 0.f, 0.f}; if (i < N) v[k] = __builtin_nontemporal_load(src + i); }
#pragma unroll
          for (int k = 0; k < 8; ++k) { const size_t i = i0 + k * NT; if (i < N) { u32x2 o; o.x = pk2(v[k].x, v[k].y); o.y = pk2(v[k].z, v[k].w); dst[i] = o; } } } }
    { const f32x4* src = (const f32x4*)GIN(0); u32x2* dst = WSP(u32x2, WS_H);
      constexpr size_t N = (size_t)T * DM / 4;
      for (size_t i0 = gt; i0 < N; i0 += 8 * NT) { f32x4 v[8];
#pragma unroll
          for (int k = 0; k < 8; ++k) { const size_t i = i0 + k * NT; v[k] = (f32x4){0.f, 0.f, 0.f, 0.f}; if (i < N) v[k] = __builtin_nontemporal_load(src + i); }
#pragma unroll
          for (int k = 0; k < 8; ++k) { const size_t i = i0 + k * NT; if (i < N) { u32x2 o; o.x = pk2(v[k].x, v[k].y); o.y = pk2(v[k].z, v[k].w); dst[i] = o; } } } }
#ifdef CHECK_NAN_FILL
    { u32x4* dst = WSP(u32x4, WS_CM); const u32x4 nn = {0xffffffffu, 0xffffffffu, 0xffffffffu, 0xffffffffu};
      for (size_t i = gt; i < (WS_END - WS_CM) / 16; i += NT) dst[i] = nn;
      u32x4* d2 = WSP(u32x4, WS_YMIX); for (size_t i = gt; i < (WS_XS - WS_YMIX) / 16; i += NT) d2[i] = nn; }
#endif
    { float* dst = WSP(float, WS_WTL);
      for (size_t i = gt; i < (size_t)DEPTH * 2 * 16 * DM; i += NT) { const int ls = (int)(i >> 15), l = ls >> 1, sset = ls & 1, k = (int)(i >> 4) & (DM - 1), c = (int)i & 15;
          const float* w = sset ? GIN(14) + (size_t)l * DM * NE : GIN(3) + (size_t)l * DM * DIN + DINP; const int ldw = sset ? NE : DIN; const float* g = (sset ? GIN(13) : GIN(2)) + (size_t)l * DM;
          dst[((size_t)ls * 16 + c) * DM + k] = g[k] * w[(size_t)k * ldw + c]; } }
    { float2* ta = WSP(float2, WS_TABA); for (size_t i = gt; i < (size_t)SEQ * 16; i += NT) { const int s = (int)(i >> 4), j = (int)(i & 15); float c, sn; sincos_d((double)s * INV_A[j], c, sn); ta[i] = make_float2(c, sn); }
      float2* tb = WSP(float2, WS_TABB); for (size_t i = gt; i < 64 * 32; i += NT) { const int s = (int)(i >> 5), j = (int)(i & 31); float c, sn; sincos_d((double)s * INV_B[j], c, sn); tb[i] = make_float2(c, sn); } }
}

template <int MODE>
__device__ __forceinline__ void phase_norm(Frame& F, const float* __restrict__ wtg, float* __restrict__ out16, float* __restrict__ rsout) {
    const bf16* H = WSP(bf16, WS_H);
    LAS float* wT = (LAS float*)F.lds;
#pragma unroll 1
    for (int h = 0; h < 2; ++h) { f32x4 st[8];
#pragma unroll
      for (int i = 0; i < 8; ++i) st[i] = *(const f32x4*)(wtg + 4 * (F.tid + NTHR * (8 * h + i)));
#pragma unroll
      for (int i = 0; i < 8; ++i) *(LAS f32x4*)(wT + 4 * (F.tid + NTHR * (8 * h + i))) = st[i]; }
    __syncthreads();
    const int gw = F.vcu * NWAVES + F.wave, NGW = F.G * NWAVES, lane = F.lane;
    for (int r0 = gw * 4; r0 < T; r0 += NGW * 4) {
        f32x4 v[4][8];
#pragma unroll
        for (int rr = 0; rr < 4; ++rr) { const bf16* hr = H + (size_t)(r0 + rr) * DM; float ss = 0.f;
#pragma unroll
            for (int j = 0; j < 8; ++j) { const u32x2 hw = *(const u32x2*)(hr + 4 * lane + 256 * j); v[rr][j].x = __uint_as_float(hw.x << 16); v[rr][j].y = __uint_as_float(hw.x & 0xffff0000u); v[rr][j].z = __uint_as_float(hw.y << 16); v[rr][j].w = __uint_as_float(hw.y & 0xffff0000u); ss += (v[rr][j].x * v[rr][j].x + v[rr][j].y * v[rr][j].y) + (v[rr][j].z * v[rr][j].z + v[rr][j].w * v[rr][j].w); }
            const float rs = rsqrtf(wave_sum(ss) * (1.0f / DM) + EPS); if (lane == 0) rsout[r0 + rr] = rs;
#pragma unroll
            for (int j = 0; j < 8; ++j) v[rr][j] = v[rr][j] * rs; }
        float a[64];
#pragma unroll
        for (int c = 0; c < 16; ++c) { float p0 = 0.f, p1 = 0.f, p2 = 0.f, p3 = 0.f; asm volatile("" ::: "memory");
#pragma unroll
            for (int j = 0; j < 8; ++j) { const f32x4 w = *(const LAS f32x4*)(wT + c * DM + 4 * lane + 256 * j);
                p0 += (v[0][j].x * w.x + v[0][j].y * w.y) + (v[0][j].z * w.z + v[0][j].w * w.w); p1 += (v[1][j].x * w.x + v[1][j].y * w.y) + (v[1][j].z * w.z + v[1][j].w * w.w);
                p2 += (v[2][j].x * w.x + v[2][j].y * w.y) + (v[2][j].z * w.z + v[2][j].w * w.w); p3 += (v[3][j].x * w.x + v[3][j].y * w.y) + (v[3][j].z * w.z + v[3][j].w * w.w); }
            a[c] = p0; a[16 + c] = p1; a[32 + c] = p2; a[48 + c] = p3; }
#define TR_STEP(N, M) _Pragma("unroll") for (int k = 0; k < (N) / 2; ++k) { const bool up = (lane & (M)) != 0; const float keep = up ? a[k + (N) / 2] : a[k], send = up ? a[k] : a[k + (N) / 2]; a[k] = keep + __shfl_xor(send, (M)); }
        TR_STEP(64, 32) TR_STEP(32, 16) TR_STEP(16, 8) TR_STEP(8, 4) TR_STEP(4, 2) TR_STEP(2, 1)
#undef TR_STEP
        float mine = a[0];
        if (MODE == 2) { float m = mine; m = fmaxf(m, __shfl_xor(m, 1)); m = fmaxf(m, __shfl_xor(m, 2)); m = fmaxf(m, __shfl_xor(m, 4)); m = fmaxf(m, __shfl_xor(m, 8));
            const float e = expf(mine - m); float sden = e; sden += __shfl_xor(sden, 1); sden += __shfl_xor(sden, 2); sden += __shfl_xor(sden, 4); sden += __shfl_xor(sden, 8); mine = e / sden; }
        if (MODE == 2) out16[((size_t)((r0 >> 12) * 16 + (lane & 15))) * SEQ + (r0 & (SEQ - 1)) + (lane >> 4)] = mine;
        else out16[(size_t)r0 * 16 + lane] = mine;
    }
}

namespace pg8 {
#define PG8_LAS __attribute__((address_space(3)))
typedef unsigned short bf16_t;
typedef short bf16x8 __attribute__((ext_vector_type(8)));
typedef float f32x4 __attribute__((ext_vector_type(4)));
typedef unsigned u32x4 __attribute__((ext_vector_type(4)));
constexpr int BM = 256, BK = 64, HALF = 128, HTB = HALF * BK * 2, STAGE_BYTES = 8 * HTB, NXCD = 8, WGM = 8;
__host__ __device__ __forceinline__ int lds_byte(int r, int c) { const int st = (r >> 4) * 2 + (c >> 5), rr = r & 15, cc = c & 31, ob = rr * 64 + cc * 2; return st * 1024 + (ob ^ (((ob >> 9) & 1) << 5)); }
__host__ __device__ __forceinline__ void stage_rc(int b, int& R, int& C) { const int st = b / 1024, sb = b % 1024, swz = sb ^ (((sb >> 9) & 1) << 5); R = (st >> 1) * 16 + swz / 64; C = (st & 1) * 32 + (swz % 64) / 2; }
__host__ __device__ __forceinline__ int perm32(int rho) { const int n = rho >> 4, i = rho & 15; return 8 * (i >> 2) + 4 * n + (i & 3); }
struct Unit { int pm, pn; };
struct Gemm { const bf16_t* A; const bf16_t* Bt; int M, N, K; };
struct StaticOrder {
    static constexpr bool GATHER = false;
    int nM, nN, nwg, G, c;
    __host__ __device__ void init(int M, int N, int G_, int c_) { nM = M / BM; nN = N / BM; nwg = nM * nN; G = G_; c = c_; }
    __host__ __device__ bool next(int i, Unit& u) const {
        const long L = (long)i * G + c; if (L >= nwg) return false;
        int wgid = (int)L; { const int q = nwg / NXCD, r = nwg % NXCD, xcd = wgid % NXCD, off = wgid / NXCD; wgid = (xcd < r ? xcd * (q + 1) : r * (q + 1) + (xcd - r) * q) + off; }
        const int nig = WGM * nN, gid = wgid / nig, fm = gid * WGM, gsz = (nM - fm) < WGM ? (nM - fm) : WGM;
        u.pm = fm + ((wgid % nig) % gsz); u.pn = (wgid % nig) / gsz; return true;
    }
    __device__ __forceinline__ void a_ready(const Unit&) const {}
    __device__ __forceinline__ void done(const Unit&) const {}
};
struct TailOrder {
    static constexpr bool GATHER = false;
    int c, first;
    __device__ bool next(int i, Unit& u) const { if (c < first || c >= first + 128 || i >= 2) return false; const int L = (c - first) * 2 + i; u.pm = L >> 3; u.pn = L & 7; return true; }
    __device__ __forceinline__ void a_ready(const Unit&) const {}
    __device__ __forceinline__ void done(const Unit&) const {}
};
struct ShadowOrder {
    static constexpr bool GATHER = false;
    int c;
    __device__ bool next(int i, Unit& u) const { const int L = c + 224 * i; if (c < 0 || L >= 256) return false; u.pm = L >> 3; u.pn = L & 7; return true; }
    __device__ __forceinline__ void a_ready(const Unit&) const {}
    __device__ __forceinline__ void done(const Unit&) const {}
};
struct GroupedOrder {
    static constexpr bool GATHER = false;
    int G, c;
    __device__ bool next(int i, Unit& u) const { const int L = i * G + c; if (L >= 512) return false; const int e = L >> 5, w = L & 31; u.pm = 4 * e + (w & 3); u.pn = 8 * e + (w >> 2); return true; }
    __device__ __forceinline__ void a_ready(const Unit&) const {}
    __device__ __forceinline__ void done(const Unit&) const {}
};
struct GroupedGatherOrder {
    static constexpr bool GATHER = true;
    int G, c; const int* seli;
    __device__ bool next(int i, Unit& u) const { const int L = i * G + c; if (L >= 512) return false; const int e = L >> 5, w = L & 31; u.pm = 4 * e + (w & 3); u.pn = 8 * e + (w >> 2); return true; }
    __device__ __forceinline__ int arow(const Unit& u, int r) const { const int row = u.pm * 256 + r, e = row >> 10, q = row & 1023, b = q >> 9, slot = q & 511; return b * 4096 + seli[(b * 16 + e) * 512 + slot]; }
    __device__ __forceinline__ void a_ready(const Unit&) const {}
    __device__ __forceinline__ void done(const Unit&) const {}
};
__device__ __forceinline__ unsigned cvt_pk_bf16(float lo, float hi) { return cvt_pk_rne(lo, hi); }
struct EpiBf16 {
    static constexpr bool PERM = true, AFTER_DRAIN = false;
    bf16_t* O; int ldc;
    __device__ __forceinline__ void operator()(const f32x4 (&acc)[2][2][4][2], const Unit& u, int wr, int wc, int fr, int fq) const {
        const int row0 = u.pm * BM + wr * 64 + fr, col0 = u.pn * BM + wc * 32 + 8 * fq;
        asm volatile("s_nop 15\n\ts_nop 7" ::: "memory");
#pragma unroll
        for (int ai = 0; ai < 2; ++ai)
#pragma unroll
            for (int m = 0; m < 4; ++m) { bf16_t* rowp = O + (size_t)(row0 + ai * HALF + m * 16) * ldc + col0;
#pragma unroll
                for (int bj = 0; bj < 2; ++bj) { const f32x4 v0 = acc[ai][bj][m][0], v1 = acc[ai][bj][m][1];
                    u32x4 w; w.x = cvt_pk_bf16(v0[0], v0[1]); w.y = cvt_pk_bf16(v0[2], v0[3]); w.z = cvt_pk_bf16(v1[0], v1[1]); w.w = cvt_pk_bf16(v1[2], v1[3]);
                    *(u32x4*)(rowp + bj * HALF) = w; } }
    }
};
__device__ __forceinline__ float bfe(const u32x4& w, int e) { const unsigned x = w[e >> 1]; return __uint_as_float((e & 1) ? (x & 0xffff0000u) : (x << 16)); }
struct EpiBf16Rs {
    static constexpr bool PERM = true, AFTER_DRAIN = false;
    bf16_t* O; int ldc; const float* rs;
    __device__ __forceinline__ void operator()(const f32x4 (&acc)[2][2][4][2], const Unit& u, int wr, int wc, int fr, int fq) const {
        const int row0 = u.pm * BM + wr * 64 + fr, col0 = u.pn * BM + wc * 32 + 8 * fq;
#pragma unroll
        for (int ai = 0; ai < 2; ++ai)
#pragma unroll
            for (int m = 0; m < 4; ++m) { const int row = row0 + ai * HALF + m * 16; const float s = rs[row]; bf16_t* rowp = O + (size_t)row * ldc + col0;
#pragma unroll
                for (int bj = 0; bj < 2; ++bj) { const f32x4 v0 = acc[ai][bj][m][0] * s, v1 = acc[ai][bj][m][1] * s;
                    u32x4 w; w.x = cvt_pk_bf16(v0[0], v0[1]); w.y = cvt_pk_bf16(v0[2], v0[3]); w.z = cvt_pk_bf16(v1[0], v1[1]); w.w = cvt_pk_bf16(v1[2], v1[3]);
                    *(u32x4*)(rowp + bj * HALF) = w; } }
    }
};
struct EpiResidBf16 {
    static constexpr bool PERM = true, AFTER_DRAIN = false;
    bf16_t* H; int ldc;
    __device__ __forceinline__ void operator()(const f32x4 (&acc)[2][2][4][2], const Unit& u, int wr, int wc, int fr, int fq) const {
        const int row0 = u.pm * BM + wr * 64 + fr, col0 = u.pn * BM + wc * 32 + 8 * fq;
#pragma unroll
        for (int ai = 0; ai < 2; ++ai)
#pragma unroll
            for (int m = 0; m < 4; ++m) { bf16_t* rowp = H + (size_t)(row0 + ai * HALF + m * 16) * ldc + col0;
                u32x4 h[2];
#pragma unroll
                for (int bj = 0; bj < 2; ++bj) h[bj] = *(const u32x4*)(rowp + bj * HALF);
#pragma unroll
                for (int bj = 0; bj < 2; ++bj) { const f32x4 v0 = acc[ai][bj][m][0], v1 = acc[ai][bj][m][1];
                    u32x4 w; w.x = cvt_pk_bf16(bfe(h[bj], 0) + v0[0], bfe(h[bj], 1) + v0[1]); w.y = cvt_pk_bf16(bfe(h[bj], 2) + v0[2], bfe(h[bj], 3) + v0[3]);
                    w.z = cvt_pk_bf16(bfe(h[bj], 4) + v1[0], bfe(h[bj], 5) + v1[1]); w.w = cvt_pk_bf16(bfe(h[bj], 6) + v1[2], bfe(h[bj], 7) + v1[3]);
                    *(u32x4*)(rowp + bj * HALF) = w; }
                asm volatile("" ::: "memory"); }
    }
};
struct EpiPleBf16 {
    static constexpr bool PERM = true, AFTER_DRAIN = false;
    const bf16_t* Hin; bf16_t* Hout; const bf16_t* PL; const float* rs;
    __device__ __forceinline__ void operator()(const f32x4 (&acc)[2][2][4][2], const Unit& u, int wr, int wc, int fr, int fq) const {
        const int row0 = u.pm * BM + wr * 64 + fr, col0 = u.pn * BM + wc * 32 + 8 * fq;
#pragma unroll
        for (int ai = 0; ai < 2; ++ai)
#pragma unroll
            for (int m = 0; m < 4; ++m) { const int row = row0 + ai * HALF + m * 16; const float s = rs[row]; const size_t off = (size_t)row * 2048 + col0;
                u32x4 h[2], p[2];
#pragma unroll
                for (int bj = 0; bj < 2; ++bj) { h[bj] = *(const u32x4*)(Hin + off + bj * HALF); p[bj] = *(const u32x4*)(PL + off + bj * HALF); }
#pragma unroll
                for (int bj = 0; bj < 2; ++bj) { float o[8];
#pragma unroll
                    for (int e = 0; e < 8; ++e) { const float a = acc[ai][bj][m][e >> 2][e & 3] * s; o[e] = bfe(h[bj], e) + __builtin_amdgcn_rcpf(1.0f + __expf(-a)) * bfe(p[bj], e); }
                    u32x4 w; w.x = cvt_pk_bf16(o[0], o[1]); w.y = cvt_pk_bf16(o[2], o[3]); w.z = cvt_pk_bf16(o[4], o[5]); w.w = cvt_pk_bf16(o[6], o[7]);
                    *(u32x4*)(Hout + off + bj * HALF) = w; }
                asm volatile("" ::: "memory"); }
    }
};
struct EpiResidF32 {
    static constexpr bool PERM = false, AFTER_DRAIN = false;
    float* H; int ldc;
    __device__ __forceinline__ void operator()(const f32x4 (&acc)[2][2][4][2], const Unit& u, int wr, int wc, int fr, int fq) const {
        const int row0 = u.pm * BM + wr * 64 + fr, col0 = u.pn * BM + wc * 32 + 4 * fq;
#pragma unroll
        for (int ai = 0; ai < 2; ++ai)
#pragma unroll
            for (int m = 0; m < 4; ++m) { float* rowp = H + (size_t)(row0 + ai * HALF + m * 16) * ldc + col0;
                f32x4 h[2][2];
#pragma unroll
                for (int bj = 0; bj < 2; ++bj)
#pragma unroll
                    for (int n = 0; n < 2; ++n) h[bj][n] = *(const f32x4*)(rowp + bj * HALF + n * 16);
#pragma unroll
                for (int bj = 0; bj < 2; ++bj)
#pragma unroll
                    for (int n = 0; n < 2; ++n) *(f32x4*)(rowp + bj * HALF + n * 16) = h[bj][n] + acc[ai][bj][m][n];
                asm volatile("" ::: "memory"); }
    }
};
struct EpiGateUp {
    static constexpr bool PERM = true, AFTER_DRAIN = false;
    bf16_t* HID; const float* selr;
    __device__ __forceinline__ void operator()(const f32x4 (&acc)[2][2][4][2], const Unit& u, int wr, int wc, int fr, int fq) const {
        const int row0 = u.pm * BM + wr * 64 + fr, col0 = (u.pn & 7) * 128 + wc * 32 + 8 * fq;
#pragma unroll
        for (int ai = 0; ai < 2; ++ai)
#pragma unroll
            for (int m = 0; m < 4; ++m) { float o[8]; const float s = selr[row0 + ai * HALF + m * 16];
#pragma unroll
                for (int n = 0; n < 2; ++n)
#pragma unroll
                    for (int j = 0; j < 4; ++j) { const float g = acc[ai][0][m][n][j] * s, up = acc[ai][1][m][n][j] * s; o[4 * n + j] = g * __builtin_amdgcn_rcpf(1.0f + __expf(-g)) * up; }
                u32x4 w; w.x = cvt_pk_bf16(o[0], o[1]); w.y = cvt_pk_bf16(o[2], o[3]); w.z = cvt_pk_bf16(o[4], o[5]); w.w = cvt_pk_bf16(o[6], o[7]);
                *(u32x4*)(HID + (size_t)(row0 + ai * HALF + m * 16) * 1024 + col0) = w; }
    }
};
struct EpiDownBf16 {
    static constexpr bool PERM = true, AFTER_DRAIN = false;
    bf16_t* O; const float* gate;
    __device__ __forceinline__ void operator()(const f32x4 (&acc)[2][2][4][2], const Unit& u, int wr, int wc, int fr, int fq) const {
        const int row0 = u.pm * BM + wr * 64 + fr, col0 = (u.pn & 7) * BM + wc * 32 + 8 * fq;
#pragma unroll
        for (int ai = 0; ai < 2; ++ai)
#pragma unroll
            for (int m = 0; m < 4; ++m) { const int row = row0 + ai * HALF + m * 16; const float gt = gate[row]; bf16_t* rowp = O + (size_t)row * 2048 + col0;
#pragma unroll
                for (int bj = 0; bj < 2; ++bj) { const f32x4 v0 = acc[ai][bj][m][0] * gt, v1 = acc[ai][bj][m][1] * gt;
                    u32x4 w; w.x = cvt_pk_bf16(v0[0], v0[1]); w.y = cvt_pk_bf16(v0[2], v0[3]); w.z = cvt_pk_bf16(v1[0], v1[1]); w.w = cvt_pk_bf16(v1[2], v1[3]);
                    *(u32x4*)(rowp + bj * HALF) = w; } }
    }
};
struct EpiPleF32 {
    static constexpr bool PERM = false, AFTER_DRAIN = false;
    float* H; const bf16_t* PL;
    __device__ __forceinline__ void operator()(const f32x4 (&acc)[2][2][4][2], const Unit& u, int wr, int wc, int fr, int fq) const {
        typedef unsigned u32x2v __attribute__((ext_vector_type(2)));
        const int row0 = u.pm * BM + wr * 64 + fr, col0 = u.pn * BM + wc * 32 + 4 * fq;
#pragma unroll
        for (int ai = 0; ai < 2; ++ai)
#pragma unroll
            for (int m = 0; m < 4; ++m) { const size_t off = (size_t)(row0 + ai * HALF + m * 16) * 2048 + col0;
                f32x4 h[2][2]; u32x2v p[2][2];
#pragma unroll
                for (int bj = 0; bj < 2; ++bj)
#pragma unroll
                    for (int n = 0; n < 2; ++n) { h[bj][n] = *(const f32x4*)(H + off + bj * HALF + n * 16); p[bj][n] = *(const u32x2v*)(PL + off + bj * HALF + n * 16); }
#pragma unroll
                for (int bj = 0; bj < 2; ++bj)
#pragma unroll
                    for (int n = 0; n < 2; ++n) { const f32x4 a = acc[ai][bj][m][n]; f32x4 pl; pl[0] = __uint_as_float(p[bj][n].x << 16); pl[1] = __uint_as_float(p[bj][n].x & 0xffff0000u); pl[2] = __uint_as_float(p[bj][n].y << 16); pl[3] = __uint_as_float(p[bj][n].y & 0xffff0000u);
                        f32x4 o;
#pragma unroll
                        for (int j = 0; j < 4; ++j) o[j] = h[bj][n][j] + __builtin_amdgcn_rcpf(1.0f + __expf(-a[j])) * pl[j];
                        *(f32x4*)(H + off + bj * HALF + n * 16) = o; }
                asm volatile("" ::: "memory"); }
    }
};
template <class Epi, class Sched, bool STAMP = false>
__device__ __forceinline__ void gemm_phase(PG8_LAS unsigned char* lds, const Gemm g, const Sched& S, const Epi& E, unsigned long long* stamps, const int wave0) {
    int tid_ = wave0 * 64 + lane_id(); asm volatile("" : "+v"(tid_));
    const int tid = tid_, wid = __builtin_amdgcn_readfirstlane(tid >> 6), lane = tid & 63, wr = wid >> 2, wc = wid & 3, fr = lane & 15, fq = lane >> 4;
    const int K = g.K, nt = K / BK;
    int ts_lo = 0, ts_hi = 0, nts = 0; const unsigned long long rt_entry = STAMP ? (unsigned long long)wall_clock64() : 0ull;
#define PG8_STAMP() do { if (STAMP && wid == 0 && nts < 64) { const unsigned long long _c = (unsigned long long)clock64(); \
        ts_lo = (lane == nts) ? (int)(unsigned)_c : ts_lo; ts_hi = (lane == nts) ? (int)(unsigned)(_c >> 32) : ts_hi; ++nts; } } while (0)
    PG8_STAMP();
    unsigned voffA[2], voffB[2];
    unsigned gvc[2][2] = {{0u, 0u}, {0u, 0u}}, gvn[2][2] = {{0u, 0u}, {0u, 0u}}; int gR[2] = {0, 0}, gC[2] = {0, 0};
#pragma unroll
    for (int i = 0; i < 2; ++i) { int R, C; stage_rc(tid * 16 + i * 8192, R, C); const int Rb = Epi::PERM ? ((R & ~31) + perm32(R & 31)) : R;
        voffA[i] = (unsigned)(R * K + C) * 2u; voffB[i] = (unsigned)(Rb * K + C) * 2u; gR[i] = R; gC[i] = C; }
    const size_t kstep = (size_t)(BK * 2);
    const size_t hstep = (size_t)HALF * K * 2;
    const size_t tstep = 2 * hstep;
    const unsigned ldsw = (unsigned)wid * 1024u;
    const int aoff = lds_byte(wr * 64 + fr, fq * 8), boff = lds_byte(wc * 32 + fr, fq * 8);
#define PG8_SA(b, h) (((b) * 2 + (h)) * HTB)
#define PG8_SB(b, h) ((4 + (b) * 2 + (h)) * HTB)
#define PG8_STAGE(bufoff, gbase, voff) do { _Pragma("unroll") for (int _i = 0; _i < 2; ++_i) \
        __builtin_amdgcn_global_load_lds((const unsigned*)((const char*)(gbase) + (voff)[_i]), (PG8_LAS unsigned*)(lds + (bufoff) + ldsw + _i * 8192), 16, 0, 0); } while (0)
#define PG8_STAGE_A(bufoff, gbase, h, un) do { if constexpr (Sched::GATHER) { unsigned _o[2]; _o[0] = (un) ? gvn[h][0] : gvc[h][0]; _o[1] = (un) ? gvn[h][1] : gvc[h][1]; PG8_STAGE(bufoff, gbase, _o); } \
        else { PG8_STAGE(bufoff, (gbase) + ((h) ? hstep : (size_t)0), voffA); } } while (0)
#define PG8_GOFF(dst, u) do { _Pragma("unroll") for (int _h = 0; _h < 2; ++_h) _Pragma("unroll") for (int _i = 0; _i < 2; ++_i) dst[_h][_i] = ((unsigned)S.arow(u, _h * HALF + gR[_i]) * (unsigned)K + (unsigned)gC[_i]) * 2u; } while (0)
#define PG8_LDA(dst, b, h) do { _Pragma("unroll") for (int m = 0; m < 4; ++m) _Pragma("unroll") for (int k = 0; k < 2; ++k) dst[m][k] = *(const PG8_LAS bf16x8*)(lds + PG8_SA(b, h) + aoff + m * 2048 + k * 1024); } while (0)
#define PG8_LDB(dst, b, h) do { _Pragma("unroll") for (int n = 0; n < 2; ++n) _Pragma("unroll") for (int k = 0; k < 2; ++k) dst[n][k] = *(const PG8_LAS bf16x8*)(lds + PG8_SB(b, h) + boff + n * 2048 + k * 1024); } while (0)
#define PG8_MMA(ai, bj, At, Bt) do { __builtin_amdgcn_s_setprio(1); _Pragma("unroll") for (int m = 0; m < 4; ++m) _Pragma("unroll") for (int n = 0; n < 2; ++n) _Pragma("unroll") for (int k = 0; k < 2; ++k) \
        acc[ai][bj][m][n] = __builtin_amdgcn_mfma_f32_16x16x32_bf16(Bt[n][k], At[m][k], acc[ai][bj][m][n], 0, 0, 0); __builtin_amdgcn_s_setprio(0); } while (0)
#define PG8_WAIT_V(n) asm volatile("s_waitcnt vmcnt(" #n ")" ::: "memory")
#define PG8_WAIT_L(n) asm volatile("s_waitcnt lgkmcnt(" #n ")" ::: "memory")
#define PG8_BAR __builtin_amdgcn_s_barrier()
#define PG8_SCHED __builtin_amdgcn_sched_barrier(0)
    Unit cur, nxt; int ui = 0;
    if (!S.next(0, cur)) return;
    f32x4 acc[2][2][4][2];
#pragma unroll
    for (int a = 0; a < 2; ++a)
#pragma unroll
        for (int b = 0; b < 2; ++b)
#pragma unroll
            for (int m = 0; m < 4; ++m)
#pragma unroll
                for (int n = 0; n < 2; ++n) acc[a][b][m][n] = (f32x4){0.f, 0.f, 0.f, 0.f};
    bf16x8 At[4][2], B0[2][2], B1[2][2];
    const char* cA = (const char*)g.A + (Sched::GATHER ? (size_t)0 : (size_t)cur.pm * tstep); const char* cB = (const char*)g.Bt + (size_t)cur.pn * tstep;
    if constexpr (Sched::GATHER) PG8_GOFF(gvc, cur);
    S.a_ready(cur);
    PG8_STAGE(PG8_SB(0, 0), cB, voffB); PG8_STAGE_A(PG8_SA(0, 0), cA, 0, false); PG8_STAGE(PG8_SB(0, 1), cB + hstep, voffB); PG8_STAGE_A(PG8_SA(0, 1), cA, 1, false);
    if (wr == 1) PG8_BAR;
    PG8_WAIT_V(4); PG8_BAR;
    PG8_STAGE(PG8_SB(1, 0), cB + kstep, voffB); PG8_STAGE_A(PG8_SA(1, 0), cA + kstep, 0, false); PG8_STAGE(PG8_SB(1, 1), cB + hstep + kstep, voffB);
    PG8_WAIT_V(6); PG8_BAR;
    PG8_STAMP();
    for (;;) {
        const bool has_next = S.next(ui + 1, nxt);
        if constexpr (Sched::GATHER) { if (has_next) PG8_GOFF(gvn, nxt); }
        const char* nA = (has_next && !Sched::GATHER) ? (const char*)g.A + (size_t)nxt.pm * tstep : cA; const char* nB = has_next ? (const char*)g.Bt + (size_t)nxt.pn * tstep : cB;
        for (int t = 0; t < nt; t += 2) {
            const bool last = (t == nt - 2);
            const char* a1 = cA + (size_t)(t + 1) * kstep;
            const char* a2 = last ? nA : cA + (size_t)(t + 2) * kstep; const char* b2 = last ? nB : cB + (size_t)(t + 2) * kstep;
            const char* a3 = a2 + kstep; const char* b3 = b2 + kstep;
            if (last && has_next) S.a_ready(nxt);
            const bool un = last && has_next;
            PG8_LDB(B0, 0, 0); PG8_SCHED; PG8_LDA(At, 0, 0); PG8_STAGE_A(PG8_SA(1, 1), a1, 1, false);
            PG8_WAIT_L(8); PG8_BAR; PG8_WAIT_L(0); PG8_MMA(0, 0, At, B0); PG8_BAR; PG8_SCHED;
            PG8_LDB(B1, 0, 1); PG8_STAGE(PG8_SB(0, 0), b2, voffB);
            PG8_BAR; PG8_WAIT_L(0); PG8_MMA(0, 1, At, B1); PG8_BAR;
            PG8_LDA(At, 0, 1); PG8_STAGE_A(PG8_SA(0, 0), a2, 0, un);
            PG8_BAR; PG8_WAIT_L(0); PG8_MMA(1, 0, At, B0); PG8_BAR; PG8_SCHED;
            PG8_STAGE(PG8_SB(0, 1), b2 + hstep, voffB);
            PG8_WAIT_V(6); PG8_BAR; PG8_MMA(1, 1, At, B1); PG8_BAR;
            PG8_LDB(B0, 1, 0); PG8_SCHED; PG8_LDA(At, 1, 0); PG8_STAGE_A(PG8_SA(0, 1), a2, 1, un);
            PG8_WAIT_L(8); PG8_BAR; PG8_WAIT_L(0); PG8_MMA(0, 0, At, B0); PG8_BAR; PG8_SCHED;
            PG8_LDB(B1, 1, 1); PG8_STAGE(PG8_SB(1, 0), b3, voffB);
            PG8_BAR; PG8_WAIT_L(0); PG8_MMA(0, 1, At, B1); PG8_BAR;
            PG8_LDA(At, 1, 1); PG8_STAGE_A(PG8_SA(1, 0), a3, 0, un);
            PG8_BAR; PG8_WAIT_L(0); PG8_MMA(1, 0, At, B0); PG8_BAR; PG8_SCHED;
            PG8_STAGE(PG8_SB(1, 1), b3 + hstep, voffB);
            PG8_WAIT_V(6); PG8_BAR; PG8_MMA(1, 1, At, B1); PG8_BAR;
        }
        PG8_STAMP();
        if constexpr (!Epi::AFTER_DRAIN) { E(acc, cur, wr, wc, fr, fq); S.done(cur); }
        PG8_STAMP();
        if (!has_next) break;
#pragma unroll
        for (int a = 0; a < 2; ++a)
#pragma unroll
            for (int b = 0; b < 2; ++b)
#pragma unroll
                for (int m = 0; m < 4; ++m)
#pragma unroll
                    for (int n = 0; n < 2; ++n) acc[a][b][m][n] = (f32x4){0.f, 0.f, 0.f, 0.f};
        cur = nxt; cA = nA; cB = nB; ++ui;
        if constexpr (Sched::GATHER) { _Pragma("unroll") for (int _h = 0; _h < 2; ++_h) _Pragma("unroll") for (int _i = 0; _i < 2; ++_i) gvc[_h][_i] = gvn[_h][_i]; }
    }
    PG8_WAIT_V(0);
    if (wr == 0) PG8_BAR;
    PG8_BAR;
    if constexpr (Epi::AFTER_DRAIN) { E.fused(acc, cur, wr, wc, fr, fq, lds, wid, lane); S.done(cur); }
    PG8_STAMP();
    if (STAMP && wid == 0) { stamps[lane] = lane < nts ? (((unsigned long long)(unsigned)ts_hi << 32) | (unsigned)ts_lo) : 0ull;
        if (lane == 62) stamps[62] = rt_entry; if (lane == 63) stamps[63] = (unsigned long long)wall_clock64(); }
#undef PG8_STAMP
#undef PG8_SA
#undef PG8_SB
#undef PG8_STAGE
#undef PG8_STAGE_A
#undef PG8_GOFF
#undef PG8_LDA
#undef PG8_LDB
#undef PG8_MMA
#undef PG8_WAIT_V
#undef PG8_WAIT_L
#undef PG8_BAR
#undef PG8_SCHED
}
}


namespace attn {
using bf16 = unsigned short;
constexpr int   D = 128, NW = 8, QBLK = 32, KVBLK = 64;
constexpr float SCALE = 0.088388347648318440f;
constexpr float THR = 8.f;
constexpr int SDEPTH = 1;
constexpr int LDQ = 5120, LDK = 5120, LDO = 2048;
constexpr size_t SHM_V = KVBLK * D * 2, SHM_K = KVBLK * D * 2, SHM_ATTN = 2 * SHM_V + 2 * SHM_K + NW * 64 * 4;
using bf16x8 = __attribute__((ext_vector_type(8))) short;
using s16x4  = __attribute__((ext_vector_type(4))) short;
using f32x16 = __attribute__((ext_vector_type(16))) float;
using f32x8  = __attribute__((ext_vector_type(8))) float;
using u32x4  = __attribute__((ext_vector_type(4))) unsigned;
#define KSWZ(row, colB) ((row) * 256 + ((colB) ^ (((row) & 7) << 4)))
#define SBAR() __builtin_amdgcn_sched_barrier(0)
__device__ __forceinline__ int crow(int r, int hi) { return (r & 3) + 8 * (r >> 2) + 4 * hi; }
__device__ __forceinline__ unsigned cvtpk(float lo, float hi) { return cvt_pk_rne(lo, hi); }
template <typename TIn> struct Stage;
template <> struct Stage<bf16>  { using T = bf16x8;
  __device__ static __forceinline__ T ld8(const bf16* p) { return *reinterpret_cast<const bf16x8*>(p); }
  __device__ static __forceinline__ bf16x8 tobf(T x) { return x; } };
template <> struct Stage<float> { using T = f32x8;
  __device__ static __forceinline__ T ld8(const float* p) { return *reinterpret_cast<const f32x8*>(p); }
  __device__ static __forceinline__ bf16x8 tobf(T x) {
    u32x4 w = {cvtpk(x[0], x[1]), cvtpk(x[2], x[3]), cvtpk(x[4], x[5]), cvtpk(x[6], x[7])}; return *reinterpret_cast<bf16x8*>(&w); } };

__device__ __forceinline__ void partialSM(f32x16& p0, f32x16& p1, float& m_reg, float& mn, float& alpha) {
  constexpr float C = SCALE * 1.4426950408889634f;
  float pmax = p0[0]; for (int r = 1; r < 16; ++r) pmax = fmaxf(pmax, p0[r]); for (int r = 0; r < 16; ++r) pmax = fmaxf(pmax, p1[r]);
  { auto rr = __builtin_amdgcn_permlane32_swap(__float_as_uint(pmax), __float_as_uint(pmax), false, false);
    pmax = fmaxf(__uint_as_float(rr[0]), __uint_as_float(rr[1])); }
  if (__builtin_expect(__all(pmax - m_reg <= THR / SCALE), 1)) { mn = m_reg; alpha = 1.f; }
  else { mn = fmaxf(m_reg, pmax); alpha = __builtin_amdgcn_exp2f((m_reg - mn) * C); m_reg = mn; }
  float mnC = -mn * C;
  for (int r = 0; r < 16; ++r) p0[r] = fmaf(p0[r], C, mnC); for (int r = 0; r < 16; ++r) p1[r] = fmaf(p1[r], C, mnC);
  for (int r = 0; r < 16; ++r) p0[r] = __builtin_amdgcn_exp2f(p0[r]);
}
__device__ __forceinline__ void finishSM(f32x16& p0, f32x16& p1, float alpha, float& l_reg, bf16x8& pa0, bf16x8& pa1, bf16x8& pa2, bf16x8& pa3) {
  for (int r = 0; r < 16; ++r) p1[r] = __builtin_amdgcn_exp2f(p1[r]);
  float ps = 0; for (int r = 0; r < 16; ++r) ps += p0[r]; for (int r = 0; r < 16; ++r) ps += p1[r];
  { auto rr = __builtin_amdgcn_permlane32_swap(__float_as_uint(ps), __float_as_uint(ps), false, false);
    ps = __uint_as_float(rr[0]) + __uint_as_float(rr[1]); }
  l_reg = l_reg * alpha + ps;
#define PK4(P, BASE, OUT) do { unsigned a0 = cvtpk(P[BASE + 0], P[BASE + 1]), a1 = cvtpk(P[BASE + 2], P[BASE + 3]);   \
    unsigned b0 = cvtpk(P[BASE + 4], P[BASE + 5]), b1 = cvtpk(P[BASE + 6], P[BASE + 7]);                              \
    auto r0 = __builtin_amdgcn_permlane32_swap(a0, b0, false, false); auto r1 = __builtin_amdgcn_permlane32_swap(a1, b1, false, false); \
    u32x4 w = {r0[0], r1[0], r0[1], r1[1]}; OUT = *reinterpret_cast<bf16x8*>(&w); } while (0)
  PK4(p0, 0, pa0); PK4(p0, 8, pa1); PK4(p1, 0, pa2); PK4(p1, 8, pa3);
#undef PK4
}
__device__ __forceinline__ void qkt(f32x16& p0, f32x16& p1, const bf16* Ks, const bf16x8* qr, int r32, int hi) {
  p0 = f32x16{}; p1 = f32x16{};
  for (int d0 = 0; d0 < 8; ++d0) { int cb = (d0 * 16 + hi * 8) * 2;
    bf16x8 b0 = *reinterpret_cast<const bf16x8*>((const char*)Ks + KSWZ(r32, cb));
    bf16x8 b1 = *reinterpret_cast<const bf16x8*>((const char*)Ks + KSWZ(32 + r32, cb));
    p0 = __builtin_amdgcn_mfma_f32_32x32x16_bf16(b0, qr[d0], p0, 0, 0, 0);
    p1 = __builtin_amdgcn_mfma_f32_32x32x16_bf16(b1, qr[d0], p1, 0, 0, 0); }
}
__device__ __forceinline__ int v_st(int k, int c) { const int kk = (k & ~0xC) | ((k & 4) << 1) | ((k & 8) >> 1); return ((kk >> 3) * 4 + (c >> 5)) * 512 + ((kk & 7) * 32 + (c & 31)) * 2; }
__device__ __forceinline__ int v_rd_base(int lane) { return ((lane & 3) << 3) | (((lane >> 2) & 3) << 6) | (((lane >> 4) & 1) << 5) | (((lane >> 5) & 1) << 8); }
constexpr int v_rd_off(int d0, int ks, int half) { return d0 * 512 + ks * 4096 + half * 2048; }
template <int OFF> __device__ __forceinline__ s16x4 tr_read(int vb) {
  s16x4 r; asm volatile("ds_read_b64_tr_b16 %0, %1 offset:%2" : "=&v"(r) : "v"(vb), "i"(OFF) : "memory"); return r;
}
template <int D0> __device__ __forceinline__ void pv_one(f32x16& od, int vb, bf16x8 pa0, bf16x8 pa1, bf16x8 pa2, bf16x8 pa3) {
  const s16x4 l0 = tr_read<v_rd_off(D0, 0, 0)>(vb), h0 = tr_read<v_rd_off(D0, 0, 1)>(vb), l1 = tr_read<v_rd_off(D0, 1, 0)>(vb), h1 = tr_read<v_rd_off(D0, 1, 1)>(vb);
  const s16x4 l2 = tr_read<v_rd_off(D0, 2, 0)>(vb), h2 = tr_read<v_rd_off(D0, 2, 1)>(vb), l3 = tr_read<v_rd_off(D0, 3, 0)>(vb), h3 = tr_read<v_rd_off(D0, 3, 1)>(vb);
  asm volatile("s_waitcnt lgkmcnt(0)" ::: "memory"); SBAR();
#define PK(L, H) (bf16x8){L[0], L[1], L[2], L[3], H[0], H[1], H[2], H[3]}
  od = __builtin_amdgcn_mfma_f32_32x32x16_bf16(pa0, PK(l0, h0), od, 0, 0, 0);
  od = __builtin_amdgcn_mfma_f32_32x32x16_bf16(pa1, PK(l1, h1), od, 0, 0, 0);
  od = __builtin_amdgcn_mfma_f32_32x32x16_bf16(pa2, PK(l2, h2), od, 0, 0, 0);
  od = __builtin_amdgcn_mfma_f32_32x32x16_bf16(pa3, PK(l3, h3), od, 0, 0, 0);
#undef PK
}
__device__ __forceinline__ void pv_d0(f32x16* o, int vb, bf16x8 pa0, bf16x8 pa1, bf16x8 pa2, bf16x8 pa3) {
  pv_one<0>(o[0], vb, pa0, pa1, pa2, pa3); pv_one<1>(o[1], vb, pa0, pa1, pa2, pa3); pv_one<2>(o[2], vb, pa0, pa1, pa2, pa3); pv_one<3>(o[3], vb, pa0, pa1, pa2, pa3);
}

template <typename TQ>
__device__ __forceinline__ void attn_dense_body(const TQ* __restrict__ Qb, const bf16* __restrict__ Kh, const bf16* __restrict__ Vh,
                                                float* __restrict__ Ob, int seq, char* lds, const int wave0) {
  using St = Stage<bf16>; using SQ = Stage<TQ>;
  int tid_ = wave0 * 64 + lane_id(); asm volatile("" : "+v"(tid_));
  const int tid = tid_, wid = tid >> 6, lane = tid & 63, r32 = lane & 31, hi = lane >> 5;
  bf16* V_lds = (bf16*)lds; bf16* K_lds = (bf16*)(lds + 2 * SHM_V);
  float* ws = (float*)(lds + 2 * SHM_V + 2 * SHM_K) + wid * 64; float* li_l = ws; float* al_l = ws + 32;
  float m_reg = -1e30f, l_reg = 0; f32x16 o[4] = {}; bf16x8 qr[8];
  const TQ* Qw = Qb + (long)(wid * QBLK + r32) * LDQ + hi * 8;
#pragma unroll
  for (int d0 = 0; d0 < 8; ++d0) qr[d0] = SQ::tobf(SQ::ld8(Qw + d0 * 16));
  const int sr = tid >> 4, sc = (tid & 15) * 8, vst0 = v_st(sr, sc), vst1 = v_st(32 + sr, sc);
  const int vb0 = (int)(uintptr_t)V_lds + v_rd_base(lane);
  struct { typename St::T vs0, vs1, ks0, ks1; } sr_[SDEPTH];
#define SLOAD(i, k0) do { sr_[i].vs0 = St::ld8(&Vh[(long)((k0) + sr) * LDK + sc]); sr_[i].vs1 = St::ld8(&Vh[(long)((k0) + 32 + sr) * LDK + sc]); \
    sr_[i].ks0 = St::ld8(&Kh[(long)((k0) + sr) * LDK + sc]); sr_[i].ks1 = St::ld8(&Kh[(long)((k0) + 32 + sr) * LDK + sc]); } while (0)
#define SWRITE(b, i) do { *(bf16x8*)((char*)V_lds + (b) * SHM_V + vst0) = St::tobf(sr_[i].vs0);          \
    *(bf16x8*)((char*)V_lds + (b) * SHM_V + vst1) = St::tobf(sr_[i].vs1); int kc = sc * 2;               \
    *(bf16x8*)((char*)K_lds + (b) * SHM_K + KSWZ(sr, kc)) = St::tobf(sr_[i].ks0);                       \
    *(bf16x8*)((char*)K_lds + (b) * SHM_K + KSWZ(32 + sr, kc)) = St::tobf(sr_[i].ks1); } while (0)
#define SWAIT() do { if constexpr (SDEPTH == 2) asm volatile("s_waitcnt vmcnt(4)" ::: "memory"); else asm volatile("s_waitcnt vmcnt(0)" ::: "memory"); } while (0)
#define RESC(a) do { if (__any((a) < 1.f)) { if (hi == 0) al_l[r32] = (a); asm volatile("s_waitcnt lgkmcnt(0)" ::: "memory"); \
    for (int d = 0; d < 4; ++d) for (int r = 0; r < 16; ++r) o[d][r] *= al_l[crow(r, hi)]; } } while (0)
  f32x16 pA0, pA1, pB0, pB1; float mnA, mnB, alA, alB; bf16x8 pa0, pa1, pa2, pa3; const int NT = seq / KVBLK;
  constexpr int SE = 0, SO = SDEPTH - 1;
  SLOAD(SE, 0); asm volatile("s_waitcnt vmcnt(0)" ::: "memory"); SWRITE(0, SE); __syncthreads();
  qkt(pA0, pA1, K_lds, qr, r32, hi); partialSM(pA0, pA1, m_reg, mnA, alA);
  SLOAD(SO, KVBLK); if constexpr (SDEPTH == 2) { if (2 < NT) SLOAD(SE, 2 * KVBLK); }
  SWAIT(); SWRITE(1, SO); __syncthreads();
  for (int j = 1; j + 1 < NT; j += 2) {
    SBAR(); qkt(pB0, pB1, (bf16*)((char*)K_lds + SHM_K), qr, r32, hi);
    finishSM(pA0, pA1, alA, l_reg, pa0, pa1, pa2, pa3); SBAR();
    SLOAD(SO, (j + SDEPTH) * KVBLK); SBAR();
    pv_d0(o, vb0, pa0, pa1, pa2, pa3); partialSM(pB0, pB1, m_reg, mnB, alB);
    __syncthreads(); SWAIT(); SWRITE(0, SE);
    RESC(alB); __syncthreads();
    SBAR(); qkt(pA0, pA1, K_lds, qr, r32, hi);
    finishSM(pB0, pB1, alB, l_reg, pa0, pa1, pa2, pa3); SBAR();
    if (SDEPTH == 1 || j + 3 < NT) SLOAD(SE, (j + 1 + SDEPTH) * KVBLK); SBAR();
    pv_d0(o, vb0 + (int)SHM_V, pa0, pa1, pa2, pa3); partialSM(pA0, pA1, m_reg, mnA, alA);
    __syncthreads(); SWAIT(); SWRITE(1, SO);
    RESC(alA); __syncthreads();
  }
  SBAR(); qkt(pB0, pB1, (bf16*)((char*)K_lds + SHM_K), qr, r32, hi);
  finishSM(pA0, pA1, alA, l_reg, pa0, pa1, pa2, pa3); SBAR();
  pv_d0(o, vb0, pa0, pa1, pa2, pa3); partialSM(pB0, pB1, m_reg, mnB, alB);
  __syncthreads(); RESC(alB);
  finishSM(pB0, pB1, alB, l_reg, pa0, pa1, pa2, pa3); SBAR();
  pv_d0(o, vb0 + (int)SHM_V, pa0, pa1, pa2, pa3);
  if (hi == 0) li_l[r32] = l_reg; asm volatile("s_waitcnt lgkmcnt(0)" ::: "memory");
  float rli[16];
#pragma unroll
  for (int r = 0; r < 16; ++r) rli[r] = __builtin_amdgcn_rcpf(li_l[crow(r, hi)]);
  float* Ow = Ob + (long)(wid * QBLK) * LDO;
#pragma unroll
  for (int r = 0; r < 16; ++r) { int orow = crow(r, hi);
    for (int d0 = 0; d0 < 4; ++d0) Ow[(long)orow * LDO + d0 * 32 + r32] = o[d0][r] * rli[r]; }
#undef SLOAD
#undef SWRITE
#undef SWAIT
#undef RESC
}

}

template <class Epi>
__device__ __forceinline__ void naive_gemm(Frame& F, const bf16* __restrict__ A, int lda, const bf16* __restrict__ Bt, int ldb, int M, int N, int K, const Epi& epi) {
    LAS float* As = (LAS float*)F.lds;
    LAS float* Bs = As + 32 * 132;
    const int tid = F.tid, tm = tid >> 4, tn = tid & 15;
    const int ntm = M / 128, ntn = N / 64;
    for (int tile = F.vcu; tile < ntm * ntn; tile += F.G) {
        const int pm = tile / ntn, pn = tile % ntn;
        float acc[4][4];
#pragma unroll
        for (int i = 0; i < 4; ++i)
#pragma unroll
            for (int j = 0; j < 4; ++j) acc[i][j] = 0.f;
        for (int k0 = 0; k0 < K; k0 += 32) {
            { const int r = tid >> 2, ks = (tid & 3) * 8; const bf16x8 v = *(const bf16x8*)(A + (size_t)(pm * 128 + r) * lda + k0 + ks);
#pragma unroll
              for (int j = 0; j < 8; ++j) As[(ks + j) * 132 + r] = bf2f((bf16)v[j]); }
            if (tid < 256) { const int r = tid >> 2, ks = (tid & 3) * 8; const bf16x8 v = *(const bf16x8*)(Bt + (size_t)(pn * 64 + r) * ldb + k0 + ks);
#pragma unroll
              for (int j = 0; j < 8; ++j) Bs[(ks + j) * 68 + r] = bf2f((bf16)v[j]); }
            __syncthreads();
#pragma unroll 8
            for (int kk = 0; kk < 32; ++kk) { const f32x4 a = *(const LAS f32x4*)(As + kk * 132 + tm * 4); const f32x4 b = *(const LAS f32x4*)(Bs + kk * 68 + tn * 4);
#pragma unroll
                for (int i = 0; i < 4; ++i)
#pragma unroll
                    for (int j = 0; j < 4; ++j) acc[i][j] = fmaf(a[i], b[j], acc[i][j]); }
            __syncthreads();
        }
#pragma unroll
        for (int i = 0; i < 4; ++i)
#pragma unroll
            for (int j = 0; j < 4; ++j) epi(pm * 128 + tm * 4 + i, pn * 64 + tn * 4 + j, acc[i][j]);
    }
}

__device__ __forceinline__ void phase_post(Frame& F, int l) {
    bf16* PROJ = WSP(bf16, WS_PROJ);
    const float2* TA = WSP(float2, WS_TABA); const float2* TB = WSP(float2, WS_TABB);
    const float* qn = GIN(5) + l * HD; const float* kn = GIN(6) + l * HD;
    const int gw = F.vcu * NWAVES + F.wave, NGW = F.G * NWAVES, lane = F.lane;
    const int sgA = lane >> 3, iA = (lane & 7) * 2, baseA = (sgA < 4 ? COL_AQ + sgA * HD : COL_AK + (sgA - 4) * HD) + iA;
    const int hsel = lane >> 5, q = lane & 31, hf = q >> 4, i2 = (q & 15) * 2, eo = hf * 64 + i2;
    const float gq0 = qn[eo], gq1 = qn[eo + 1], gq2 = qn[eo + 32], gq3 = qn[eo + 33], gk0 = kn[eo], gk1 = kn[eo + 1], gk2 = kn[eo + 32], gk3 = kn[eo + 33];
    for (int t = gw; t < T; t += NGW) {
        const int s = t & (SEQ - 1);
        bf16* row = PROJ + (size_t)t * DINP;
        const unsigned a1 = *(const unsigned*)(row + baseA), a2 = *(const unsigned*)(row + baseA + 16);
        const f32x4 csa = *(const f32x4*)(TA + s * 16 + iA);
        const int pos = hf == 0 ? (s >> 6) : (s & 63); const f32x4 csb = *(const f32x4*)(TB + pos * 32 + i2);
        unsigned b1[5], b2[5];
#pragma unroll
        for (int p = 0; p < 5; ++p) { const int hh = 2 * p + hsel, base = (p < 4 ? COL_BQ + hh * HD : COL_BK + (hh - 8) * HD) + eo; b1[p] = *(const unsigned*)(row + base); b2[p] = *(const unsigned*)(row + base + 32); }
        { const float x1l = __uint_as_float(a1 << 16), x1h = __uint_as_float(a1 & 0xffff0000u), x2l = __uint_as_float(a2 << 16), x2h = __uint_as_float(a2 & 0xffff0000u);
          *(unsigned*)(row + baseA) = pk2(x1l * csa.x - x2l * csa.y, x1h * csa.z - x2h * csa.w); *(unsigned*)(row + baseA + 16) = pk2(x2l * csa.x + x1l * csa.y, x2h * csa.z + x1h * csa.w); }
#pragma unroll
        for (int p = 0; p < 5; ++p) { const int hh = 2 * p + hsel, base = (p < 4 ? COL_BQ + hh * HD : COL_BK + (hh - 8) * HD) + eo;
            float x1l = __uint_as_float(b1[p] << 16), x1h = __uint_as_float(b1[p] & 0xffff0000u), x2l = __uint_as_float(b2[p] << 16), x2h = __uint_as_float(b2[p] & 0xffff0000u);
            float ss = (x1l * x1l + x1h * x1h) + (x2l * x2l + x2h * x2h);
            ss += __shfl_xor(ss, 1); ss += __shfl_xor(ss, 2); ss += __shfl_xor(ss, 4); ss += __shfl_xor(ss, 8); ss += __shfl_xor(ss, 16);
            const float rs = rsqrtf(ss * (1.0f / HD) + EPS);
            x1l = x1l * rs * (p < 4 ? gq0 : gk0); x1h = x1h * rs * (p < 4 ? gq1 : gk1); x2l = x2l * rs * (p < 4 ? gq2 : gk2); x2h = x2h * rs * (p < 4 ? gq3 : gk3);
            *(unsigned*)(row + base) = pk2(x1l * csb.x - x2l * csb.y, x1h * csb.z - x2h * csb.w); *(unsigned*)(row + base + 32) = pk2(x2l * csb.x + x1l * csb.y, x2h * csb.z + x1h * csb.w); }
    }
}
__device__ __forceinline__ void phase_dn_prep_naive(Frame& F, int l) {
    const bf16* PROJ = WSP(bf16, WS_PROJ); const float* TL = WSP(float, WS_TL);
    float* DQ = WSP(float, WS_DQ); float* DK = WSP(float, WS_DK); float* DV = WSP(float, WS_DV); float* DB = WSP(float, WS_DB); float* DG = WSP(float, WS_DG);
    const float* cw = GIN(4) + (size_t)l * 5 * 1536;
    const int gw = F.vcu * NWAVES + F.wave, NGW = F.G * NWAVES, lane = F.lane;
    for (int t = gw; t < T; t += NGW) {
        const int s = t & (SEQ - 1);
#pragma unroll 1
        for (int g = 0; g < 12; ++g) {
            float val[2];
#pragma unroll
            for (int u = 0; u < 2; ++u) { const int c = 128 * g + 64 * u + lane; float a = 0.f;
#pragma unroll
                for (int j = 0; j < 5; ++j) { const int sp = s - 2 + j; if (sp >= 0 && sp < SEQ) a += bf2f(PROJ[(size_t)(t - 2 + j) * DINP + COL_CQKV + c]) * cw[j * 1536 + c]; }
                val[u] = siluf_(a); }
            float* dst = g < 4 ? DQ : (g < 8 ? DK : DV);
            if (g < 8) { const float ss = wave_sum(val[0] * val[0] + val[1] * val[1]); const float rs = rsqrtf(ss + EPS) * (g < 4 ? 0.08838834764831845f : 1.0f); val[0] *= rs; val[1] *= rs; }
            dst[(size_t)t * 512 + (g & 3) * 128 + lane] = val[0]; dst[(size_t)t * 512 + (g & 3) * 128 + 64 + lane] = val[1];
        }
        if (lane < 8) { const int dir = lane >> 2, hh = lane & 3; const float bl = TL[(size_t)t * 16 + dir * 4 + hh], al = TL[(size_t)t * 16 + 8 + dir * 4 + hh];
            const float A = expf(GIN(9)[(l * 2 + dir) * 4 + hh]); const float dtb = GIN(10)[(l * 2 + dir) * 4 + hh];
            DB[((size_t)dir * T + t) * 4 + hh] = sigmoidf_(bl); DG[((size_t)dir * T + t) * 4 + hh] = -A * softplusf_(al + dtb); }
    }
}


namespace dn {
typedef float f32x4 __attribute__((ext_vector_type(4)));
typedef short bf16x8 __attribute__((ext_vector_type(8)));
typedef short bf16x4 __attribute__((ext_vector_type(4)));
constexpr int KB_OFF = 0, QB_OFF = 17408, VB_OFF = 34816;
constexpr int KDT_OFF = 52224, UT_OFF = 70656, WT_OFF = 89088;
constexpr int AM_OFF = 107520;
constexpr int QKM_OFF = 123904;
constexpr int GC_OFF = 133120;
__device__ __forceinline__ unsigned cvtpk(float lo, float hi) { return cvt_pk_rne(lo, hi); }
__device__ __forceinline__ f32x4 mfma16(bf16x8 a, bf16x8 b, f32x4 c) { return __builtin_amdgcn_mfma_f32_16x16x32_bf16(a, b, c, 0, 0, 0); }
__device__ __forceinline__ void mfma_settle() { asm volatile("s_nop 15\n\ts_nop 7" ::: "memory"); }
}

__device__ __forceinline__ void phase_dn_chunk(Frame& F, int l) {
    using namespace dn;
#define WSQ(type, off) ((type*)(wsq + (off)))
    LAS unsigned char* L = F.lds;
    LAS float* GC = (LAS float*)(L + GC_OFF);
    const int wave = F.wave;
    for (int u = F.vcu; u < 1024; u += F.G) {
        int tid_ = wave * 64 + lane_id(); asm volatile("" : "+v"(tid_));
        const int tid = tid_, lane = tid & 63, g4 = lane >> 4, l15 = lane & 15;
        const int dir = u >> 9, b = (u >> 8) & 1, hh = (u >> 6) & 3, c = u & 63;
        const int chain = dir * 8 + b * 4 + hh, cs = dir ? 63 - c : c;
        const size_t ub = (size_t)chain * 64 + cs;
        GAS unsigned char* wsq_ = (GAS unsigned char*)F.ws; asm volatile("" : "+s"(wsq_)); unsigned char* wsq = (unsigned char*)wsq_;
        __syncthreads();
        if (wave == 0) {
            const int pos = dir ? 63 - lane : lane; const size_t t = (size_t)b * SEQ + c * 64 + pos;
            const float* TL = WSQ(float, WS_TL); const float bl = TL[t * 16 + dir * 4 + hh], al = TL[t * 16 + 8 + dir * 4 + hh];
            const float Acoef = expf(GIN(9)[(l * 2 + dir) * 4 + hh]), dtb = GIN(10)[(l * 2 + dir) * 4 + hh];
            float gc = -Acoef * softplusf_(al + dtb);
#pragma unroll
            for (int o = 1; o < 64; o <<= 1) { const float tv = bperm(gc, lane >= o ? lane - o : lane); if (lane >= o) gc += tv; }
            const float glast = bperm(gc, 63);
            const float beta = sigmoidf_(bl), egc = expf(gc); GC[lane] = gc; GC[64 + lane] = beta; GC[128 + lane] = egc; GC[192 + lane] = expf(glast - gc); if (lane == 0) GC[256] = expf(glast); GC[320 + lane] = beta * egc;
        }
        __syncthreads();
#ifndef DBG_NOCONV
        if (tid < 384) {
            const int rg = tid / 48, o = tid % 48, part = o >> 4, oo = o & 15;
            const int chl = part * 512 + hh * 128 + oo * 8;
            const float* cw = GIN(4) + (size_t)l * 5 * 1536;
            const bf16* src = WSQ(bf16, WS_PROJ) + (size_t)(b * SEQ) * DINP + COL_CQKV + chl;
            float w[5][8];
#pragma unroll
            for (int j = 0; j < 5; ++j) { const f32x4 w0 = *(const f32x4*)(cw + j * 1536 + chl), w1 = *(const f32x4*)(cw + j * 1536 + chl + 4);
                w[j][0] = w0.x; w[j][1] = w0.y; w[j][2] = w0.z; w[j][3] = w0.w; w[j][4] = w1.x; w[j][5] = w1.y; w[j][6] = w1.z; w[j][7] = w1.w; }
            bf16x8 xin[12];
#pragma unroll
            for (int dr = 0; dr < 12; ++dr) { const int sq = c * 64 + rg * 8 - 2 + dr; xin[dr] = (bf16x8){0, 0, 0, 0, 0, 0, 0, 0}; if (sq >= 0 && sq < SEQ) xin[dr] = *(const bf16x8*)(src + (size_t)sq * DINP); }
#pragma unroll
            for (int hp = 0; hp < 2; ++hp) {
                float acc[4][8];
#pragma unroll
                for (int r = 0; r < 4; ++r)
#pragma unroll
                    for (int e = 0; e < 8; ++e) acc[r][e] = 0.f;
#pragma unroll
                for (int dr = 0; dr < 8; ++dr) { float xf[8];
#pragma unroll
                        for (int e = 0; e < 8; ++e) xf[e] = bf2f((bf16)xin[4 * hp + dr][e]);
#pragma unroll
                        for (int r = 0; r < 4; ++r) { const int j = dr - r; if (j >= 0 && j < 5) {
#pragma unroll
                            for (int e = 0; e < 8; ++e) acc[r][e] = fmaf(xf[e], w[j][e], acc[r][e]); } } }
#pragma unroll
                for (int r = 0; r < 4; ++r) {
#pragma unroll
                    for (int e = 0; e < 8; ++e) acc[r][e] = siluf_(acc[r][e]);
                    if (part < 2) { float ss = 0.f;
#pragma unroll
                        for (int e = 0; e < 8; ++e) ss = fmaf(acc[r][e], acc[r][e], ss);
                        ss += bperm(ss, lane ^ 1); ss += bperm(ss, lane ^ 2); ss += bperm(ss, lane ^ 4); ss += bperm(ss, lane ^ 8);
                        const float rs = rsqrtf(ss + EPS) * (part == 0 ? 0.08838834764831845f : 1.0f);
#pragma unroll
                        for (int e = 0; e < 8; ++e) acc[r][e] *= rs; }
                    const int i = dir ? 63 - (rg * 8 + hp * 4 + r) : rg * 8 + hp * 4 + r;
                    u32x4 pk; pk.x = cvtpk(acc[r][0], acc[r][1]); pk.y = cvtpk(acc[r][2], acc[r][3]); pk.z = cvtpk(acc[r][4], acc[r][5]); pk.w = cvtpk(acc[r][6], acc[r][7]);
                    *(LAS u32x4*)(L + (part == 0 ? QB_OFF : (part == 1 ? KB_OFF : VB_OFF)) + i * 272 + oo * 16) = pk;
                }
                if (part == 1) {
                    const int ib = dir ? 60 - rg * 8 - hp * 4 : rg * 8 + hp * 4;
                    float kd[4];
#pragma unroll
                    for (int m = 0; m < 4; ++m) kd[m] = GC[192 + ib + m];
#pragma unroll
                    for (int e = 0; e < 8; ++e) { float v4[4];
#pragma unroll
                        for (int m = 0; m < 4; ++m) v4[m] = (dir ? acc[3 - m][e] : acc[m][e]) * kd[m];
                        u32x2 pk; pk.x = cvtpk(v4[0], v4[1]); pk.y = cvtpk(v4[2], v4[3]);
                        *(LAS u32x2*)(L + KDT_OFF + (oo * 8 + e) * 144 + ib * 2) = pk; }
                }
            }
        }
        __syncthreads();
#endif
        { const int sel = wave >> 2, rt = wave & 3;
          f32x4 acc[4];
#pragma unroll
          for (int ct = 0; ct < 4; ++ct) acc[ct] = (f32x4){0.f, 0.f, 0.f, 0.f};
          const LAS unsigned char* ab2 = L + (sel ? QB_OFF : KB_OFF) + (16 * rt + l15) * 272 + g4 * 16; const LAS unsigned char* bb2 = L + KB_OFF + l15 * 272 + g4 * 16;
#pragma unroll
          for (int kb = 0; kb < 4; ++kb) { const bf16x8 a = *(const LAS bf16x8*)(ab2 + kb * 64);
#pragma unroll
              for (int ct = 0; ct < 4; ++ct) { const bf16x8 bb = *(const LAS bf16x8*)(bb2 + ct * 4352 + kb * 64); acc[ct] = mfma16(a, bb, acc[ct]); } }
#pragma unroll
          for (int ct = 0; ct < 4; ++ct)
#pragma unroll
              for (int r = 0; r < 4; ++r) { const int i = 16 * rt + 4 * g4 + r, j = 16 * ct + l15; const float dec = j <= i ? expf(GC[i] - GC[j]) : 0.f; const float val = acc[ct][r] * dec;
                  if (sel == 0) ((LAS float*)(L + AM_OFF))[i * 64 + j] = j < i ? GC[64 + i] * val : 0.f;
                  else ((LAS bf16*)(L + QKM_OFF))[i * 72 + j] = (bf16)f2bf(val); } }
        __syncthreads();
#ifndef DBG_NOSOLVE
        if (tid < 256) {
            const LAS bf16* srcc = (const LAS bf16*)(L + (tid < 128 ? VB_OFF : KB_OFF)) + (tid & 127); const LAS float* scv = GC + (tid < 128 ? 64 : 320);
            LAS unsigned char* xrow = L + (tid < 128 ? UT_OFF + tid * 144 : WT_OFF + (tid - 128) * 144);
            int zoff; asm volatile("v_mov_b32 %0, 0" : "=v"(zoff));
            const LAS float* AM = (const LAS float*)(L + AM_OFF) + zoff;
#pragma unroll
            for (int r = 0; r < 4; ++r) {
                float acc[16];
#pragma unroll
                for (int ii = 0; ii < 16; ++ii) acc[ii] = scv[16 * r + ii] * bf2f(srcc[(16 * r + ii) * 136]);
#pragma unroll 1
                for (int sb = 0; sb < r; ++sb) {
                    const u32x4 x0 = *(const LAS u32x4*)(xrow + sb * 32), x1 = *(const LAS u32x4*)(xrow + sb * 32 + 16); float xs[16];
                    xs[0] = __uint_as_float(x0.x << 16); xs[1] = __uint_as_float(x0.x & 0xffff0000u); xs[2] = __uint_as_float(x0.y << 16); xs[3] = __uint_as_float(x0.y & 0xffff0000u);
                    xs[4] = __uint_as_float(x0.z << 16); xs[5] = __uint_as_float(x0.z & 0xffff0000u); xs[6] = __uint_as_float(x0.w << 16); xs[7] = __uint_as_float(x0.w & 0xffff0000u);
                    xs[8] = __uint_as_float(x1.x << 16); xs[9] = __uint_as_float(x1.x & 0xffff0000u); xs[10] = __uint_as_float(x1.y << 16); xs[11] = __uint_as_float(x1.y & 0xffff0000u);
                    xs[12] = __uint_as_float(x1.z << 16); xs[13] = __uint_as_float(x1.z & 0xffff0000u); xs[14] = __uint_as_float(x1.w << 16); xs[15] = __uint_as_float(x1.w & 0xffff0000u);
#pragma unroll
                    for (int ii = 0; ii < 16; ++ii) { const LAS float* ar = AM + (16 * r + ii) * 64 + 16 * sb; float s0 = 0.f, s1 = 0.f; if ((ii & 3) == 0) asm volatile("" ::: "memory");
#pragma unroll
                        for (int q = 0; q < 4; ++q) { const f32x4 a = *(const LAS f32x4*)(ar + 4 * q); s0 = fmaf(a.x, xs[4 * q], s0); s1 = fmaf(a.y, xs[4 * q + 1], s1); s0 = fmaf(a.z, xs[4 * q + 2], s0); s1 = fmaf(a.w, xs[4 * q + 3], s1); }
                        acc[ii] -= s0 + s1; }
                }
#pragma unroll
                for (int ii = 1; ii < 16; ++ii) { const LAS float* ar = AM + (16 * r + ii) * 64 + 16 * r; float s0 = 0.f, s1 = 0.f;
#pragma unroll
                    for (int q = 0; q < (ii + 3) / 4; ++q) { const f32x4 a = *(const LAS f32x4*)(ar + 4 * q); s0 = fmaf(a.x, acc[4 * q], s0); s1 = fmaf(a.y, acc[4 * q + 1], s1); s0 = fmaf(a.z, acc[4 * q + 2], s0); s1 = fmaf(a.w, acc[4 * q + 3], s1); }
                    acc[ii] -= s0 + s1; }
                u32x4 pk; pk.x = cvtpk(acc[0], acc[1]); pk.y = cvtpk(acc[2], acc[3]); pk.z = cvtpk(acc[4], acc[5]); pk.w = cvtpk(acc[6], acc[7]); *(LAS u32x4*)(xrow + r * 32) = pk;
                pk.x = cvtpk(acc[8], acc[9]); pk.y = cvtpk(acc[10], acc[11]); pk.z = cvtpk(acc[12], acc[13]); pk.w = cvtpk(acc[14], acc[15]); *(LAS u32x4*)(xrow + r * 32 + 16) = pk;
            }
        }
        __syncthreads();
#endif
        { const int sel = wave >> 2, it = wave & 3;
          f32x4 acc[8];
#pragma unroll
          for (int dt = 0; dt < 8; ++dt) acc[dt] = (f32x4){0.f, 0.f, 0.f, 0.f};
          const LAS unsigned char* bb4 = L + QKM_OFF + (16 * it + l15) * 144 + g4 * 16; const LAS unsigned char* ab4 = L + (sel ? UT_OFF : WT_OFF) + l15 * 144 + g4 * 16;
#pragma unroll
          for (int kb = 0; kb < 2; ++kb) { const bf16x8 bb = *(const LAS bf16x8*)(bb4 + kb * 64);
#pragma unroll
              for (int dt = 0; dt < 8; ++dt) { const bf16x8 a = *(const LAS bf16x8*)(ab4 + dt * 2304 + kb * 64); acc[dt] = mfma16(a, bb, acc[dt]); } }
          mfma_settle();
          const int i = 16 * it + l15, trow = dir ? 63 - i : i;
          if (sel == 0) { bf16* CP = WSQ(bf16, WS_CP) + (ub * 64 + trow) * 128; const float eg = GC[128 + i];
#pragma unroll
              for (int dt = 0; dt < 8; ++dt) { const int d = 16 * dt + 4 * g4; const u32x2 qw = *(const LAS u32x2*)(L + QB_OFF + i * 272 + d * 2);
                  const float q0 = __uint_as_float(qw.x << 16), q1 = __uint_as_float(qw.x & 0xffff0000u), q2 = __uint_as_float(qw.y << 16), q3 = __uint_as_float(qw.y & 0xffff0000u);
                  u32x2 o; o.x = cvtpk(q0 * eg - acc[dt][0], q1 * eg - acc[dt][1]); o.y = cvtpk(q2 * eg - acc[dt][2], q3 * eg - acc[dt][3]); *(u32x2*)(CP + 32 * (dt >> 1) + 8 * g4 + 4 * (dt & 1)) = o; } }
          else { float* CR = WSQ(float, WS_CR) + (ub * 64 + trow) * 128;
#pragma unroll
              for (int dt = 0; dt < 8; ++dt) *(f32x4*)(CR + 16 * dt + 4 * g4) = acc[dt]; } }
        { f32x4 acc[8];
#pragma unroll
          for (int ct = 0; ct < 8; ++ct) acc[ct] = (f32x4){0.f, 0.f, 0.f, 0.f};
          const LAS unsigned char* lane_off = L + l15 * 144 + g4 * 16;
#pragma unroll
          for (int kb = 0; kb < 2; ++kb) { const bf16x8 a = *(const LAS bf16x8*)(lane_off + WT_OFF + wave * 2304 + kb * 64);
#pragma unroll
              for (int ct = 0; ct < 8; ++ct) { const bf16x8 bb = *(const LAS bf16x8*)(lane_off + KDT_OFF + ct * 2304 + kb * 64); acc[ct] = mfma16(a, bb, acc[ct]); } }
          mfma_settle();
          bf16* CM = WSQ(bf16, WS_CM) + ub * 16384; const float eg = GC[256];
          const int dpp = 32 * (wave >> 1) + 8 * g4 + 4 * (wave & 1);
#pragma unroll
          for (int ct = 0; ct < 8; ++ct) { const int d = 16 * ct + l15, dp = 16 * wave + 4 * g4; float m[4];
#pragma unroll
              for (int r = 0; r < 4; ++r) m[r] = (d == dp + r ? eg : 0.f) - acc[ct][r];
              u32x2 o; o.x = cvtpk(m[0], m[1]); o.y = cvtpk(m[2], m[3]); *(u32x2*)(CM + (size_t)d * 128 + dpp) = o; }
#pragma unroll
          for (int ct = 0; ct < 8; ++ct) acc[ct] = (f32x4){0.f, 0.f, 0.f, 0.f};
#pragma unroll
          for (int kb = 0; kb < 2; ++kb) { const bf16x8 a = *(const LAS bf16x8*)(lane_off + KDT_OFF + wave * 2304 + kb * 64);
#pragma unroll
              for (int ct = 0; ct < 8; ++ct) { const bf16x8 bb = *(const LAS bf16x8*)(lane_off + UT_OFF + ct * 2304 + kb * 64); acc[ct] = mfma16(a, bb, acc[ct]); } }
          mfma_settle();
          bf16* CN = WSQ(bf16, WS_CN) + ub * 16384;
#pragma unroll
          for (int ct = 0; ct < 8; ++ct) { u32x2 o; o.x = cvtpk(acc[ct][0], acc[ct][1]); o.y = cvtpk(acc[ct][2], acc[ct][3]); *(u32x2*)(CN + ((size_t)(ct * 8 + wave) * 64 + lane) * 4) = o; } }
    }
}
#undef WSQ

#define DN_SCAN_STEP(cs, NS, MS) do {            \
        const LAS unsigned char* Mb = L + ((cs) & 1) * 34816;                                                                                        \
        const int c4 = (cs) + 3 < 64 ? (cs) + 3 : 63, c5 = (cs) + 4 < 64 ? (cs) + 4 : 63;                                                           \
        if (active) {                                                                                                                               \
        bf16* cso = CS + (size_t)(cs) * 16384 + ((size_t)(wv * 8) * 64 + lane) * 4;                                                                  \
        unsigned sp[8][2]; f32x4 acc[8];                                                                                                            \
        _Pragma("unroll") for (int r = 0; r < 8; ++r) { sp[r][0] = cvtpk(S[r][0], S[r][1]); sp[r][1] = cvtpk(S[r][2], S[r][3]); u32x2 o; o.x = sp[r][0]; o.y = sp[r][1]; *(u32x2*)(cso + 256 * r) = o; \
            acc[r][0] = __uint_as_float(NS[r].x << 16); acc[r][1] = __uint_as_float(NS[r].x & 0xffff0000u); acc[r][2] = __uint_as_float(NS[r].y << 16); acc[r][3] = __uint_as_float(NS[r].y & 0xffff0000u); } \
        _Pragma("unroll") for (int r = 0; r < 8; ++r) NS[r] = *(const u32x2*)(CN + (size_t)c4 * 16384 + ((size_t)(wv * 8 + r) * 64 + lane) * 4);         \
        _Pragma("unroll") for (int kb = 0; kb < 4; ++kb) { u32x4 bw; bw.x = sp[2 * kb][0]; bw.y = sp[2 * kb][1]; bw.z = sp[2 * kb + 1][0]; bw.w = sp[2 * kb + 1][1]; const bf16x8 bfrag = *reinterpret_cast<bf16x8*>(&bw); \
            _Pragma("unroll") for (int r = 0; r < 8; ++r)                                                                                           \
                acc[r] = mfma16(*(const LAS bf16x8*)(Mb + (16 * r + l15) * 272 + (32 * kb + 8 * g4) * 2), bfrag, acc[r]); }                            \
        _Pragma("unroll") for (int r = 0; r < 8; ++r) S[r] = acc[r];                                                                                 \
        } else {     \
                                \
          LAS unsigned char* Mn = L + (((cs) + 1) & 1) * 34816;                                                                                      \
          _Pragma("unroll") for (int q = 0; q < 8; ++q) { const int id = tl + 256 * q; *(LAS u32x4*)(Mn + (id >> 4) * 272 + (id & 15) * 16) = MS[q]; }   \
          _Pragma("unroll") for (int q = 0; q < 8; ++q) MS[q] = *(const u32x4*)(CM + (size_t)c5 * 16384 + (size_t)(tl + 256 * q) * 8);                 \
        }                                                                                                                                           \
        asm volatile("s_waitcnt lgkmcnt(0)" ::: "memory"); __builtin_amdgcn_s_barrier(); asm volatile("" ::: "memory");     \
    } while (0)
__device__ __forceinline__ void phase_dn_scan(Frame& F) {
    using namespace dn;
    if (blockIdx.x >= 32) return;
    const int chain = (int)blockIdx.x >> 1, tid = F.tid, lane = F.lane, wave = F.wave, g4 = lane >> 4, l15 = lane & 15;
    const bool active = wave < 4; const int wv = ((int)blockIdx.x & 1) * 4 + (wave & 3);
    const int tl = tid & 255;
    LAS unsigned char* L = F.lds;
    const bf16* CM = WSP(bf16, WS_CM) + (size_t)chain * 64 * 16384; const bf16* CN = WSP(bf16, WS_CN) + (size_t)chain * 64 * 16384; bf16* CS = WSP(bf16, WS_CS) + (size_t)chain * 64 * 16384;
    f32x4 S[8];
#pragma unroll
    for (int r = 0; r < 8; ++r) S[r] = (f32x4){0.f, 0.f, 0.f, 0.f};
    u32x4 m0[8], m1[8], m2[8]; u32x2 n0[8], n1[8], n2[8];
#pragma unroll
    for (int q = 0; q < 8; ++q) { m0[q] = (u32x4){0u, 0u, 0u, 0u}; m1[q] = m0[q]; m2[q] = m0[q]; }
#pragma unroll
    for (int r = 0; r < 8; ++r) { n0[r] = (u32x2){0u, 0u}; n1[r] = n0[r]; n2[r] = n0[r]; }
    __syncthreads();
    if (!active) {
#pragma unroll
        for (int q = 0; q < 8; ++q) { const size_t o = (size_t)(tl + 256 * q) * 8; m0[q] = *(const u32x4*)(CM + o); m1[q] = *(const u32x4*)(CM + 16384 + o); m2[q] = *(const u32x4*)(CM + 2 * 16384 + o); }
#pragma unroll
        for (int q = 0; q < 8; ++q) { const int id = tl + 256 * q; *(LAS u32x4*)(L + (id >> 4) * 272 + (id & 15) * 16) = m0[q]; }
#pragma unroll
        for (int q = 0; q < 8; ++q) m0[q] = *(const u32x4*)(CM + 3 * 16384 + (size_t)(tl + 256 * q) * 8);
    } else {
#pragma unroll
        for (int r = 0; r < 8; ++r) { const size_t o = ((size_t)(wv * 8 + r) * 64 + lane) * 4; n0[r] = *(const u32x2*)(CN + o); n1[r] = *(const u32x2*)(CN + 16384 + o); n2[r] = *(const u32x2*)(CN + 2 * 16384 + o); }
    }
    __syncthreads();
#pragma unroll 1
    for (int cs = 0; cs < 63; cs += 3) {
        DN_SCAN_STEP(cs, n0, m1);
        DN_SCAN_STEP(cs + 1, n1, m2);
        DN_SCAN_STEP(cs + 2, n2, m0);
    }
    DN_SCAN_STEP(63, n0, m1);
}
#undef DN_SCAN_STEP

__device__ __forceinline__ void phase_dn_out(Frame& F, int l, const int ufirst, const int ustep, const int uend) {
    using namespace dn;
    const bf16* PROJ = WSP(bf16, WS_PROJ); bf16* Y = WSP(bf16, WS_Y); const float* gn = GIN(11) + (size_t)l * HD;
    const int lane = F.lane, wave = F.wave, g4 = lane >> 4, l15 = lane & 15, it = wave & 3, vh = wave >> 2;
    LAS float* part = (LAS float*)F.lds;
    for (int u = ufirst; u < uend; u += ustep) {
        const int b = u >> 8, hh = (u >> 6) & 3, c = u & 63;
        f32x4 acc[4];
#pragma unroll
        for (int q = 0; q < 4; ++q) acc[q] = (f32x4){0.f, 0.f, 0.f, 0.f};
#pragma unroll
        for (int dir = 0; dir < 2; ++dir) { const int chain = dir * 8 + b * 4 + hh, cs = dir ? 63 - c : c; const size_t ub = (size_t)chain * 64 + cs;
            const bf16* CP = WSP(bf16, WS_CP) + ub * 8192 + (size_t)(16 * it + l15) * 128 + 8 * g4; const bf16* CS = WSP(bf16, WS_CS) + ub * 16384 + (size_t)lane * 4; const float* CR = WSP(float, WS_CR) + ub * 8192 + (size_t)(16 * it + l15) * 128;
#pragma unroll
            for (int kb = 0; kb < 4; ++kb) { const bf16x8 bb = *(const bf16x8*)(CP + 32 * kb);
#pragma unroll
                for (int q = 0; q < 4; ++q) { const bf16* sp_ = CS + (size_t)((vh * 4 + q) * 8 + 2 * kb) * 256; const u32x2 a0 = *(const u32x2*)sp_, a1 = *(const u32x2*)(sp_ + 256); u32x4 aw; aw.x = a0.x; aw.y = a0.y; aw.z = a1.x; aw.w = a1.y;
                    acc[q] = mfma16(*reinterpret_cast<bf16x8*>(&aw), bb, acc[q]); } }
#pragma unroll
            for (int q = 0; q < 4; ++q) acc[q] += *(const f32x4*)(CR + 16 * (vh * 4 + q) + 4 * g4); }
        float ss = 0.f;
#pragma unroll
        for (int q = 0; q < 4; ++q) ss += (acc[q][0] * acc[q][0] + acc[q][1] * acc[q][1]) + (acc[q][2] * acc[q][2] + acc[q][3] * acc[q][3]);
        ss += __shfl_xor(ss, 16); ss += __shfl_xor(ss, 32);
        const int i = 16 * it + l15; const size_t t = (size_t)b * SEQ + c * 64 + i;
        u32x2 zw4[4]; f32x4 gg4[4];
#pragma unroll
        for (int q = 0; q < 4; ++q) { const int vv = 16 * (vh * 4 + q) + 4 * g4; zw4[q] = *(const u32x2*)(PROJ + t * DINP + COL_CZ + hh * HD + vv); gg4[q] = *(const f32x4*)(gn + vv); }
        __syncthreads();
        if (g4 == 0) part[vh * 64 + 16 * it + l15] = ss;
        __syncthreads();
        const float rs = rsqrtf((part[i] + part[64 + i]) * (1.0f / HD) + EPS);
#pragma unroll
        for (int q = 0; q < 4; ++q) { const int vv = 16 * (vh * 4 + q) + 4 * g4; const u32x2 zw = zw4[q]; const f32x4 gg = gg4[q];
            const float z0 = __uint_as_float(zw.x << 16), z1 = __uint_as_float(zw.x & 0xffff0000u), z2 = __uint_as_float(zw.y << 16), z3 = __uint_as_float(zw.y & 0xffff0000u);
            u32x2 o; o.x = cvtpk(acc[q][0] * rs * gg.x * siluf_(z0), acc[q][1] * rs * gg.y * siluf_(z1)); o.y = cvtpk(acc[q][2] * rs * gg.z * siluf_(z2), acc[q][3] * rs * gg.w * siluf_(z3));
            *(u32x2*)(Y + t * DM + 1536 + hh * HD + vv) = o; }
    }
}

__device__ __forceinline__ void dn_chain_naive(Frame& F, int chain) {
    const int dir = chain >> 3, b = (chain >> 2) & 1, hh = chain & 3;
    const float* DQ = WSP(float, WS_DQ); const float* DK = WSP(float, WS_DK); const float* DV = WSP(float, WS_DV); const float* DB = WSP(float, WS_DB); const float* DG = WSP(float, WS_DG);
    float* DO = WSP(float, WS_DO);
    LAS float* kb = (LAS float*)F.lds; LAS float* qb = kb + 64 * 128; LAS float* vb = qb + 64 * 128; LAS float* bb = vb + 64 * 128; LAS float* gb = bb + 64;
    const int tid = F.tid, v = tid >> 2, kq = tid & 3;
    float S[32];
#pragma unroll
    for (int j = 0; j < 32; ++j) S[j] = 0.f;
    for (int c0 = 0; c0 < SEQ; c0 += 64) {
        __syncthreads();
        for (int idx = tid; idx < 64 * 128; idx += NTHR) { const int i = idx >> 7, d = idx & 127; const int sq = c0 + i, pos = dir ? SEQ - 1 - sq : sq; const size_t o = (size_t)(b * SEQ + pos) * 512 + hh * 128 + d;
            kb[idx] = DK[o]; qb[idx] = DQ[o]; vb[idx] = DV[o]; }
        if (tid < 64) { const int sq = c0 + tid, pos = dir ? SEQ - 1 - sq : sq; const size_t o = ((size_t)dir * T + b * SEQ + pos) * 4 + hh; bb[tid] = DB[o]; gb[tid] = DG[o]; }
        __syncthreads();
        for (int i = 0; i < 64; ++i) {
            const float a = expf(gb[i]), beta = bb[i];
            float ks = 0.f;
#pragma unroll
            for (int j = 0; j < 32; ++j) ks = fmaf(kb[i * 128 + kq * 32 + j], S[j], ks);
            ks += __shfl_xor(ks, 1); ks += __shfl_xor(ks, 2);
            const float vn = beta * (vb[i * 128 + v] - a * ks);
            float o = 0.f;
#pragma unroll
            for (int j = 0; j < 32; ++j) { S[j] = fmaf(kb[i * 128 + kq * 32 + j], vn, a * S[j]); o = fmaf(qb[i * 128 + kq * 32 + j], S[j], o); }
            o += __shfl_xor(o, 1); o += __shfl_xor(o, 2);
            if (kq == 0) { const int sq = c0 + i, pos = dir ? SEQ - 1 - sq : sq; DO[((size_t)dir * T + b * SEQ + pos) * 512 + hh * 128 + v] = o; }
        }
    }
    __syncthreads();
}
struct AttnAcc { float m, l, o0, o1; };
__device__ __forceinline__ void attn_key(AttnAcc& st, float q0, float q1, const bf16* krow, const bf16* vrow, int lane) {
    const unsigned kw = *(const unsigned*)(krow + 2 * lane), vw = *(const unsigned*)(vrow + 2 * lane);
    const float sc = wave_sum(q0 * __uint_as_float(kw << 16) + q1 * __uint_as_float(kw & 0xffff0000u)) * 0.08838834764831845f;
    const float mn = fmaxf(st.m, sc), al = __expf(st.m - mn), p = __expf(sc - mn);
    st.l = st.l * al + p; st.o0 = st.o0 * al + p * __uint_as_float(vw << 16); st.o1 = st.o1 * al + p * __uint_as_float(vw & 0xffff0000u); st.m = mn;
}
__device__ __forceinline__ void phase_mix_naive(Frame& F, unsigned* scan_cnt) {
    const bf16* PROJ = WSP(bf16, WS_PROJ); float* YMIX = WSP(float, WS_YMIX);
    if (NAIVE_DN) { if (F.vcu < 16) dn_chain_naive(F, F.vcu); } else { phase_dn_scan(F); asm volatile("s_waitcnt vmcnt(0)" ::: "memory"); __syncthreads();
        if (blockIdx.x < 32 && F.tid == 0) {
            __builtin_amdgcn_fence(__ATOMIC_RELEASE, "agent"); asm volatile("s_waitcnt vmcnt(0)" ::: "memory"); (void)xb_add(scan_cnt, 1u); } }
    const int gw = F.vcu * NWAVES + F.wave, NGW = F.G * NWAVES, lane = F.lane;
    if (NAIVE_ATTN_A) for (int u = gw; u < T * 4; u += NGW) { const int t = u >> 2, hh = u & 3, b = t >> 12, s = t & (SEQ - 1);
        const unsigned qw = *(const unsigned*)(PROJ + (size_t)t * DINP + COL_AQ + hh * HD + 2 * lane); const float q0 = __uint_as_float(qw << 16), q1 = __uint_as_float(qw & 0xffff0000u);
        AttnAcc st{-1e30f, 0.f, 0.f, 0.f};
        for (int pat = 0; pat < 3; ++pat) { const int dil = pat == 0 ? 1 : (pat == 1 ? 4 : 16);
            for (int dlt = -64; dlt <= 64; ++dlt) { const int sp = s + dil * dlt; if (sp < 0 || sp >= SEQ) continue;
                const bf16* kr = PROJ + (size_t)(b * SEQ + sp) * DINP; attn_key(st, q0, q1, kr + COL_AK + hh * HD, kr + COL_AV + hh * HD, lane); } }
        const float inv = 1.0f / st.l; *(float2*)(YMIX + (size_t)t * DM + hh * HD + 2 * lane) = make_float2(st.o0 * inv, st.o1 * inv); }
    if (NAIVE_ATTN_B) for (int u = gw; u < T * 8; u += NGW) { const int t = u >> 3, hq = u & 7, kvh = hq >> 2, b = t >> 12;
        const unsigned qw = *(const unsigned*)(PROJ + (size_t)t * DINP + COL_BQ + hq * HD + 2 * lane); const float q0 = __uint_as_float(qw << 16), q1 = __uint_as_float(qw & 0xffff0000u);
        AttnAcc st{-1e30f, 0.f, 0.f, 0.f};
        const bf16* kr = PROJ + (size_t)(b * SEQ) * DINP;
        for (int j = 0; j < SEQ; ++j, kr += DINP) attn_key(st, q0, q1, kr + COL_BK + kvh * HD, kr + COL_BV + kvh * HD, lane);
        const float inv = 1.0f / st.l; *(float2*)(YMIX + (size_t)t * DM + 512 + hq * HD + 2 * lane) = make_float2(st.o0 * inv, st.o1 * inv); }
}


__device__ __forceinline__ void phase_attn_b(Frame& F, char* lds_gen) {
    const bf16* PROJ = WSP(bf16, WS_PROJ); float* YMIX = WSP(float, WS_YMIX);
    for (int u = F.vcu; u < BATCH * 8 * 16; u += F.G) {
        const int b = u >> 7, kvh = (u >> 6) & 1, hq = kvh * 4 + ((u >> 4) & 3), qb = u & 15;
        const bf16* Qb = PROJ + (size_t)(b * SEQ + qb * 256) * DINP + COL_BQ + hq * HD;
        const bf16* Kh = PROJ + (size_t)(b * SEQ) * DINP + COL_BK + kvh * HD;
        const bf16* Vh = PROJ + (size_t)(b * SEQ) * DINP + COL_BV + kvh * HD;
        float* Ob = YMIX + (size_t)(b * SEQ + qb * 256) * DM + 512 + hq * HD;
        attn::attn_dense_body<attn::bf16>(Qb, Kh, Vh, Ob, SEQ, lds_gen, F.wave);
        __syncthreads();
    }
}


constexpr size_t WS_OPA = WS_TMP;
constexpr size_t WS_LSE = WS_TMP + (size_t)3 * T * 512 * 4;
__device__ __forceinline__ void phase_attn_a(Frame& F) {
    using namespace dn;
    constexpr int K_OFF = 0, VT_OFF = 69632;
    LAS unsigned char* L = F.lds;
    const int wave = F.wave;
    if (F.G > 64 && blockIdx.x < 32) return;
    const int ufirst = F.G > 64 ? (int)blockIdx.x - 32 : (int)blockIdx.x, ustep = F.G > 64 ? F.G - 32 : F.G;
    for (int u = ufirst; u < 768; u += ustep) {
        int tid_ = wave * 64 + lane_id(); asm volatile("" : "+v"(tid_));
        const int tid = tid_, lane = tid & 63, g4 = lane >> 4, l15 = lane & 15;
        GAS unsigned char* wsq_ = (GAS unsigned char*)F.ws; asm volatile("" : "+s"(wsq_)); unsigned char* wsq = (unsigned char*)wsq_;
        const bf16* PROJ = (const bf16*)(wsq + WS_PROJ);
        const int p = u >> 8, rem = u & 255, b = rem >> 7, hh = (rem >> 5) & 3, w32 = rem & 31;
        const int dsh = 2 * p, dil = 1 << dsh, Lf = SEQ >> dsh, nblk = Lf >> 7;
        const int r = w32 / nblk, i0 = (w32 % nblk) * 128;
        const bf16* base = PROJ + (size_t)(b * SEQ + r) * DINP + hh * HD;
        const size_t jstride = (size_t)dil * DINP;
        __syncthreads();
#pragma unroll
        for (int q = 0; q < 8; ++q) { const int id = tid + 512 * q, row = id >> 4, c16 = id & 15, j = i0 - 64 + row;
            u32x4 v = {0u, 0u, 0u, 0u}; if (j >= 0 && j < Lf) v = *(const u32x4*)(base + (size_t)j * jstride + COL_AK + c16 * 8);
            *(LAS u32x4*)(L + K_OFF + row * 272 + c16 * 16) = v; }
#pragma unroll
        for (int g = 0; g < 8; ++g) { const int kk0 = 32 * wave + 4 * g; unsigned rv[4];
#pragma unroll
            for (int m = 0; m < 4; ++m) { const int j = i0 - 64 + kk0 + m; rv[m] = (j >= 0 && j < Lf) ? *(const unsigned*)(base + (size_t)j * jstride + COL_AV + 2 * lane) : 0u; }
            u32x2 lo, hi; lo.x = (rv[0] & 0xffffu) | (rv[1] << 16); lo.y = (rv[2] & 0xffffu) | (rv[3] << 16); hi.x = (rv[0] >> 16) | (rv[1] & 0xffff0000u); hi.y = (rv[2] >> 16) | (rv[3] & 0xffff0000u);
            *(LAS u32x2*)(L + VT_OFF + (2 * lane) * 528 + kk0 * 2) = lo; *(LAS u32x2*)(L + VT_OFF + (2 * lane + 1) * 528 + kk0 * 2) = hi; }
        const int iq = i0 + 16 * wave + l15;
        bf16x8 qf[4];
#pragma unroll
        for (int kb = 0; kb < 4; ++kb) qf[kb] = *(const bf16x8*)(base + (size_t)iq * jstride + COL_AQ + 32 * kb + 8 * g4);
        __syncthreads();
        f32x4 sc[9];
        const LAS unsigned char* kb_ = L + K_OFF + (16 * wave + l15) * 272 + g4 * 16;
#pragma unroll
        for (int kt = 0; kt < 9; ++kt) { sc[kt] = (f32x4){0.f, 0.f, 0.f, 0.f};
#pragma unroll
            for (int kb = 0; kb < 4; ++kb) sc[kt] = mfma16(*(const LAS bf16x8*)(kb_ + kt * 4352 + kb * 64), qf[kb], sc[kt]); }
        constexpr float C = 0.08838834764831845f * 1.4426950408889634f;
        float mx = -3.0e38f;
#pragma unroll
        for (int kt = 0; kt < 9; ++kt)
#pragma unroll
            for (int rr = 0; rr < 4; ++rr) { const int dlt = -64 + 16 * kt + 4 * g4 + rr - l15, j = iq + dlt; const bool ok = dlt >= -64 && dlt <= 64 && j >= 0 && j < Lf;
                sc[kt][rr] = ok ? sc[kt][rr] : -3.0e38f; mx = fmaxf(mx, sc[kt][rr]); }
        mx = fmaxf(mx, __shfl_xor(mx, 16)); mx = fmaxf(mx, __shfl_xor(mx, 32));
        float lsum = 0.f; const float mC = mx * C;
#pragma unroll
        for (int kt = 0; kt < 9; ++kt)
#pragma unroll
            for (int rr = 0; rr < 4; ++rr) { const float pv = sc[kt][rr] > -1.0e38f ? __builtin_amdgcn_exp2f(sc[kt][rr] * C - mC) : 0.f; sc[kt][rr] = pv; lsum += pv; }
        lsum += __shfl_xor(lsum, 16); lsum += __shfl_xor(lsum, 32);
        f32x4 o[8];
#pragma unroll
        for (int dt = 0; dt < 8; ++dt) o[dt] = (f32x4){0.f, 0.f, 0.f, 0.f};
        const LAS unsigned char* vb_ = L + VT_OFF + l15 * 528 + (16 * wave + 4 * g4) * 2;
#pragma unroll
        for (int pp = 0; pp < 5; ++pp) { u32x4 bw; bw.x = cvtpk(sc[2 * pp][0], sc[2 * pp][1]); bw.y = cvtpk(sc[2 * pp][2], sc[2 * pp][3]);
            if (pp < 4) { bw.z = cvtpk(sc[2 * pp + 1][0], sc[2 * pp + 1][1]); bw.w = cvtpk(sc[2 * pp + 1][2], sc[2 * pp + 1][3]); } else { bw.z = 0u; bw.w = 0u; }
            const bf16x8 bfrag = *reinterpret_cast<bf16x8*>(&bw);
#pragma unroll
            for (int dt = 0; dt < 8; ++dt) { const u32x2 a0 = *(const LAS u32x2*)(vb_ + dt * 8448 + pp * 64); u32x2 a1 = {0u, 0u}; if (pp < 4) a1 = *(const LAS u32x2*)(vb_ + dt * 8448 + pp * 64 + 32);
                u32x4 aw; aw.x = a0.x; aw.y = a0.y; aw.z = a1.x; aw.w = a1.y; o[dt] = mfma16(*reinterpret_cast<bf16x8*>(&aw), bfrag, o[dt]); } }
        const float inv = 1.0f / lsum;
        const size_t t = (size_t)b * SEQ + (size_t)iq * dil + r;
        bf16* OP = (bf16*)(wsq + WS_OPA) + ((size_t)p * T + t) * 512 + hh * HD + 4 * g4;
#pragma unroll
        for (int dt = 0; dt < 8; ++dt) { u32x2 w; w.x = cvtpk(o[dt][0] * inv, o[dt][1] * inv); w.y = cvtpk(o[dt][2] * inv, o[dt][3] * inv); *(u32x2*)(OP + 16 * dt) = w; }
        if (g4 == 0) ((float*)(wsq + WS_LSE))[((size_t)p * T + t) * 4 + hh] = mx * 0.08838834764831845f + __logf(lsum);
    }
}

__device__ __forceinline__ void phase_ynorm(Frame& F, int l, bool naive_dn) {
    const bf16* PROJ = WSP(bf16, WS_PROJ); float* YMIX = WSP(float, WS_YMIX); bf16* Y = WSP(bf16, WS_Y); const float* DO = WSP(float, WS_DO);
    const float* ga = GIN(7) + (size_t)l * 512; const float* gb = GIN(8) + (size_t)l * 1024; const float* gn = GIN(11) + (size_t)l * HD;
    const int gw = F.vcu * NWAVES + F.wave, NGW = F.G * NWAVES, lane = F.lane;
    for (int t = gw; t < T; t += NGW) {
        if (naive_dn) {
#pragma unroll
            for (int hh = 0; hh < 4; ++hh) { const size_t o = (size_t)t * 512 + hh * HD; const float o0 = DO[o + lane] + DO[(size_t)T * 512 + o + lane], o1 = DO[o + lane + 64] + DO[(size_t)T * 512 + o + lane + 64];
                const float rs = rsqrtf(wave_sum(o0 * o0 + o1 * o1) * (1.0f / HD) + EPS);
                const float z0 = bf2f(PROJ[(size_t)t * DINP + COL_CZ + hh * HD + lane]), z1 = bf2f(PROJ[(size_t)t * DINP + COL_CZ + hh * HD + lane + 64]);
                Y[(size_t)t * DM + 1536 + hh * HD + lane] = (bf16)f2bf(o0 * rs * gn[lane] * siluf_(z0)); Y[(size_t)t * DM + 1536 + hh * HD + lane + 64] = (bf16)f2bf(o1 * rs * gn[lane + 64] * siluf_(z1)); }
        }
        const float* yr = YMIX + (size_t)t * DM; bf16* yo = Y + (size_t)t * DM;
        f32x4 bq[4];
#pragma unroll
        for (int j = 0; j < 4; ++j) bq[j] = *(const f32x4*)(yr + 512 + 256 * j + 4 * lane);
        { f32x4 a0, a1;
          if (NAIVE_ATTN_A) { a0 = *(const f32x4*)(yr + 4 * lane); a1 = *(const f32x4*)(yr + 256 + 4 * lane); }
          else { const bf16* OPA = WSP(bf16, WS_OPA); const float* LSE = WSP(float, WS_LSE); const int h0 = lane >> 5;
              float l0[3], l1[3];
#pragma unroll
              for (int p = 0; p < 3; ++p) { l0[p] = LSE[((size_t)p * T + t) * 4 + h0]; l1[p] = LSE[((size_t)p * T + t) * 4 + 2 + h0]; }
              const float m0 = fmaxf(l0[0], fmaxf(l0[1], l0[2])), m1 = fmaxf(l1[0], fmaxf(l1[1], l1[2]));
              float w0[3], w1[3], s0 = 0.f, s1 = 0.f;
#pragma unroll
              for (int p = 0; p < 3; ++p) { w0[p] = __expf(l0[p] - m0); w1[p] = __expf(l1[p] - m1); s0 += w0[p]; s1 += w1[p]; }
              a0 = (f32x4){0.f, 0.f, 0.f, 0.f}; a1 = a0;
#pragma unroll
              for (int p = 0; p < 3; ++p) { const u32x2 x0 = *(const u32x2*)(OPA + ((size_t)p * T + t) * 512 + 4 * lane), x1 = *(const u32x2*)(OPA + ((size_t)p * T + t) * 512 + 256 + 4 * lane);
                  const f32x4 f0 = {__uint_as_float(x0.x << 16), __uint_as_float(x0.x & 0xffff0000u), __uint_as_float(x0.y << 16), __uint_as_float(x0.y & 0xffff0000u)}, f1 = {__uint_as_float(x1.x << 16), __uint_as_float(x1.x & 0xffff0000u), __uint_as_float(x1.y << 16), __uint_as_float(x1.y & 0xffff0000u)};
                  a0 += f0 * (w0[p] / s0); a1 += f1 * (w1[p] / s1); } }
          const float rs = rsqrtf(wave_sum((a0.x * a0.x + a0.y * a0.y) + (a0.z * a0.z + a0.w * a0.w) + (a1.x * a1.x + a1.y * a1.y) + (a1.z * a1.z + a1.w * a1.w)) * (1.0f / 512) + EPS);
          const f32x4 g0 = *(const f32x4*)(ga + 4 * lane), g1 = *(const f32x4*)(ga + 256 + 4 * lane); a0 = a0 * rs * g0; a1 = a1 * rs * g1;
          u32x2 o; o.x = pk2(a0.x, a0.y); o.y = pk2(a0.z, a0.w); *(u32x2*)(yo + 4 * lane) = o; o.x = pk2(a1.x, a1.y); o.y = pk2(a1.z, a1.w); *(u32x2*)(yo + 256 + 4 * lane) = o; }
        { f32x4 a[4]; float ss = 0.f;
#pragma unroll
          for (int j = 0; j < 4; ++j) { a[j] = bq[j]; ss += (a[j].x * a[j].x + a[j].y * a[j].y) + (a[j].z * a[j].z + a[j].w * a[j].w); }
          const float rs = rsqrtf(wave_sum(ss) * (1.0f / 1024) + EPS);
#pragma unroll
          for (int j = 0; j < 4; ++j) { const f32x4 g = *(const f32x4*)(gb + 256 * j + 4 * lane); a[j] = a[j] * rs * g; u32x2 o; o.x = pk2(a[j].x, a[j].y); o.y = pk2(a[j].z, a[j].w); *(u32x2*)(yo + 512 + 256 * j + 4 * lane) = o; } }
    }
}

__device__ __forceinline__ void phase_select(Frame& F) {
    const float* AFF = WSP(float, WS_AFF); int* SELI = WSP(int, WS_SELI); float* SELG = WSP(float, WS_SELG); int* SLOT = WSP(int, WS_SLOT); float* SELR = WSP(float, WS_SELR); const float* RS2 = WSP(float, WS_RS) + T;
    LAS unsigned* key = (LAS unsigned*)F.lds;
    LAS unsigned* hist = key + 4096;
    LAS unsigned* ctl = hist + 256;
    LAS unsigned* scan = ctl + 8;
    const int tid = F.tid;
    for (int u = F.vcu; u < BATCH * NE; u += F.G) {
        const int b = u / NE, e = u % NE;
        __syncthreads();
        for (int i = tid; i < SEQ; i += NTHR) key[i] = __float_as_uint(AFF[(size_t)(b * NE + e) * SEQ + i]);
        if (tid == 0) { ctl[0] = 0u; ctl[2] = CAP; }
        __syncthreads();
        for (int pass = 3; pass >= 0; --pass) {
            const int shift = pass * 8; const unsigned hmask = pass == 3 ? 0u : ~((1u << (shift + 8)) - 1u);
            if (tid < 256) hist[tid] = 0u;
            __syncthreads();
            const unsigned prefix = ctl[0];
            if (pass == 3) {
                for (int i = tid; i < SEQ; i += NTHR) { const unsigned bin = key[i] >> 24; unsigned long long rem = __ballot(1);
                    while (rem) { const int leader = __builtin_ctzll(rem); const unsigned v = (unsigned)__builtin_amdgcn_readlane((int)bin, leader); const unsigned long long m = __ballot(bin == v) & rem;
                        if ((tid & 63) == leader) __hip_atomic_fetch_add(hist + v, (unsigned)__builtin_popcountll(m), __ATOMIC_RELAXED, __HIP_MEMORY_SCOPE_WORKGROUP);
                        rem &= ~m; } }
            } else
            for (int i = tid; i < SEQ; i += NTHR) { const unsigned k = key[i]; if ((k & hmask) == (prefix & hmask)) __hip_atomic_fetch_add(hist + ((k >> shift) & 255u), 1u, __ATOMIC_RELAXED, __HIP_MEMORY_SCOPE_WORKGROUP); }
            __syncthreads();
            if (tid < 64) {
                const unsigned want = ctl[2]; const unsigned c0 = hist[4 * tid], c1 = hist[4 * tid + 1], c2 = hist[4 * tid + 2], c3 = hist[4 * tid + 3]; const unsigned sl = (c0 + c1) + (c2 + c3);
                unsigned suf = sl;
#pragma unroll
                for (int o = 1; o < 64; o <<= 1) { const unsigned tv = __shfl_down(suf, o); if (tid + o < 64) suf += tv; }
                unsigned cum = suf - sl;
                int bsel = -1; unsigned cb = 0;
                if (cum < want && cum + c3 >= want) { bsel = 3; cb = cum; } cum += c3;
                if (bsel < 0 && cum < want && cum + c2 >= want) { bsel = 2; cb = cum; } cum += c2;
                if (bsel < 0 && cum < want && cum + c1 >= want) { bsel = 1; cb = cum; } cum += c1;
                if (bsel < 0 && cum < want && cum + c0 >= want) { bsel = 0; cb = cum; }
                if (bsel >= 0) { ctl[0] = prefix | ((unsigned)(4 * tid + bsel) << shift); ctl[2] = want - cb; } }
            __syncthreads();
        }
        const unsigned thr = ctl[0], want_eq = ctl[2];
        unsigned cg = 0, ce = 0;
#pragma unroll
        for (int j = 0; j < 8; ++j) { const unsigned k = key[8 * tid + j]; cg += k > thr; ce += k == thr; }
        scan[tid] = cg; scan[512 + tid] = ce;
        __syncthreads();
        if (tid < 64) { unsigned sg = 0, se = 0;
            unsigned lg[8], le[8];
#pragma unroll
            for (int j = 0; j < 8; ++j) { lg[j] = scan[8 * tid + j]; le[j] = scan[512 + 8 * tid + j]; sg += lg[j]; se += le[j]; }
            unsigned pg = sg, pe = se;
#pragma unroll
            for (int o = 1; o < 64; o <<= 1) { const unsigned tg = __shfl_up(pg, o), te = __shfl_up(pe, o); if (tid >= o) { pg += tg; pe += te; } }
            unsigned bg = pg - sg, be = pe - se;
#pragma unroll
            for (int j = 0; j < 8; ++j) { scan[8 * tid + j] = bg; scan[512 + 8 * tid + j] = be; bg += lg[j]; be += le[j]; }
        }
        __syncthreads();
        unsigned pg = scan[tid], pe = scan[512 + tid];
#pragma unroll
        for (int j = 0; j < 8; ++j) { const int i = 8 * tid + j; const unsigned k = key[i]; int slot = -1;
            if (k > thr) { slot = (int)(pg + (pe < want_eq ? pe : want_eq)); pg++; }
            else if (k == thr) { if (pe < want_eq) slot = (int)(pg + pe); pe++; }
            SLOT[(size_t)(b * NE + e) * SEQ + i] = slot;
            if (slot >= 0) { SELI[(size_t)(b * NE + e) * CAP + slot] = i; SELG[(size_t)e * 1024 + b * CAP + slot] = __uint_as_float(k); SELR[(size_t)e * 1024 + b * CAP + slot] = RS2[b * SEQ + i]; } }
    }
}
__device__ __forceinline__ void phase_gather(Frame& F) {
    const int* SELI = WSP(int, WS_SELI); const bf16* HN = WSP(bf16, WS_HN); bf16* XS = WSP(bf16, WS_XS);
    const int gw = F.vcu * NWAVES + F.wave, NGW = F.G * NWAVES, lane = F.lane;
    for (int r = gw; r < NE * 1024; r += NGW) { const int e = r >> 10, q = r & 1023, b = q >> 9, slot = q & 511; const int i = SELI[(size_t)(b * NE + e) * CAP + slot];
        const u32x4* src = (const u32x4*)(HN + (size_t)(b * SEQ + i) * DM); u32x4* dst = (u32x4*)(XS + (size_t)r * DM);
#pragma unroll
        for (int j = 0; j < 4; ++j) dst[lane + 64 * j] = src[lane + 64 * j]; }
}
#define ADD_BF4(V, W) do { (V).x += __uint_as_float((W).x << 16); (V).y += __uint_as_float((W).x & 0xffff0000u); (V).z += __uint_as_float((W).y << 16); (V).w += __uint_as_float((W).y & 0xffff0000u); } while (0)
__device__ __forceinline__ void phase_combine(Frame& F) {
    const bf16* H = WSP(bf16, WS_H); bf16* H1 = WSP(bf16, WS_HN); float* RS3 = WSP(float, WS_RS) + 2 * T; const int* SLOT = WSP(int, WS_SLOT); const bf16* YEXP = WSP(bf16, WS_YEXP);
    const int gw = F.vcu * NWAVES + F.wave, NGW = F.G * NWAVES, lane = F.lane;
    int nslot = -1; u32x2 hw[8];
    if (gw < T) { nslot = lane < NE ? SLOT[(size_t)((gw >> 12) * NE + lane) * SEQ + (gw & (SEQ - 1))] : -1;
#pragma unroll
        for (int j = 0; j < 8; ++j) hw[j] = *(const u32x2*)(H + (size_t)gw * DM + 4 * lane + 256 * j); }
    for (int t = gw; t < T; t += NGW) { const int b = t >> 12;
        const int myslot = nslot; f32x4 v[8];
#pragma unroll
        for (int j = 0; j < 8; ++j) { v[j].x = __uint_as_float(hw[j].x << 16); v[j].y = __uint_as_float(hw[j].x & 0xffff0000u); v[j].z = __uint_as_float(hw[j].y << 16); v[j].w = __uint_as_float(hw[j].y & 0xffff0000u); }
        const int tn = t + NGW;
        if (tn < T) { nslot = lane < NE ? SLOT[(size_t)((tn >> 12) * NE + lane) * SEQ + (tn & (SEQ - 1))] : -1;
#pragma unroll
            for (int j = 0; j < 8; ++j) hw[j] = *(const u32x2*)(H + (size_t)tn * DM + 4 * lane + 256 * j); }
        unsigned long long mask = __ballot(myslot >= 0);
        while (mask) {
            const int e0 = __builtin_ctzll(mask); mask &= mask - 1; const int s0 = __builtin_amdgcn_readlane(myslot, e0);
            const bool h1 = mask != 0; int e1 = e0, s1 = s0; if (h1) { e1 = __builtin_ctzll(mask); mask &= mask - 1; s1 = __builtin_amdgcn_readlane(myslot, e1); }
            const bool h2 = mask != 0; int e2 = e0, s2 = s0; if (h2) { e2 = __builtin_ctzll(mask); mask &= mask - 1; s2 = __builtin_amdgcn_readlane(myslot, e2); }
            const bf16* y0 = YEXP + (size_t)(e0 * 1024 + b * CAP + s0) * DM + 4 * lane; const bf16* y1 = YEXP + (size_t)(e1 * 1024 + b * CAP + s1) * DM + 4 * lane; const bf16* y2 = YEXP + (size_t)(e2 * 1024 + b * CAP + s2) * DM + 4 * lane;
            u32x2 w0[8], w1[8], w2[8];
#pragma unroll
            for (int j = 0; j < 8; ++j) w0[j] = *(const u32x2*)(y0 + 256 * j);
            if (h1) {
#pragma unroll
                for (int j = 0; j < 8; ++j) w1[j] = *(const u32x2*)(y1 + 256 * j); }
            if (h2) {
#pragma unroll
                for (int j = 0; j < 8; ++j) w2[j] = *(const u32x2*)(y2 + 256 * j); }
#pragma unroll
            for (int j = 0; j < 8; ++j) ADD_BF4(v[j], w0[j]);
            if (h1) {
#pragma unroll
                for (int j = 0; j < 8; ++j) ADD_BF4(v[j], w1[j]); }
            if (h2) {
#pragma unroll
                for (int j = 0; j < 8; ++j) ADD_BF4(v[j], w2[j]); }
        }
        float ss = 0.f;
#pragma unroll
        for (int j = 0; j < 8; ++j) { u32x2 w; w.x = pk2(v[j].x, v[j].y); w.y = pk2(v[j].z, v[j].w); *(u32x2*)(H1 + (size_t)t * DM + 4 * lane + 256 * j) = w; ss += (v[j].x * v[j].x + v[j].y * v[j].y) + (v[j].z * v[j].z + v[j].w * v[j].w); }
        const float rs = rsqrtf(wave_sum(ss) * (1.0f / DM) + EPS); if (lane == 0) RS3[t] = rs;
    }
}
#undef ADD_BF4
__device__ __forceinline__ void phase_final(Frame& F, float oscale) {
    const bf16* H = WSP(bf16, WS_H); const float* gain = GIN(21);
    const int gw = F.vcu * NWAVES + F.wave, NGW = F.G * NWAVES, lane = F.lane;
    for (int t = gw; t < T; t += NGW) { const bf16* hr = H + (size_t)t * DM; f32x4 v[8]; float ss = 0.f;
#pragma unroll
        for (int j = 0; j < 8; ++j) { const u32x2 w = *(const u32x2*)(hr + 4 * lane + 256 * j); v[j].x = __uint_as_float(w.x << 16); v[j].y = __uint_as_float(w.x & 0xffff0000u); v[j].z = __uint_as_float(w.y << 16); v[j].w = __uint_as_float(w.y & 0xffff0000u); ss += (v[j].x * v[j].x + v[j].y * v[j].y) + (v[j].z * v[j].z + v[j].w * v[j].w); }
        const float rs = rsqrtf(wave_sum(ss) * (1.0f / DM) + EPS);
#pragma unroll
        for (int j = 0; j < 8; ++j) { const f32x4 g = *(const f32x4*)(gain + 4 * lane + 256 * j); *(f32x4*)(F.out + (size_t)t * DM + 4 * lane + 256 * j) = v[j] * (rs * oscale) * g; } }
}


#ifdef DBG_CHECKSUM
constexpr int CW_SUM = 8192;
constexpr size_t WS_PREV = WS_DQ;
__device__ __forceinline__ void dbg_checksum(Frame& F) {
    struct Buf { size_t off, bytes; };
    const Buf bufs[9] = {{WS_TL, (size_t)T * 16 * 4}, {WS_PROJ, (size_t)T * DINP * 2}, {WS_CM, (size_t)16 * 64 * 16384 * 2}, {WS_CN, (size_t)16 * 64 * 16384 * 2}, {WS_CP, (size_t)16 * 64 * 8192 * 2},
                         {WS_CR, (size_t)16 * 64 * 8192 * 4}, {WS_CS, (size_t)16 * 64 * 16384 * 2}, {WS_Y, (size_t)T * DM * 2}, {WS_H, (size_t)T * DM * 4}};
    const size_t gt = (size_t)F.vcu * NTHR + F.tid, NT = (size_t)F.G * NTHR;
#pragma unroll 1
    for (int k = 0; k < 9; ++k) { const unsigned* p = (const unsigned*)(F.ws + bufs[k].off); unsigned a = 0;
        for (size_t i = gt; i < bufs[k].bytes / 4; i += NT) a += p[i] * (unsigned)(2654435761u + 2u * (unsigned)(i & 1023));
#pragma unroll
        for (int o = 1; o < 64; o <<= 1) a += __shfl_xor(a, o);
        if (F.lane == 0) __hip_atomic_fetch_add((unsigned*)(F.ws + WS_CTL) + CW_SUM + k, a, __ATOMIC_RELAXED, __HIP_MEMORY_SCOPE_AGENT); }
}
__device__ __forceinline__ unsigned dbg_compare(Frame& F) {
    const unsigned* cur = (const unsigned*)(F.ws + WS_CTL) + CW_SUM; const unsigned* prev = (const unsigned*)(F.ws + WS_PREV);
    unsigned code = 0;
    if (__hip_atomic_load(prev, __ATOMIC_RELAXED, __HIP_MEMORY_SCOPE_AGENT) == 0x600DF00Du) {
#pragma unroll 1
        for (int k = 0; k < 9; ++k) if (__hip_atomic_load(prev + 1 + k, __ATOMIC_RELAXED, __HIP_MEMORY_SCOPE_AGENT) != __hip_atomic_load(cur + k, __ATOMIC_RELAXED, __HIP_MEMORY_SCOPE_AGENT)) code |= 1u << k; }
    return code;
}
__device__ __forceinline__ void dbg_store_prev(Frame& F) {
    if (F.vcu == 0 && F.tid == 0) { const unsigned* cur = (const unsigned*)(F.ws + WS_CTL) + CW_SUM; unsigned* prev = (unsigned*)(F.ws + WS_PREV);
        for (int k = 0; k < 9; ++k) __hip_atomic_store(prev + 1 + k, __hip_atomic_load(cur + k, __ATOMIC_RELAXED, __HIP_MEMORY_SCOPE_AGENT), __ATOMIC_RELAXED, __HIP_MEMORY_SCOPE_AGENT);
        __hip_atomic_store(prev, 0x600DF00Du, __ATOMIC_RELAXED, __HIP_MEMORY_SCOPE_AGENT); }
}
#endif

struct EpiStoreBf16 { bf16* C; int ldc; __device__ __forceinline__ void operator()(int m, int n, float v) const { C[(size_t)m * ldc + n] = (bf16)f2bf(v); } };
struct EpiStoreF32 { float* C; int ldc; __device__ __forceinline__ void operator()(int m, int n, float v) const { C[(size_t)m * ldc + n] = v; } };
struct EpiResid { float* H; __device__ __forceinline__ void operator()(int m, int n, float v) const { H[(size_t)m * DM + n] += v; } };
struct EpiDown { bf16* C; const float* gate; __device__ __forceinline__ void operator()(int m, int n, float v) const { C[(size_t)m * DM + n] = (bf16)f2bf(v * gate[m]); } };
struct EpiPle { float* H; const bf16* PL; __device__ __forceinline__ void operator()(int m, int n, float v) const { H[(size_t)m * DM + n] += sigmoidf_(v) * bf2f(PL[(size_t)m * DM + n]); } };

#ifndef NAIVE_GEMM
#define NAIVE_GEMM 0
#endif
constexpr int NPL = 14;
constexpr int NPHASES = 1 + DEPTH * NPL + 1;
struct Args { const float* in[22]; float* out; unsigned char* ws; int ph_lo, ph_hi; };

#ifndef ONLY
#define ONLY -1
#endif
#ifndef MASK
#define MASK 0xFFFF
#endif
#define EN(j) ((ONLY < 0 || ONLY == (j)) && ((MASK >> (j)) & 1))
#ifndef REPMASK
#define REPMASK 0
#endif
#define NREP(b) (((REPMASK >> (b)) & 1) ? 2 : 1)
#define REPEAT(b) for (int rep_ = 0; rep_ < NREP(b); ++rep_, __syncthreads())
#define IN(k) (lo <= (k) && (k) < hi)
#define INL(j) (EN((j) + 1) && IN(pb + (j)) && seam(pb + (j)))
#define LAUNDER() do { GAS unsigned char* w_ = (GAS unsigned char*)args.ws; int t_ = wave0 * 64 + lane_id(); const float* const __attribute__((address_space(4)))* i_ = (const float* const __attribute__((address_space(4)))*)__builtin_amdgcn_kernarg_segment_ptr(); int v_ = vcu0, g_ = (int)gridDim.x; asm volatile("" : "+s"(w_), "+v"(t_), "+s"(i_), "+s"(v_), "+s"(g_)); F.ws = (unsigned char*)w_; F.tid = t_; F.lane = t_ & 63; F.wave = wave0; F.in = i_; F.vcu = v_; F.G = g_; } while (0)
#define seam(k) (((k) > lo) ? (bar_sync(bar, (unsigned*)(args.ws + WS_CTL) + CW_BAR), true) : true)

template <int l>
__device__ __forceinline__ void layer_phases(Frame& F, const Args& args, XcdBarrier& bar, const int lo, const int hi, const int vcu0, unsigned char* lds_raw, const int wave0) {
        const int pb = 1 + l * NPL;
#define wl (F.ws + WS_W + (size_t)l * SZ_LAYERW)
        if (INL(0)) REPEAT(1) { LAUNDER(); phase_norm<1>(F, WSP(float, WS_WTL) + (size_t)(2 * l) * 16 * DM, WSP(float, WS_TL), WSP(float, WS_RS)); }
        if (INL(1)) REPEAT(2) { LAUNDER();
#if NAIVE_GEMM
            EpiStoreBf16 E{WSP(bf16, WS_PROJ), DINP}; naive_gemm(F, WSP(bf16, WS_HN), DM, (const bf16*)(wl + OFF_WIN), DM, T, DINP, DM, E);
#else
            { pg8::Gemm g{WSP(bf16, WS_H), (const bf16*)(wl + OFF_WIN), T, DINP, DM}; pg8::StaticOrder S; S.init(T, DINP, F.G, (int)blockIdx.x); pg8::EpiBf16Rs E{WSP(bf16, WS_PROJ), DINP, WSP(float, WS_RS)};
              pg8::gemm_phase<pg8::EpiBf16Rs, pg8::StaticOrder>(F.lds, g, S, E, nullptr, F.wave); }
#endif
        }
        if (INL(2)) { REPEAT(3) { LAUNDER(); if (NAIVE_DN) phase_dn_prep_naive(F, l); else phase_dn_chunk(F, l); } __syncthreads(); LAUNDER(); phase_post(F, l); }
        if (INL(3)) { REPEAT(4) { LAUNDER(); phase_mix_naive(F, (unsigned*)(F.ws + WS_CTL) + CW_SCAN + 64 * l); } if (!NAIVE_ATTN_A) REPEAT(5) { __syncthreads(); LAUNDER(); phase_attn_a(F); } if (!NAIVE_ATTN_B) REPEAT(6) { __syncthreads(); LAUNDER(); phase_attn_b(F, (char*)lds_raw); }
            if (!NAIVE_DN && F.G == 256 && blockIdx.x >= 32) { __syncthreads(); LAUNDER();
                unsigned* cnt = (unsigned*)(F.ws + WS_CTL) + CW_SCAN + 64 * l;
                if (F.tid == 0) { while (xb_ld(cnt) < 32u) __builtin_amdgcn_s_sleep(1); __builtin_amdgcn_fence(__ATOMIC_ACQUIRE, "agent"); asm volatile("s_waitcnt vmcnt(0)" ::: "memory"); }
                __syncthreads();
                const int n = (int)blockIdx.x - 32, first = n >= 96 ? n - 96 : 384 + n, step = n >= 96 ? 128 : 96, end = n >= 96 ? 384 : 512;
                phase_dn_out(F, l, first, step, end); } }
        if (INL(4)) { LAUNDER(); if (!NAIVE_DN && F.G != 256) { phase_dn_out(F, l, F.vcu, F.G, 512); __syncthreads(); LAUNDER(); } REPEAT(8) phase_ynorm(F, l, NAIVE_DN != 0); }
        if (INL(5)) { LAUNDER();
#if NAIVE_GEMM
            EpiResid E{WSP(float, WS_H)}; naive_gemm(F, WSP(bf16, WS_Y), DM, (const bf16*)(wl + OFF_WOUT), DM, T, DM, DM, E);
#else
            pg8::Gemm g{WSP(bf16, WS_Y), (const bf16*)(wl + OFF_WOUT), T, DM, DM}; pg8::StaticOrder S; S.init(T, DM, F.G, (int)blockIdx.x); pg8::EpiResidBf16 E{WSP(bf16, WS_H), DM};
            pg8::gemm_phase<pg8::EpiResidBf16, pg8::StaticOrder>(F.lds, g, S, E, nullptr, F.wave);
#endif
        }
        if (INL(6)) REPEAT(9) { LAUNDER(); phase_norm<2>(F, WSP(float, WS_WTL) + (size_t)(2 * l + 1) * 16 * DM, WSP(float, WS_AFF), WSP(float, WS_RS) + T); }
        if (INL(7)) REPEAT(10) { LAUNDER(); phase_select(F);
#if !NAIVE_GEMM
            if (F.G == 256 && F.vcu >= 32) { pg8::Gemm g{WSP(bf16, WS_PB) + (size_t)l * T * PLE, (const bf16*)(wl + OFF_WP), T, DM, PLE}; pg8::ShadowOrder S{F.vcu - 32}; pg8::EpiBf16 E{WSP(bf16, WS_PL), DM};
              pg8::gemm_phase<pg8::EpiBf16, pg8::ShadowOrder>(F.lds, g, S, E, nullptr, F.wave); }
#endif
        }
        if (NAIVE_GEMM && INL(8)) REPEAT(11) { LAUNDER(); phase_gather(F); }
        if (INL(9)) REPEAT(12) { LAUNDER();
#if NAIVE_GEMM
            for (int e = 0; e < NE; ++e) { EpiStoreF32 E{WSP(float, WS_TMP) + (size_t)e * 1024 * 2048, 2048};
                naive_gemm(F, WSP(bf16, WS_XS) + (size_t)e * 1024 * DM, DM, (const bf16*)(wl + OFF_WGU) + (size_t)e * 2048 * DM, DM, 1024, 2048, DM, E); }
            { EpiStoreBf16 E{WSP(bf16, WS_PL), DM}; naive_gemm(F, WSP(bf16, WS_PB) + (size_t)l * T * PLE, PLE, (const bf16*)(wl + OFF_WP), PLE, T, DM, PLE, E); }
#else
            { pg8::Gemm g{WSP(bf16, WS_H), (const bf16*)(wl + OFF_WGU), NE * 1024, NE * 2048, DM}; pg8::GroupedGatherOrder S{F.G, F.vcu, WSP(int, WS_SELI)}; pg8::EpiGateUp E{WSP(bf16, WS_HID), WSP(float, WS_SELR)};
              pg8::gemm_phase<pg8::EpiGateUp, pg8::GroupedGatherOrder>(F.lds, g, S, E, nullptr, F.wave); }
#endif
        }
#if !NAIVE_GEMM
        if (F.G != 256 && INL(10)) REPEAT(13) { LAUNDER(); pg8::Gemm g{WSP(bf16, WS_PB) + (size_t)l * T * PLE, (const bf16*)(wl + OFF_WP), T, DM, PLE}; pg8::StaticOrder S; S.init(T, DM, F.G, (int)blockIdx.x); pg8::EpiBf16 E{WSP(bf16, WS_PL), DM};
              pg8::gemm_phase<pg8::EpiBf16, pg8::StaticOrder>(F.lds, g, S, E, nullptr, F.wave); }
#endif
        if (NAIVE_GEMM && INL(10)) {
            const float* TMP = WSP(float, WS_TMP); bf16* HID = WSP(bf16, WS_HID);
            for (size_t i = (size_t)F.vcu * NTHR + F.tid; i < (size_t)NE * 1024 * EFF; i += (size_t)F.G * NTHR) { const size_t r = i >> 10; const int f = (int)(i & 1023);
                const float gt = TMP[r * 2048 + (f >> 7) * 256 + (f & 127)], up = TMP[r * 2048 + (f >> 7) * 256 + 128 + (f & 127)]; HID[i] = (bf16)f2bf(siluf_(gt) * up); }
        }
        if (INL(11)) REPEAT(14) { LAUNDER();
#if NAIVE_GEMM
            for (int e = 0; e < NE; ++e) { EpiDown E{WSP(bf16, WS_YEXP) + (size_t)e * 1024 * DM, WSP(float, WS_SELG) + (size_t)e * 1024};
                naive_gemm(F, WSP(bf16, WS_HID) + (size_t)e * 1024 * EFF, EFF, (const bf16*)(wl + OFF_WD) + (size_t)e * 2048 * EFF, EFF, 1024, DM, EFF, E); }
#else
            pg8::Gemm g{WSP(bf16, WS_HID), (const bf16*)(wl + OFF_WD), NE * 1024, NE * 2048, EFF}; pg8::GroupedOrder S{F.G, F.vcu}; pg8::EpiDownBf16 E{WSP(bf16, WS_YEXP), WSP(float, WS_SELG)};
            pg8::gemm_phase<pg8::EpiDownBf16, pg8::GroupedOrder>(F.lds, g, S, E, nullptr, F.wave);
#endif
        }
        if (INL(12)) { LAUNDER(); phase_combine(F); }
        if (INL(13)) { LAUNDER();
#if NAIVE_GEMM
            EpiPle E{WSP(float, WS_H), WSP(bf16, WS_PL)}; naive_gemm(F, WSP(bf16, WS_HN), DM, (const bf16*)(wl + OFF_WPG), DM, T, DM, DM, E);
#else
            pg8::Gemm g{WSP(bf16, WS_HN), (const bf16*)(wl + OFF_WPG), T, DM, DM}; pg8::StaticOrder S; S.init(T, DM, F.G, (int)blockIdx.x); pg8::EpiPleBf16 E{WSP(bf16, WS_HN), WSP(bf16, WS_H), WSP(bf16, WS_PL), WSP(float, WS_RS) + 2 * T};
            pg8::gemm_phase<pg8::EpiPleBf16, pg8::StaticOrder>(F.lds, g, S, E, nullptr, F.wave);
#endif
        }
}

__global__ void __launch_bounds__(NTHR, 2) mk_fwd(Args args) {
    extern __shared__ __attribute__((aligned(16))) unsigned char lds_raw[];
    Frame F;
    F.lds = (LAS unsigned char*)lds_raw;
    const int wave0 = __builtin_amdgcn_readfirstlane((int)threadIdx.x >> 6);
    F.wave = wave0; F.tid = wave0 * 64 + lane_id(); F.lane = F.tid & 63;
    F.G = gridDim.x; { const int bx = blockIdx.x; F.vcu = (F.G % 8 == 0) ? (bx % 8) * (F.G / 8) + bx / 8 : bx; }
    const int vcu0 = F.vcu;
    F.in = (const float* const __attribute__((address_space(4)))*)__builtin_amdgcn_kernarg_segment_ptr(); F.out = args.out; F.ws = args.ws;
    const int lo = args.ph_lo, hi = args.ph_hi;
    volatile LAS unsigned* misc = (volatile LAS unsigned*)(F.lds + LDS_MISC);
#ifdef CHECK_NAN_FILL
    for (int i = F.tid; i < LDS_MISC / 4; i += NTHR) ((LAS unsigned*)F.lds)[i] = 0xffffffffu;
    __syncthreads();
#endif
    if (F.tid < 4) misc[F.tid] = 0u;
    __syncthreads();
    XcdBarrier bar; bar.bar = (unsigned*)(args.ws + WS_CTL) + CW_BAR; bar.x = 0; bar.st = misc; bar.w0 = wave0;
    if (hi - lo > 1) bar = xcd_barrier_post((unsigned*)(args.ws + WS_CTL) + CW_BAR, misc, wave0);
    if (EN(0) && IN(0)) REPEAT(0) phase_prologue(F);
    layer_phases<0>(F, args, bar, lo, hi, vcu0, lds_raw, wave0);
    layer_phases<1>(F, args, bar, lo, hi, vcu0, lds_raw, wave0);
    layer_phases<2>(F, args, bar, lo, hi, vcu0, lds_raw, wave0);
    layer_phases<3>(F, args, bar, lo, hi, vcu0, lds_raw, wave0);
#ifdef DBG_CHECKSUM
    if (IN(NPHASES - 1)) { xcd_barrier(bar); LAUNDER(); dbg_checksum(F); xcd_barrier(bar); const unsigned code = dbg_compare(F); xcd_barrier(bar); dbg_store_prev(F); phase_final(F, 1.0f + (float)code); }
#else
    if (EN(15) && IN(NPHASES - 1) && seam(NPHASES - 1)) phase_final(F, 1.0f);
#endif
#undef IN
#undef INL
#undef seam
#undef wl
}

extern "C" void kernel_launch(void* const* d_in, const int* in_sizes, int n_in, void* d_out, int out_size, void* d_ws, size_t ws_size, hipStream_t stream) {
    static int grid = 0;
    if (grid == 0) {
        if (n_in != 22 || out_size != T * DM || ws_size < WS_END) { fprintf(stderr, "kernel_launch: unexpected shapes (n_in %d out %d ws %zu need %zu)\n", n_in, out_size, ws_size, (size_t)WS_END); grid = -1; return; }
        int dev = 0, cus = 0;
        if (hipGetDevice(&dev) != hipSuccess || hipDeviceGetAttribute(&cus, hipDeviceAttributeMultiprocessorCount, dev) != hipSuccess) { grid = -1; return; }
        if (hipFuncSetAttribute((const void*)mk_fwd, hipFuncAttributeMaxDynamicSharedMemorySize, LDS_BYTES) != hipSuccess) { fprintf(stderr, "kernel_launch: hipFuncSetAttribute failed\n"); grid = -1; return; }
        grid = cus;
    }
    if (grid < 0) return;
    Args a{};
    for (int i = 0; i < 22; ++i) a.in[i] = (const float*)d_in[i];
    a.out = (float*)d_out; a.ws = (unsigned char*)d_ws;
    if (hipMemsetAsync((char*)d_ws + WS_CTL, 0, CTL_BYTES, stream) != hipSuccess) { fprintf(stderr, "kernel_launch: memset failed\n"); return; }
#if N_LAUNCH_PER_PHASE
    for (int ph = 0; ph < NPHASES; ++ph) {
        a.ph_lo = ph; a.ph_hi = ph + 1;
        hipLaunchKernelGGL(mk_fwd, dim3(grid), dim3(NTHR), LDS_BYTES, stream, a);
    }
#else
    a.ph_lo = 0; a.ph_hi = NPHASES;
    hipLaunchKernelGGL(mk_fwd, dim3(grid), dim3(NTHR), LDS_BYTES, stream, a);
#endif
}
```
